# Optimizing an MI355X kernel written in HIP

```python
import math
import jax, jax.numpy as jnp
from jax import lax
import numpy as np

D_MODEL = 1024
BATCH = 16
SEQ = 4096
DEPTH = 2

CHUNK = 64
N_MIXERS = 2
DA_HEADS = 8
DA_HEAD_DIM = 64
DA_V_DIM = 2 * DA_HEAD_DIM
DA_PROJ = 3 * DA_HEADS * 2 * DA_HEAD_DIM
Q_BLOCK = 128
GLA_HEADS = 4
GLA_KEY_WIDTH = D_MODEL // 2
GLA_VAL_WIDTH = D_MODEL
GLA_DK = GLA_KEY_WIDTH // GLA_HEADS
GLA_DV = GLA_VAL_WIDTH // GLA_HEADS
GLA_PROJ = 2 * GLA_KEY_WIDTH + 2 * GLA_VAL_WIDTH
GLA_GATE_RANK = 16
GLA_TAU = 16.0
FFN_DIM = 2816
N_EXPERTS = 8
TOP_K = 2
EXPERT_DIM = 3584
EXPERT_BLOCK = 256
NORM_EPS = 1e-6

kernel_name = "hybrid_diffattn_gla_moe_adaln_encoder"


def rms_norm(x, g):
    xf = x.astype(jnp.float32)
    y = xf * lax.rsqrt(jnp.mean(xf * xf, axis=-1, keepdims=True) + NORM_EPS)
    return (y * g.astype(jnp.float32)).astype(x.dtype)


def alibi_slopes(n_heads):
    return 2.0 ** (-8.0 * jnp.arange(1, n_heads + 1, dtype=jnp.float32) / n_heads)


def swiglu(x, w1, w3, w2):
    return (jax.nn.silu(x @ w1) * (x @ w3)) @ w2


def diff_attention(h, w_in, q_gain, k_gain, lam_q1, lam_k1, lam_q2, lam_k2, subln_g, w_out, lambda_init):
    B, S, _ = h.shape
    H, Dh = DA_HEADS, DA_HEAD_DIM
    q, k, v = jnp.split(h @ w_in, 3, axis=-1)
    q = rms_norm(q.reshape(B, S, H, 2, Dh), q_gain)
    k = rms_norm(k.reshape(B, S, H, 2, Dh), k_gain)
    v = v.reshape(B, S, H, DA_V_DIM)
    f32 = jnp.float32
    lam = (jnp.exp(jnp.sum(lam_q1.astype(f32) * lam_k1.astype(f32)))
           - jnp.exp(jnp.sum(lam_q2.astype(f32) * lam_k2.astype(f32))) + lambda_init)
    slopes = alibi_slopes(H)
    key_pos = jnp.arange(S, dtype=jnp.int32)
    n_qb = S // Q_BLOCK
    q_blocks = jnp.moveaxis(q.reshape(B, n_qb, Q_BLOCK, H, 2, Dh), 1, 0)
    scale = Dh ** -0.5

    def attend_block(args):
        q_blk, start = args
        q_pos = start + jnp.arange(Q_BLOCK, dtype=jnp.int32)
        visible = (key_pos // CHUNK)[None, :] <= (q_pos // CHUNK)[:, None]
        dist = jnp.abs(q_pos[:, None] - key_pos[None, :]).astype(f32)
        bias = -slopes[:, None, None] * dist
        scores = jnp.einsum('bqhmd,bshmd->bhmqs', q_blk, k).astype(f32) * scale + bias[None, :, None]
        scores = jnp.where(visible, scores, -jnp.inf)
        p = jax.nn.softmax(scores, axis=-1)
        p_diff = (p[:, :, 0] - lam * p[:, :, 1]).astype(v.dtype)
        return jnp.einsum('bhqs,bshe->bqhe', p_diff, v)

    starts = jnp.arange(n_qb, dtype=jnp.int32) * Q_BLOCK
    o = lax.map(attend_block, (q_blocks, starts))
    o = jnp.moveaxis(o, 0, 1).reshape(B, S, H, DA_V_DIM)
    o = rms_norm(o, subln_g) * (1.0 - lambda_init)
    return o.reshape(B, S, H * DA_V_DIM) @ w_out


def gla_mixer(h, w_in, w_a1, w_a2, b_a, out_g, w_out):
    B, S, _ = h.shape
    H, dk, dv = GLA_HEADS, GLA_DK, GLA_DV
    n = S // CHUNK
    f32 = jnp.float32
    q, k, v, r = jnp.split(h @ w_in, [GLA_KEY_WIDTH, 2 * GLA_KEY_WIDTH, 2 * GLA_KEY_WIDTH + GLA_VAL_WIDTH], axis=-1)
    log_a = jax.nn.log_sigmoid(((h @ w_a1) @ w_a2 + b_a).astype(f32)) / GLA_TAU

    def chunked(t, d):
        return t.astype(f32).reshape(B, n, CHUNK, H, d)

    q = chunked(q, dk) * dk ** -0.5
    k = chunked(k, dk)
    v = chunked(v, dv)
    b = jnp.cumsum(chunked(log_a, dk), axis=2)
    b_last = b[:, :, -1]
    q_dec = q * jnp.exp(b)
    k_inv = k * jnp.exp(-b)
    k_dec = k * jnp.exp(b_last[:, :, None] - b)
    causal = jnp.tril(jnp.ones((CHUNK, CHUNK), dtype=bool))
    attn = jnp.where(causal, jnp.einsum('bnthk,bnshk->bnhts', q_dec, k_inv), 0.0)
    o_intra = jnp.einsum('bnhts,bnshv->bnthv', attn, v)

    def step(state, xs):
        q_c, k_c, v_c, decay = xs
        o_c = jnp.einsum('bthk,bhkv->bthv', q_c, state)
        state = decay[..., None] * state + jnp.einsum('bshk,bshv->bhkv', k_c, v_c)
        return state, o_c

    xs = (jnp.moveaxis(q_dec, 1, 0), jnp.moveaxis(k_dec, 1, 0), jnp.moveaxis(v, 1, 0),
          jnp.moveaxis(jnp.exp(b_last), 1, 0))
    _, o_inter = lax.scan(step, jnp.zeros((B, H, dk, dv), f32), xs)
    o = o_intra + jnp.moveaxis(o_inter, 0, 1)
    o = rms_norm(o.reshape(B, S, H, dv), out_g).astype(h.dtype)
    o = o * jax.nn.silu(r).reshape(B, S, H, dv)
    return o.reshape(B, S, GLA_VAL_WIDTH) @ w_out


def moe_swiglu(h, router_w, w1, w3, w2):
    B, S, D = h.shape
    N = B * S
    A = N * TOP_K
    xf = h.reshape(N, D)
    logits = (xf @ router_w).astype(jnp.float32)
    top_val, top_idx = lax.top_k(logits, TOP_K)
    gates = jax.nn.softmax(top_val, axis=-1)
    e_flat = top_idx.reshape(A).astype(jnp.int32)
    tok_flat = jnp.repeat(jnp.arange(N, dtype=jnp.int32), TOP_K)
    g_flat = gates.reshape(A)
    e_s, tok_s, g_s = lax.sort((e_flat, tok_flat, g_flat), num_keys=1)
    counts = jax.ops.segment_sum(jnp.ones((A,), jnp.int32), e_flat, num_segments=N_EXPERTS)
    padded = (counts + EXPERT_BLOCK - 1) // EXPERT_BLOCK * EXPERT_BLOCK
    pend = jnp.cumsum(padded)
    pstart = pend - padded
    ustart = jnp.cumsum(counts) - counts
    dest = pstart[e_s] + (jnp.arange(A, dtype=jnp.int32) - ustart[e_s])
    P = A + N_EXPERTS * EXPERT_BLOCK
    buf_tok = jnp.full((P,), N, jnp.int32).at[dest].set(tok_s)
    buf_g = jnp.zeros((P,), jnp.float32).at[dest].set(g_s)
    n_blocks = P // EXPERT_BLOCK
    block_starts = jnp.arange(n_blocks, dtype=jnp.int32) * EXPERT_BLOCK
    block_exp = jnp.clip(jnp.searchsorted(pend, block_starts, side='right'), 0, N_EXPERTS - 1)
    x_pad = jnp.concatenate([xf, jnp.zeros((1, D), xf.dtype)], axis=0)

    def expert_block(args):
        tok_b, e = args
        return swiglu(x_pad[tok_b], w1[e], w3[e], w2[e])

    y = lax.map(expert_block, (buf_tok.reshape(n_blocks, EXPERT_BLOCK), block_exp))
    y = y.reshape(P, D) * buf_g[:, None].astype(y.dtype)
    out = jax.ops.segment_sum(y, buf_tok, num_segments=N + 1)[:N]
    return out.reshape(B, S, D)


def setup_inputs(seed: int = 0) -> dict:
    key = jax.random.key(seed)
    ks = iter(jax.random.split(key, 40))
    n_a = (DEPTH + 1) // 2
    n_b = DEPTH // 2
    D = D_MODEL

    def nrm(shape, scale):
        return jax.random.normal(next(ks), shape, jnp.float32) * scale

    def gain(shape):
        return 1.0 + nrm(shape, 0.05)

    return {
        "x": nrm((BATCH, SEQ, D), 1.0),
        "c": nrm((BATCH, D), 1.0),
        "ada_w": nrm((DEPTH, D, 6 * D), D ** -0.5),
        "ada_b": nrm((DEPTH, 6 * D), 0.02),
        "norm1_g": gain((DEPTH, D)),
        "norm2_g": gain((DEPTH, D)),
        "da_w_in": nrm((n_a, D, DA_PROJ), D ** -0.5),
        "da_q_gain": gain((n_a, 2, DA_HEAD_DIM)),
        "da_k_gain": gain((n_a, 2, DA_HEAD_DIM)),
        "da_lam_q1": nrm((n_a, DA_HEAD_DIM), 0.1),
        "da_lam_k1": nrm((n_a, DA_HEAD_DIM), 0.1),
        "da_lam_q2": nrm((n_a, DA_HEAD_DIM), 0.1),
        "da_lam_k2": nrm((n_a, DA_HEAD_DIM), 0.1),
        "da_subln_g": gain((n_a, DA_V_DIM)),
        "da_w_out": nrm((n_a, DA_HEADS * DA_V_DIM, D), (DA_HEADS * DA_V_DIM) ** -0.5),
        "gla_w_in": nrm((n_b, D, GLA_PROJ), D ** -0.5),
        "gla_w_a1": nrm((n_b, D, GLA_GATE_RANK), D ** -0.5),
        "gla_w_a2": nrm((n_b, GLA_GATE_RANK, GLA_KEY_WIDTH), GLA_GATE_RANK ** -0.5),
        "gla_b_a": nrm((n_b, GLA_KEY_WIDTH), 0.1),
        "gla_out_g": gain((n_b, GLA_DV)),
        "gla_w_out": nrm((n_b, GLA_VAL_WIDTH, D), GLA_VAL_WIDTH ** -0.5),
        "ffn_w1": nrm((n_a, D, FFN_DIM), D ** -0.5),
        "ffn_w3": nrm((n_a, D, FFN_DIM), D ** -0.5),
        "ffn_w2": nrm((n_a, FFN_DIM, D), FFN_DIM ** -0.5),
        "moe_router": nrm((n_b, D, N_EXPERTS), D ** -0.5),
        "moe_w1": nrm((n_b, N_EXPERTS, D, EXPERT_DIM), D ** -0.5),
        "moe_w3": nrm((n_b, N_EXPERTS, D, EXPERT_DIM), D ** -0.5),
        "moe_w2": nrm((n_b, N_EXPERTS, EXPERT_DIM, D), EXPERT_DIM ** -0.5),
    }


def reference(x, c, ada_w, ada_b, norm1_g, norm2_g,
              da_w_in, da_q_gain, da_k_gain, da_lam_q1, da_lam_k1, da_lam_q2, da_lam_k2, da_subln_g, da_w_out,
              gla_w_in, gla_w_a1, gla_w_a2, gla_b_a, gla_out_g, gla_w_out,
              ffn_w1, ffn_w3, ffn_w2,
              moe_router, moe_w1, moe_w3, moe_w2):
    c_act = jax.nn.silu(c)
    for i in range(DEPTH):
        j = i // N_MIXERS
        mod = c_act @ ada_w[i] + ada_b[i]
        shift1, scale1, gate1, shift2, scale2, gate2 = jnp.split(mod[:, None, :], 6, axis=-1)
        h = rms_norm(x, norm1_g[i]) * (1.0 + scale1) + shift1
        if i % N_MIXERS == 0:
            lambda_init = 0.8 - 0.6 * math.exp(-0.3 * i)
            y = diff_attention(h, da_w_in[j], da_q_gain[j], da_k_gain[j], da_lam_q1[j], da_lam_k1[j],
                               da_lam_q2[j], da_lam_k2[j], da_subln_g[j], da_w_out[j], lambda_init)
        else:
            y = gla_mixer(h, gla_w_in[j], gla_w_a1[j], gla_w_a2[j], gla_b_a[j], gla_out_g[j], gla_w_out[j])
        x = x + gate1 * y
        h = rms_norm(x, norm2_g[i]) * (1.0 + scale2) + shift2
        if i % 2 == 0:
            y = swiglu(h, ffn_w1[j], ffn_w3[j], ffn_w2[j])
        else:
            y = moe_swiglu(h, moe_router[j], moe_w1[j], moe_w3[j], moe_w2[j])
        x = x + gate2 * y
    return x
```

```cpp
#include <hip/hip_runtime.h>
#include <cstdio>
#include <cstdint>

#ifndef PROBE_DUP
#define PROBE_DUP -1
#endif
#ifndef MK_N_LAUNCHES
#define MK_N_LAUNCHES 1
#endif

#define LAS __attribute__((address_space(3)))
#define GAS __attribute__((address_space(1)))
typedef unsigned short bf16;
typedef short bf16x8 __attribute__((ext_vector_type(8)));
typedef short s16x4 __attribute__((ext_vector_type(4)));
typedef float f32x4 __attribute__((ext_vector_type(4)));
typedef float f32x2 __attribute__((ext_vector_type(2)));
typedef float f32x16 __attribute__((ext_vector_type(16)));
typedef unsigned u32x4 __attribute__((ext_vector_type(4)));
typedef unsigned u32x2 __attribute__((ext_vector_type(2)));

constexpr int D = 1024, BATCH = 16, SEQ = 4096, M = BATCH * SEQ;
constexpr int FFN = 2816, NEXP = 8, EXPD = 3584;
constexpr int GLA_N = 3584;
constexpr float EPS = 1e-6f;
constexpr float LOG2E = 1.4426950408889634f;
constexpr int NWAVES = 8;
constexpr int MAXSLOT = M + NEXP * 256;

constexpr size_t MiB = 1u << 20;
constexpr size_t WS_CTL = 0, CTL_ZERO_BYTES = 64 * 1024;
constexpr size_t WS_MOD = 256 * 1024;
constexpr size_t WS_LCNT = 1 * MiB + 256 * 1024;
constexpr size_t WS_META = 1 * MiB + 512 * 1024;
constexpr size_t WS_ROUTE = 2 * MiB;
constexpr size_t WS_TOKSLOT = 4 * MiB;
constexpr size_t WS_GSLOT = 5 * MiB;
constexpr size_t WS_W_DAIN = 8 * MiB, WS_W_DAOUT = 14 * MiB, WS_W_FFN13 = 16 * MiB, WS_W_FFN2 = 27 * MiB;
constexpr size_t WS_W_GLAIN = 33 * MiB, WS_W_GLAOUT = 40 * MiB, WS_W_MOE13 = 42 * MiB, WS_W_MOE2 = 154 * MiB;
constexpr size_t WS_H = 210 * MiB;
constexpr size_t WS_Q = 338 * MiB;
constexpr size_t WS_END = WS_Q + 464 * MiB;
constexpr size_t WS_XB = WS_END;
constexpr size_t WS_TOTAL = WS_XB + (size_t)M * D * 2;
constexpr size_t GA_UNIT = 43008;
static_assert(4096 * GA_UNIT <= (size_t)M * D * 4, "the GLA per-chunk operands are parked in d_out (free until the last phase writes the result)");
static_assert(WS_TOKSLOT + 2 * MAXSLOT * 4 <= WS_GSLOT && WS_GSLOT + 2 * MAXSLOT * 4 <= WS_W_DAIN, "ws map");
static_assert(WS_W_FFN2 + (size_t)D * FFN * 2 <= WS_W_GLAIN && WS_W_GLAIN + (size_t)GLA_N * D * 2 <= WS_W_GLAOUT, "ws map");
static_assert(WS_W_MOE13 + (size_t)NEXP * 2 * EXPD * D * 2 <= WS_W_MOE2 && WS_W_MOE2 + (size_t)NEXP * D * EXPD * 2 <= WS_H, "ws map");
static_assert((size_t)MAXSLOT * EXPD * 2 <= 464 * MiB && (size_t)M * 3072 * 2 + (size_t)M * 512 * 2 <= 464 * MiB, "ws map");
constexpr int CW_BAR = 4096, CW_KCNT = 8192;

constexpr int RING_BYTES = 131072;
constexpr int TAB_OFF = RING_BYTES;
constexpr int MISC_OFF = 155648;
constexpr int LDS_BYTES = MISC_OFF + 1024;

__device__ __forceinline__ unsigned f2bf(float f) { unsigned u = __builtin_bit_cast(unsigned, f); return (u + 0x7fffu + ((u >> 16) & 1u)) >> 16; }
__device__ __forceinline__ unsigned pk2(float lo, float hi) { return f2bf(lo) | (f2bf(hi) << 16); }
__device__ __forceinline__ float bf2f(unsigned short b) { return __builtin_bit_cast(float, ((unsigned)b) << 16); }
__device__ __forceinline__ unsigned cvt_pk_bf16(float lo, float hi) { unsigned r; asm volatile("v_cvt_pk_bf16_f32 %0, %1, %2" : "=v"(r) : "v"(lo), "v"(hi)); return r; }
__device__ __forceinline__ float wave_sum(float v) {
#pragma unroll
    for (int o = 1; o < 64; o <<= 1) v += __shfl_xor(v, o);
    return v;
}
__device__ __forceinline__ float wave_max(float v) {
#pragma unroll
    for (int o = 1; o < 64; o <<= 1) v = fmaxf(v, __shfl_xor(v, o));
    return v;
}
typedef int v8i __attribute__((ext_vector_type(8)));
typedef int v4i __attribute__((ext_vector_type(4)));
constexpr bool FFN_UP8 = false, FFN_DN8 = true, MOE_UP8 = true, MOE_DN8 = true;
constexpr float W8_SCALE = 64.0f, H8_SCALE = 8.0f, A8_SCALE = 4.0f;
__device__ __forceinline__ float clamp448(float x) { return fminf(fmaxf(x, -448.0f), 448.0f); }
__device__ __forceinline__ unsigned pk_fp8x4(float a, float b, float c, float d) {
    unsigned w = 0u; w = __builtin_amdgcn_cvt_pk_fp8_f32(clamp448(a), clamp448(b), w, false); w = __builtin_amdgcn_cvt_pk_fp8_f32(clamp448(c), clamp448(d), w, true); return w; }
__device__ __forceinline__ f32x4 ld_bf16x4(const bf16* p) { const u32x2 w = *(const u32x2*)p; return (f32x4){__builtin_bit_cast(float, w[0] << 16), __builtin_bit_cast(float, w[0] & 0xffff0000u), __builtin_bit_cast(float, w[1] << 16), __builtin_bit_cast(float, w[1] & 0xffff0000u)}; }
__device__ __forceinline__ void st_bf16x4(bf16* p, f32x4 v) { *(u32x2*)p = (u32x2){cvt_pk_bf16(v[0], v[1]), cvt_pk_bf16(v[2], v[3])}; }
__device__ __forceinline__ float fast_silu(float a) { return a * __builtin_amdgcn_rcpf(1.0f + __builtin_amdgcn_exp2f(-a * LOG2E)); }

namespace pg8 {
constexpr int BM = 256, BK = 64, HALF = 128, HTB = HALF * BK * 2, STAGE_BYTES = 8 * HTB, NXCD = 8, WGM = 8;
__host__ __device__ __forceinline__ int lds_byte(int r, int c) { const int st = (r >> 4) * 2 + (c >> 5), rr = r & 15, cc = c & 31, ob = rr * 64 + cc * 2; return st * 1024 + (ob ^ (((ob >> 9) & 1) << 5)); }
__host__ __device__ __forceinline__ void stage_rc(int b, int& R, int& C) { const int st = b / 1024, sb = b % 1024, swz = sb ^ (((sb >> 9) & 1) << 5); R = (st >> 1) * 16 + swz / 64; C = (st & 1) * 32 + (swz % 64) / 2; }
__host__ __device__ __forceinline__ int perm32(int rho) { const int n = rho >> 4, i = rho & 15; return 8 * (i >> 2) + 4 * n + (i & 3); }

struct Unit { int pm, pn, k0, nk, part; };
struct TileOrder {
    int nM, nN, nwg, G, c;
    __device__ void init(int nM_, int nN_, int G_, int c_) { nM = nM_; nN = nN_; nwg = nM * nN; G = G_; c = c_; }
    __device__ bool next(int i, Unit& u) const { return at((long)i * G + c, u); }
    __device__ bool at(const long L, Unit& u) const {
        if (L >= nwg) return false;
        int wgid = (int)L; { const int q = nwg / NXCD, r = nwg % NXCD, xcd = wgid % NXCD, off = wgid / NXCD; wgid = (xcd < r ? xcd * (q + 1) : r * (q + 1) + (xcd - r) * q) + off; }
        const int nig = WGM * nN, gid = wgid / nig, fm = gid * WGM, gsz = (nM - fm) < WGM ? (nM - fm) : WGM;
        u.pm = fm + ((wgid % nig) % gsz); u.pn = (wgid % nig) / gsz; return true;
    }
};
struct DenseSched : TileOrder {
    const char* A; const char* Bt; size_t tstep;
    __device__ __forceinline__ const char* a_base(const Unit& u) const { return A + (size_t)u.pm * tstep; }
    __device__ __forceinline__ const char* b_base(const Unit& u) const { return Bt + (size_t)u.pn * tstep; }
    __device__ __forceinline__ unsigned row_off(const Unit&, int) const { return 0u; }
};
struct MoeSched : TileOrder {
    const char* A; const char* Bt; size_t a_tstep, b_tstep, b_estride; const int* tokslot; unsigned rowbytes; int g1, g2, g3, g4, g5, g6, g7;
    __device__ __forceinline__ int expert(int pm) const { const int r = pm * 256; return (r >= g1) + (r >= g2) + (r >= g3) + (r >= g4) + (r >= g5) + (r >= g6) + (r >= g7); }
    __device__ __forceinline__ const char* a_base(const Unit& u) const { return A + (size_t)u.pm * a_tstep; }
    __device__ __forceinline__ const char* b_base(const Unit& u) const { return Bt + (size_t)expert(u.pm) * b_estride + (size_t)u.pn * b_tstep; }
    __device__ __forceinline__ unsigned row_off(const Unit& u, int r) const { int t = tokslot[u.pm * 256 + r]; t = t < 0 ? 0 : t; return (unsigned)t * rowbytes; }
};
struct MoeSchedTail : MoeSched {
    int pmT, pnT, k0T, nkT;
    __device__ bool next(int i, Unit& u) const { if (i != 0) return false; u.pm = pmT; u.pn = pnT; u.k0 = k0T; u.nk = nkT; u.part = 1; return true; }
};

struct EpiQKV {
    static constexpr bool PERM = true;
    bf16* Q; size_t tstride; const float* qg; const float* kg; float qscale;
    __device__ __forceinline__ void operator()(const f32x4 (&acc)[2][2][4][2], const Unit& u, int wr, int wc, int fr, int fq) const {
        const int t = u.pn >> 2;
        bf16* base = Q + (size_t)t * tstride;
        const int lc0 = 256 * (u.pn & 3) + 64 * wc + 8 * fq;
        const int row0 = u.pm * BM + wr * 64 + fr;
        if (t < 2) {
            const float* g = qg; if (t == 1) g = kg;
            g += 64 * (wc & 1) + 8 * fq;
            f32x4 gv[2][2];
#pragma unroll
            for (int bj = 0; bj < 2; ++bj)
#pragma unroll
                for (int n = 0; n < 2; ++n) gv[bj][n] = *(const f32x4*)(g + 32 * bj + 4 * n);
            float sc = 1.0f; if (t == 0) sc = qscale;
#pragma unroll
            for (int ai = 0; ai < 2; ++ai)
#pragma unroll
                for (int m = 0; m < 4; ++m) {
                    float ss = 0.f;
#pragma unroll
                    for (int bj = 0; bj < 2; ++bj)
#pragma unroll
                        for (int n = 0; n < 2; ++n) { const f32x4 x = acc[ai][bj][m][n]; ss += (x[0] * x[0] + x[1] * x[1]) + (x[2] * x[2] + x[3] * x[3]); }
                    ss += __shfl_xor(ss, 16); ss += __shfl_xor(ss, 32);
                    const float rs = __builtin_amdgcn_rsqf(ss * (1.0f / 64.0f) + EPS) * sc;
                    bf16* rowp = base + (size_t)(row0 + ai * HALF + m * 16) * D + lc0;
#pragma unroll
                    for (int bj = 0; bj < 2; ++bj) { const f32x4 v0 = acc[ai][bj][m][0] * rs * gv[bj][0], v1 = acc[ai][bj][m][1] * rs * gv[bj][1];
                        u32x4 w; w.x = cvt_pk_bf16(v0[0], v0[1]); w.y = cvt_pk_bf16(v0[2], v0[3]); w.z = cvt_pk_bf16(v1[0], v1[1]); w.w = cvt_pk_bf16(v1[2], v1[3]);
                        *(u32x4*)(rowp + 32 * bj) = w; }
                }
        } else {
#pragma unroll
            for (int ai = 0; ai < 2; ++ai)
#pragma unroll
                for (int m = 0; m < 4; ++m) { bf16* rowp = base + (size_t)(row0 + ai * HALF + m * 16) * D + lc0;
#pragma unroll
                    for (int bj = 0; bj < 2; ++bj) { const f32x4 v0 = acc[ai][bj][m][0], v1 = acc[ai][bj][m][1];
                        u32x4 w; w.x = cvt_pk_bf16(v0[0], v0[1]); w.y = cvt_pk_bf16(v0[2], v0[3]); w.z = cvt_pk_bf16(v1[0], v1[1]); w.w = cvt_pk_bf16(v1[2], v1[3]);
                        *(u32x4*)(rowp + 32 * bj) = w; } }
        }
    }
};
template <bool BASE16, bool OUT16> struct EpiResid {
    static constexpr bool PERM = false;
    const void* base; void* out; const float* gate; float descale;
    __device__ __forceinline__ void operator()(const f32x4 (&acc)[2][2][4][2], const Unit& u, int wr, int wc, int fr, int fq) const {
        const int row0 = u.pm * BM + wr * 64 + fr, col0 = u.pn * BM + wc * 32 + 4 * fq, b = u.pm >> 4;
        f32x4 gv[2][2];
#pragma unroll
        for (int bj = 0; bj < 2; ++bj)
#pragma unroll
            for (int n = 0; n < 2; ++n) gv[bj][n] = *(const f32x4*)(gate + (size_t)b * 6144 + col0 + bj * HALF + n * 16) * descale;
#pragma unroll
        for (int ai = 0; ai < 2; ++ai)
#pragma unroll
            for (int m = 0; m < 4; ++m) { const size_t off = (size_t)(row0 + ai * HALF + m * 16) * D + col0;
#pragma unroll
                for (int bj = 0; bj < 2; ++bj)
#pragma unroll
                    for (int n = 0; n < 2; ++n) { const size_t o = off + bj * HALF + n * 16;
                        const f32x4 bs = BASE16 ? ld_bf16x4((const bf16*)base + o) : *(const f32x4*)((const float*)base + o);
                        const f32x4 r = bs + gv[bj][n] * acc[ai][bj][m][n];
                        if constexpr (OUT16) st_bf16x4((bf16*)out + o, r); else *(f32x4*)((float*)out + o) = r; }
                asm volatile("" ::: "memory"); }
    }
};
template <bool OUT8> struct EpiSwiGLU {
    static constexpr bool PERM = true;
    void* O; int ldo; float descale;
    __device__ __forceinline__ void operator()(const f32x4 (&acc)[2][2][4][2], const Unit& u, int wr, int wc, int fr, int fq) const {
        const int row0 = u.pm * BM + wr * 64 + fr, col0 = u.pn * HALF + wc * 32 + 8 * fq;
#pragma unroll
        for (int ai = 0; ai < 2; ++ai)
#pragma unroll
            for (int m = 0; m < 4; ++m) { const unsigned eo = (unsigned)(row0 + ai * HALF + m * 16) * (unsigned)ldo + (unsigned)col0;
                f32x4 v0, v1;
#pragma unroll
                for (int i = 0; i < 4; ++i) { v0[i] = fast_silu(acc[ai][0][m][0][i] * descale) * (acc[ai][1][m][0][i] * descale); v1[i] = fast_silu(acc[ai][0][m][1][i] * descale) * (acc[ai][1][m][1][i] * descale); }
                if constexpr (OUT8) { v0 = v0 * A8_SCALE; v1 = v1 * A8_SCALE; *(u32x2*)((unsigned char*)O + eo) = (u32x2){pk_fp8x4(v0[0], v0[1], v0[2], v0[3]), pk_fp8x4(v1[0], v1[1], v1[2], v1[3])}; }
                else { u32x4 w; w.x = cvt_pk_bf16(v0[0], v0[1]); w.y = cvt_pk_bf16(v0[2], v0[3]); w.z = cvt_pk_bf16(v1[0], v1[1]); w.w = cvt_pk_bf16(v1[2], v1[3]); *(u32x4*)((bf16*)O + eo) = w; } }
    }
};
struct EpiGLA {
    static constexpr bool PERM = true;
    bf16* P; bf16* LA; const float* ba; const float* og;
    __device__ __forceinline__ void operator()(const f32x4 (&acc)[2][2][4][2], const Unit& u, int wr, int wc, int fr, int fq) const {
        const int row0 = u.pm * BM + wr * 64 + fr;
        if (u.pn < 12) {
            const int col0 = u.pn * BM + wc * 32 + 8 * fq; const bool isr = u.pn >= 8;
            f32x4 gv[2][2];
#pragma unroll
            for (int bj = 0; bj < 2; ++bj)
#pragma unroll
                for (int n = 0; n < 2; ++n) gv[bj][n] = isr ? *(const f32x4*)(og + wc * 32 + 8 * fq + bj * HALF + 4 * n) : (f32x4){1.f, 1.f, 1.f, 1.f};
#pragma unroll
            for (int ai = 0; ai < 2; ++ai)
#pragma unroll
                for (int m = 0; m < 4; ++m) { bf16* rowp = P + (size_t)(row0 + ai * HALF + m * 16) * 3072 + col0;
#pragma unroll
                    for (int bj = 0; bj < 2; ++bj) { f32x4 v0 = acc[ai][bj][m][0], v1 = acc[ai][bj][m][1];
                        if (isr) {
#pragma unroll
                            for (int i = 0; i < 4; ++i) { v0[i] = gv[bj][0][i] * fast_silu(v0[i]); v1[i] = gv[bj][1][i] * fast_silu(v1[i]); } }
                        u32x4 w; w.x = cvt_pk_bf16(v0[0], v0[1]); w.y = cvt_pk_bf16(v0[2], v0[3]); w.z = cvt_pk_bf16(v1[0], v1[1]); w.w = cvt_pk_bf16(v1[2], v1[3]);
                        *(u32x4*)(rowp + bj * HALF) = w; } }
        } else {
            const int col0 = (u.pn - 12) * BM + wc * 32 + 8 * fq;
            f32x4 bv[2][2];
#pragma unroll
            for (int bj = 0; bj < 2; ++bj)
#pragma unroll
                for (int n = 0; n < 2; ++n) bv[bj][n] = *(const f32x4*)(ba + col0 + bj * HALF + 4 * n);
#pragma unroll
            for (int ai = 0; ai < 2; ++ai)
#pragma unroll
                for (int m = 0; m < 4; ++m) { bf16* rowp = LA + (size_t)(row0 + ai * HALF + m * 16) * 512 + col0;
#pragma unroll
                    for (int bj = 0; bj < 2; ++bj) { f32x4 v[2];
#pragma unroll
                        for (int n = 0; n < 2; ++n)
#pragma unroll
                            for (int i = 0; i < 4; ++i) { const float z = acc[ai][bj][m][n][i] + bv[bj][n][i];
                                v[n][i] = (fminf(z, 0.f) - __logf(1.0f + __expf(-fabsf(z)))) * (1.0f / 16.0f); }
                        u32x4 w; w.x = cvt_pk_bf16(v[0][0], v[0][1]); w.y = cvt_pk_bf16(v[0][2], v[0][3]); w.z = cvt_pk_bf16(v[1][0], v[1][1]); w.w = cvt_pk_bf16(v[1][2], v[1][3]);
                        *(u32x4*)(rowp + bj * HALF) = w; } }
        }
    }
};
template <bool FINAL> struct EpiMoeDown {
    static constexpr bool PERM = false;
    const int* tokslot; const float* gslot; bf16* xb; float* outf; const float* gate; float descale;
    __device__ __forceinline__ void operator()(const f32x4 (&acc)[2][2][4][2], const Unit& u, int wr, int wc, int fr, int fq) const {
        const int srow0 = u.pm * BM + wr * 64 + fr, col0 = u.pn * BM + wc * 32 + 4 * fq;
#pragma unroll
        for (int ai = 0; ai < 2; ++ai)
#pragma unroll
            for (int m = 0; m < 4; ++m) { const int srow = srow0 + ai * HALF + m * 16; const int tok = tokslot[srow];
                if (tok >= 0) { const float g = gslot[srow] * descale; const float* gp = gate + (size_t)(tok >> 12) * 6144 + col0; const size_t ro = (size_t)tok * D + col0;
#pragma unroll
                    for (int bj = 0; bj < 2; ++bj)
#pragma unroll
                        for (int n = 0; n < 2; ++n) { const f32x4 gv = *(const f32x4*)(gp + bj * HALF + n * 16); const f32x4 bs = ld_bf16x4(xb + ro + bj * HALF + n * 16);
                            const f32x4 r = bs + gv * g * acc[ai][bj][m][n];
                            if constexpr (FINAL) *(f32x4*)(outf + ro + bj * HALF + n * 16) = r; else st_bf16x4(xb + ro + bj * HALF + n * 16, r); } }
                asm volatile("" ::: "memory"); }
    }
    __device__ __forceinline__ void slice(const f32x4 (&v)[2][2], const Unit& u, int ai, int m, int wr, int wc, int fr, int fq) const {
        const int srow = u.pm * BM + wr * 64 + fr + ai * HALF + m * 16, col0 = u.pn * BM + wc * 32 + 4 * fq; const int tok = tokslot[srow];
        if (tok >= 0) { const float g = gslot[srow] * descale; const float* gp = gate + (size_t)(tok >> 12) * 6144 + col0; const size_t ro = (size_t)tok * D + col0;
#pragma unroll
            for (int bj = 0; bj < 2; ++bj)
#pragma unroll
                for (int n = 0; n < 2; ++n) { const f32x4 gv = *(const f32x4*)(gp + bj * HALF + n * 16); const f32x4 bs = ld_bf16x4(xb + ro + bj * HALF + n * 16);
                    const f32x4 r = bs + gv * g * v[bj][n];
                    if constexpr (FINAL) *(f32x4*)(outf + ro + bj * HALF + n * 16) = r; else st_bf16x4(xb + ro + bj * HALF + n * 16, r); } }
    }
};
struct EpiPartStore {
    static constexpr bool PERM = false;
    float* part;
    __device__ __forceinline__ void operator()(const f32x4 (&acc)[2][2][4][2], const Unit&, int wr, int wc, int fr, int fq) const {
        f32x4* p = (f32x4*)part + ((wr * 4 + wc) * 64 + fq * 16 + fr);
#pragma unroll
        for (int ai = 0; ai < 2; ++ai)
#pragma unroll
            for (int bj = 0; bj < 2; ++bj)
#pragma unroll
                for (int m = 0; m < 4; ++m)
#pragma unroll
                    for (int n = 0; n < 2; ++n) { *p = acc[ai][bj][m][n]; p += 512; asm volatile("" : "+v"(p)); }
    }
};

template <class Epi, class Sched, bool ALIGN_EPI, bool GATHER, bool FP8 = false, bool KSPLIT = false>
__device__ __forceinline__ void gemm_phase(LAS unsigned char* lds, const int RB, const Sched& S, const Epi& E) {
    const int tid = threadIdx.x, wid = __builtin_amdgcn_readfirstlane(tid >> 6), lane = tid & 63, wr = wid >> 2, wc = wid & 3, fr = lane & 15, fq = lane >> 4;
    const int nt = RB / 128;
    unsigned voffB0, voffA0;
    const size_t kstep = (size_t)(BK * 2);
    const size_t hstep = (size_t)HALF * RB;
    const size_t qstep = (size_t)64 * RB;
    { int R, C; stage_rc(tid * 16, R, C); const int Rb = Epi::PERM ? ((R & ~31) + perm32(R & 31)) : R;
        voffB0 = (unsigned)(Rb * RB + C * 2); voffA0 = (unsigned)(R * RB + C * 2); }
    LAS unsigned* mytab = (LAS unsigned*)(lds + STAGE_BYTES) + tid;
#define PG8_TABFILL(par, U) do { _Pragma("unroll") for (int _h = 0; _h < 2; ++_h) _Pragma("unroll") for (int _i = 0; _i < 2; ++_i) { int _R, _C; stage_rc(tid * 16 + _i * 8192, _R, _C); \
        mytab[((par) * 4 + _h * 2 + _i) * 512] = S.row_off(U, _h * HALF + _R) + (unsigned)_C * 2u; } } while (0)
    const unsigned ldsw = (unsigned)wid * 1024u;
    const int aoff = lds_byte(wr * 64 + fr, fq * 8), boff = lds_byte(wc * 32 + fr, fq * 8);
#define PG8_SA(b, h) (((b) * 2 + (h)) * HTB)
#define PG8_SB(b, h) ((4 + (b) * 2 + (h)) * HTB)
#define PG8_STAGE_B(bufoff, gbase) do { _Pragma("unroll") for (int _i = 0; _i < 2; ++_i) \
        __builtin_amdgcn_global_load_lds((const unsigned*)((const char*)(gbase) + _i * qstep + voffB0), (LAS unsigned*)(lds + (bufoff) + ldsw + _i * 8192), 16, 0, 0); } while (0)
#define PG8_STAGE_A(bufoff, gbase, va, h) do { _Pragma("unroll") for (int _i = 0; _i < 2; ++_i) \
        __builtin_amdgcn_global_load_lds((const unsigned*)((const char*)(gbase) + (GATHER ? (size_t)0 : (size_t)(h) * hstep + _i * qstep) + (GATHER ? (va)[h][_i] : voffA0)), (LAS unsigned*)(lds + (bufoff) + ldsw + _i * 8192), 16, 0, 0); } while (0)
#define PG8_LDA(dst, b, h) do { _Pragma("unroll") for (int m = 0; m < 4; ++m) { if constexpr (FP8) dst##8[m] = __builtin_shufflevector(*(const LAS v4i*)(lds + PG8_SA(b, h) + aoff + m * 2048), *(const LAS v4i*)(lds + PG8_SA(b, h) + aoff + m * 2048 + 1024), 0, 1, 2, 3, 4, 5, 6, 7); \
        else { _Pragma("unroll") for (int k = 0; k < 2; ++k) dst[m][k] = *(const LAS bf16x8*)(lds + PG8_SA(b, h) + aoff + m * 2048 + k * 1024); } } } while (0)
#define PG8_LDB(dst, b, h) do { _Pragma("unroll") for (int n = 0; n < 2; ++n) { if constexpr (FP8) dst##8[n] = __builtin_shufflevector(*(const LAS v4i*)(lds + PG8_SB(b, h) + boff + n * 2048), *(const LAS v4i*)(lds + PG8_SB(b, h) + boff + n * 2048 + 1024), 0, 1, 2, 3, 4, 5, 6, 7); \
        else { _Pragma("unroll") for (int k = 0; k < 2; ++k) dst[n][k] = *(const LAS bf16x8*)(lds + PG8_SB(b, h) + boff + n * 2048 + k * 1024); } } } while (0)
#define PG8_CAT(x0, x1) __builtin_shufflevector(__builtin_bit_cast(v4i, x0), __builtin_bit_cast(v4i, x1), 0, 1, 2, 3, 4, 5, 6, 7)
#define PG8_MMA(ai, bj, At, Bt) do { __builtin_amdgcn_s_setprio(1); _Pragma("unroll") for (int m = 0; m < 4; ++m) _Pragma("unroll") for (int n = 0; n < 2; ++n) { \
        if constexpr (FP8) asm volatile("v_mfma_scale_f32_16x16x128_f8f6f4 %0, %1, %2, %0, %3, %3 op_sel_hi:[0,0,0]" : "+v"(acc[ai][bj][m][n]) : "v"(Bt##8[n]), "v"(At##8[m]), "v"(sc8));   \
        else { _Pragma("unroll") for (int k = 0; k < 2; ++k) acc[ai][bj][m][n] = __builtin_amdgcn_mfma_f32_16x16x32_bf16(Bt[n][k], At[m][k], acc[ai][bj][m][n], 0, 0, 0); } } \
        __builtin_amdgcn_s_setprio(0); } while (0)
#define PG8_WAIT_V(n) asm volatile("s_waitcnt vmcnt(" #n ")" ::: "memory")
#define PG8_WAIT_L(n) asm volatile("s_waitcnt lgkmcnt(" #n ")" ::: "memory")
#define PG8_BAR __builtin_amdgcn_s_barrier()
#define PG8_SCHED __builtin_amdgcn_sched_barrier(0)
    Unit cur, nxt; int ui = 0;
    if (!S.next(0, cur)) return;
    f32x4 acc[2][2][4][2];
#pragma unroll
    for (int a = 0; a < 2; ++a)
#pragma unroll
        for (int b = 0; b < 2; ++b)
#pragma unroll
            for (int m = 0; m < 4; ++m)
#pragma unroll
                for (int n = 0; n < 2; ++n) acc[a][b][m][n] = (f32x4){0.f, 0.f, 0.f, 0.f};
    const int sc8 = 0x7f7f7f7f;
    bf16x8 At[4][2], B0[2][2], B1[2][2]; v8i At8[4], B08[2], B18[2];
    const char* cA = S.a_base(cur); const char* cB = S.b_base(cur);
    if constexpr (KSPLIT) { cA += (size_t)cur.k0 * kstep; cB += (size_t)cur.k0 * kstep; }
    unsigned cvA[2][2] = {{0u, 0u}, {0u, 0u}};
    if constexpr (GATHER) {
        PG8_TABFILL(0, cur);
#pragma unroll
        for (int h = 0; h < 2; ++h)
#pragma unroll
            for (int i = 0; i < 2; ++i) cvA[h][i] = mytab[(h * 2 + i) * 512];
    }
    PG8_STAGE_B(PG8_SB(0, 0), cB); PG8_STAGE_B(PG8_SB(0, 1), cB + hstep); PG8_STAGE_A(PG8_SA(0, 0), cA, cvA, 0); PG8_STAGE_A(PG8_SA(0, 1), cA, cvA, 1);
    if (wr == 1) PG8_BAR;
    PG8_WAIT_V(2); PG8_BAR;
    PG8_STAGE_B(PG8_SB(1, 0), cB + kstep); PG8_STAGE_A(PG8_SA(1, 0), cA + kstep, cvA, 0); PG8_STAGE_B(PG8_SB(1, 1), cB + hstep + kstep);
    PG8_WAIT_V(6); PG8_BAR;
    for (;;) {
        const bool has_next = S.next(ui + 1, nxt);
        const char* nA = has_next ? S.a_base(nxt) : cA; const char* nB = has_next ? S.b_base(nxt) : cB;
        if constexpr (KSPLIT) { if (has_next) { nA += (size_t)nxt.k0 * kstep; nB += (size_t)nxt.k0 * kstep; } }
        if constexpr (GATHER) { if (has_next) PG8_TABFILL((ui + 1) & 1, nxt); }
        const int ntc = KSPLIT ? cur.nk : nt;
#pragma unroll 1
        for (int t = 0; t < ntc; t += 2) {
            const bool last = (t == ntc - 2);
            const char* a1 = cA + (size_t)(t + 1) * kstep;
            const char* a2 = last ? nA : cA + (size_t)(t + 2) * kstep; const char* b2 = last ? nB : cB + (size_t)(t + 2) * kstep;
            const char* a3 = a2 + kstep; const char* b3 = b2 + kstep;
            unsigned wA[2][2] = {{0u, 0u}, {0u, 0u}};
            if constexpr (GATHER) {
                const int pc = ui & 1, pw = (last && has_next) ? (pc ^ 1) : pc;
#pragma unroll
                for (int i = 0; i < 2; ++i) { cvA[1][i] = mytab[(pc * 4 + 2 + i) * 512]; wA[0][i] = mytab[(pw * 4 + i) * 512]; wA[1][i] = mytab[(pw * 4 + 2 + i) * 512]; }
            }
            PG8_LDB(B0, 0, 0); PG8_LDB(B1, 0, 1); PG8_SCHED; PG8_LDA(At, 0, 0); PG8_STAGE_A(PG8_SA(1, 1), a1, cvA, 1);
            PG8_WAIT_V(8); PG8_WAIT_L(0); PG8_BAR; PG8_MMA(0, 0, At, B0); PG8_MMA(0, 1, At, B1); PG8_BAR; PG8_SCHED;
            PG8_LDA(At, 0, 1); PG8_STAGE_B(PG8_SB(0, 0), b2); PG8_STAGE_B(PG8_SB(0, 1), b2 + hstep); PG8_STAGE_A(PG8_SA(0, 0), a2, wA, 0);
            PG8_WAIT_V(8); PG8_WAIT_L(0); PG8_BAR; PG8_MMA(1, 0, At, B0); PG8_MMA(1, 1, At, B1); PG8_BAR; PG8_SCHED;
            PG8_LDB(B0, 1, 0); PG8_LDB(B1, 1, 1); PG8_SCHED; PG8_LDA(At, 1, 0); PG8_STAGE_A(PG8_SA(0, 1), a2, wA, 1);
            PG8_WAIT_V(8); PG8_WAIT_L(0); PG8_BAR; PG8_MMA(0, 0, At, B0); PG8_MMA(0, 1, At, B1); PG8_BAR; PG8_SCHED;
            PG8_LDA(At, 1, 1); PG8_STAGE_B(PG8_SB(1, 0), b3); PG8_STAGE_B(PG8_SB(1, 1), b3 + hstep); PG8_STAGE_A(PG8_SA(1, 0), a3, wA, 0);
            PG8_WAIT_V(8); PG8_WAIT_L(0); PG8_BAR; PG8_MMA(1, 0, At, B0); PG8_MMA(1, 1, At, B1); PG8_BAR; PG8_SCHED;
        }
        if constexpr (ALIGN_EPI) { if (wr == 0) PG8_BAR; }
        if constexpr (FP8) asm volatile("s_nop 15\n\ts_nop 15" ::: "memory");
        { int el; asm volatile("v_mbcnt_lo_u32_b32 %0, -1, 0\n\tv_mbcnt_hi_u32_b32 %0, -1, %0" : "=v"(el));
          E(acc, cur, wr, wc, el & 15, el >> 4); }
        if (!has_next) break;
#pragma unroll
        for (int a = 0; a < 2; ++a)
#pragma unroll
            for (int b = 0; b < 2; ++b)
#pragma unroll
                for (int m = 0; m < 4; ++m)
#pragma unroll
                    for (int n = 0; n < 2; ++n) acc[a][b][m][n] = (f32x4){0.f, 0.f, 0.f, 0.f};
        cur = nxt; cA = nA; cB = nB; ++ui;
        if constexpr (ALIGN_EPI) { if (wr == 1) PG8_BAR; }
    }
    PG8_WAIT_V(0);
    if constexpr (!ALIGN_EPI) { if (wr == 0) PG8_BAR; }
    PG8_BAR;
#undef PG8_SA
#undef PG8_SB
#undef PG8_STAGE_A
#undef PG8_TABFILL
#undef PG8_STAGE_B
#undef PG8_LDA
#undef PG8_LDB
#undef PG8_MMA
#undef PG8_CAT
#undef PG8_WAIT_V
#undef PG8_WAIT_L
#undef PG8_BAR
#undef PG8_SCHED
}
}

#define XB_TMO      128
#define XB_XCNT(j)  (256  + 64 * (j))
#define XB_XSUB(j)  (1280 + 64 * (j))
#define XB_XGEN(j)  (2304 + 64 * (j))
#define XB_TOP      3328
#define XB_TOPGEN   3392
#define XCD_BAR_WORDS 3456
#define XB_SPIN_CAP (1u << 18)
__device__ __forceinline__ unsigned xb_ld(unsigned* p)              { return __hip_atomic_load(p, __ATOMIC_RELAXED, __HIP_MEMORY_SCOPE_AGENT); }
__device__ __forceinline__ unsigned xb_add(unsigned* p, unsigned v) { return __hip_atomic_fetch_add(p, v, __ATOMIC_RELAXED, __HIP_MEMORY_SCOPE_AGENT); }
__device__ __forceinline__ unsigned xb_xcc_id() { return (unsigned)__builtin_amdgcn_s_getreg((3 << 11) | 20) & 0xFu; }
#define XB_SPIN(cond, bar) do { unsigned _sp = 0; while (cond) { __builtin_amdgcn_s_sleep(1); \
    if ((++_sp & 255u) == 0u) { if (xb_ld(&(bar)[XB_TMO])) break; if (_sp > XB_SPIN_CAP) { atomicAdd(&(bar)[XB_TMO], 1u); break; } } } } while (0)
struct XcdBarrier { unsigned* bar; unsigned x; volatile LAS unsigned* st; };
__device__ __forceinline__ XcdBarrier xcd_barrier_post(unsigned* bar, volatile LAS unsigned* st) {
    XcdBarrier b; b.bar = bar; b.x = xb_xcc_id(); b.st = st;
    if (threadIdx.x == 0) (void)xb_add(&bar[XB_XCNT(b.x)], 1u);
    return b;
}
__device__ __forceinline__ void xcd_barrier_complete(unsigned* bar, unsigned x, unsigned& nloc, unsigned& nx) {
    const unsigned G = gridDim.x * gridDim.y * gridDim.z;
    unsigned sum, cnt, mine, sp = 0u;
    for (;;) {
        sum = 0u; cnt = 0u; mine = 0u;
#pragma unroll
        for (unsigned j = 0; j < 16; ++j) { const unsigned c = xb_ld(&bar[XB_XCNT(j)]); sum += c; cnt += (c > 0u) ? 1u : 0u; mine = (j == x) ? c : mine; }
        if (sum == G) break;
        __builtin_amdgcn_s_sleep(1);
        if ((++sp & 255u) == 0u) { if (xb_ld(&bar[XB_TMO])) break; if (sp > XB_SPIN_CAP) { atomicAdd(&bar[XB_TMO], 1u); break; } }
    }
    nloc = mine > 0u ? mine : 1u; nx = cnt > 0u ? cnt : 1u;
}
__device__ __forceinline__ void xcd_barrier(const XcdBarrier& b) {
    asm volatile("s_waitcnt vmcnt(0)" ::: "memory");
    __syncthreads();
    if (threadIdx.x == 0) {
        unsigned* bar = b.bar;
        __builtin_amdgcn_s_waitcnt(0);
        unsigned nloc = b.st[0], nx = b.st[1];
        if (nloc == 0u) { xcd_barrier_complete(bar, b.x, nloc, nx); b.st[0] = nloc; b.st[1] = nx; }
        const unsigned old = xb_add(&bar[XB_XSUB(b.x)], 1u);
        const unsigned gen = old / nloc;
        if (old + 1u == (gen + 1u) * nloc) {
            __builtin_amdgcn_fence(__ATOMIC_RELEASE, "agent");
            asm volatile("s_waitcnt vmcnt(0)" ::: "memory");
            const unsigned og = xb_add(&bar[XB_TOP], 1u);
            const unsigned tg = og / nx;
            if (og + 1u == (tg + 1u) * nx) xb_add(&bar[XB_TOPGEN], 1u);
            else XB_SPIN(xb_ld(&bar[XB_TOPGEN]) == tg, bar);
            __builtin_amdgcn_fence(__ATOMIC_ACQUIRE, "agent");
            xb_add(&bar[XB_XGEN(b.x)], 1u);
            asm volatile("s_waitcnt vmcnt(0)" ::: "memory");
        } else {
            XB_SPIN(xb_ld(&bar[XB_XGEN(b.x)]) == gen, bar);
            __builtin_amdgcn_fence(__ATOMIC_ACQUIRE, "agent");
            asm volatile("s_waitcnt vmcnt(0)" ::: "memory");
        }
    }
    __syncthreads();
}

struct Args {
    const float* x; const float* c; const float* ada_w; const float* ada_b; const float* norm1_g; const float* norm2_g;
    const float* da_w_in; const float* da_q_gain; const float* da_k_gain; const float* da_lam_q1; const float* da_lam_k1; const float* da_lam_q2; const float* da_lam_k2;
    const float* da_subln_g; const float* da_w_out;
    const float* gla_w_in; const float* gla_w_a1; const float* gla_w_a2; const float* gla_b_a; const float* gla_out_g; const float* gla_w_out;
    const float* ffn_w1; const float* ffn_w3; const float* ffn_w2;
    const float* moe_router; const float* moe_w1; const float* moe_w3; const float* moe_w2;
    float* out; unsigned char* ws; int ph_lo, ph_hi;
};

__device__ __forceinline__ void p0_transpose_item(const float* W, int ldw, int k0, int n0, bf16* WT, int dst_row0, int Kp, LAS float* scr, int lane) {
#pragma unroll 8
    for (int i = 0; i < 32; ++i) { const int kk = 2 * i + (lane >> 5); scr[kk * 33 + (lane & 31)] = W[(size_t)(k0 + kk) * ldw + n0 + (lane & 31)]; }
    asm volatile("s_waitcnt lgkmcnt(0)" ::: "memory");
    const int c = lane & 7;
#pragma unroll
    for (int j = 0; j < 4; ++j) { const int n = (lane >> 3) + 8 * j; const LAS float* s = scr + (8 * c) * 33 + n;
        u32x4 o; o.x = pk2(s[0 * 33], s[1 * 33]); o.y = pk2(s[2 * 33], s[3 * 33]); o.z = pk2(s[4 * 33], s[5 * 33]); o.w = pk2(s[6 * 33], s[7 * 33]);
        *(u32x4*)(WT + (size_t)(dst_row0 + n) * Kp + k0 + 8 * c) = o; }
    asm volatile("s_waitcnt lgkmcnt(0)" ::: "memory");
}

__device__ __forceinline__ void p0_transpose_item8(const float* W, int ldw, int k0, int n0, unsigned char* WT8, int dst_row0, int Kp, LAS float* scr, int lane) {
#pragma unroll 8
    for (int i = 0; i < 32; ++i) { const int kk = 2 * i + (lane >> 5); scr[kk * 33 + (lane & 31)] = W[(size_t)(k0 + kk) * ldw + n0 + (lane & 31)]; }
    asm volatile("s_waitcnt lgkmcnt(0)" ::: "memory");
    const int c = lane & 7;
#pragma unroll
    for (int j = 0; j < 4; ++j) { const int n = (lane >> 3) + 8 * j; const LAS float* sp = scr + (8 * c) * 33 + n;
        const u32x2 o = (u32x2){pk_fp8x4(sp[0 * 33] * W8_SCALE, sp[1 * 33] * W8_SCALE, sp[2 * 33] * W8_SCALE, sp[3 * 33] * W8_SCALE), pk_fp8x4(sp[4 * 33] * W8_SCALE, sp[5 * 33] * W8_SCALE, sp[6 * 33] * W8_SCALE, sp[7 * 33] * W8_SCALE)};
        *(u32x2*)(WT8 + (size_t)(dst_row0 + n) * Kp + k0 + 8 * c) = o; }
    asm volatile("s_waitcnt lgkmcnt(0)" ::: "memory");
}

namespace att {
__device__ __forceinline__ int crow(int r, int hi) { return (r & 3) + 8 * (r >> 2) + 4 * hi; }
__host__ __device__ constexpr int dwin(int h) { return (int)(150.0 / (1.4426950408889634 / (double)(1 << (h + 1)))); }
__host__ __device__ constexpr int tstart(int h, int jq) { const int q0 = 128 * jq, d = dwin(h); return q0 > d ? (q0 - d) / 64 : 0; }
struct Plan { unsigned char n[16]; unsigned char u[16][48]; };
constexpr Plan make_plan() {
    Plan p{}; int load[16] = {};
    for (int w = 0; w < 16; ++w) p.n[w] = 0;
    for (int h = 7; h >= 0; --h) {
        int cost[32] = {}, ord[32] = {};
        for (int j = 0; j < 32; ++j) { cost[j] = 2 * j + 2 - tstart(h, j); ord[j] = j; }
        for (int a = 1; a < 32; ++a) { const int x = ord[a]; int b = a - 1; while (b >= 0 && cost[ord[b]] < cost[x]) { ord[b + 1] = ord[b]; --b; } ord[b + 1] = x; }
        for (int a = 0; a < 32; ++a) { int best = 0; for (int w = 1; w < 16; ++w) if (load[w] < load[best]) best = w;
            p.u[best][p.n[best]++] = (unsigned char)(h * 32 + ord[a]); load[best] += cost[ord[a]]; }
    }
    return p;
}
__device__ const Plan PLAN = make_plan();
constexpr int BUFB = 32768, NBUF = 3, KOFF = 0, VOFF = 16384, WSF_OFF = NBUF * BUFB;
__device__ __forceinline__ s16x4 vtr(const LAS unsigned char* p) { return __builtin_bit_cast(s16x4, __builtin_amdgcn_ds_read_tr16_b64_v4i16((LAS s16x4*)p)); }

__device__ __forceinline__ void attn_unit(LAS unsigned char* lds, const bf16* Q, const bf16* K, const bf16* V, bf16* O, int b, int h, int jq,
                                          float sl2, float mref0, float mref1, float lam, const float* subg) {
    const int tid = threadIdx.x, lane = tid & 63, r32 = lane & 31, hi = lane >> 5; const int wid = __builtin_amdgcn_readfirstlane(tid >> 6);
    const int mp = wid >> 2, w4 = wid & 3;
    const size_t rowbase = (size_t)b * SEQ; const int q0 = jq * 128;
    const int nT = (q0 >> 6) + 2, myc = (q0 + 32 * w4) >> 6, t0 = tstart(h, jq);
    const bf16* Qw = Q + (rowbase + q0 + 32 * w4 + r32) * D + h * 128 + mp * 64 + hi * 8;
    bf16x8 qr[4];
#pragma unroll
    for (int d0 = 0; d0 < 4; ++d0) qr[d0] = *(const bf16x8*)(Qw + d0 * 16);
    const bf16* ksrc = K + (rowbase + lane) * D + h * 128 + wid * 8;
    const int p0 = wid, p1 = wid + 8;
    const bf16* vsrc0 = V + (rowbase + 16 * (p0 & 3) + (lane >> 2)) * D + h * 128 + 32 * (p0 >> 2) + (lane & 3) * 8;
    const bf16* vsrc1 = V + (rowbase + 16 * (p1 & 3) + (lane >> 2)) * D + h * 128 + 32 * (p1 >> 2) + (lane & 3) * 8;
#define ATT_DMA(t, bs) do { const size_t go = (size_t)(t) * 64 * D; LAS unsigned char* bb = lds + (bs) * BUFB; \
        __builtin_amdgcn_global_load_lds((const unsigned*)(ksrc + go), (LAS unsigned*)(bb + KOFF + wid * 1024), 16, 0, 0); \
        __builtin_amdgcn_global_load_lds((const unsigned*)(ksrc + go + 64), (LAS unsigned*)(bb + KOFF + 8192 + wid * 1024), 16, 0, 0); \
        __builtin_amdgcn_global_load_lds((const unsigned*)(vsrc0 + go), (LAS unsigned*)(bb + VOFF + p0 * 1024), 16, 0, 0); \
        __builtin_amdgcn_global_load_lds((const unsigned*)(vsrc1 + go), (LAS unsigned*)(bb + VOFF + p1 * 1024), 16, 0, 0); } while (0)
    const float qpos = (float)(q0 + 32 * w4 + r32);
    const float mref = mp ? mref1 : mref0;
    const float baseL = -sl2 * qpos - mref;
    float lsum = 0.f; f32x16 o[4];
#pragma unroll
    for (int d0 = 0; d0 < 4; ++d0)
#pragma unroll
        for (int r = 0; r < 16; ++r) o[d0][r] = 0.f;
    ATT_DMA(t0, 0);
    if (t0 + 1 < nT) ATT_DMA(t0 + 1, 1);
    int slot = 0;
    for (int t = t0; t < nT; ++t) {
        if (t + 1 < nT) asm volatile("s_waitcnt vmcnt(4)" ::: "memory"); else asm volatile("s_waitcnt vmcnt(0)" ::: "memory");
        asm volatile("s_waitcnt lgkmcnt(0)" ::: "memory"); __builtin_amdgcn_s_barrier(); asm volatile("" ::: "memory");
        if (t + 2 < nT) { const int s2 = slot >= 1 ? slot - 1 : 2; ATT_DMA(t + 2, s2); }
        if (t <= myc) {
            const LAS unsigned char* bb = lds + slot * BUFB;
            f32x16 c0, c1;
            if (t < myc) {
                const float kb = baseL + sl2 * (float)(64 * t + 4 * hi);
#pragma unroll
                for (int r = 0; r < 16; ++r) { c0[r] = kb + sl2 * (float)((r & 3) + 8 * (r >> 2)); c1[r] = kb + sl2 * (float)((r & 3) + 8 * (r >> 2) + 32); }
            } else {
                const float qk = qpos - (float)(64 * t + 4 * hi);
#pragma unroll
                for (int r = 0; r < 16; ++r) { c0[r] = -sl2 * fabsf(qk - (float)((r & 3) + 8 * (r >> 2))) - mref; c1[r] = -sl2 * fabsf(qk - (float)((r & 3) + 8 * (r >> 2) + 32)) - mref; }
            }
            const LAS unsigned char* kb_ = bb + KOFF + mp * 8192 + hi * 1024 + r32 * 16;
#pragma unroll
            for (int d0 = 0; d0 < 4; ++d0) {
                const bf16x8 k0 = *(const LAS bf16x8*)(kb_ + d0 * 2048);
                const bf16x8 k1 = *(const LAS bf16x8*)(kb_ + d0 * 2048 + 512);
                c0 = __builtin_amdgcn_mfma_f32_32x32x16_bf16(k0, qr[d0], c0, 0, 0, 0);
                c1 = __builtin_amdgcn_mfma_f32_32x32x16_bf16(k1, qr[d0], c1, 0, 0, 0);
            }
            float sacc = 0.f;
#pragma unroll
            for (int r = 0; r < 16; ++r) { c0[r] = __builtin_amdgcn_exp2f(c0[r]); c1[r] = __builtin_amdgcn_exp2f(c1[r]); sacc += c0[r] + c1[r]; }
            lsum += sacc;
            u32x4 pw[4];
#pragma unroll
            for (int g = 0; g < 4; ++g) { pw[0][g] = cvt_pk_bf16(c0[2 * g], c0[2 * g + 1]); pw[1][g] = cvt_pk_bf16(c0[8 + 2 * g], c0[8 + 2 * g + 1]);
                pw[2][g] = cvt_pk_bf16(c1[2 * g], c1[2 * g + 1]); pw[3][g] = cvt_pk_bf16(c1[8 + 2 * g], c1[8 + 2 * g + 1]); }
            const LAS unsigned char* vp = bb + VOFF + ((lane >> 4) & 1) * 32 + (lane & 3) * 8 + (4 * hi + ((lane & 15) >> 2)) * 64;
#pragma unroll
            for (int d0 = 0; d0 < 4; ++d0)
#pragma unroll
                for (int ks = 0; ks < 4; ++ks) {
                    const s16x4 lo = vtr(vp + d0 * 4096 + ks * 1024), hh = vtr(vp + d0 * 4096 + ks * 1024 + 512);
                    const bf16x8 vf = (bf16x8){lo[0], lo[1], lo[2], lo[3], hh[0], hh[1], hh[2], hh[3]};
                    o[d0] = __builtin_amdgcn_mfma_f32_32x32x16_bf16(__builtin_bit_cast(bf16x8, pw[ks]), vf, o[d0], 0, 0, 0);
                }
        }
        slot = slot == 2 ? 0 : slot + 1;
    }
#undef ATT_DMA
    lsum += __shfl_xor(lsum, 32);
    LAS float* wsf = (LAS float*)(lds + WSF_OFF) + wid * 32;
    if (hi == 0) wsf[r32] = lsum;
    asm volatile("s_waitcnt lgkmcnt(0)" ::: "memory");
    float rl[16];
#pragma unroll
    for (int r = 0; r < 16; ++r) rl[r] = __builtin_amdgcn_rcpf(wsf[crow(r, hi)]);
#pragma unroll
    for (int d0 = 0; d0 < 4; ++d0)
#pragma unroll
        for (int r = 0; r < 16; ++r) o[d0][r] *= rl[r];
    __syncthreads();
    LAS float* X = (LAS float*)lds + w4 * 4096;
    if (mp == 1) {
#pragma unroll
        for (int d0 = 0; d0 < 4; ++d0)
#pragma unroll
            for (int r = 0; r < 16; ++r) X[(d0 * 16 + r) * 64 + lane] = o[d0][r];
    }
    __syncthreads();
    if (mp == 0) {
        float ss[16];
#pragma unroll
        for (int r = 0; r < 16; ++r) ss[r] = 0.f;
#pragma unroll
        for (int d0 = 0; d0 < 4; ++d0)
#pragma unroll
            for (int r = 0; r < 16; ++r) { const float dd = o[d0][r] - lam * X[(d0 * 16 + r) * 64 + lane]; o[d0][r] = dd; ss[r] += dd * dd; }
#pragma unroll
        for (int r = 0; r < 16; ++r) {
            float s = ss[r];
#pragma unroll
            for (int of = 1; of < 32; of <<= 1) s += __shfl_xor(s, of);
            ss[r] = __builtin_amdgcn_rsqf(s * (1.0f / 128.0f) + EPS) * 0.8f;
        }
        bf16* Ow = O + (rowbase + q0 + 32 * w4) * D + h * 128 + r32;
#pragma unroll
        for (int d0 = 0; d0 < 4; ++d0) { const float gcol = subg[32 * d0 + r32];
#pragma unroll
            for (int r = 0; r < 16; ++r) Ow[(size_t)crow(r, hi) * D + 32 * d0] = (bf16)f2bf(o[d0][r] * ss[r] * gcol); }
    }
    __syncthreads();
}
}

__global__ void __launch_bounds__(NWAVES * 64, 2) mk_fwd(Args args) {
    extern __shared__ __attribute__((aligned(16))) unsigned char lds_raw[];
    LAS unsigned char* lds = (LAS unsigned char*)lds_raw;
    volatile LAS unsigned* MISC = (volatile LAS unsigned*)(lds + MISC_OFF);
    const int tid = threadIdx.x, lane = tid & 63, wave = __builtin_amdgcn_readfirstlane(tid >> 6);
    const int G = gridDim.x; const int bx = blockIdx.x;
    const int vcu = (G % 8 == 0) ? (bx % 8) * (G / 8) + bx / 8 : bx;
    unsigned char* ws = args.ws;
    unsigned* ctl = (unsigned*)(ws + WS_CTL);
    float* MOD = (float*)(ws + WS_MOD);
    unsigned* LCNT = (unsigned*)(ws + WS_LCNT);
    int* META = (int*)(ws + WS_META);
    u32x4* ROUTE = (u32x4*)(ws + WS_ROUTE);
    int* TOKSLOT = (int*)(ws + WS_TOKSLOT);
    float* GSLOT = (float*)(ws + WS_GSLOT);
    bf16* W_DAIN = (bf16*)(ws + WS_W_DAIN); bf16* W_DAOUT = (bf16*)(ws + WS_W_DAOUT); bf16* W_FFN13 = (bf16*)(ws + WS_W_FFN13); bf16* W_FFN2 = (bf16*)(ws + WS_W_FFN2);
    bf16* W_GLAIN = (bf16*)(ws + WS_W_GLAIN); bf16* W_GLAOUT = (bf16*)(ws + WS_W_GLAOUT); bf16* W_MOE13 = (bf16*)(ws + WS_W_MOE13); bf16* W_MOE2 = (bf16*)(ws + WS_W_MOE2);
    bf16* HB = (bf16*)(ws + WS_H);
    bf16* QB = (bf16*)(ws + WS_Q);
    bf16* KB = QB + (size_t)M * D; bf16* VB = KB + (size_t)M * D;
    bf16* ACTB = QB;
    bf16* GP = QB;
    bf16* GLAB = QB + (size_t)M * 3072;
    float* out = args.out;
    bf16* XB = (bf16*)(ws + WS_XB);
    float* KPART = (float*)(ws + WS_Q + 320 * MiB);
    static_assert(MOE_DN8 && (size_t)MAXSLOT * EXPD <= 320 * MiB && 320 * MiB + 256 * (size_t)(32 * 512 * 16) <= 464 * MiB, "K-split partials do not fit behind the MoE activations");

    for (int u = tid; u < 256; u += NWAVES * 64) ((LAS unsigned*)(lds + MISC_OFF))[u] = 0u;
    __syncthreads();
    XcdBarrier bar; bar.bar = ctl + CW_BAR; bar.x = 0; bar.st = nullptr;
    if (MK_N_LAUNCHES == 1) bar = xcd_barrier_post(ctl + CW_BAR, MISC + 8);
    const int lo = args.ph_lo, hi = args.ph_hi;
#define IN(k) (lo <= (k) && (k) < hi)
#define SEAM(k) do { if (IN(k) && IN((k) + 1)) xcd_barrier(bar); } while (0)
    const int gw = vcu * NWAVES + wave, NGW = G * NWAVES;

    if (IN(0)) {
        if (bx < 192) {
            LAS float* cact = (LAS float*)lds;
            for (int e = tid; e < 16 * 1024; e += 512) { const int b = e >> 10, k = e & 1023; const float v = args.c[e]; cact[k * 16 + b] = v / (1.0f + __expf(-v)); }
            __syncthreads();
            const int col = tid & 63, ks = tid >> 6, n = bx * 64 + col, layer = n / 6144, nn = n % 6144;
            const float* wp = args.ada_w + (size_t)layer * 1024 * 6144 + nn;
            float a[16];
#pragma unroll
            for (int b = 0; b < 16; ++b) a[b] = 0.f;
            for (int k = ks * 128; k < ks * 128 + 128; ++k) { const float w = wp[(size_t)k * 6144];
#pragma unroll
                for (int q = 0; q < 4; ++q) { const f32x4 cv = *(const LAS f32x4*)(cact + k * 16 + 4 * q); a[4 * q] += cv[0] * w; a[4 * q + 1] += cv[1] * w; a[4 * q + 2] += cv[2] * w; a[4 * q + 3] += cv[3] * w; } }
            LAS float* red = (LAS float*)(lds + 65536);
#pragma unroll
            for (int b = 0; b < 16; ++b) red[(ks * 16 + b) * 64 + col] = a[b];
            __syncthreads();
            for (int e = tid; e < 1024; e += 512) { const int b = e >> 6, cc = e & 63; float s = 0.f;
#pragma unroll
                for (int k8 = 0; k8 < 8; ++k8) s += red[(k8 * 16 + b) * 64 + cc];
                const int n2 = bx * 64 + cc, l2 = n2 / 6144, nn2 = n2 % 6144;
                MOD[((size_t)l2 * 16 + b) * 6144 + nn2] = s + args.ada_b[l2 * 6144 + nn2]; }
            __syncthreads();
        }
        for (int i = bx * 512 + tid; i < 2 * MAXSLOT; i += G * 512) TOKSLOT[i] = -1;
        LAS float* scr = (LAS float*)(lds + wave * 16384);
        constexpr int I_DAIN = 16 * 96, I_SQ = 16 * 32, I_F13 = 16 * 88, I_F2 = 44 * 32, I_GLAIN = 16 * 96, I_GA = 512;
        constexpr int NITEMS = I_DAIN + I_SQ + 2 * I_F13 + I_F2 + I_GLAIN + I_SQ + I_GA;
        for (int it = gw; it < NITEMS; it += NGW) {
            int r = it;
            if (r < I_DAIN) { const int kb = r / 96, nb = r % 96, n0 = 32 * nb, l = n0 & 255;
                p0_transpose_item(args.da_w_in, 3072, 64 * kb, n0, W_DAIN, (n0 & ~255) + 128 * ((l >> 5) & 1) + 32 * (l >> 6), D, scr, lane); continue; } r -= I_DAIN;
            if (r < I_SQ) { const int kb = r / 32, nb = r % 32; p0_transpose_item(args.da_w_out, D, 64 * kb, 32 * nb, W_DAOUT, 32 * nb, D, scr, lane); continue; } r -= I_SQ;
            if (r < 2 * I_F13) { const int w = r / I_F13, q = r % I_F13, kb = q / 88, nb = q % 88, n0 = 32 * nb;
                if (FFN_UP8) p0_transpose_item8(w ? args.ffn_w3 : args.ffn_w1, FFN, 64 * kb, n0, (unsigned char*)W_FFN13, (n0 >> 7) * 256 + w * 128 + (n0 & 127), D, scr, lane);
                else p0_transpose_item(w ? args.ffn_w3 : args.ffn_w1, FFN, 64 * kb, n0, W_FFN13, (n0 >> 7) * 256 + w * 128 + (n0 & 127), D, scr, lane); continue; } r -= 2 * I_F13;
            if (r < I_F2) { const int kb = r / 32, nb = r % 32; if (FFN_DN8) p0_transpose_item8(args.ffn_w2, D, 64 * kb, 32 * nb, (unsigned char*)W_FFN2, 32 * nb, FFN, scr, lane); else p0_transpose_item(args.ffn_w2, D, 64 * kb, 32 * nb, W_FFN2, 32 * nb, FFN, scr, lane); continue; } r -= I_F2;
            if (r < I_GLAIN) { const int kb = r / 96, nb = r % 96; p0_transpose_item(args.gla_w_in, 3072, 64 * kb, 32 * nb, W_GLAIN, 32 * nb, D, scr, lane); continue; } r -= I_GLAIN;
            if (r < I_SQ) { const int kb = r / 32, nb = r % 32; p0_transpose_item(args.gla_w_out, D, 64 * kb, 32 * nb, W_GLAOUT, 32 * nb, D, scr, lane); continue; } r -= I_SQ;
            if (r < I_GA) {
                const int j = r; float a2[16];
#pragma unroll
                for (int q = 0; q < 16; ++q) a2[q] = args.gla_w_a2[q * 512 + j];
                bf16* dst = W_GLAIN + (size_t)(3072 + j) * D + lane * 16;
                unsigned pk[8];
#pragma unroll
                for (int kk = 0; kk < 16; kk += 2) { float s0 = 0.f, s1 = 0.f; const float* w1p = args.gla_w_a1 + (size_t)(lane * 16 + kk) * 16;
#pragma unroll
                    for (int q = 0; q < 16; ++q) { s0 += w1p[q] * a2[q]; s1 += w1p[16 + q] * a2[q]; }
                    pk[kk >> 1] = pk2(s0, s1); }
                *(u32x4*)dst = (u32x4){pk[0], pk[1], pk[2], pk[3]}; *(u32x4*)(dst + 8) = (u32x4){pk[4], pk[5], pk[6], pk[7]};
                continue; }
        }
    }
    SEAM(0);

#define NORM_LOAD(XSRC, SRC16, m_, v_, s_) do { s_ = 0.f; \
            _Pragma("unroll") for (int j = 0; j < 4; ++j) { v_[j] = (SRC16) ? ld_bf16x4((const bf16*)(XSRC) + (size_t)(m_) * D + 4 * lane + 256 * j) : *((const f32x4*)((const float*)(XSRC) + (size_t)(m_) * D) + lane + 64 * j); s_ += (v_[j][0] * v_[j][0] + v_[j][1] * v_[j][1]) + (v_[j][2] * v_[j][2] + v_[j][3] * v_[j][3]); } } while (0)
#define NORM_ROW(GVEC, MODROW, ROUTER, OUT8, m_, v_, s_) do { const int m = (m_); const int b = m >> 12; f32x4 (&v)[4] = v_; \
            const float* mrow = (MODROW) + (size_t)b * 6144; \
            const float rstd = __builtin_amdgcn_rsqf(wave_sum(s_) * (1.0f / D) + EPS); \
            _Pragma("unroll") for (int j = 0; j < 4; ++j) { const f32x4 gg = *((const f32x4*)(GVEC) + lane + 64 * j), sh = *((const f32x4*)mrow + lane + 64 * j), sc = *((const f32x4*)(mrow + 1024) + lane + 64 * j); \
                v[j] = v[j] * rstd * gg * (sc + 1.0f) + sh; } \
            if (OUT8) { unsigned* o4 = (unsigned*)((unsigned char*)HB + (size_t)m * D) + lane; \
                _Pragma("unroll") for (int j = 0; j < 4; ++j) o4[64 * j] = pk_fp8x4(v[j][0] * H8_SCALE, v[j][1] * H8_SCALE, v[j][2] * H8_SCALE, v[j][3] * H8_SCALE); } \
            else { u32x2* o8 = (u32x2*)(HB + (size_t)m * D) + lane; \
                _Pragma("unroll") for (int j = 0; j < 4; ++j) o8[64 * j] = (u32x2){pk2(v[j][0], v[j][1]), pk2(v[j][2], v[j][3])}; } \
            if (ROUTER) { ROUTER_BODY } } while (0)
#define NORM_PHASE(XSRC, SRC16, GVEC, MODROW, ROUTER, OUT8) do { \
        const int rpw = (M + NGW - 1) / NGW; const int r_lo = (ROUTER ? (bx * NWAVES + wave) : gw) * rpw; \
        for (int rr = 0; rr < rpw; rr += 2) { const int m0 = r_lo + rr; if (m0 >= M) break; const bool two = (rr + 1 < rpw) && (m0 + 1 < M); \
            f32x4 va[4], vb[4]; float sa, sb = 0.f; \
            NORM_LOAD(XSRC, SRC16, m0, va, sa); if (two) NORM_LOAD(XSRC, SRC16, m0 + 1, vb, sb); \
            NORM_ROW(GVEC, MODROW, ROUTER, OUT8, m0, va, sa); if (two) NORM_ROW(GVEC, MODROW, ROUTER, OUT8, m0 + 1, vb, sb); } } while (0)
#define ROUTER_BODY
    if (IN(1)) { NORM_PHASE(args.x, false, args.norm1_g, MOD, 0, false); }
    SEAM(1);

    if (IN(2)) {
        pg8::DenseSched S; S.init(M / 256, 12, G, bx); S.A = (const char*)HB; S.Bt = (const char*)W_DAIN; S.tstep = (size_t)256 * D * 2;
        pg8::EpiQKV E{QB, (size_t)M * D, args.da_q_gain, args.da_k_gain, 0.125f * LOG2E};
        pg8::gemm_phase<pg8::EpiQKV, pg8::DenseSched, true, false>(lds, 2 * D, S, E);
    }
    SEAM(2);

    if (IN(3)) {
        float a1 = args.da_lam_q1[lane] * args.da_lam_k1[lane], a2 = args.da_lam_q2[lane] * args.da_lam_k2[lane];
        const float lam = __expf(wave_sum(a1)) - __expf(wave_sum(a2)) + 0.2f;
        const float gq0 = wave_max(fabsf(args.da_q_gain[lane])), gq1 = wave_max(fabsf(args.da_q_gain[64 + lane]));
        const float gk0 = wave_max(fabsf(args.da_k_gain[lane])), gk1 = wave_max(fabsf(args.da_k_gain[64 + lane]));
        const float mref0 = 8.0f * LOG2E * gq0 * gk0 * 1.01f, mref1 = 8.0f * LOG2E * gq1 * gk1 * 1.01f;
        for (int rep = 0; rep < (PROBE_DUP == 3 ? 2 : 1); ++rep)
        for (int bb = vcu >> 4; bb < BATCH; bb += (G >= 16 ? (G >> 4) : 1)) {
            const int w16 = vcu & 15, nu = att::PLAN.n[w16];
            for (int i = 0; i < nu; ++i) { const int hj = att::PLAN.u[w16][i], h = hj >> 5, jq = hj & 31;
                const float sl2 = LOG2E * exp2f(-(float)(h + 1));
                att::attn_unit(lds, QB, KB, VB, HB, bb, h, jq, sl2, mref0, mref1, lam, args.da_subln_g); }
        }
    }
    SEAM(3);

    if (IN(4)) {
        pg8::DenseSched S; S.init(M / 256, 4, G, bx); S.A = (const char*)HB; S.Bt = (const char*)W_DAOUT; S.tstep = (size_t)256 * D * 2;
        pg8::EpiResid<false, true> E{args.x, XB, MOD + 2048, 1.0f};
        pg8::gemm_phase<pg8::EpiResid<false, true>, pg8::DenseSched, true, false>(lds, 2 * D, S, E);
    }
    SEAM(4);
    if (IN(5)) { NORM_PHASE(XB, true, args.norm2_g, MOD + 3072, 0, FFN_UP8); }
    SEAM(5);

    if (IN(6)) {
        pg8::DenseSched S; S.init(M / 256, 2 * FFN / 256, G, bx); S.A = (const char*)HB; S.Bt = (const char*)W_FFN13; S.tstep = (size_t)256 * D * (FFN_UP8 ? 1 : 2);
        pg8::EpiSwiGLU<FFN_DN8> E{ACTB, FFN, FFN_UP8 ? 1.0f / (H8_SCALE * W8_SCALE) : 1.0f};
        pg8::gemm_phase<pg8::EpiSwiGLU<FFN_DN8>, pg8::DenseSched, true, false, FFN_UP8>(lds, D * (FFN_UP8 ? 1 : 2), S, E);
    }
    SEAM(6);
    if (IN(7)) {
        pg8::DenseSched S; S.init(M / 256, 4, G, bx); S.A = (const char*)ACTB; S.Bt = (const char*)W_FFN2; S.tstep = (size_t)256 * FFN * (FFN_DN8 ? 1 : 2);
        pg8::EpiResid<true, true> E{XB, XB, MOD + 5 * 1024, FFN_DN8 ? 1.0f / (A8_SCALE * W8_SCALE) : 1.0f};
        pg8::gemm_phase<pg8::EpiResid<true, true>, pg8::DenseSched, true, false, FFN_DN8>(lds, FFN * (FFN_DN8 ? 1 : 2), S, E);
    }
    SEAM(7);

    float* MOD1 = MOD + 16 * 6144;
    if (IN(8)) { NORM_PHASE(XB, true, args.norm1_g + D, MOD1, 0, false); }
    SEAM(8);
    if (IN(9)) {
        pg8::DenseSched S; S.init(M / 256, GLA_N / 256, G, bx); S.A = (const char*)HB; S.Bt = (const char*)W_GLAIN; S.tstep = (size_t)256 * D * 2;
        pg8::EpiGLA E{GP, GLAB, args.gla_b_a, args.gla_out_g};
        pg8::gemm_phase<pg8::EpiGLA, pg8::DenseSched, true, false>(lds, 2 * D, S, E);
    }
    SEAM(9);

    unsigned char* GA = (unsigned char*)out;
    static_assert(4096 * GA_UNIT <= 192 * MiB && 256 * MiB <= (size_t)M * D * 4 && (size_t)M * 512 * 2 >= 64 * MiB, "o-fragment parking");
#define OFRAG(b_, n_, h_) (((b_) < 8 ? (unsigned char*)GLAB : (unsigned char*)out + 192 * MiB) + (size_t)(((((b_) & 7) * 64 + (n_)) * 4) + (h_)) * 32768)
    if (IN(10)) {
        LAS unsigned char* QDp = lds; LAS unsigned char* KDTc = lds + 16384; LAS unsigned char* ATc = lds + 32768; LAS float* DV = (LAS float*)(lds + 40960);
        LAS bf16* KI = (LAS bf16*)(lds + 43008); LAS float* QT = (LAS float*)(lds + 60416);
        const int fr = lane & 15, fq = lane >> 4;
        const int j = tid & 127, tq = tid >> 7;
        const int cq = j >> 4, wq = j & 15, hq = (wq >> 2) & 1, jq2 = ((wq >> 3) << 2) | (wq & 3);
        for (int rep = 0; rep < (PROBE_DUP == 10 ? 2 : 1); ++rep)
        for (int u = bx; u < 4096; u += G) {
            const int h = u & 3, n = (u >> 2) & 63, b = u >> 8;
            const size_t R0 = (size_t)b * SEQ + 64 * n;
            float la[16], qv[16], kv[16];
#pragma unroll
            for (int i = 0; i < 16; ++i) { const size_t row = R0 + 16 * tq + i; la[i] = bf2f(GLAB[row * 512 + h * 128 + j]); qv[i] = bf2f(GP[row * 3072 + h * 128 + j]); kv[i] = bf2f(GP[row * 3072 + 512 + h * 128 + j]); }
#pragma unroll
            for (int i = 1; i < 16; ++i) la[i] += la[i - 1];
            QT[tq * 128 + j] = la[15];
            __syncthreads();
            float pre = 0.f, tot = 0.f;
#pragma unroll
            for (int q = 0; q < 4; ++q) { const float v = QT[q * 128 + j]; tot += v; pre += (q < tq) ? v : 0.f; }
            unsigned kdp[8];
#pragma unroll
            for (int i = 0; i < 16; ++i) { const float bb = pre + la[i]; const int t = 16 * tq + i;
                *(LAS bf16*)(QDp + (((cq * 2 + hq) * 64 + t) * 16) + jq2 * 2) = (bf16)f2bf(qv[i] * 0.08838834764831845f * __expf(bb));
                KI[t * 136 + j] = (bf16)f2bf(kv[i] * __expf(-bb));
                const float kd = kv[i] * __expf(tot - bb);
                if (i & 1) kdp[i >> 1] |= f2bf(kd) << 16; else kdp[i >> 1] = f2bf(kd); }
            *(LAS u32x4*)(KDTc + ((2 * tq) * 128 + j) * 16) = (u32x4){kdp[0], kdp[1], kdp[2], kdp[3]};
            *(LAS u32x4*)(KDTc + ((2 * tq + 1) * 128 + j) * 16) = (u32x4){kdp[4], kdp[5], kdp[6], kdp[7]};
            if (tq == 0) DV[j] = __expf(tot);
            __syncthreads();
#pragma unroll
            for (int q = 0; q < 2; ++q) { const int idx = 2 * wave + q, ti = idx >> 2, si = idx & 3;
                f32x4 c = (f32x4){0.f, 0.f, 0.f, 0.f};
                if (si <= ti) {
#pragma unroll
                    for (int ks = 0; ks < 4; ++ks) { const int cc = 2 * ks + (fq >> 1), jb = 4 * (fq & 1), t = 16 * ti + fr;
                        const u32x2 alo = *(const LAS u32x2*)(QDp + (((cc * 2 + 0) * 64 + t) * 16) + jb * 2), ahi = *(const LAS u32x2*)(QDp + (((cc * 2 + 1) * 64 + t) * 16) + jb * 2);
                        const u32x4 af = (u32x4){alo[0], alo[1], ahi[0], ahi[1]};
                        const bf16x8 bfr = *(const LAS bf16x8*)(KI + (16 * si + fr) * 136 + 32 * ks + 8 * fq);
                        c = __builtin_amdgcn_mfma_f32_16x16x32_bf16(__builtin_bit_cast(bf16x8, af), bfr, c, 0, 0, 0); }
                }
#pragma unroll
                for (int r = 0; r < 4; ++r) { const int t = 16 * ti + 4 * fq + r, sx = 16 * si + fr; *(LAS bf16*)(ATc + (((sx >> 3) * 64 + t) * 16) + (sx & 7) * 2) = (bf16)f2bf(sx <= t ? c[r] : 0.f); } }
            __syncthreads();
            { u32x4* dst = (u32x4*)(GA + (size_t)u * GA_UNIT);
              for (int v = tid; v < 41472 / 16; v += 512) dst[v] = *(const LAS u32x4*)(lds + v * 16); }
            __syncthreads();
        }
    }
    SEAM(10);

    const int sstride = G >= 256 ? 4 : (G >= 128 ? 2 : 1);
    const bool is_scan = (vcu % sstride == 0) && (vcu / sstride < 64);
    const int scan_id = vcu / sstride;
    const int copy_id = vcu < 64 * sstride ? (vcu / sstride) * (sstride - 1) + (vcu % sstride) - 1 : 64 * (sstride - 1) + (vcu - 64 * sstride);
    if (IN(11) && !is_scan) {
        LAS float* scr = (LAS float*)(lds + wave * 16384);
        constexpr int I_M13 = 16 * 112, I_M2 = 56 * 32, NIT = NEXP * 2 * I_M13 + NEXP * I_M2;
        const int nwv = (G - 64) * NWAVES;
        for (int rep = 0; rep < (PROBE_DUP == 20 ? 2 : 1); ++rep)
        for (int it = copy_id * NWAVES + wave; it < NIT; it += nwv) {
            int r = it;
            if (r < NEXP * 2 * I_M13) { const int e = r / (2 * I_M13), q2 = r % (2 * I_M13), w = q2 / I_M13, q = q2 % I_M13, kb = q / 112, nb = q % 112, n0 = 32 * nb;
                if (MOE_UP8) p0_transpose_item8((w ? args.moe_w3 : args.moe_w1) + (size_t)e * D * EXPD, EXPD, 64 * kb, n0, (unsigned char*)W_MOE13 + (size_t)e * 2 * EXPD * D, (n0 >> 7) * 256 + w * 128 + (n0 & 127), D, scr, lane);
                else p0_transpose_item((w ? args.moe_w3 : args.moe_w1) + (size_t)e * D * EXPD, EXPD, 64 * kb, n0, W_MOE13 + (size_t)e * 2 * EXPD * D, (n0 >> 7) * 256 + w * 128 + (n0 & 127), D, scr, lane); continue; }
            r -= NEXP * 2 * I_M13;
            { const int e = r / I_M2, q = r % I_M2, kb = q / 32, nb = q % 32;
                if (MOE_DN8) p0_transpose_item8(args.moe_w2 + (size_t)e * EXPD * D, D, 64 * kb, 32 * nb, (unsigned char*)W_MOE2 + (size_t)e * D * EXPD, 32 * nb, EXPD, scr, lane);
                else p0_transpose_item(args.moe_w2 + (size_t)e * EXPD * D, D, 64 * kb, 32 * nb, W_MOE2 + (size_t)e * D * EXPD, 32 * nb, EXPD, scr, lane); }
        }
    }
    if (IN(11) && is_scan) {
        const int b = scan_id >> 2, h = scan_id & 3;
        constexpr int BUFB = 74752, VOFF = 41984, GO_OFF = 2 * BUFB;
        LAS float* GO = (LAS float*)(lds + GO_OFF);
        if (tid < 256) GO[tid] = args.gla_out_g[tid];
        const int r32 = lane & 31, hh = lane >> 5;
        const int c0 = 32 * wave;
        const unsigned char* gabase = GA + ((size_t)b * 256 + h) * GA_UNIT;
        const bf16* vsrc = GP + ((size_t)b * SEQ + (lane >> 2)) * 3072 + 1024 + h * 256 + 32 * wave + (lane & 3) * 8;
#define GLA_DMA(n_, bs_) do { LAS unsigned char* bb_ = lds + (bs_) * BUFB; const unsigned char* ga_ = gabase + (size_t)(n_) * 4 * GA_UNIT; \
        _Pragma("unroll") for (int k_ = 0; k_ < 6; ++k_) { int p_ = wave + 8 * k_; p_ = p_ > 40 ? 40 : p_; \
            __builtin_amdgcn_global_load_lds((const unsigned*)(ga_ + p_ * 1024 + lane * 16), (LAS unsigned*)(bb_ + p_ * 1024), 16, 0, 0); } \
        _Pragma("unroll") for (int ks_ = 0; ks_ < 4; ++ks_) \
            __builtin_amdgcn_global_load_lds((const unsigned*)(vsrc + ((size_t)(n_) * 64 + 16 * ks_) * 3072), (LAS unsigned*)(bb_ + VOFF + (ks_ * 8 + wave) * 1024), 16, 0, 0); } while (0)
#define GLA_BAR() do { asm volatile("s_waitcnt lgkmcnt(0)" ::: "memory"); __builtin_amdgcn_s_barrier(); asm volatile("" ::: "memory"); } while (0)
        for (int rep = 0; rep < (PROBE_DUP == 11 ? 2 : 1); ++rep) {
        f32x16 Sacc[4];
#pragma unroll
        for (int kt = 0; kt < 4; ++kt)
#pragma unroll
            for (int r = 0; r < 16; ++r) Sacc[kt][r] = 0.f;
        GLA_DMA(0, 0);
        asm volatile("s_waitcnt vmcnt(0)" ::: "memory");
        for (int n = 0; n < 64; ++n) {
            const size_t R0 = (size_t)b * SEQ + 64 * n;
            asm volatile("s_waitcnt vmcnt(4)" ::: "memory");
            GLA_BAR();
            if (n + 1 < 64) GLA_DMA(n + 1, (n + 1) & 1);
            LAS unsigned char* bb = lds + (n & 1) * BUFB;
            const LAS unsigned char* QDp = bb; const LAS unsigned char* KDTc = bb + 16384; const LAS unsigned char* ATc = bb + 32768; const LAS float* DV = (const LAS float*)(bb + 40960);
            bf16x8 vf[4];
#pragma unroll
            for (int ks = 0; ks < 4; ++ks) { const LAS unsigned char* vp = bb + VOFF + (ks * 8 + wave) * 1024 + ((lane >> 4) & 1) * 32 + (lane & 3) * 8 + (8 * hh + ((lane & 15) >> 2)) * 64;
                const s16x4 lo = att::vtr(vp), hi4 = att::vtr(vp + 256); vf[ks] = (bf16x8){lo[0], lo[1], lo[2], lo[3], hi4[0], hi4[1], hi4[2], hi4[3]}; }
            f32x16 o[2];
#pragma unroll
            for (int tt = 0; tt < 2; ++tt)
#pragma unroll
                for (int r = 0; r < 16; ++r) o[tt][r] = 0.f;
            bf16x8 qa[16], aa[6];
#pragma unroll
            for (int kt = 0; kt < 4; ++kt)
#pragma unroll
                for (int sx = 0; sx < 2; ++sx)
#pragma unroll
                    for (int tt = 0; tt < 2; ++tt) qa[(kt * 2 + sx) * 2 + tt] = *(const LAS bf16x8*)(QDp + ((((kt * 2 + sx) * 2 + hh) * 64 + 32 * tt + r32) * 16));
#pragma unroll
            for (int i = 0; i < 6; ++i) { const int tt = i < 2 ? 0 : 1, ks = i < 2 ? i : i - 2;
                aa[i] = *(const LAS bf16x8*)(ATc + (((2 * ks + hh) * 64 + 32 * tt + r32) * 16)); }
            __builtin_amdgcn_sched_barrier(0);
#pragma unroll
            for (int kt = 0; kt < 4; ++kt)
#pragma unroll
                for (int sx = 0; sx < 2; ++sx) {
                    u32x4 sb;
#pragma unroll
                    for (int g = 0; g < 4; ++g) sb[g] = cvt_pk_bf16(Sacc[kt][8 * sx + 2 * g], Sacc[kt][8 * sx + 2 * g + 1]);
#pragma unroll
                    for (int tt = 0; tt < 2; ++tt) o[tt] = __builtin_amdgcn_mfma_f32_32x32x16_bf16(qa[(kt * 2 + sx) * 2 + tt], __builtin_bit_cast(bf16x8, sb), o[tt], 0, 0, 0);
                }
#pragma unroll
            for (int i = 0; i < 6; ++i) { const int tt = i < 2 ? 0 : 1, ks = i < 2 ? i : i - 2;
                o[tt] = __builtin_amdgcn_mfma_f32_32x32x16_bf16(aa[i], vf[ks], o[tt], 0, 0, 0); }
            __builtin_amdgcn_sched_barrier(0);
            { u32x4* dst = (u32x4*)(OFRAG(b, n, h)) + (wave * 4) * 64 + lane;
#pragma unroll
              for (int tt = 0; tt < 2; ++tt)
#pragma unroll
                  for (int q = 0; q < 2; ++q) { u32x4 w;
#pragma unroll
                      for (int g = 0; g < 4; ++g) w[g] = cvt_pk_bf16(o[tt][8 * q + 2 * g], o[tt][8 * q + 2 * g + 1]);
                      dst[(tt * 2 + q) * 64] = w; } }
            __builtin_amdgcn_sched_barrier(0);
            f32x4 dvv[16]; bf16x8 ka[16];
#pragma unroll
            for (int kt = 0; kt < 4; ++kt)
#pragma unroll
                for (int g = 0; g < 4; ++g) dvv[kt * 4 + g] = *(const LAS f32x4*)(DV + 32 * kt + 8 * g + 4 * hh);
#pragma unroll
            for (int ks = 0; ks < 4; ++ks)
#pragma unroll
                for (int kt = 0; kt < 4; ++kt) ka[ks * 4 + kt] = *(const LAS bf16x8*)(KDTc + (((2 * ks + hh) * 128 + 32 * kt + r32) * 16));
            __builtin_amdgcn_sched_barrier(0);
#pragma unroll
            for (int kt = 0; kt < 4; ++kt)
#pragma unroll
                for (int g = 0; g < 4; ++g)
#pragma unroll
                    for (int e = 0; e < 4; ++e) Sacc[kt][4 * g + e] *= dvv[kt * 4 + g][e];
#pragma unroll
            for (int ks = 0; ks < 4; ++ks)
#pragma unroll
                for (int kt = 0; kt < 4; ++kt) Sacc[kt] = __builtin_amdgcn_mfma_f32_32x32x16_bf16(ka[ks * 4 + kt], vf[ks], Sacc[kt], 0, 0, 0);
        }
        asm volatile("s_waitcnt vmcnt(0)" ::: "memory");
        GLA_BAR();
        }
#undef GLA_DMA
#undef GLA_BAR
    }
    if (IN(11)) {
        static_assert(MK_N_LAUNCHES == 1, "the scan follow-up sits behind an in-phase grid barrier");
        xcd_barrier(bar);
        LAS float* OS = (LAS float*)lds;
        const int r32 = lane & 31, hh = lane >> 5, c0 = 32 * wave;
        u32x4 fr[4], rwv[4];
#define P10C_LOAD(u_) do { const int b_ = (u_) >> 8, n_ = ((u_) >> 2) & 63, h_ = (u_) & 3; const u32x4* src_ = (const u32x4*)(OFRAG(b_, n_, h_)) + (wave * 4) * 64 + lane; \
            _Pragma("unroll") for (int k_ = 0; k_ < 4; ++k_) fr[k_] = src_[k_ * 64]; \
            const bf16* rp0_ = GP + ((size_t)b_ * SEQ + 64 * n_ + (tid >> 3)) * 3072 + 2048 + h_ * 256 + 32 * (tid & 7); \
            _Pragma("unroll") for (int i_ = 0; i_ < 4; ++i_) rwv[i_] = *(const u32x4*)(rp0_ + 8 * i_); } while (0)
        int u = bx;
        if (u < 4096) P10C_LOAD(u);
        for (; u < 4096; u += G) {
            const int b = u >> 8, n = (u >> 2) & 63, h = u & 3; const size_t R0 = (size_t)b * SEQ + 64 * n;
            u32x4 rw_c[4];
#pragma unroll
            for (int i = 0; i < 4; ++i) rw_c[i] = rwv[i];
            __syncthreads();
#pragma unroll
            for (int tt = 0; tt < 2; ++tt)
#pragma unroll
                for (int q = 0; q < 2; ++q)
#pragma unroll
                    for (int g = 0; g < 4; ++g) { const unsigned w = fr[tt * 2 + q][g]; const int r = 8 * q + 2 * g;
                        OS[(32 * tt + att::crow(r, hh)) * 260 + c0 + r32] = __builtin_bit_cast(float, w << 16);
                        OS[(32 * tt + att::crow(r + 1, hh)) * 260 + c0 + r32] = __builtin_bit_cast(float, w & 0xffff0000u); }
            __syncthreads();
            if (u + G < 4096) P10C_LOAD(u + G);
            { const int t = tid >> 3, seg = tid & 7; f32x4 ov[8]; float ss = 0.f;
#pragma unroll
              for (int i = 0; i < 8; ++i) { ov[i] = *(const LAS f32x4*)(OS + t * 260 + 32 * seg + 4 * i); ss += (ov[i][0] * ov[i][0] + ov[i][1] * ov[i][1]) + (ov[i][2] * ov[i][2] + ov[i][3] * ov[i][3]); }
              ss += __shfl_xor(ss, 1); ss += __shfl_xor(ss, 2); ss += __shfl_xor(ss, 4);
              const float rs = __builtin_amdgcn_rsqf(ss * (1.0f / 256.0f) + EPS);
              bf16* op = HB + (R0 + t) * D + h * 256 + 32 * seg;
#pragma unroll
              for (int i = 0; i < 4; ++i) { const u32x4 rw = rw_c[i]; u32x4 w;
#pragma unroll
                  for (int e = 0; e < 4; ++e) { const float r0 = __builtin_bit_cast(float, rw[e] << 16), r1 = __builtin_bit_cast(float, rw[e] & 0xffff0000u);
                      const int cidx = 8 * i + 2 * e;
                      const float v0 = ov[(cidx) >> 2][(cidx) & 3] * rs * r0, v1 = ov[(cidx + 1) >> 2][(cidx + 1) & 3] * rs * r1;
                      w[e] = pk2(v0, v1); }
                  *(u32x4*)(op + 8 * i) = w; } }
        }
#undef P10C_LOAD
    }
    SEAM(11);


    if (IN(12)) {
        pg8::DenseSched S; S.init(M / 256, 4, G, bx); S.A = (const char*)HB; S.Bt = (const char*)W_GLAOUT; S.tstep = (size_t)256 * D * 2;
        pg8::EpiResid<true, true> E{XB, XB, MOD1 + 2048, 1.0f};
        pg8::gemm_phase<pg8::EpiResid<true, true>, pg8::DenseSched, true, false>(lds, 2 * D, S, E);
    }
    SEAM(12);

    if (IN(13)) {
        LAS float* RW = (LAS float*)lds;
        LAS unsigned* EL = (LAS unsigned*)(lds + 32768);
        LAS float* GL = (LAS float*)(lds + 32768 + 4096);
        for (int e = tid; e < 8192; e += 512) { const int k = e >> 3, ex = e & 7;
            RW[((((k >> 8) * 4 + (k & 3)) * 2 + (ex >> 2)) * 64 + ((k & 255) >> 2)) * 4 + (ex & 3)] = args.moe_router[e]; }
        __syncthreads();
#undef ROUTER_BODY
#define ROUTER_BODY { float lg[8]; \
            _Pragma("unroll") for (int e = 0; e < 8; ++e) lg[e] = 0.f; \
            _Pragma("unroll") for (int j = 0; j < 4; ++j) _Pragma("unroll") for (int i = 0; i < 4; ++i) { const f32x4 w0 = *((const LAS f32x4*)RW + ((j * 4 + i) * 2) * 64 + lane), w1 = *((const LAS f32x4*)RW + ((j * 4 + i) * 2 + 1) * 64 + lane); const float hv = v[j][i]; \
                lg[0] += hv * w0[0]; lg[1] += hv * w0[1]; lg[2] += hv * w0[2]; lg[3] += hv * w0[3]; lg[4] += hv * w1[0]; lg[5] += hv * w1[1]; lg[6] += hv * w1[2]; lg[7] += hv * w1[3]; } \
            _Pragma("unroll") for (int e = 0; e < 8; ++e) lg[e] = wave_sum(lg[e]); \
            float v1 = lg[0]; \
            _Pragma("unroll") for (int e = 1; e < 8; ++e) v1 = fmaxf(v1, lg[e]); \
            int e1 = 7; \
            _Pragma("unroll") for (int e = 6; e >= 0; --e) e1 = (lg[e] == v1) ? e : e1; \
            float v2 = -3.0e38f; \
            _Pragma("unroll") for (int e = 0; e < 8; ++e) v2 = fmaxf(v2, (e == e1) ? -3.0e38f : lg[e]); \
            int e2 = -1; \
            _Pragma("unroll") for (int e = 7; e >= 0; --e) e2 = (e != e1 && lg[e] == v2) ? e : e2; \
            if (lane == 0) { EL[m - wg_row0] = (unsigned)e1 | ((unsigned)e2 << 8); GL[m - wg_row0] = v1 - v2; } }
        const int rpw12 = (M + NGW - 1) / NGW, rows_wg12 = rpw12 * NWAVES, wg_row0 = bx * rows_wg12;
        NORM_PHASE(XB, true, args.norm2_g + D, MOD1 + 3072, 1, MOE_UP8);
        __syncthreads();
        {
            int nrows = M - wg_row0; nrows = nrows > rows_wg12 ? rows_wg12 : nrows;
            for (int r = tid; r < nrows; r += 512) { const unsigned ew = EL[r]; const unsigned e1 = ew & 255u, e2 = ew >> 8; unsigned l1 = 0, l2 = 0;
                for (int q = 0; q < r; ++q) { const unsigned w = EL[q]; l1 += ((w & 255u) == e1) ? 1u : 0u; l2 += ((w >> 8) == e2) ? 1u : 0u; }
                ROUTE[wg_row0 + r] = (u32x4){ew, __builtin_bit_cast(unsigned, GL[r]), l1, l2}; }
            if (tid < 16) { const unsigned e = tid & 7; unsigned cnt = 0; for (int q = 0; q < nrows; ++q) { const unsigned w = EL[q]; cnt += ((tid < 8 ? (w & 255u) : (w >> 8)) == e) ? 1u : 0u; } LCNT[bx * 16 + tid] = cnt; }
        }
    }
    SEAM(13);

    if (IN(14)) {
        LAS int* PRE = (LAS int*)lds;
        LAS int* GOFF = (LAS int*)(lds + 256);
        if (tid < 16) { int pre = 0, tot = 0; for (int w = 0; w < G; ++w) { const int v = (int)LCNT[w * 16 + tid]; tot += v; pre += (w < bx) ? v : 0; } PRE[tid] = pre; ((LAS int*)(lds + 512))[tid] = (tot + 255) & ~255; }
        __syncthreads();
        if (tid < 2) { int acc = 0; for (int e = 0; e < 8; ++e) { GOFF[tid * 9 + e] = acc; acc += ((LAS int*)(lds + 512))[tid * 8 + e]; } GOFF[tid * 9 + 8] = acc;
            if (bx == 0) { for (int e = 0; e < 9; ++e) META[tid * 16 + e] = GOFF[tid * 9 + e]; } }
        __syncthreads();
        const int rpw = (M + NGW - 1) / NGW, rows_wg = rpw * NWAVES;
        for (int r = tid; r < rows_wg; r += 512) { const int m = bx * rows_wg + r; if (m >= M) break;
            const u32x4 rt = ROUTE[m]; const int e1 = rt[0] & 255, e2 = (rt[0] >> 8) & 255; const unsigned gbits = rt[1]; const float gap = __builtin_bit_cast(float, gbits); const float g1 = 1.0f / (1.0f + expf(-gap));
            const int s1 = GOFF[e1] + PRE[e1] + (int)rt[2], s2 = GOFF[9 + e2] + PRE[8 + e2] + (int)rt[3];
            TOKSLOT[s1] = m; GSLOT[s1] = g1; TOKSLOT[MAXSLOT + s2] = m; GSLOT[MAXSLOT + s2] = 1.0f - g1; }
    }
    SEAM(14);

#define MOE_SCHED(S, p) do { const int* mt = META + (p) * 16; S.g1 = mt[1]; S.g2 = mt[2]; S.g3 = mt[3]; S.g4 = mt[4]; S.g5 = mt[5]; S.g6 = mt[6]; S.g7 = mt[7]; } while (0)
#pragma unroll
    for (int p = 0; p < 2; ++p) {
        if (IN(15 + 2 * p)) {
            pg8::MoeSched S; MOE_SCHED(S, p); const int nP = META[p * 16 + 8] >> 8;
            S.init(nP, 2 * EXPD / 256, G, bx); S.A = (const char*)HB; S.a_tstep = 0; S.Bt = (const char*)W_MOE13; S.b_tstep = (size_t)256 * D * (MOE_UP8 ? 1 : 2); S.b_estride = (size_t)2 * EXPD * D * (MOE_UP8 ? 1 : 2);
            S.tokslot = TOKSLOT + p * MAXSLOT; S.rowbytes = D * (MOE_UP8 ? 1 : 2);
            pg8::EpiSwiGLU<MOE_DN8> E{ACTB, EXPD, MOE_UP8 ? 1.0f / (H8_SCALE * W8_SCALE) : 1.0f};
            pg8::gemm_phase<pg8::EpiSwiGLU<MOE_DN8>, pg8::MoeSched, true, true, MOE_UP8>(lds, D * (MOE_UP8 ? 1 : 2), S, E);
        }
        SEAM(15 + 2 * p);
        if (IN(16 + 2 * p)) {
            pg8::MoeSched S; MOE_SCHED(S, p); const int nP = META[p * 16 + 8] >> 8;
            constexpr int RBD = EXPD * (MOE_DN8 ? 1 : 2), NTD = RBD / 128;
            int nPm = nP, jpart = -1; const int qpart = bx & 7;
            { const int nwg = nP * 4, nfull = nwg / G, nrem = nwg - nfull * G; if (nrem > 0 && 8 * nrem <= G && (nfull * G) % 4 == 0 && NTD >= 16) { nPm = nfull * G / 4; if (bx < 8 * nrem) jpart = bx >> 3; } }
            S.init(nPm, 4, G, bx); S.A = (const char*)ACTB; S.a_tstep = (size_t)256 * RBD; S.Bt = (const char*)W_MOE2; S.b_tstep = (size_t)256 * RBD; S.b_estride = (size_t)D * RBD;
            S.tokslot = TOKSLOT + p * MAXSLOT; S.rowbytes = 0;
#define MOE_DOWN(FINAL_) do { pg8::EpiMoeDown<FINAL_> E{TOKSLOT + p * MAXSLOT, GSLOT + p * MAXSLOT, XB, out, MOD1 + 5 * 1024, MOE_DN8 ? 1.0f / (A8_SCALE * W8_SCALE) : 1.0f}; \
                if (nPm > 0) pg8::gemm_phase<pg8::EpiMoeDown<FINAL_>, pg8::MoeSched, true, false, MOE_DN8>(lds, RBD, S, E); \
                if (jpart >= 0) {       \
                    const int gsz = nP - nPm; pg8::Unit u; u.pm = nPm + jpart % gsz; u.pn = jpart / gsz; \
                    { pg8::MoeSchedTail T; MOE_SCHED(T, p); T.init(nP, 4, G, bx); T.A = S.A; T.a_tstep = S.a_tstep; T.Bt = S.Bt; T.b_tstep = S.b_tstep; T.b_estride = S.b_estride; T.tokslot = S.tokslot; T.rowbytes = 0; \
                      constexpr int P = NTD / 2, base = P / 8, extra = P % 8; T.pmT = u.pm; T.pnT = u.pn; T.k0T = 2 * (qpart * base + (qpart < extra ? qpart : extra)); T.nkT = 2 * (base + (qpart < extra ? 1 : 0)); \
                      pg8::EpiPartStore EP{KPART + (size_t)bx * (32 * 512 * 4)}; \
                      pg8::gemm_phase<pg8::EpiPartStore, pg8::MoeSchedTail, true, false, MOE_DN8, true>(lds, RBD, T, EP); } \
                    unsigned* kc = ctl + CW_KCNT + p * 64 + jpart; \
                    asm volatile("s_waitcnt vmcnt(0)" ::: "memory"); __syncthreads(); \
                    if (tid == 0) { __builtin_amdgcn_fence(__ATOMIC_RELEASE, "agent"); asm volatile("s_waitcnt vmcnt(0)" ::: "memory"); (void)xb_add(kc, 1u); \
                        XB_SPIN(xb_ld(kc) < 8u, ctl + CW_BAR); __builtin_amdgcn_fence(__ATOMIC_ACQUIRE, "agent"); asm volatile("s_waitcnt vmcnt(0)" ::: "memory"); } \
                    __syncthreads(); \
                    const int ai = qpart >> 2, m = qpart & 3; \
                    f32x4 v[2][2]; \
                    _Pragma("unroll") for (int bj = 0; bj < 2; ++bj) _Pragma("unroll") for (int n = 0; n < 2; ++n) { f32x4 a = (f32x4){0.f, 0.f, 0.f, 0.f}; \
                        const f32x4* pp = (const f32x4*)(KPART + (size_t)(jpart * 8) * (32 * 512 * 4)) + (size_t)((((ai * 2 + bj) * 4 + m) * 2 + n) * 512 + tid); \
                        _Pragma("unroll") for (int qq = 0; qq < 8; ++qq) a += pp[(size_t)qq * (32 * 512)]; \
                        v[bj][n] = a; } \
                    E.slice(v, u, ai, m, wave >> 2, wave & 3, lane & 15, lane >> 4); } } while (0)
            if (p == 0) MOE_DOWN(false); else MOE_DOWN(true);
#undef MOE_DOWN
        }
        if (p == 0) SEAM(16);
    }
#undef IN
#undef SEAM
}


constexpr int N_PHASES = 19;
extern "C" void kernel_launch(void* const* d_in, const int* in_sizes, int n_in, void* d_out, int out_size, void* d_ws, size_t ws_size, hipStream_t stream) {
    static int grid = 0;
    if (grid == 0) {
        if (n_in != 28 || in_sizes[0] != M * D || out_size != M * D || ws_size < WS_TOTAL) { fprintf(stderr, "kernel_launch: unexpected problem shape (n_in %d, out %d, ws %zu)\n", n_in, out_size, ws_size); grid = -1; return; }
        int dev = 0, cus = 0, per_cu = 0;
        if (hipGetDevice(&dev) != hipSuccess || hipDeviceGetAttribute(&cus, hipDeviceAttributeMultiprocessorCount, dev) != hipSuccess) { grid = -1; return; }
        if (hipFuncSetAttribute((const void*)mk_fwd, hipFuncAttributeMaxDynamicSharedMemorySize, LDS_BYTES) != hipSuccess) { fprintf(stderr, "kernel_launch: hipFuncSetAttribute failed\n"); grid = -1; return; }
        if (hipOccupancyMaxActiveBlocksPerMultiprocessor(&per_cu, (const void*)mk_fwd, NWAVES * 64, LDS_BYTES) != hipSuccess || per_cu < 1) { fprintf(stderr, "kernel_launch: occupancy query reports %d\n", per_cu); }
        (void)hipGetLastError();
        grid = cus;
        if (grid < 128) { fprintf(stderr, "kernel_launch: built for a >= 128-CU device (64 GLA scan workgroups + weight-copy workgroups); got %d\n", grid); grid = -1; return; }
    }
    if (grid < 0) return;
    if (hipMemsetAsync((char*)d_ws + WS_CTL, 0, CTL_ZERO_BYTES, stream) != hipSuccess) return;
    Args a{};
    const float** ap = (const float**)&a;
    for (int i = 0; i < 28; ++i) ap[i] = (const float*)d_in[i];
    a.out = (float*)d_out; a.ws = (unsigned char*)d_ws;
    if (MK_N_LAUNCHES == 1) { a.ph_lo = 0; a.ph_hi = N_PHASES; hipLaunchKernelGGL(mk_fwd, dim3(grid), dim3(NWAVES * 64), LDS_BYTES, stream, a); }
    else { for (int p = 0; p < N_PHASES; ++p) { a.ph_lo = p; a.ph_hi = p + 1; hipLaunchKernelGGL(mk_fwd, dim3(grid), dim3(NWAVES * 64), LDS_BYTES, stream, a); } }
}
```

```cpp
#include <hip/hip_runtime.h>
#include <cstdio>
#include <cstdint>

#ifndef PROBE_DUP
#define PROBE_DUP -1
#endif
#ifndef MK_N_LAUNCHES
#define MK_N_LAUNCHES 1
#endif

#define LAS __attribute__((address_space(3)))
#define GAS __attribute__((address_space(1)))
typedef unsigned short bf16;
typedef short bf16x8 __attribute__((ext_vector_type(8)));
typedef short s16x4 __attribute__((ext_vector_type(4)));
typedef float f32x4 __attribute__((ext_vector_type(4)));
typedef float f32x2 __attribute__((ext_vector_type(2)));
typedef float f32x16 __attribute__((ext_vector_type(16)));
typedef unsigned u32x4 __attribute__((ext_vector_type(4)));
typedef unsigned u32x2 __attribute__((ext_vector_type(2)));

constexpr int D = 1024, BATCH = 16, SEQ = 4096, M = BATCH * SEQ;
constexpr int FFN = 2816, NEXP = 8, EXPD = 3584;
constexpr int GLA_N = 3584;
constexpr float EPS = 1e-6f;
constexpr float LOG2E = 1.4426950408889634f;
constexpr int NWAVES = 8;
constexpr int MAXSLOT = M + NEXP * 256;

constexpr size_t MiB = 1u << 20;
constexpr size_t WS_CTL = 0, CTL_ZERO_BYTES = 64 * 1024;
constexpr size_t WS_MOD = 256 * 1024;
constexpr size_t WS_LCNT = 1 * MiB + 256 * 1024;
constexpr size_t WS_META = 1 * MiB + 512 * 1024;
constexpr size_t WS_ROUTE = 2 * MiB;
constexpr size_t WS_TOKSLOT = 4 * MiB;
constexpr size_t WS_GSLOT = 5 * MiB;
constexpr size_t WS_W_DAIN = 8 * MiB, WS_W_DAOUT = 14 * MiB, WS_W_FFN13 = 16 * MiB, WS_W_FFN2 = 27 * MiB;
constexpr size_t WS_W_GLAIN = 33 * MiB, WS_W_GLAOUT = 40 * MiB, WS_W_MOE13 = 42 * MiB, WS_W_MOE2 = 154 * MiB;
constexpr size_t WS_H = 210 * MiB;
constexpr size_t WS_Q = 338 * MiB;
constexpr size_t WS_END = WS_Q + 464 * MiB;
constexpr size_t WS_XB = WS_END;
constexpr size_t WS_TOTAL = WS_XB + (size_t)M * D * 2;
constexpr size_t GA_UNIT = 43008;
static_assert(4096 * GA_UNIT <= (size_t)M * D * 4, "the GLA per-chunk operands are parked in d_out (free until the last phase writes the result)");
static_assert(WS_TOKSLOT + 2 * MAXSLOT * 4 <= WS_GSLOT && WS_GSLOT + 2 * MAXSLOT * 4 <= WS_W_DAIN, "ws map");
static_assert(WS_W_FFN2 + (size_t)D * FFN * 2 <= WS_W_GLAIN && WS_W_GLAIN + (size_t)GLA_N * D * 2 <= WS_W_GLAOUT, "ws map");
static_assert(WS_W_MOE13 + (size_t)NEXP * 2 * EXPD * D * 2 <= WS_W_MOE2 && WS_W_MOE2 + (size_t)NEXP * D * EXPD * 2 <= WS_H, "ws map");
static_assert((size_t)MAXSLOT * EXPD * 2 <= 464 * MiB && (size_t)M * 3072 * 2 + (size_t)M * 512 * 2 <= 464 * MiB, "ws map");
constexpr int CW_BAR = 4096, CW_KCNT = 8192;

constexpr int RING_BYTES = 131072;
constexpr int TAB_OFF = RING_BYTES;
constexpr int MISC_OFF = 155648;
constexpr int LDS_BYTES = MISC_OFF + 1024;

__device__ __forceinline__ unsigned f2bf(float f) { unsigned u = __builtin_bit_cast(unsigned, f); return (u + 0x7fffu + ((u >> 16) & 1u)) >> 16; }
__device__ __forceinline__ unsigned pk2(float lo, float hi) { return f2bf(lo) | (f2bf(hi) << 16); }
__device__ __forceinline__ float bf2f(unsigned short b) { return __builtin_bit_cast(float, ((unsigned)b) << 16); }
__device__ __forceinline__ unsigned cvt_pk_bf16(float lo, float hi) { unsigned r; asm volatile("v_cvt_pk_bf16_f32 %0, %1, %2" : "=v"(r) : "v"(lo), "v"(hi)); return r; }
__device__ __forceinline__ float wave_sum(float v) {
#pragma unroll
    for (int o = 1; o < 64; o <<= 1) v += __shfl_xor(v, o);
    return v;
}
__device__ __forceinline__ float wave_max(float v) {
#pragma unroll
    for (int o = 1; o < 64; o <<= 1) v = fmaxf(v, __shfl_xor(v, o));
    return v;
}
typedef int v8i __attribute__((ext_vector_type(8)));
typedef int v4i __attribute__((ext_vector_type(4)));
constexpr bool FFN_UP8 = false, FFN_DN8 = true, MOE_UP8 = true, MOE_DN8 = true;
constexpr float W8_SCALE = 64.0f, H8_SCALE = 8.0f, A8_SCALE = 4.0f;
__device__ __forceinline__ float clamp448(float x) { return fminf(fmaxf(x, -448.0f), 448.0f); }
__device__ __forceinline__ unsigned pk_fp8x4(float a, float b, float c, float d) {
    unsigned w = 0u; w = __builtin_amdgcn_cvt_pk_fp8_f32(clamp448(a), clamp448(b), w, false); w = __builtin_amdgcn_cvt_pk_fp8_f32(clamp448(c), clamp448(d), w, true); return w; }
__device__ __forceinline__ f32x4 ld_bf16x4(const bf16* p) { const u32x2 w = *(const u32x2*)p; return (f32x4){__builtin_bit_cast(float, w[0] << 16), __builtin_bit_cast(float, w[0] & 0xffff0000u), __builtin_bit_cast(float, w[1] << 16), __builtin_bit_cast(float, w[1] & 0xffff0000u)}; }
__device__ __forceinline__ void st_bf16x4(bf16* p, f32x4 v) { *(u32x2*)p = (u32x2){cvt_pk_bf16(v[0], v[1]), cvt_pk_bf16(v[2], v[3])}; }
__device__ __forceinline__ float fast_silu(float a) { return a * __builtin_amdgcn_rcpf(1.0f + __builtin_amdgcn_exp2f(-a * LOG2E)); }

namespace pg8 {
constexpr int BM = 256, BK = 64, HALF = 128, HTB = HALF * BK * 2, STAGE_BYTES = 8 * HTB, NXCD = 8, WGM = 8;
__host__ __device__ __forceinline__ int lds_byte(int r, int c) { const int st = (r >> 4) * 2 + (c >> 5), rr = r & 15, cc = c & 31, ob = rr * 64 + cc * 2; return st * 1024 + (ob ^ (((ob >> 9) & 1) << 5)); }
__host__ __device__ __forceinline__ void stage_rc(int b, int& R, int& C) { const int st = b / 1024, sb = b % 1024, swz = sb ^ (((sb >> 9) & 1) << 5); R = (st >> 1) * 16 + swz / 64; C = (st & 1) * 32 + (swz % 64) / 2; }
__host__ __device__ __forceinline__ int perm32(int rho) { const int n = rho >> 4, i = rho & 15; return 8 * (i >> 2) + 4 * n + (i & 3); }

struct Unit { int pm, pn, k0, nk, part; };
struct TileOrder {
    int nM, nN, nwg, G, c;
    __device__ void init(int nM_, int nN_, int G_, int c_) { nM = nM_; nN = nN_; nwg = nM * nN; G = G_; c = c_; }
    __device__ bool next(int i, Unit& u) const { return at((long)i * G + c, u); }
    __device__ bool at(const long L, Unit& u) const {
        if (L >= nwg) return false;
        int wgid = (int)L; { const int q = nwg / NXCD, r = nwg % NXCD, xcd = wgid % NXCD, off = wgid / NXCD; wgid = (xcd < r ? xcd * (q + 1) : r * (q + 1) + (xcd - r) * q) + off; }
        const int nig = WGM * nN, gid = wgid / nig, fm = gid * WGM, gsz = (nM - fm) < WGM ? (nM - fm) : WGM;
        u.pm = fm + ((wgid % nig) % gsz); u.pn = (wgid % nig) / gsz; return true;
    }
};
struct DenseSched : TileOrder {
    const char* A; const char* Bt; size_t tstep;
    __device__ __forceinline__ const char* a_base(const Unit& u) const { return A + (size_t)u.pm * tstep; }
    __device__ __forceinline__ const char* b_base(const Unit& u) const { return Bt + (size_t)u.pn * tstep; }
    __device__ __forceinline__ unsigned row_off(const Unit&, int) const { return 0u; }
};
struct MoeSched : TileOrder {
    const char* A; const char* Bt; size_t a_tstep, b_tstep, b_estride; const int* tokslot; unsigned rowbytes; int g1, g2, g3, g4, g5, g6, g7;
    __device__ __forceinline__ int expert(int pm) const { const int r = pm * 256; return (r >= g1) + (r >= g2) + (r >= g3) + (r >= g4) + (r >= g5) + (r >= g6) + (r >= g7); }
    __device__ __forceinline__ const char* a_base(const Unit& u) const { return A + (size_t)u.pm * a_tstep; }
    __device__ __forceinline__ const char* b_base(const Unit& u) const { return Bt + (size_t)expert(u.pm) * b_estride + (size_t)u.pn * b_tstep; }
    __device__ __forceinline__ unsigned row_off(const Unit& u, int r) const { int t = tokslot[u.pm * 256 + r]; t = t < 0 ? 0 : t; return (unsigned)t * rowbytes; }
};
struct MoeSchedTail : MoeSched {
    int pmT, pnT, k0T, nkT;
    __device__ bool next(int i, Unit& u) const { if (i != 0) return false; u.pm = pmT; u.pn = pnT; u.k0 = k0T; u.nk = nkT; u.part = 1; return true; }
};

struct EpiQKV {
    static constexpr bool PERM = true;
    bf16* Q; size_t tstride; const float* qg; const float* kg; float qscale;
    __device__ __forceinline__ void operator()(const f32x4 (&acc)[2][2][4][2], const Unit& u, int wr, int wc, int fr, int fq) const {
        const int t = u.pn >> 2;
        bf16* base = Q + (size_t)t * tstride;
        const int lc0 = 256 * (u.pn & 3) + 64 * wc + 8 * fq;
        const int row0 = u.pm * BM + wr * 64 + fr;
        if (t < 2) {
            const float* g = qg; if (t == 1) g = kg;
            g += 64 * (wc & 1) + 8 * fq;
            f32x4 gv[2][2];
#pragma unroll
            for (int bj = 0; bj < 2; ++bj)
#pragma unroll
                for (int n = 0; n < 2; ++n) gv[bj][n] = *(const f32x4*)(g + 32 * bj + 4 * n);
            float sc = 1.0f; if (t == 0) sc = qscale;
#pragma unroll
            for (int ai = 0; ai < 2; ++ai)
#pragma unroll
                for (int m = 0; m < 4; ++m) {
                    float ss = 0.f;
#pragma unroll
                    for (int bj = 0; bj < 2; ++bj)
#pragma unroll
                        for (int n = 0; n < 2; ++n) { const f32x4 x = acc[ai][bj][m][n]; ss += (x[0] * x[0] + x[1] * x[1]) + (x[2] * x[2] + x[3] * x[3]); }
                    ss += __shfl_xor(ss, 16); ss += __shfl_xor(ss, 32);
                    const float rs = __builtin_amdgcn_rsqf(ss * (1.0f / 64.0f) + EPS) * sc;
                    bf16* rowp = base + (size_t)(row0 + ai * HALF + m * 16) * D + lc0;
#pragma unroll
                    for (int bj = 0; bj < 2; ++bj) { const f32x4 v0 = acc[ai][bj][m][0] * rs * gv[bj][0], v1 = acc[ai][bj][m][1] * rs * gv[bj][1];
                        u32x4 w; w.x = cvt_pk_bf16(v0[0], v0[1]); w.y = cvt_pk_bf16(v0[2], v0[3]); w.z = cvt_pk_bf16(v1[0], v1[1]); w.w = cvt_pk_bf16(v1[2], v1[3]);
                        *(u32x4*)(rowp + 32 * bj) = w; }
                }
        } else {
#pragma unroll
            for (int ai = 0; ai < 2; ++ai)
#pragma unroll
                for (int m = 0; m < 4; ++m) { bf16* rowp = base + (size_t)(row0 + ai * HALF + m * 16) * D + lc0;
#pragma unroll
                    for (int bj = 0; bj < 2; ++bj) { const f32x4 v0 = acc[ai][bj][m][0], v1 = acc[ai][bj][m][1];
                        u32x4 w; w.x = cvt_pk_bf16(v0[0], v0[1]); w.y = cvt_pk_bf16(v0[2], v0[3]); w.z = cvt_pk_bf16(v1[0], v1[1]); w.w = cvt_pk_bf16(v1[2], v1[3]);
                        *(u32x4*)(rowp + 32 * bj) = w; } }
        }
    }
};
template <bool BASE16, bool OUT16> struct EpiResid {
    static constexpr bool PERM = false;
    const void* base; void* out; const float* gate; float descale;
    __device__ __forceinline__ void operator()(const f32x4 (&acc)[2][2][4][2], const Unit& u, int wr, int wc, int fr, int fq) const {
        const int row0 = u.pm * BM + wr * 64 + fr, col0 = u.pn * BM + wc * 32 + 4 * fq, b = u.pm >> 4;
        f32x4 gv[2][2];
#pragma unroll
        for (int bj = 0; bj < 2; ++bj)
#pragma unroll
            for (int n = 0; n < 2; ++n) gv[bj][n] = *(const f32x4*)(gate + (size_t)b * 6144 + col0 + bj * HALF + n * 16) * descale;
#pragma unroll
        for (int ai = 0; ai < 2; ++ai)
#pragma unroll
            for (int m = 0; m < 4; ++m) { const size_t off = (size_t)(row0 + ai * HALF + m * 16) * D + col0;
#pragma unroll
                for (int bj = 0; bj < 2; ++bj)
#pragma unroll
                    for (int n = 0; n < 2; ++n) { const size_t o = off + bj * HALF + n * 16;
                        const f32x4 bs = BASE16 ? ld_bf16x4((const bf16*)base + o) : *(const f32x4*)((const float*)base + o);
                        const f32x4 r = bs + gv[bj][n] * acc[ai][bj][m][n];
                        if constexpr (OUT16) st_bf16x4((bf16*)out + o, r); else *(f32x4*)((float*)out + o) = r; }
                asm volatile("" ::: "memory"); }
    }
};
template <bool OUT8> struct EpiSwiGLU {
    static constexpr bool PERM = true;
    void* O; int ldo; float descale;
    __device__ __forceinline__ void operator()(const f32x4 (&acc)[2][2][4][2], const Unit& u, int wr, int wc, int fr, int fq) const {
        const int row0 = u.pm * BM + wr * 64 + fr, col0 = u.pn * HALF + wc * 32 + 8 * fq;
#pragma unroll
        for (int ai = 0; ai < 2; ++ai)
#pragma unroll
            for (int m = 0; m < 4; ++m) { const unsigned eo = (unsigned)(row0 + ai * HALF + m * 16) * (unsigned)ldo + (unsigned)col0;
                f32x4 v0, v1;
#pragma unroll
                for (int i = 0; i < 4; ++i) { v0[i] = fast_silu(acc[ai][0][m][0][i] * descale) * (acc[ai][1][m][0][i] * descale); v1[i] = fast_silu(acc[ai][0][m][1][i] * descale) * (acc[ai][1][m][1][i] * descale); }
                if constexpr (OUT8) { v0 = v0 * A8_SCALE; v1 = v1 * A8_SCALE; *(u32x2*)((unsigned char*)O + eo) = (u32x2){pk_fp8x4(v0[0], v0[1], v0[2], v0[3]), pk_fp8x4(v1[0], v1[1], v1[2], v1[3])}; }
                else { u32x4 w; w.x = cvt_pk_bf16(v0[0], v0[1]); w.y = cvt_pk_bf16(v0[2], v0[3]); w.z = cvt_pk_bf16(v1[0], v1[1]); w.w = cvt_pk_bf16(v1[2], v1[3]); *(u32x4*)((bf16*)O + eo) = w; } }
    }
};
struct EpiGLA {
    static constexpr bool PERM = true;
    bf16* P; bf16* LA; const float* ba; const float* og;
    __device__ __forceinline__ void operator()(const f32x4 (&acc)[2][2][4][2], const Unit& u, int wr, int wc, int fr, int fq) const {
        const int row0 = u.pm * BM + wr * 64 + fr;
        if (u.pn < 12) {
            const int col0 = u.pn * BM + wc * 32 + 8 * fq; const bool isr = u.pn >= 8;
            f32x4 gv[2][2];
#pragma unroll
            for (int bj = 0; bj < 2; ++bj)
#pragma unroll
                for (int n = 0; n < 2; ++n) gv[bj][n] = isr ? *(const f32x4*)(og + wc * 32 + 8 * fq + bj * HALF + 4 * n) : (f32x4){1.f, 1.f, 1.f, 1.f};
#pragma unroll
            for (int ai = 0; ai < 2; ++ai)
#pragma unroll
                for (int m = 0; m < 4; ++m) { bf16* rowp = P + (size_t)(row0 + ai * HALF + m * 16) * 3072 + col0;
#pragma unroll
                    for (int bj = 0; bj < 2; ++bj) { f32x4 v0 = acc[ai][bj][m][0], v1 = acc[ai][bj][m][1];
                        if (isr) {
#pragma unroll
                            for (int i = 0; i < 4; ++i) { v0[i] = gv[bj][0][i] * fast_silu(v0[i]); v1[i] = gv[bj][1][i] * fast_silu(v1[i]); } }
                        u32x4 w; w.x = cvt_pk_bf16(v0[0], v0[1]); w.y = cvt_pk_bf16(v0[2], v0[3]); w.z = cvt_pk_bf16(v1[0], v1[1]); w.w = cvt_pk_bf16(v1[2], v1[3]);
                        *(u32x4*)(rowp + bj * HALF) = w; } }
        } else {
            const int col0 = (u.pn - 12) * BM + wc * 32 + 8 * fq;
            f32x4 bv[2][2];
#pragma unroll
            for (int bj = 0; bj < 2; ++bj)
#pragma unroll
                for (int n = 0; n < 2; ++n) bv[bj][n] = *(const f32x4*)(ba + col0 + bj * HALF + 4 * n);
#pragma unroll
            for (int ai = 0; ai < 2; ++ai)
#pragma unroll
                for (int m = 0; m < 4; ++m) { bf16* rowp = LA + (size_t)(row0 + ai * HALF + m * 16) * 512 + col0;
#pragma unroll
                    for (int bj = 0; bj < 2; ++bj) { f32x4 v[2];
#pragma unroll
                        for (int n = 0; n < 2; ++n)
#pragma unroll
                            for (int i = 0; i < 4; ++i) { const float z = acc[ai][bj][m][n][i] + bv[bj][n][i];
                                v[n][i] = (fminf(z, 0.f) - __logf(1.0f + __expf(-fabsf(z)))) * (1.0f / 16.0f); }
                        u32x4 w; w.x = cvt_pk_bf16(v[0][0], v[0][1]); w.y = cvt_pk_bf16(v[0][2], v[0][3]); w.z = cvt_pk_bf16(v[1][0], v[1][1]); w.w = cvt_pk_bf16(v[1][2], v[1][3]);
                        *(u32x4*)(rowp + bj * HALF) = w; } }
        }
    }
};
template <bool FINAL> struct EpiMoeDown {
    static constexpr bool PERM = false;
    const int* tokslot; const float* gslot; bf16* xb; float* outf; const float* gate; float descale;
    __device__ __forceinline__ void operator()(const f32x4 (&acc)[2][2][4][2], const Unit& u, int wr, int wc, int fr, int fq) const {
        const int srow0 = u.pm * BM + wr * 64 + fr, col0 = u.pn * BM + wc * 32 + 4 * fq;
#pragma unroll
        for (int ai = 0; ai < 2; ++ai)
#pragma unroll
            for (int m = 0; m < 4; ++m) { const int srow = srow0 + ai * HALF + m * 16; const int tok = tokslot[srow];
                if (tok >= 0) { const float g = gslot[srow] * descale; const float* gp = gate + (size_t)(tok >> 12) * 6144 + col0; const size_t ro = (size_t)tok * D + col0;
#pragma unroll
                    for (int bj = 0; bj < 2; ++bj)
#pragma unroll
                        for (int n = 0; n < 2; ++n) { const f32x4 gv = *(const f32x4*)(gp + bj * HALF + n * 16); const f32x4 bs = ld_bf16x4(xb + ro + bj * HALF + n * 16);
                            const f32x4 r = bs + gv * g * acc[ai][bj][m][n];
                            if constexpr (FINAL) *(f32x4*)(outf + ro + bj * HALF + n * 16) = r; else st_bf16x4(xb + ro + bj * HALF + n * 16, r); } }
                asm volatile("" ::: "memory"); }
    }
    __device__ __forceinline__ void slice(const f32x4 (&v)[2][2], const Unit& u, int ai, int m, int wr, int wc, int fr, int fq) const {
        const int srow = u.pm * BM + wr * 64 + fr + ai * HALF + m * 16, col0 = u.pn * BM + wc * 32 + 4 * fq; const int tok = tokslot[srow];
        if (tok >= 0) { const float g = gslot[srow] * descale; const float* gp = gate + (size_t)(tok >> 12) * 6144 + col0; const size_t ro = (size_t)tok * D + col0;
#pragma unroll
            for (int bj = 0; bj < 2; ++bj)
#pragma unroll
                for (int n = 0; n < 2; ++n) { const f32x4 gv = *(const f32x4*)(gp + bj * HALF + n * 16); const f32x4 bs = ld_bf16x4(xb + ro + bj * HALF + n * 16);
                    const f32x4 r = bs + gv * g * v[bj][n];
                    if constexpr (FINAL) *(f32x4*)(outf + ro + bj * HALF + n * 16) = r; else st_bf16x4(xb + ro + bj * HALF + n * 16, r); } }
    }
};
struct EpiPartStore {
    static constexpr bool PERM = false;
    float* part;
    __device__ __forceinline__ void operator()(const f32x4 (&acc)[2][2][4][2], const Unit&, int wr, int wc, int fr, int fq) const {
        f32x4* p = (f32x4*)part + ((wr * 4 + wc) * 64 + fq * 16 + fr);
#pragma unroll
        for (int ai = 0; ai < 2; ++ai)
#pragma unroll
            for (int bj = 0; bj < 2; ++bj)
#pragma unroll
                for (int m = 0; m < 4; ++m)
#pragma unroll
                    for (int n = 0; n < 2; ++n) { *p = acc[ai][bj][m][n]; p += 512; asm volatile("" : "+v"(p)); }
    }
};

template <class Epi, class Sched, bool ALIGN_EPI, bool GATHER, bool FP8 = false, bool KSPLIT = false>
__device__ __forceinline__ void gemm_phase(LAS unsigned char* lds, const int RB, const Sched& S, const Epi& E) {
    const int tid = threadIdx.x, wid = __builtin_amdgcn_readfirstlane(tid >> 6), lane = tid & 63, wr = wid >> 2, wc = wid & 3, fr = lane & 15, fq = lane >> 4;
    const int nt = RB / 128;
    unsigned voffB0, voffA0;
    const size_t kstep = (size_t)(BK * 2);
    const size_t hstep = (size_t)HALF * RB;
    const size_t qstep = (size_t)64 * RB;
    { int R, C; stage_rc(tid * 16, R, C); const int Rb = Epi::PERM ? ((R & ~31) + perm32(R & 31)) : R;
        voffB0 = (unsigned)(Rb * RB + C * 2); voffA0 = (unsigned)(R * RB + C * 2); }
    LAS unsigned* mytab = (LAS unsigned*)(lds + STAGE_BYTES) + tid;
#define PG8_TABFILL(par, U) do { _Pragma("unroll") for (int _h = 0; _h < 2; ++_h) _Pragma("unroll") for (int _i = 0; _i < 2; ++_i) { int _R, _C; stage_rc(tid * 16 + _i * 8192, _R, _C); \
        mytab[((par) * 4 + _h * 2 + _i) * 512] = S.row_off(U, _h * HALF + _R) + (unsigned)_C * 2u; } } while (0)
    const unsigned ldsw = (unsigned)wid * 1024u;
    const int aoff = lds_byte(wr * 64 + fr, fq * 8), boff = lds_byte(wc * 32 + fr, fq * 8);
#define PG8_SA(b, h) (((b) * 2 + (h)) * HTB)
#define PG8_SB(b, h) ((4 + (b) * 2 + (h)) * HTB)
#define PG8_STAGE_B(bufoff, gbase) do { _Pragma("unroll") for (int _i = 0; _i < 2; ++_i) \
        __builtin_amdgcn_global_load_lds((const unsigned*)((const char*)(gbase) + _i * qstep + voffB0), (LAS unsigned*)(lds + (bufoff) + ldsw + _i * 8192), 16, 0, 0); } while (0)
#define PG8_STAGE_A(bufoff, gbase, va, h) do { _Pragma("unroll") for (int _i = 0; _i < 2; ++_i) \
        __builtin_amdgcn_global_load_lds((const unsigned*)((const char*)(gbase) + (GATHER ? (size_t)0 : (size_t)(h) * hstep + _i * qstep) + (GATHER ? (va)[h][_i] : voffA0)), (LAS unsigned*)(lds + (bufoff) + ldsw + _i * 8192), 16, 0, 0); } while (0)
#define PG8_LDA(dst, b, h) do { _Pragma("unroll") for (int m = 0; m < 4; ++m) { if constexpr (FP8) dst##8[m] = __builtin_shufflevector(*(const LAS v4i*)(lds + PG8_SA(b, h) + aoff + m * 2048), *(const LAS v4i*)(lds + PG8_SA(b, h) + aoff + m * 2048 + 1024), 0, 1, 2, 3, 4, 5, 6, 7); \
        else { _Pragma("unroll") for (int k = 0; k < 2; ++k) dst[m][k] = *(const LAS bf16x8*)(lds + PG8_SA(b, h) + aoff + m * 2048 + k * 1024); } } } while (0)
#define PG8_LDB(dst, b, h) do { _Pragma("unroll") for (int n = 0; n < 2; ++n) { if constexpr (FP8) dst##8[n] = __builtin_shufflevector(*(const LAS v4i*)(lds + PG8_SB(b, h) + boff + n * 2048), *(const LAS v4i*)(lds + PG8_SB(b, h) + boff + n * 2048 + 1024), 0, 1, 2, 3, 4, 5, 6, 7); \
        else { _Pragma("unroll") for (int k = 0; k < 2; ++k) dst[n][k] = *(const LAS bf16x8*)(lds + PG8_SB(b, h) + boff + n * 2048 + k * 1024); } } } while (0)
#define PG8_CAT(x0, x1) __builtin_shufflevector(__builtin_bit_cast(v4i, x0), __builtin_bit_cast(v4i, x1), 0, 1, 2, 3, 4, 5, 6, 7)
#define PG8_MMA(ai, bj, At, Bt) do { __builtin_amdgcn_s_setprio(1); _Pragma("unroll") for (int m = 0; m < 4; ++m) _Pragma("unroll") for (int n = 0; n < 2; ++n) { \
        if constexpr (FP8) asm volatile("v_mfma_scale_f32_16x16x128_f8f6f4 %0, %1, %2, %0, %3, %3 op_sel_hi:[0,0,0]" : "+v"(acc[ai][bj][m][n]) : "v"(Bt##8[n]), "v"(At##8[m]), "v"(sc8));   \
        else { _Pragma("unroll") for (int k = 0; k < 2; ++k) acc[ai][bj][m][n] = __builtin_amdgcn_mfma_f32_16x16x32_bf16(Bt[n][k], At[m][k], acc[ai][bj][m][n], 0, 0, 0); } } \
        __builtin_amdgcn_s_setprio(0); } while (0)
#define PG8_WAIT_V(n) asm volatile("s_waitcnt vmcnt(" #n ")" ::: "memory")
#define PG8_WAIT_L(n) asm volatile("s_waitcnt lgkmcnt(" #n ")" ::: "memory")
#define PG8_BAR __builtin_amdgcn_s_barrier()
#define PG8_SCHED __builtin_amdgcn_sched_barrier(0)
    Unit cur, nxt; int ui = 0;
    if (!S.next(0, cur)) return;
    f32x4 acc[2][2][4][2];
#pragma unroll
    for (int a = 0; a < 2; ++a)
#pragma unroll
        for (int b = 0; b < 2; ++b)
#pragma unroll
            for (int m = 0; m < 4; ++m)
#pragma unroll
                for (int n = 0; n < 2; ++n) acc[a][b][m][n] = (f32x4){0.f, 0.f, 0.f, 0.f};
    const int sc8 = 0x7f7f7f7f;
    bf16x8 At[4][2], B0[2][2], B1[2][2]; v8i At8[4], B08[2], B18[2];
    const char* cA = S.a_base(cur); const char* cB = S.b_base(cur);
    if constexpr (KSPLIT) { cA += (size_t)cur.k0 * kstep; cB += (size_t)cur.k0 * kstep; }
    unsigned cvA[2][2] = {{0u, 0u}, {0u, 0u}};
    if constexpr (GATHER) {
        PG8_TABFILL(0, cur);
#pragma unroll
        for (int h = 0; h < 2; ++h)
#pragma unroll
            for (int i = 0; i < 2; ++i) cvA[h][i] = mytab[(h * 2 + i) * 512];
    }
    PG8_STAGE_B(PG8_SB(0, 0), cB); PG8_STAGE_B(PG8_SB(0, 1), cB + hstep); PG8_STAGE_A(PG8_SA(0, 0), cA, cvA, 0); PG8_STAGE_A(PG8_SA(0, 1), cA, cvA, 1);
    if (wr == 1) PG8_BAR;
    PG8_WAIT_V(2); PG8_BAR;
    PG8_STAGE_B(PG8_SB(1, 0), cB + kstep); PG8_STAGE_A(PG8_SA(1, 0), cA + kstep, cvA, 0); PG8_STAGE_B(PG8_SB(1, 1), cB + hstep + kstep);
    PG8_WAIT_V(6); PG8_BAR;
    for (;;) {
        const bool has_next = S.next(ui + 1, nxt);
        const char* nA = has_next ? S.a_base(nxt) : cA; const char* nB = has_next ? S.b_base(nxt) : cB;
        if constexpr (KSPLIT) { if (has_next) { nA += (size_t)nxt.k0 * kstep; nB += (size_t)nxt.k0 * kstep; } }
        if constexpr (GATHER) { if (has_next) PG8_TABFILL((ui + 1) & 1, nxt); }
        const int ntc = KSPLIT ? cur.nk : nt;
#pragma unroll 1
        for (int t = 0; t < ntc; t += 2) {
            const bool last = (t == ntc - 2);
            const char* a1 = cA + (size_t)(t + 1) * kstep;
            const char* a2 = last ? nA : cA + (size_t)(t + 2) * kstep; const char* b2 = last ? nB : cB + (size_t)(t + 2) * kstep;
            const char* a3 = a2 + kstep; const char* b3 = b2 + kstep;
            unsigned wA[2][2] = {{0u, 0u}, {0u, 0u}};
            if constexpr (GATHER) {
                const int pc = ui & 1, pw = (last && has_next) ? (pc ^ 1) : pc;
#pragma unroll
                for (int i = 0; i < 2; ++i) { cvA[1][i] = mytab[(pc * 4 + 2 + i) * 512]; wA[0][i] = mytab[(pw * 4 + i) * 512]; wA[1][i] = mytab[(pw * 4 + 2 + i) * 512]; }
            }
            PG8_LDB(B0, 0, 0); PG8_LDB(B1, 0, 1); PG8_SCHED; PG8_LDA(At, 0, 0); PG8_STAGE_A(PG8_SA(1, 1), a1, cvA, 1);
            PG8_WAIT_V(8); PG8_WAIT_L(0); PG8_BAR; PG8_MMA(0, 0, At, B0); PG8_MMA(0, 1, At, B1); PG8_BAR; PG8_SCHED;
            PG8_LDA(At, 0, 1); PG8_STAGE_B(PG8_SB(0, 0), b2); PG8_STAGE_B(PG8_SB(0, 1), b2 + hstep); PG8_STAGE_A(PG8_SA(0, 0), a2, wA, 0);
            PG8_WAIT_V(8); PG8_WAIT_L(0); PG8_BAR; PG8_MMA(1, 0, At, B0); PG8_MMA(1, 1, At, B1); PG8_BAR; PG8_SCHED;
            PG8_LDB(B0, 1, 0); PG8_LDB(B1, 1, 1); PG8_SCHED; PG8_LDA(At, 1, 0); PG8_STAGE_A(PG8_SA(0, 1), a2, wA, 1);
            PG8_WAIT_V(8); PG8_WAIT_L(0); PG8_BAR; PG8_MMA(0, 0, At, B0); PG8_MMA(0, 1, At, B1); PG8_BAR; PG8_SCHED;
            PG8_LDA(At, 1, 1); PG8_STAGE_B(PG8_SB(1, 0), b3); PG8_STAGE_B(PG8_SB(1, 1), b3 + hstep); PG8_STAGE_A(PG8_SA(1, 0), a3, wA, 0);
            PG8_WAIT_V(8); PG8_WAIT_L(0); PG8_BAR; PG8_MMA(1, 0, At, B0); PG8_MMA(1, 1, At, B1); PG8_BAR; PG8_SCHED;
        }
        if constexpr (ALIGN_EPI) { if (wr == 0) PG8_BAR; }
        if constexpr (FP8) asm volatile("s_nop 15\n\ts_nop 15" ::: "memory");
        { int el; asm volatile("v_mbcnt_lo_u32_b32 %0, -1, 0\n\tv_mbcnt_hi_u32_b32 %0, -1, %0" : "=v"(el));
          E(acc, cur, wr, wc, el & 15, el >> 4); }
        if (!has_next) break;
#pragma unroll
        for (int a = 0; a < 2; ++a)
#pragma unroll
            for (int b = 0; b < 2; ++b)
#pragma unroll
                for (int m = 0; m < 4; ++m)
#pragma unroll
                    for (int n = 0; n < 2; ++n) acc[a][b][m][n] = (f32x4){0.f, 0.f, 0.f, 0.f};
        cur = nxt; cA = nA; cB = nB; ++ui;
        if constexpr (ALIGN_EPI) { if (wr == 1) PG8_BAR; }
    }
    PG8_WAIT_V(0);
    if constexpr (!ALIGN_EPI) { if (wr == 0) PG8_BAR; }
    PG8_BAR;
#undef PG8_SA
#undef PG8_SB
#undef PG8_STAGE_A
#undef PG8_TABFILL
#undef PG8_STAGE_B
#undef PG8_LDA
#undef PG8_LDB
#undef PG8_MMA
#undef PG8_CAT
#undef PG8_WAIT_V
#undef PG8_WAIT_L
#undef PG8_BAR
#undef PG8_SCHED
}
}

#define XB_TMO      128
#define XB_XCNT(j)  (256  + 64 * (j))
#define XB_XSUB(j)  (1280 + 64 * (j))
#define XB_XGEN(j)  (2304 + 64 * (j))
#define XB_TOP      3328
#define XB_TOPGEN   3392
#define XCD_BAR_WORDS 3456
#define XB_SPIN_CAP (1u << 18)
__device__ __forceinline__ unsigned xb_ld(unsigned* p)              { return __hip_atomic_load(p, __ATOMIC_RELAXED, __HIP_MEMORY_SCOPE_AGENT); }
__device__ __forceinline__ unsigned xb_add(unsigned* p, unsigned v) { return __hip_atomic_fetch_add(p, v, __ATOMIC_RELAXED, __HIP_MEMORY_SCOPE_AGENT); }
__device__ __forceinline__ unsigned xb_xcc_id() { return (unsigned)__builtin_amdgcn_s_getreg((3 << 11) | 20) & 0xFu; }
#define XB_SPIN(cond, bar) do { unsigned _sp = 0; while (cond) { __builtin_amdgcn_s_sleep(1); \
    if ((++_sp & 255u) == 0u) { if (xb_ld(&(bar)[XB_TMO])) break; if (_sp > XB_SPIN_CAP) { atomicAdd(&(bar)[XB_TMO], 1u); break; } } } } while (0)
struct XcdBarrier { unsigned* bar; unsigned x; volatile LAS unsigned* st; };
__device__ __forceinline__ XcdBarrier xcd_barrier_post(unsigned* bar, volatile LAS unsigned* st) {
    XcdBarrier b; b.bar = bar; b.x = xb_xcc_id(); b.st = st;
    if (threadIdx.x == 0) (void)xb_add(&bar[XB_XCNT(b.x)], 1u);
    return b;
}
__device__ __forceinline__ void xcd_barrier_complete(unsigned* bar, unsigned x, unsigned& nloc, unsigned& nx) {
    const unsigned G = gridDim.x * gridDim.y * gridDim.z;
    unsigned sum, cnt, mine, sp = 0u;
    for (;;) {
        sum = 0u; cnt = 0u; mine = 0u;
#pragma unroll
        for (unsigned j = 0; j < 16; ++j) { const unsigned c = xb_ld(&bar[XB_XCNT(j)]); sum += c; cnt += (c > 0u) ? 1u : 0u; mine = (j == x) ? c : mine; }
        if (sum == G) break;
        __builtin_amdgcn_s_sleep(1);
        if ((++sp & 255u) == 0u) { if (xb_ld(&bar[XB_TMO])) break; if (sp > XB_SPIN_CAP) { atomicAdd(&bar[XB_TMO], 1u); break; } }
    }
    nloc = mine > 0u ? mine : 1u; nx = cnt > 0u ? cnt : 1u;
}
__device__ __forceinline__ void xcd_barrier(const XcdBarrier& b) {
    asm volatile("s_waitcnt vmcnt(0)" ::: "memory");
    __syncthreads();
    if (threadIdx.x == 0) {
        unsigned* bar = b.bar;
        __builtin_amdgcn_s_waitcnt(0);
        unsigned nloc = b.st[0], nx = b.st[1];
        if (nloc == 0u) { xcd_barrier_complete(bar, b.x, nloc, nx); b.st[0] = nloc; b.st[1] = nx; }
        const unsigned old = xb_add(&bar[XB_XSUB(b.x)], 1u);
        const unsigned gen = old / nloc;
        if (old + 1u == (gen + 1u) * nloc) {
            __builtin_amdgcn_fence(__ATOMIC_RELEASE, "agent");
            asm volatile("s_waitcnt vmcnt(0)" ::: "memory");
            const unsigned og = xb_add(&bar[XB_TOP], 1u);
            const unsigned tg = og / nx;
            if (og + 1u == (tg + 1u) * nx) xb_add(&bar[XB_TOPGEN], 1u);
            else XB_SPIN(xb_ld(&bar[XB_TOPGEN]) == tg, bar);
            __builtin_amdgcn_fence(__ATOMIC_ACQUIRE, "agent");
            xb_add(&bar[XB_XGEN(b.x)], 1u);
            asm volatile("s_waitcnt vmcnt(0)" ::: "memory");
        } else {
            XB_SPIN(xb_ld(&bar[XB_XGEN(b.x)]) == gen, bar);
            __builtin_amdgcn_fence(__ATOMIC_ACQUIRE, "agent");
            asm volatile("s_waitcnt vmcnt(0)" ::: "memory");
        }
    }
    __syncthreads();
}

struct Args {
    const float* x; const float* c; const float* ada_w; const float* ada_b; const float* norm1_g; const float* norm2_g;
    const float* da_w_in; const float* da_q_gain; const float* da_k_gain; const float* da_lam_q1; const float* da_lam_k1; const float* da_lam_q2; const float* da_lam_k2;
    const float* da_subln_g; const float* da_w_out;
    const float* gla_w_in; const float* gla_w_a1; const float* gla_w_a2; const float* gla_b_a; const float* gla_out_g; const float* gla_w_out;
    const float* ffn_w1; const float* ffn_w3; const float* ffn_w2;
    const float* moe_router; const float* moe_w1; const float* moe_w3; const float* moe_w2;
    float* out; unsigned char* ws; int ph_lo, ph_hi;
};

__device__ __forceinline__ void p0_transpose_item(const float* W, int ldw, int k0, int n0, bf16* WT, int dst_row0, int Kp, LAS float* scr, int lane) {
#pragma unroll 8
    for (int i = 0; i < 32; ++i) { const int kk = 2 * i + (lane >> 5); scr[kk * 33 + (lane & 31)] = W[(size_t)(k0 + kk) * ldw + n0 + (lane & 31)]; }
    asm volatile("s_waitcnt lgkmcnt(0)" ::: "memory");
    const int c = lane & 7;
#pragma unroll
    for (int j = 0; j < 4; ++j) { const int n = (lane >> 3) + 8 * j; const LAS float* s = scr + (8 * c) * 33 + n;
        u32x4 o; o.x = pk2(s[0 * 33], s[1 * 33]); o.y = pk2(s[2 * 33], s[3 * 33]); o.z = pk2(s[4 * 33], s[5 * 33]); o.w = pk2(s[6 * 33], s[7 * 33]);
        *(u32x4*)(WT + (size_t)(dst_row0 + n) * Kp + k0 + 8 * c) = o; }
    asm volatile("s_waitcnt lgkmcnt(0)" ::: "memory");
}

__device__ __forceinline__ void p0_transpose_item8(const float* W, int ldw, int k0, int n0, unsigned char* WT8, int dst_row0, int Kp, LAS float* scr, int lane) {
#pragma unroll 8
    for (int i = 0; i < 32; ++i) { const int kk = 2 * i + (lane >> 5); scr[kk * 33 + (lane & 31)] = W[(size_t)(k0 + kk) * ldw + n0 + (lane & 31)]; }
    asm volatile("s_waitcnt lgkmcnt(0)" ::: "memory");
    const int c = lane & 7;
#pragma unroll
    for (int j = 0; j < 4; ++j) { const int n = (lane >> 3) + 8 * j; const LAS float* sp = scr + (8 * c) * 33 + n;
        const u32x2 o = (u32x2){pk_fp8x4(sp[0 * 33] * W8_SCALE, sp[1 * 33] * W8_SCALE, sp[2 * 33] * W8_SCALE, sp[3 * 33] * W8_SCALE), pk_fp8x4(sp[4 * 33] * W8_SCALE, sp[5 * 33] * W8_SCALE, sp[6 * 33] * W8_SCALE, sp[7 * 33] * W8_SCALE)};
        *(u32x2*)(WT8 + (size_t)(dst_row0 + n) * Kp + k0 + 8 * c) = o; }
    asm volatile("s_waitcnt lgkmcnt(0)" ::: "memory");
}

namespace att {
__device__ __forceinline__ int crow(int r, int hi) { return (r & 3) + 8 * (r >> 2) + 4 * hi; }
__host__ __device__ constexpr int dwin(int h) { return (int)(150.0 / (1.4426950408889634 / (double)(1 << (h + 1)))); }
__host__ __device__ constexpr int tstart(int h, int jq) { const int q0 = 128 * jq, d = dwin(h); return q0 > d ? (q0 - d) / 64 : 0; }
struct Plan { unsigned char n[16]; unsigned char u[16][48]; };
constexpr Plan make_plan() {
    Plan p{}; int load[16] = {};
    for (int w = 0; w < 16; ++w) p.n[w] = 0;
    for (int h = 7; h >= 0; --h) {
        int cost[32] = {}, ord[32] = {};
        for (int j = 0; j < 32; ++j) { cost[j] = 2 * j + 2 - tstart(h, j); ord[j] = j; }
        for (int a = 1; a < 32; ++a) { const int x = ord[a]; int b = a - 1; while (b >= 0 && cost[ord[b]] < cost[x]) { ord[b + 1] = ord[b]; --b; } ord[b + 1] = x; }
        for (int a = 0; a < 32; ++a) { int best = 0; for (int w = 1; w < 16; ++w) if (load[w] < load[best]) best = w;
            p.u[best][p.n[best]++] = (unsigned char)(h * 32 + ord[a]); load[best] += cost[ord[a]]; }
    }
    return p;
}
__device__ const Plan PLAN = make_plan();
constexpr int BUFB = 32768, NBUF = 3, KOFF = 0, VOFF = 16384, WSF_OFF = NBUF * BUFB;
__device__ __forceinline__ s16x4 vtr(const LAS unsigned char* p) { return __builtin_bit_cast(s16x4, __builtin_amdgcn_ds_read_tr16_b64_v4i16((LAS s16x4*)p)); }

__device__ __forceinline__ void attn_unit(LAS unsigned char* lds, const bf16* Q, const bf16* K, const bf16* V, bf16* O, int b, int h, int jq,
                                          float sl2, float mref0, float mref1, float lam, const float* subg) {
    const int tid = threadIdx.x, lane = tid & 63, r32 = lane & 31, hi = lane >> 5; const int wid = __builtin_amdgcn_readfirstlane(tid >> 6);
    const int mp = wid >> 2, w4 = wid & 3;
    const size_t rowbase = (size_t)b * SEQ; const int q0 = jq * 128;
    const int nT = (q0 >> 6) + 2, myc = (q0 + 32 * w4) >> 6, t0 = tstart(h, jq);
    const bf16* Qw = Q + (rowbase + q0 + 32 * w4 + r32) * D + h * 128 + mp * 64 + hi * 8;
    bf16x8 qr[4];
#pragma unroll
    for (int d0 = 0; d0 < 4; ++d0) qr[d0] = *(const bf16x8*)(Qw + d0 * 16);
    const bf16* ksrc = K + (rowbase + lane) * D + h * 128 + wid * 8;
    const int p0 = wid, p1 = wid + 8;
    const bf16* vsrc0 = V + (rowbase + 16 * (p0 & 3) + (lane >> 2)) * D + h * 128 + 32 * (p0 >> 2) + (lane & 3) * 8;
    const bf16* vsrc1 = V + (rowbase + 16 * (p1 & 3) + (lane >> 2)) * D + h * 128 + 32 * (p1 >> 2) + (lane & 3) * 8;
#define ATT_DMA1(gp_, la_) asm volatile("s_mov_b32 m0, %0\n\ts_nop 0\n\tglobal_load_lds_dwordx4 %1, off" :: "s"(la_), "v"(gp_) : "memory", "m0")
#define ATT_DMA(t, bs) do { const size_t go = (size_t)(t) * 64 * D; const unsigned bb_ = (unsigned)__builtin_amdgcn_readfirstlane((int)(ldsu + (unsigned)((bs) * BUFB))); \
        ATT_DMA1(ksrc + go, bb_ + (unsigned)(KOFF + wid * 1024)); \
        ATT_DMA1(ksrc + go + 64, bb_ + (unsigned)(KOFF + 8192 + wid * 1024)); \
        ATT_DMA1(vsrc0 + go, bb_ + (unsigned)(VOFF + p0 * 1024)); \
        ATT_DMA1(vsrc1 + go, bb_ + (unsigned)(VOFF + p1 * 1024)); } while (0)
    const unsigned ldsu = (unsigned)(unsigned long long)lds;
    const float qpos = (float)(q0 + 32 * w4 + r32);
    const float mref = mp ? mref1 : mref0;
    const float baseL = -sl2 * qpos - mref, sl8 = 8.0f * sl2, sl32 = 32.0f * sl2;
    float lsum = 0.f; f32x16 o[4];
#pragma unroll
    for (int d0 = 0; d0 < 4; ++d0)
#pragma unroll
        for (int r = 0; r < 16; ++r) o[d0][r] = 0.f;
    ATT_DMA(t0, 0);
    if (t0 + 1 < nT) ATT_DMA(t0 + 1, 1);
    asm volatile("" :: "v"(qr[0]), "v"(qr[1]), "v"(qr[2]), "v"(qr[3]) : "memory");
    int slot = 0;
    for (int t = t0; t < nT; ++t) {
        if (t + 1 < nT) asm volatile("s_waitcnt vmcnt(4)" ::: "memory"); else asm volatile("s_waitcnt vmcnt(0)" ::: "memory");
        asm volatile("s_waitcnt lgkmcnt(0)" ::: "memory"); __builtin_amdgcn_s_barrier(); asm volatile("" ::: "memory");
        if (t + 2 < nT) { const int s2 = slot >= 1 ? slot - 1 : 2; ATT_DMA(t + 2, s2); }
        if (t <= myc) {
            const LAS unsigned char* bb = lds + slot * BUFB;
            f32x16 c0, c1;
            if (t < myc) {
                const float kb = baseL + sl2 * (float)(64 * t + 4 * hi);
#pragma unroll
                for (int r = 0; r < 16; ++r) { c0[r] = (r == 0) ? kb : ((r & 3) ? c0[r - 1] + sl2 : c0[r - 4] + sl8); c1[r] = c0[r] + sl32; }
            } else {
                const float qk = qpos - (float)(64 * t + 4 * hi);
                float x[16];
#pragma unroll
                for (int r = 0; r < 16; ++r) { x[r] = (r == 0) ? qk : ((r & 3) ? x[r - 1] - 1.0f : x[r - 4] - 8.0f); c0[r] = -sl2 * fabsf(x[r]) - mref; c1[r] = -sl2 * fabsf(x[r] - 32.0f) - mref; }
            }
            const LAS unsigned char* kb_ = bb + KOFF + mp * 8192 + hi * 1024 + r32 * 16;
#define ATT_SB() __builtin_amdgcn_sched_barrier(0)
            bf16x8 kf[8];
#pragma unroll
            for (int d0 = 0; d0 < 4; ++d0) { kf[2 * d0] = *(const LAS bf16x8*)(kb_ + d0 * 2048); kf[2 * d0 + 1] = *(const LAS bf16x8*)(kb_ + d0 * 2048 + 512); }
            const LAS unsigned char* vp = bb + VOFF + ((lane >> 4) & 1) * 32 + (lane & 3) * 8 + (4 * hi + ((lane & 15) >> 2)) * 64;
            s16x4 vlo[16], vhi[16];
#pragma unroll
            for (int ks = 0; ks < 2; ++ks)
#pragma unroll
                for (int d0 = 0; d0 < 4; ++d0) { vlo[d0 * 4 + ks] = vtr(vp + d0 * 4096 + ks * 1024); vhi[d0 * 4 + ks] = vtr(vp + d0 * 4096 + ks * 1024 + 512); }
            ATT_SB();
#pragma unroll
            for (int d0 = 0; d0 < 4; ++d0) c0 = __builtin_amdgcn_mfma_f32_32x32x16_bf16(kf[2 * d0], qr[d0], c0, 0, 0, 0);
            ATT_SB();
            float sacc = 0.f;
#pragma unroll
            for (int d0 = 0; d0 < 4; ++d0) {
                c1 = __builtin_amdgcn_mfma_f32_32x32x16_bf16(kf[2 * d0 + 1], qr[d0], c1, 0, 0, 0);
                ATT_SB();
#pragma unroll
                for (int e = 0; e < 4; ++e) { c0[4 * d0 + e] = __builtin_amdgcn_exp2f(c0[4 * d0 + e]); sacc += c0[4 * d0 + e]; }
                ATT_SB();
            }
            u32x4 pw[4];
#pragma unroll
            for (int g = 0; g < 4; ++g) { pw[0][g] = cvt_pk_bf16(c0[2 * g], c0[2 * g + 1]); pw[1][g] = cvt_pk_bf16(c0[8 + 2 * g], c0[8 + 2 * g + 1]); }
#pragma unroll
            for (int ks = 2; ks < 4; ++ks)
#pragma unroll
                for (int d0 = 0; d0 < 4; ++d0) { vlo[d0 * 4 + ks] = vtr(vp + d0 * 4096 + ks * 1024); vhi[d0 * 4 + ks] = vtr(vp + d0 * 4096 + ks * 1024 + 512); }
            ATT_SB();
#pragma unroll
            for (int j = 0; j < 8; ++j) { const int ks = j >> 2, d0 = j & 3;
                { const s16x4 lo = vlo[d0 * 4 + ks], hh = vhi[d0 * 4 + ks];
                  const bf16x8 vf = (bf16x8){lo[0], lo[1], lo[2], lo[3], hh[0], hh[1], hh[2], hh[3]};
                  o[d0] = __builtin_amdgcn_mfma_f32_32x32x16_bf16(__builtin_bit_cast(bf16x8, pw[ks]), vf, o[d0], 0, 0, 0); }
                ATT_SB();
                c1[2 * j] = __builtin_amdgcn_exp2f(c1[2 * j]); c1[2 * j + 1] = __builtin_amdgcn_exp2f(c1[2 * j + 1]); sacc += c1[2 * j] + c1[2 * j + 1];
                ATT_SB();
            }
            lsum += sacc;
#pragma unroll
            for (int g = 0; g < 4; ++g) { pw[2][g] = cvt_pk_bf16(c1[2 * g], c1[2 * g + 1]); pw[3][g] = cvt_pk_bf16(c1[8 + 2 * g], c1[8 + 2 * g + 1]); }
            ATT_SB();
#pragma unroll
            for (int j = 8; j < 16; ++j) { const int ks = j >> 2, d0 = j & 3;
                const s16x4 lo = vlo[d0 * 4 + ks], hh = vhi[d0 * 4 + ks];
                const bf16x8 vf = (bf16x8){lo[0], lo[1], lo[2], lo[3], hh[0], hh[1], hh[2], hh[3]};
                o[d0] = __builtin_amdgcn_mfma_f32_32x32x16_bf16(__builtin_bit_cast(bf16x8, pw[ks]), vf, o[d0], 0, 0, 0); }
#undef ATT_SB
        }
        slot = slot == 2 ? 0 : slot + 1;
    }
#undef ATT_DMA
#undef ATT_DMA1
    int el; asm volatile("v_mbcnt_lo_u32_b32 %0, -1, 0\n\tv_mbcnt_hi_u32_b32 %0, -1, %0" : "=v"(el));
    const int r32e = el & 31, hie = el >> 5;
    lsum += __shfl_xor(lsum, 32);
    LAS float* wsf = (LAS float*)(lds + WSF_OFF) + wid * 32;
    if (hie == 0) wsf[r32e] = lsum;
    asm volatile("s_waitcnt lgkmcnt(0)" ::: "memory");
    float rl[16];
#pragma unroll
    for (int r = 0; r < 16; ++r) rl[r] = __builtin_amdgcn_rcpf(wsf[crow(r, hie)]);
#pragma unroll
    for (int d0 = 0; d0 < 4; ++d0)
#pragma unroll
        for (int r = 0; r < 16; ++r) o[d0][r] *= rl[r];
    __syncthreads();
    LAS float* X = (LAS float*)lds + w4 * 4096;
    if (mp == 1) {
#pragma unroll
        for (int d0 = 0; d0 < 4; ++d0)
#pragma unroll
            for (int r = 0; r < 16; ++r) X[(d0 * 16 + r) * 64 + el] = o[d0][r];
    }
    __syncthreads();
    if (mp == 0) {
        float ss[16];
#pragma unroll
        for (int r = 0; r < 16; ++r) ss[r] = 0.f;
#pragma unroll
        for (int d0 = 0; d0 < 4; ++d0)
#pragma unroll
            for (int r = 0; r < 16; ++r) { const float dd = o[d0][r] - lam * X[(d0 * 16 + r) * 64 + el]; o[d0][r] = dd; ss[r] += dd * dd; }
#pragma unroll
        for (int r = 0; r < 16; ++r) {
            float s = ss[r];
#pragma unroll
            for (int of = 1; of < 32; of <<= 1) s += __shfl_xor(s, of);
            ss[r] = __builtin_amdgcn_rsqf(s * (1.0f / 128.0f) + EPS) * 0.8f;
        }
        bf16* Ow = O + (rowbase + q0 + 32 * w4) * D + h * 128 + r32e;
#pragma unroll
        for (int d0 = 0; d0 < 4; ++d0) { const float gcol = subg[32 * d0 + r32e];
#pragma unroll
            for (int r = 0; r < 16; ++r) Ow[(size_t)crow(r, hie) * D + 32 * d0] = (bf16)f2bf(o[d0][r] * ss[r] * gcol); }
    }
    __syncthreads();
}
}

__global__ void __launch_bounds__(NWAVES * 64, 2) mk_fwd(Args args) {
    extern __shared__ __attribute__((aligned(16))) unsigned char lds_raw[];
    LAS unsigned char* lds = (LAS unsigned char*)lds_raw;
    volatile LAS unsigned* MISC = (volatile LAS unsigned*)(lds + MISC_OFF);
    const int tid = threadIdx.x, lane = tid & 63, wave = __builtin_amdgcn_readfirstlane(tid >> 6);
    const int G = gridDim.x; const int bx = blockIdx.x;
    const int vcu = (G % 8 == 0) ? (bx % 8) * (G / 8) + bx / 8 : bx;
    unsigned char* ws = args.ws;
    unsigned* ctl = (unsigned*)(ws + WS_CTL);
    float* MOD = (float*)(ws + WS_MOD);
    unsigned* LCNT = (unsigned*)(ws + WS_LCNT);
    int* META = (int*)(ws + WS_META);
    u32x4* ROUTE = (u32x4*)(ws + WS_ROUTE);
    int* TOKSLOT = (int*)(ws + WS_TOKSLOT);
    float* GSLOT = (float*)(ws + WS_GSLOT);
    bf16* W_DAIN = (bf16*)(ws + WS_W_DAIN); bf16* W_DAOUT = (bf16*)(ws + WS_W_DAOUT); bf16* W_FFN13 = (bf16*)(ws + WS_W_FFN13); bf16* W_FFN2 = (bf16*)(ws + WS_W_FFN2);
    bf16* W_GLAIN = (bf16*)(ws + WS_W_GLAIN); bf16* W_GLAOUT = (bf16*)(ws + WS_W_GLAOUT); bf16* W_MOE13 = (bf16*)(ws + WS_W_MOE13); bf16* W_MOE2 = (bf16*)(ws + WS_W_MOE2);
    bf16* HB = (bf16*)(ws + WS_H);
    bf16* QB = (bf16*)(ws + WS_Q);
    bf16* KB = QB + (size_t)M * D; bf16* VB = KB + (size_t)M * D;
    bf16* ACTB = QB;
    bf16* GP = QB;
    bf16* GLAB = QB + (size_t)M * 3072;
    float* out = args.out;
    bf16* XB = (bf16*)(ws + WS_XB);
    float* KPART = (float*)(ws + WS_Q + 320 * MiB);
    static_assert(MOE_DN8 && (size_t)MAXSLOT * EXPD <= 320 * MiB && 320 * MiB + 256 * (size_t)(32 * 512 * 16) <= 464 * MiB, "K-split partials do not fit behind the MoE activations");

    for (int u = tid; u < 256; u += NWAVES * 64) ((LAS unsigned*)(lds + MISC_OFF))[u] = 0u;
    __syncthreads();
    XcdBarrier bar; bar.bar = ctl + CW_BAR; bar.x = 0; bar.st = nullptr;
    if (MK_N_LAUNCHES == 1) bar = xcd_barrier_post(ctl + CW_BAR, MISC + 8);
    const int lo = args.ph_lo, hi = args.ph_hi;
#define IN(k) (lo <= (k) && (k) < hi)
#define SEAM(k) do { if (IN(k) && IN((k) + 1)) xcd_barrier(bar); } while (0)
    const int gw = vcu * NWAVES + wave, NGW = G * NWAVES;

    if (IN(0)) {
        if (bx < 192) {
            LAS float* cact = (LAS float*)lds;
            for (int e = tid; e < 16 * 1024; e += 512) { const int b = e >> 10, k = e & 1023; const float v = args.c[e]; cact[k * 16 + b] = v / (1.0f + __expf(-v)); }
            __syncthreads();
            const int col = tid & 63, ks = tid >> 6, n = bx * 64 + col, layer = n / 6144, nn = n % 6144;
            const float* wp = args.ada_w + (size_t)layer * 1024 * 6144 + nn;
            float a[16];
#pragma unroll
            for (int b = 0; b < 16; ++b) a[b] = 0.f;
            for (int k = ks * 128; k < ks * 128 + 128; ++k) { const float w = wp[(size_t)k * 6144];
#pragma unroll
                for (int q = 0; q < 4; ++q) { const f32x4 cv = *(const LAS f32x4*)(cact + k * 16 + 4 * q); a[4 * q] += cv[0] * w; a[4 * q + 1] += cv[1] * w; a[4 * q + 2] += cv[2] * w; a[4 * q + 3] += cv[3] * w; } }
            LAS float* red = (LAS float*)(lds + 65536);
#pragma unroll
            for (int b = 0; b < 16; ++b) red[(ks * 16 + b) * 64 + col] = a[b];
            __syncthreads();
            for (int e = tid; e < 1024; e += 512) { const int b = e >> 6, cc = e & 63; float s = 0.f;
#pragma unroll
                for (int k8 = 0; k8 < 8; ++k8) s += red[(k8 * 16 + b) * 64 + cc];
                const int n2 = bx * 64 + cc, l2 = n2 / 6144, nn2 = n2 % 6144;
                MOD[((size_t)l2 * 16 + b) * 6144 + nn2] = s + args.ada_b[l2 * 6144 + nn2]; }
            __syncthreads();
        }
        for (int i = bx * 512 + tid; i < 2 * MAXSLOT; i += G * 512) TOKSLOT[i] = -1;
        LAS float* scr = (LAS float*)(lds + wave * 16384);
        constexpr int I_DAIN = 16 * 96, I_SQ = 16 * 32, I_F13 = 16 * 88, I_F2 = 44 * 32, I_GLAIN = 16 * 96, I_GA = 512;
        constexpr int NITEMS = I_DAIN + I_SQ + 2 * I_F13 + I_F2 + I_GLAIN + I_SQ + I_GA;
        for (int it = gw; it < NITEMS; it += NGW) {
            int r = it;
            if (r < I_DAIN) { const int kb = r / 96, nb = r % 96, n0 = 32 * nb, l = n0 & 255;
                p0_transpose_item(args.da_w_in, 3072, 64 * kb, n0, W_DAIN, (n0 & ~255) + 128 * ((l >> 5) & 1) + 32 * (l >> 6), D, scr, lane); continue; } r -= I_DAIN;
            if (r < I_SQ) { const int kb = r / 32, nb = r % 32; p0_transpose_item(args.da_w_out, D, 64 * kb, 32 * nb, W_DAOUT, 32 * nb, D, scr, lane); continue; } r -= I_SQ;
            if (r < 2 * I_F13) { const int w = r / I_F13, q = r % I_F13, kb = q / 88, nb = q % 88, n0 = 32 * nb;
                if (FFN_UP8) p0_transpose_item8(w ? args.ffn_w3 : args.ffn_w1, FFN, 64 * kb, n0, (unsigned char*)W_FFN13, (n0 >> 7) * 256 + w * 128 + (n0 & 127), D, scr, lane);
                else p0_transpose_item(w ? args.ffn_w3 : args.ffn_w1, FFN, 64 * kb, n0, W_FFN13, (n0 >> 7) * 256 + w * 128 + (n0 & 127), D, scr, lane); continue; } r -= 2 * I_F13;
            if (r < I_F2) { const int kb = r / 32, nb = r % 32; if (FFN_DN8) p0_transpose_item8(args.ffn_w2, D, 64 * kb, 32 * nb, (unsigned char*)W_FFN2, 32 * nb, FFN, scr, lane); else p0_transpose_item(args.ffn_w2, D, 64 * kb, 32 * nb, W_FFN2, 32 * nb, FFN, scr, lane); continue; } r -= I_F2;
            if (r < I_GLAIN) { const int kb = r / 96, nb = r % 96; p0_transpose_item(args.gla_w_in, 3072, 64 * kb, 32 * nb, W_GLAIN, 32 * nb, D, scr, lane); continue; } r -= I_GLAIN;
            if (r < I_SQ) { const int kb = r / 32, nb = r % 32; p0_transpose_item(args.gla_w_out, D, 64 * kb, 32 * nb, W_GLAOUT, 32 * nb, D, scr, lane); continue; } r -= I_SQ;
            if (r < I_GA) {
                const int j = r; float a2[16];
#pragma unroll
                for (int q = 0; q < 16; ++q) a2[q] = args.gla_w_a2[q * 512 + j];
                bf16* dst = W_GLAIN + (size_t)(3072 + j) * D + lane * 16;
                unsigned pk[8];
#pragma unroll
                for (int kk = 0; kk < 16; kk += 2) { float s0 = 0.f, s1 = 0.f; const float* w1p = args.gla_w_a1 + (size_t)(lane * 16 + kk) * 16;
#pragma unroll
                    for (int q = 0; q < 16; ++q) { s0 += w1p[q] * a2[q]; s1 += w1p[16 + q] * a2[q]; }
                    pk[kk >> 1] = pk2(s0, s1); }
                *(u32x4*)dst = (u32x4){pk[0], pk[1], pk[2], pk[3]}; *(u32x4*)(dst + 8) = (u32x4){pk[4], pk[5], pk[6], pk[7]};
                continue; }
        }
    }
    SEAM(0);

#define NORM_LOAD(XSRC, SRC16, m_, v_, s_) do { s_ = 0.f; \
            _Pragma("unroll") for (int j = 0; j < 4; ++j) { v_[j] = (SRC16) ? ld_bf16x4((const bf16*)(XSRC) + (size_t)(m_) * D + 4 * lane + 256 * j) : *((const f32x4*)((const float*)(XSRC) + (size_t)(m_) * D) + lane + 64 * j); s_ += (v_[j][0] * v_[j][0] + v_[j][1] * v_[j][1]) + (v_[j][2] * v_[j][2] + v_[j][3] * v_[j][3]); } } while (0)
#define NORM_ROW(GVEC, MODROW, ROUTER, OUT8, m_, v_, s_) do { const int m = (m_); const int b = m >> 12; f32x4 (&v)[4] = v_; \
            const float* mrow = (MODROW) + (size_t)b * 6144; \
            const float rstd = __builtin_amdgcn_rsqf(wave_sum(s_) * (1.0f / D) + EPS); \
            _Pragma("unroll") for (int j = 0; j < 4; ++j) { const f32x4 gg = *((const f32x4*)(GVEC) + lane + 64 * j), sh = *((const f32x4*)mrow + lane + 64 * j), sc = *((const f32x4*)(mrow + 1024) + lane + 64 * j); \
                v[j] = v[j] * rstd * gg * (sc + 1.0f) + sh; } \
            if (OUT8) { unsigned* o4 = (unsigned*)((unsigned char*)HB + (size_t)m * D) + lane; \
                _Pragma("unroll") for (int j = 0; j < 4; ++j) o4[64 * j] = pk_fp8x4(v[j][0] * H8_SCALE, v[j][1] * H8_SCALE, v[j][2] * H8_SCALE, v[j][3] * H8_SCALE); } \
            else { u32x2* o8 = (u32x2*)(HB + (size_t)m * D) + lane; \
                _Pragma("unroll") for (int j = 0; j < 4; ++j) o8[64 * j] = (u32x2){pk2(v[j][0], v[j][1]), pk2(v[j][2], v[j][3])}; } \
            if (ROUTER) { ROUTER_BODY } } while (0)
#define NORM_PHASE(XSRC, SRC16, GVEC, MODROW, ROUTER, OUT8) do { \
        const int rpw = (M + NGW - 1) / NGW; const int r_lo = (ROUTER ? (bx * NWAVES + wave) : gw) * rpw; \
        for (int rr = 0; rr < rpw; rr += 2) { const int m0 = r_lo + rr; if (m0 >= M) break; const bool two = (rr + 1 < rpw) && (m0 + 1 < M); \
            f32x4 va[4], vb[4]; float sa, sb = 0.f; \
            NORM_LOAD(XSRC, SRC16, m0, va, sa); if (two) NORM_LOAD(XSRC, SRC16, m0 + 1, vb, sb); \
            NORM_ROW(GVEC, MODROW, ROUTER, OUT8, m0, va, sa); if (two) NORM_ROW(GVEC, MODROW, ROUTER, OUT8, m0 + 1, vb, sb); } } while (0)
#define ROUTER_BODY
    if (IN(1)) { NORM_PHASE(args.x, false, args.norm1_g, MOD, 0, false); }
    SEAM(1);

    if (IN(2)) {
        pg8::DenseSched S; S.init(M / 256, 12, G, bx); S.A = (const char*)HB; S.Bt = (const char*)W_DAIN; S.tstep = (size_t)256 * D * 2;
        pg8::EpiQKV E{QB, (size_t)M * D, args.da_q_gain, args.da_k_gain, 0.125f * LOG2E};
        pg8::gemm_phase<pg8::EpiQKV, pg8::DenseSched, true, false>(lds, 2 * D, S, E);
    }
    SEAM(2);

    if (IN(3)) {
        float a1 = args.da_lam_q1[lane] * args.da_lam_k1[lane], a2 = args.da_lam_q2[lane] * args.da_lam_k2[lane];
        const float lam = __expf(wave_sum(a1)) - __expf(wave_sum(a2)) + 0.2f;
        const float gq0 = wave_max(fabsf(args.da_q_gain[lane])), gq1 = wave_max(fabsf(args.da_q_gain[64 + lane]));
        const float gk0 = wave_max(fabsf(args.da_k_gain[lane])), gk1 = wave_max(fabsf(args.da_k_gain[64 + lane]));
        const float mref0 = 8.0f * LOG2E * gq0 * gk0 * 1.01f, mref1 = 8.0f * LOG2E * gq1 * gk1 * 1.01f;
        for (int rep = 0; rep < (PROBE_DUP == 3 ? 2 : 1); ++rep)
        for (int bb = vcu >> 4; bb < BATCH; bb += (G >= 16 ? (G >> 4) : 1)) {
            const int w16 = vcu & 15, nu = att::PLAN.n[w16];
            for (int i = 0; i < nu; ++i) { const int hj = att::PLAN.u[w16][i], h = hj >> 5, jq = hj & 31;
                const float sl2 = LOG2E * exp2f(-(float)(h + 1));
                att::attn_unit(lds, QB, KB, VB, HB, bb, h, jq, sl2, mref0, mref1, lam, args.da_subln_g); }
        }
    }
    SEAM(3);

    if (IN(4)) {
        pg8::DenseSched S; S.init(M / 256, 4, G, bx); S.A = (const char*)HB; S.Bt = (const char*)W_DAOUT; S.tstep = (size_t)256 * D * 2;
        pg8::EpiResid<false, true> E{args.x, XB, MOD + 2048, 1.0f};
        pg8::gemm_phase<pg8::EpiResid<false, true>, pg8::DenseSched, true, false>(lds, 2 * D, S, E);
    }
    SEAM(4);
    if (IN(5)) { NORM_PHASE(XB, true, args.norm2_g, MOD + 3072, 0, FFN_UP8); }
    SEAM(5);

    if (IN(6)) {
        pg8::DenseSched S; S.init(M / 256, 2 * FFN / 256, G, bx); S.A = (const char*)HB; S.Bt = (const char*)W_FFN13; S.tstep = (size_t)256 * D * (FFN_UP8 ? 1 : 2);
        pg8::EpiSwiGLU<FFN_DN8> E{ACTB, FFN, FFN_UP8 ? 1.0f / (H8_SCALE * W8_SCALE) : 1.0f};
        pg8::gemm_phase<pg8::EpiSwiGLU<FFN_DN8>, pg8::DenseSched, true, false, FFN_UP8>(lds, D * (FFN_UP8 ? 1 : 2), S, E);
    }
    SEAM(6);
    if (IN(7)) {
        pg8::DenseSched S; S.init(M / 256, 4, G, bx); S.A = (const char*)ACTB; S.Bt = (const char*)W_FFN2; S.tstep = (size_t)256 * FFN * (FFN_DN8 ? 1 : 2);
        pg8::EpiResid<true, true> E{XB, XB, MOD + 5 * 1024, FFN_DN8 ? 1.0f / (A8_SCALE * W8_SCALE) : 1.0f};
        pg8::gemm_phase<pg8::EpiResid<true, true>, pg8::DenseSched, true, false, FFN_DN8>(lds, FFN * (FFN_DN8 ? 1 : 2), S, E);
    }
    SEAM(7);

    float* MOD1 = MOD + 16 * 6144;
    if (IN(8)) { NORM_PHASE(XB, true, args.norm1_g + D, MOD1, 0, false); }
    SEAM(8);
    if (IN(9)) {
        pg8::DenseSched S; S.init(M / 256, GLA_N / 256, G, bx); S.A = (const char*)HB; S.Bt = (const char*)W_GLAIN; S.tstep = (size_t)256 * D * 2;
        pg8::EpiGLA E{GP, GLAB, args.gla_b_a, args.gla_out_g};
        pg8::gemm_phase<pg8::EpiGLA, pg8::DenseSched, true, false>(lds, 2 * D, S, E);
    }
    SEAM(9);

    unsigned char* GA = (unsigned char*)out;
    static_assert(4096 * GA_UNIT <= 192 * MiB && 256 * MiB <= (size_t)M * D * 4 && (size_t)M * 512 * 2 >= 64 * MiB, "o-fragment parking");
#define OFRAG(b_, n_, h_) (((b_) < 8 ? (unsigned char*)GLAB : (unsigned char*)out + 192 * MiB) + (size_t)(((((b_) & 7) * 64 + (n_)) * 4) + (h_)) * 32768)
    if (IN(10)) {
        LAS unsigned char* QDp = lds; LAS unsigned char* KDTc = lds + 16384; LAS unsigned char* ATc = lds + 32768; LAS float* DV = (LAS float*)(lds + 40960);
        LAS bf16* KI = (LAS bf16*)(lds + 43008); LAS float* QT = (LAS float*)(lds + 60416);
        const int fr = lane & 15, fq = lane >> 4;
        const int j = tid & 127, tq = tid >> 7;
        const int cq = j >> 4, wq = j & 15, hq = (wq >> 2) & 1, jq2 = ((wq >> 3) << 2) | (wq & 3);
        for (int rep = 0; rep < (PROBE_DUP == 10 ? 2 : 1); ++rep)
        for (int u = bx; u < 4096; u += G) {
            const int h = u & 3, n = (u >> 2) & 63, b = u >> 8;
            const size_t R0 = (size_t)b * SEQ + 64 * n;
            float la[16], qv[16], kv[16];
#pragma unroll
            for (int i = 0; i < 16; ++i) { const size_t row = R0 + 16 * tq + i; la[i] = bf2f(GLAB[row * 512 + h * 128 + j]); qv[i] = bf2f(GP[row * 3072 + h * 128 + j]); kv[i] = bf2f(GP[row * 3072 + 512 + h * 128 + j]); }
#pragma unroll
            for (int i = 1; i < 16; ++i) la[i] += la[i - 1];
            QT[tq * 128 + j] = la[15];
            __syncthreads();
            float pre = 0.f, tot = 0.f;
#pragma unroll
            for (int q = 0; q < 4; ++q) { const float v = QT[q * 128 + j]; tot += v; pre += (q < tq) ? v : 0.f; }
            unsigned kdp[8];
#pragma unroll
            for (int i = 0; i < 16; ++i) { const float bb = pre + la[i]; const int t = 16 * tq + i;
                *(LAS bf16*)(QDp + (((cq * 2 + hq) * 64 + t) * 16) + jq2 * 2) = (bf16)f2bf(qv[i] * 0.08838834764831845f * __expf(bb));
                KI[t * 136 + j] = (bf16)f2bf(kv[i] * __expf(-bb));
                const float kd = kv[i] * __expf(tot - bb);
                if (i & 1) kdp[i >> 1] |= f2bf(kd) << 16; else kdp[i >> 1] = f2bf(kd); }
            *(LAS u32x4*)(KDTc + ((2 * tq) * 128 + j) * 16) = (u32x4){kdp[0], kdp[1], kdp[2], kdp[3]};
            *(LAS u32x4*)(KDTc + ((2 * tq + 1) * 128 + j) * 16) = (u32x4){kdp[4], kdp[5], kdp[6], kdp[7]};
            if (tq == 0) DV[j] = __expf(tot);
            __syncthreads();
#pragma unroll
            for (int q = 0; q < 2; ++q) { const int idx = 2 * wave + q, ti = idx >> 2, si = idx & 3;
                f32x4 c = (f32x4){0.f, 0.f, 0.f, 0.f};
                if (si <= ti) {
#pragma unroll
                    for (int ks = 0; ks < 4; ++ks) { const int cc = 2 * ks + (fq >> 1), jb = 4 * (fq & 1), t = 16 * ti + fr;
                        const u32x2 alo = *(const LAS u32x2*)(QDp + (((cc * 2 + 0) * 64 + t) * 16) + jb * 2), ahi = *(const LAS u32x2*)(QDp + (((cc * 2 + 1) * 64 + t) * 16) + jb * 2);
                        const u32x4 af = (u32x4){alo[0], alo[1], ahi[0], ahi[1]};
                        const bf16x8 bfr = *(const LAS bf16x8*)(KI + (16 * si + fr) * 136 + 32 * ks + 8 * fq);
                        c = __builtin_amdgcn_mfma_f32_16x16x32_bf16(__builtin_bit_cast(bf16x8, af), bfr, c, 0, 0, 0); }
                }
#pragma unroll
                for (int r = 0; r < 4; ++r) { const int t = 16 * ti + 4 * fq + r, sx = 16 * si + fr; *(LAS bf16*)(ATc + (((sx >> 3) * 64 + t) * 16) + (sx & 7) * 2) = (bf16)f2bf(sx <= t ? c[r] : 0.f); } }
            __syncthreads();
            { u32x4* dst = (u32x4*)(GA + (size_t)u * GA_UNIT);
              for (int v = tid; v < 41472 / 16; v += 512) dst[v] = *(const LAS u32x4*)(lds + v * 16); }
            __syncthreads();
        }
    }
    SEAM(10);

    const int sstride = G >= 256 ? 4 : (G >= 128 ? 2 : 1);
    const bool is_scan = (vcu % sstride == 0) && (vcu / sstride < 64);
    const int scan_id = vcu / sstride;
    const int copy_id = vcu < 64 * sstride ? (vcu / sstride) * (sstride - 1) + (vcu % sstride) - 1 : 64 * (sstride - 1) + (vcu - 64 * sstride);
    if (IN(11) && !is_scan) {
        LAS float* scr = (LAS float*)(lds + wave * 16384);
        constexpr int I_M13 = 16 * 112, I_M2 = 56 * 32, NIT = NEXP * 2 * I_M13 + NEXP * I_M2;
        const int nwv = (G - 64) * NWAVES;
        for (int rep = 0; rep < (PROBE_DUP == 20 ? 2 : 1); ++rep)
        for (int it = copy_id * NWAVES + wave; it < NIT; it += nwv) {
            int r = it;
            if (r < NEXP * 2 * I_M13) { const int e = r / (2 * I_M13), q2 = r % (2 * I_M13), w = q2 / I_M13, q = q2 % I_M13, kb = q / 112, nb = q % 112, n0 = 32 * nb;
                if (MOE_UP8) p0_transpose_item8((w ? args.moe_w3 : args.moe_w1) + (size_t)e * D * EXPD, EXPD, 64 * kb, n0, (unsigned char*)W_MOE13 + (size_t)e * 2 * EXPD * D, (n0 >> 7) * 256 + w * 128 + (n0 & 127), D, scr, lane);
                else p0_transpose_item((w ? args.moe_w3 : args.moe_w1) + (size_t)e * D * EXPD, EXPD, 64 * kb, n0, W_MOE13 + (size_t)e * 2 * EXPD * D, (n0 >> 7) * 256 + w * 128 + (n0 & 127), D, scr, lane); continue; }
            r -= NEXP * 2 * I_M13;
            { const int e = r / I_M2, q = r % I_M2, kb = q / 32, nb = q % 32;
                if (MOE_DN8) p0_transpose_item8(args.moe_w2 + (size_t)e * EXPD * D, D, 64 * kb, 32 * nb, (unsigned char*)W_MOE2 + (size_t)e * D * EXPD, 32 * nb, EXPD, scr, lane);
                else p0_transpose_item(args.moe_w2 + (size_t)e * EXPD * D, D, 64 * kb, 32 * nb, W_MOE2 + (size_t)e * D * EXPD, 32 * nb, EXPD, scr, lane); }
        }
    }
    if (IN(11) && is_scan) {
        const int b = scan_id >> 2, h = scan_id & 3;
        constexpr int BUFB = 74752, VOFF = 41984, GO_OFF = 2 * BUFB;
        LAS float* GO = (LAS float*)(lds + GO_OFF);
        if (tid < 256) GO[tid] = args.gla_out_g[tid];
        const int r32 = lane & 31, hh = lane >> 5;
        const int c0 = 32 * wave;
        const unsigned char* gabase = GA + ((size_t)b * 256 + h) * GA_UNIT;
        const bf16* vsrc = GP + ((size_t)b * SEQ + (lane >> 2)) * 3072 + 1024 + h * 256 + 32 * wave + (lane & 3) * 8;
#define GLA_DMA(n_, bs_) do { LAS unsigned char* bb_ = lds + (bs_) * BUFB; const unsigned char* ga_ = gabase + (size_t)(n_) * 4 * GA_UNIT; \
        _Pragma("unroll") for (int k_ = 0; k_ < 6; ++k_) { int p_ = wave + 8 * k_; p_ = p_ > 40 ? 40 : p_; \
            __builtin_amdgcn_global_load_lds((const unsigned*)(ga_ + p_ * 1024 + lane * 16), (LAS unsigned*)(bb_ + p_ * 1024), 16, 0, 0); } \
        _Pragma("unroll") for (int ks_ = 0; ks_ < 4; ++ks_) \
            __builtin_amdgcn_global_load_lds((const unsigned*)(vsrc + ((size_t)(n_) * 64 + 16 * ks_) * 3072), (LAS unsigned*)(bb_ + VOFF + (ks_ * 8 + wave) * 1024), 16, 0, 0); } while (0)
#define GLA_BAR() do { asm volatile("s_waitcnt lgkmcnt(0)" ::: "memory"); __builtin_amdgcn_s_barrier(); asm volatile("" ::: "memory"); } while (0)
        for (int rep = 0; rep < (PROBE_DUP == 11 ? 2 : 1); ++rep) {
        f32x16 Sacc[4];
#pragma unroll
        for (int kt = 0; kt < 4; ++kt)
#pragma unroll
            for (int r = 0; r < 16; ++r) Sacc[kt][r] = 0.f;
        GLA_DMA(0, 0);
        asm volatile("s_waitcnt vmcnt(0)" ::: "memory");
        for (int n = 0; n < 64; ++n) {
            const size_t R0 = (size_t)b * SEQ + 64 * n;
            asm volatile("s_waitcnt vmcnt(4)" ::: "memory");
            GLA_BAR();
            if (n + 1 < 64) GLA_DMA(n + 1, (n + 1) & 1);
            LAS unsigned char* bb = lds + (n & 1) * BUFB;
            const LAS unsigned char* QDp = bb; const LAS unsigned char* KDTc = bb + 16384; const LAS unsigned char* ATc = bb + 32768; const LAS float* DV = (const LAS float*)(bb + 40960);
            bf16x8 vf[4];
#pragma unroll
            for (int ks = 0; ks < 4; ++ks) { const LAS unsigned char* vp = bb + VOFF + (ks * 8 + wave) * 1024 + ((lane >> 4) & 1) * 32 + (lane & 3) * 8 + (8 * hh + ((lane & 15) >> 2)) * 64;
                const s16x4 lo = att::vtr(vp), hi4 = att::vtr(vp + 256); vf[ks] = (bf16x8){lo[0], lo[1], lo[2], lo[3], hi4[0], hi4[1], hi4[2], hi4[3]}; }
            f32x16 o[2];
#pragma unroll
            for (int tt = 0; tt < 2; ++tt)
#pragma unroll
                for (int r = 0; r < 16; ++r) o[tt][r] = 0.f;
            bf16x8 qa[16], aa[6];
#pragma unroll
            for (int kt = 0; kt < 4; ++kt)
#pragma unroll
                for (int sx = 0; sx < 2; ++sx)
#pragma unroll
                    for (int tt = 0; tt < 2; ++tt) qa[(kt * 2 + sx) * 2 + tt] = *(const LAS bf16x8*)(QDp + ((((kt * 2 + sx) * 2 + hh) * 64 + 32 * tt + r32) * 16));
#pragma unroll
            for (int i = 0; i < 6; ++i) { const int tt = i < 2 ? 0 : 1, ks = i < 2 ? i : i - 2;
                aa[i] = *(const LAS bf16x8*)(ATc + (((2 * ks + hh) * 64 + 32 * tt + r32) * 16)); }
            __builtin_amdgcn_sched_barrier(0);
#pragma unroll
            for (int kt = 0; kt < 4; ++kt)
#pragma unroll
                for (int sx = 0; sx < 2; ++sx) {
                    u32x4 sb;
#pragma unroll
                    for (int g = 0; g < 4; ++g) sb[g] = cvt_pk_bf16(Sacc[kt][8 * sx + 2 * g], Sacc[kt][8 * sx + 2 * g + 1]);
#pragma unroll
                    for (int tt = 0; tt < 2; ++tt) o[tt] = __builtin_amdgcn_mfma_f32_32x32x16_bf16(qa[(kt * 2 + sx) * 2 + tt], __builtin_bit_cast(bf16x8, sb), o[tt], 0, 0, 0);
                }
#pragma unroll
            for (int i = 0; i < 6; ++i) { const int tt = i < 2 ? 0 : 1, ks = i < 2 ? i : i - 2;
                o[tt] = __builtin_amdgcn_mfma_f32_32x32x16_bf16(aa[i], vf[ks], o[tt], 0, 0, 0); }
            __builtin_amdgcn_sched_barrier(0);
            { u32x4* dst = (u32x4*)(OFRAG(b, n, h)) + (wave * 4) * 64 + lane;
#pragma unroll
              for (int tt = 0; tt < 2; ++tt)
#pragma unroll
                  for (int q = 0; q < 2; ++q) { u32x4 w;
#pragma unroll
                      for (int g = 0; g < 4; ++g) w[g] = cvt_pk_bf16(o[tt][8 * q + 2 * g], o[tt][8 * q + 2 * g + 1]);
                      dst[(tt * 2 + q) * 64] = w; } }
            __builtin_amdgcn_sched_barrier(0);
            f32x4 dvv[16]; bf16x8 ka[16];
#pragma unroll
            for (int kt = 0; kt < 4; ++kt)
#pragma unroll
                for (int g = 0; g < 4; ++g) dvv[kt * 4 + g] = *(const LAS f32x4*)(DV + 32 * kt + 8 * g + 4 * hh);
#pragma unroll
            for (int ks = 0; ks < 4; ++ks)
#pragma unroll
                for (int kt = 0; kt < 4; ++kt) ka[ks * 4 + kt] = *(const LAS bf16x8*)(KDTc + (((2 * ks + hh) * 128 + 32 * kt + r32) * 16));
            __builtin_amdgcn_sched_barrier(0);
#pragma unroll
            for (int kt = 0; kt < 4; ++kt)
#pragma unroll
                for (int g = 0; g < 4; ++g)
#pragma unroll
                    for (int e = 0; e < 4; ++e) Sacc[kt][4 * g + e] *= dvv[kt * 4 + g][e];
#pragma unroll
            for (int ks = 0; ks < 4; ++ks)
#pragma unroll
                for (int kt = 0; kt < 4; ++kt) Sacc[kt] = __builtin_amdgcn_mfma_f32_32x32x16_bf16(ka[ks * 4 + kt], vf[ks], Sacc[kt], 0, 0, 0);
        }
        asm volatile("s_waitcnt vmcnt(0)" ::: "memory");
        GLA_BAR();
        }
#undef GLA_DMA
#undef GLA_BAR
    }
    if (IN(11)) {
        static_assert(MK_N_LAUNCHES == 1, "the scan follow-up sits behind an in-phase grid barrier");
        xcd_barrier(bar);
        LAS float* OS = (LAS float*)lds;
        const int r32 = lane & 31, hh = lane >> 5, c0 = 32 * wave;
        u32x4 fr[4], rwv[4];
#define P10C_LOAD(u_) do { const int b_ = (u_) >> 8, n_ = ((u_) >> 2) & 63, h_ = (u_) & 3; const u32x4* src_ = (const u32x4*)(OFRAG(b_, n_, h_)) + (wave * 4) * 64 + lane; \
            _Pragma("unroll") for (int k_ = 0; k_ < 4; ++k_) fr[k_] = src_[k_ * 64]; \
            const bf16* rp0_ = GP + ((size_t)b_ * SEQ + 64 * n_ + (tid >> 3)) * 3072 + 2048 + h_ * 256 + 32 * (tid & 7); \
            _Pragma("unroll") for (int i_ = 0; i_ < 4; ++i_) rwv[i_] = *(const u32x4*)(rp0_ + 8 * i_); } while (0)
        int u = bx;
        if (u < 4096) P10C_LOAD(u);
        for (; u < 4096; u += G) {
            const int b = u >> 8, n = (u >> 2) & 63, h = u & 3; const size_t R0 = (size_t)b * SEQ + 64 * n;
            u32x4 rw_c[4];
#pragma unroll
            for (int i = 0; i < 4; ++i) rw_c[i] = rwv[i];
            __syncthreads();
#pragma unroll
            for (int tt = 0; tt < 2; ++tt)
#pragma unroll
                for (int q = 0; q < 2; ++q)
#pragma unroll
                    for (int g = 0; g < 4; ++g) { const unsigned w = fr[tt * 2 + q][g]; const int r = 8 * q + 2 * g;
                        OS[(32 * tt + att::crow(r, hh)) * 260 + c0 + r32] = __builtin_bit_cast(float, w << 16);
                        OS[(32 * tt + att::crow(r + 1, hh)) * 260 + c0 + r32] = __builtin_bit_cast(float, w & 0xffff0000u); }
            __syncthreads();
            if (u + G < 4096) P10C_LOAD(u + G);
            { const int t = tid >> 3, seg = tid & 7; f32x4 ov[8]; float ss = 0.f;
#pragma unroll
              for (int i = 0; i < 8; ++i) { ov[i] = *(const LAS f32x4*)(OS + t * 260 + 32 * seg + 4 * i); ss += (ov[i][0] * ov[i][0] + ov[i][1] * ov[i][1]) + (ov[i][2] * ov[i][2] + ov[i][3] * ov[i][3]); }
              ss += __shfl_xor(ss, 1); ss += __shfl_xor(ss, 2); ss += __shfl_xor(ss, 4);
              const float rs = __builtin_amdgcn_rsqf(ss * (1.0f / 256.0f) + EPS);
              bf16* op = HB + (R0 + t) * D + h * 256 + 32 * seg;
#pragma unroll
              for (int i = 0; i < 4; ++i) { const u32x4 rw = rw_c[i]; u32x4 w;
#pragma unroll
                  for (int e = 0; e < 4; ++e) { const float r0 = __builtin_bit_cast(float, rw[e] << 16), r1 = __builtin_bit_cast(float, rw[e] & 0xffff0000u);
                      const int cidx = 8 * i + 2 * e;
                      const float v0 = ov[(cidx) >> 2][(cidx) & 3] * rs * r0, v1 = ov[(cidx + 1) >> 2][(cidx + 1) & 3] * rs * r1;
                      w[e] = pk2(v0, v1); }
                  *(u32x4*)(op + 8 * i) = w; } }
        }
#undef P10C_LOAD
    }
    SEAM(11);


    if (IN(12)) {
        pg8::DenseSched S; S.init(M / 256, 4, G, bx); S.A = (const char*)HB; S.Bt = (const char*)W_GLAOUT; S.tstep = (size_t)256 * D * 2;
        pg8::EpiResid<true, true> E{XB, XB, MOD1 + 2048, 1.0f};
        pg8::gemm_phase<pg8::EpiResid<true, true>, pg8::DenseSched, true, false>(lds, 2 * D, S, E);
    }
    SEAM(12);

    if (IN(13)) {
        LAS float* RW = (LAS float*)lds;
        LAS unsigned* EL = (LAS unsigned*)(lds + 32768);
        LAS float* GL = (LAS float*)(lds + 32768 + 4096);
        for (int e = tid; e < 8192; e += 512) { const int k = e >> 3, ex = e & 7;
            RW[((((k >> 8) * 4 + (k & 3)) * 2 + (ex >> 2)) * 64 + ((k & 255) >> 2)) * 4 + (ex & 3)] = args.moe_router[e]; }
        __syncthreads();
#undef ROUTER_BODY
#define ROUTER_BODY { float lg[8]; \
            _Pragma("unroll") for (int e = 0; e < 8; ++e) lg[e] = 0.f; \
            _Pragma("unroll") for (int j = 0; j < 4; ++j) _Pragma("unroll") for (int i = 0; i < 4; ++i) { const f32x4 w0 = *((const LAS f32x4*)RW + ((j * 4 + i) * 2) * 64 + lane), w1 = *((const LAS f32x4*)RW + ((j * 4 + i) * 2 + 1) * 64 + lane); const float hv = v[j][i]; \
                lg[0] += hv * w0[0]; lg[1] += hv * w0[1]; lg[2] += hv * w0[2]; lg[3] += hv * w0[3]; lg[4] += hv * w1[0]; lg[5] += hv * w1[1]; lg[6] += hv * w1[2]; lg[7] += hv * w1[3]; } \
            _Pragma("unroll") for (int e = 0; e < 8; ++e) lg[e] = wave_sum(lg[e]); \
            float v1 = lg[0]; \
            _Pragma("unroll") for (int e = 1; e < 8; ++e) v1 = fmaxf(v1, lg[e]); \
            int e1 = 7; \
            _Pragma("unroll") for (int e = 6; e >= 0; --e) e1 = (lg[e] == v1) ? e : e1; \
            float v2 = -3.0e38f; \
            _Pragma("unroll") for (int e = 0; e < 8; ++e) v2 = fmaxf(v2, (e == e1) ? -3.0e38f : lg[e]); \
            int e2 = -1; \
            _Pragma("unroll") for (int e = 7; e >= 0; --e) e2 = (e != e1 && lg[e] == v2) ? e : e2; \
            if (lane == 0) { EL[m - wg_row0] = (unsigned)e1 | ((unsigned)e2 << 8); GL[m - wg_row0] = v1 - v2; } }
        const int rpw12 = (M + NGW - 1) / NGW, rows_wg12 = rpw12 * NWAVES, wg_row0 = bx * rows_wg12;
        NORM_PHASE(XB, true, args.norm2_g + D, MOD1 + 3072, 1, MOE_UP8);
        __syncthreads();
        {
            int nrows = M - wg_row0; nrows = nrows > rows_wg12 ? rows_wg12 : nrows;
            for (int r = tid; r < nrows; r += 512) { const unsigned ew = EL[r]; const unsigned e1 = ew & 255u, e2 = ew >> 8; unsigned l1 = 0, l2 = 0;
                for (int q = 0; q < r; ++q) { const unsigned w = EL[q]; l1 += ((w & 255u) == e1) ? 1u : 0u; l2 += ((w >> 8) == e2) ? 1u : 0u; }
                ROUTE[wg_row0 + r] = (u32x4){ew, __builtin_bit_cast(unsigned, GL[r]), l1, l2}; }
            if (tid < 16) { const unsigned e = tid & 7; unsigned cnt = 0; for (int q = 0; q < nrows; ++q) { const unsigned w = EL[q]; cnt += ((tid < 8 ? (w & 255u) : (w >> 8)) == e) ? 1u : 0u; } LCNT[bx * 16 + tid] = cnt; }
        }
    }
    SEAM(13);

    if (IN(14)) {
        LAS int* PRE = (LAS int*)lds;
        LAS int* GOFF = (LAS int*)(lds + 256);
        if (tid < 16) { int pre = 0, tot = 0; for (int w = 0; w < G; ++w) { const int v = (int)LCNT[w * 16 + tid]; tot += v; pre += (w < bx) ? v : 0; } PRE[tid] = pre; ((LAS int*)(lds + 512))[tid] = (tot + 255) & ~255; }
        __syncthreads();
        if (tid < 2) { int acc = 0; for (int e = 0; e < 8; ++e) { GOFF[tid * 9 + e] = acc; acc += ((LAS int*)(lds + 512))[tid * 8 + e]; } GOFF[tid * 9 + 8] = acc;
            if (bx == 0) { for (int e = 0; e < 9; ++e) META[tid * 16 + e] = GOFF[tid * 9 + e]; } }
        __syncthreads();
        const int rpw = (M + NGW - 1) / NGW, rows_wg = rpw * NWAVES;
        for (int r = tid; r < rows_wg; r += 512) { const int m = bx * rows_wg + r; if (m >= M) break;
            const u32x4 rt = ROUTE[m]; const int e1 = rt[0] & 255, e2 = (rt[0] >> 8) & 255; const unsigned gbits = rt[1]; const float gap = __builtin_bit_cast(float, gbits); const float g1 = 1.0f / (1.0f + expf(-gap));
            const int s1 = GOFF[e1] + PRE[e1] + (int)rt[2], s2 = GOFF[9 + e2] + PRE[8 + e2] + (int)rt[3];
            TOKSLOT[s1] = m; GSLOT[s1] = g1; TOKSLOT[MAXSLOT + s2] = m; GSLOT[MAXSLOT + s2] = 1.0f - g1; }
    }
    SEAM(14);

#define MOE_SCHED(S, p) do { const int* mt = META + (p) * 16; S.g1 = mt[1]; S.g2 = mt[2]; S.g3 = mt[3]; S.g4 = mt[4]; S.g5 = mt[5]; S.g6 = mt[6]; S.g7 = mt[7]; } while (0)
#pragma unroll
    for (int p = 0; p < 2; ++p) {
        if (IN(15 + 2 * p)) {
            pg8::MoeSched S; MOE_SCHED(S, p); const int nP = META[p * 16 + 8] >> 8;
            S.init(nP, 2 * EXPD / 256, G, bx); S.A = (const char*)HB; S.a_tstep = 0; S.Bt = (const char*)W_MOE13; S.b_tstep = (size_t)256 * D * (MOE_UP8 ? 1 : 2); S.b_estride = (size_t)2 * EXPD * D * (MOE_UP8 ? 1 : 2);
            S.tokslot = TOKSLOT + p * MAXSLOT; S.rowbytes = D * (MOE_UP8 ? 1 : 2);
            pg8::EpiSwiGLU<MOE_DN8> E{ACTB, EXPD, MOE_UP8 ? 1.0f / (H8_SCALE * W8_SCALE) : 1.0f};
            pg8::gemm_phase<pg8::EpiSwiGLU<MOE_DN8>, pg8::MoeSched, true, true, MOE_UP8>(lds, D * (MOE_UP8 ? 1 : 2), S, E);
        }
        SEAM(15 + 2 * p);
        if (IN(16 + 2 * p)) {
            pg8::MoeSched S; MOE_SCHED(S, p); const int nP = META[p * 16 + 8] >> 8;
            constexpr int RBD = EXPD * (MOE_DN8 ? 1 : 2), NTD = RBD / 128;
            int nPm = nP, jpart = -1; const int qpart = bx & 7;
            { const int nwg = nP * 4, nfull = nwg / G, nrem = nwg - nfull * G; if (nrem > 0 && 8 * nrem <= G && (nfull * G) % 4 == 0 && NTD >= 16) { nPm = nfull * G / 4; if (bx < 8 * nrem) jpart = bx >> 3; } }
            S.init(nPm, 4, G, bx); S.A = (const char*)ACTB; S.a_tstep = (size_t)256 * RBD; S.Bt = (const char*)W_MOE2; S.b_tstep = (size_t)256 * RBD; S.b_estride = (size_t)D * RBD;
            S.tokslot = TOKSLOT + p * MAXSLOT; S.rowbytes = 0;
#define MOE_DOWN(FINAL_) do { pg8::EpiMoeDown<FINAL_> E{TOKSLOT + p * MAXSLOT, GSLOT + p * MAXSLOT, XB, out, MOD1 + 5 * 1024, MOE_DN8 ? 1.0f / (A8_SCALE * W8_SCALE) : 1.0f}; \
                if (nPm > 0) pg8::gemm_phase<pg8::EpiMoeDown<FINAL_>, pg8::MoeSched, true, false, MOE_DN8>(lds, RBD, S, E); \
                if (jpart >= 0) {       \
                    const int gsz = nP - nPm; pg8::Unit u; u.pm = nPm + jpart % gsz; u.pn = jpart / gsz; \
                    { pg8::MoeSchedTail T; MOE_SCHED(T, p); T.init(nP, 4, G, bx); T.A = S.A; T.a_tstep = S.a_tstep; T.Bt = S.Bt; T.b_tstep = S.b_tstep; T.b_estride = S.b_estride; T.tokslot = S.tokslot; T.rowbytes = 0; \
                      constexpr int P = NTD / 2, base = P / 8, extra = P % 8; T.pmT = u.pm; T.pnT = u.pn; T.k0T = 2 * (qpart * base + (qpart < extra ? qpart : extra)); T.nkT = 2 * (base + (qpart < extra ? 1 : 0)); \
                      pg8::EpiPartStore EP{KPART + (size_t)bx * (32 * 512 * 4)}; \
                      pg8::gemm_phase<pg8::EpiPartStore, pg8::MoeSchedTail, true, false, MOE_DN8, true>(lds, RBD, T, EP); } \
                    unsigned* kc = ctl + CW_KCNT + p * 64 + jpart; \
                    asm volatile("s_waitcnt vmcnt(0)" ::: "memory"); __syncthreads(); \
                    if (tid == 0) { __builtin_amdgcn_fence(__ATOMIC_RELEASE, "agent"); asm volatile("s_waitcnt vmcnt(0)" ::: "memory"); (void)xb_add(kc, 1u); \
                        XB_SPIN(xb_ld(kc) < 8u, ctl + CW_BAR); __builtin_amdgcn_fence(__ATOMIC_ACQUIRE, "agent"); asm volatile("s_waitcnt vmcnt(0)" ::: "memory"); } \
                    __syncthreads(); \
                    const int ai = qpart >> 2, m = qpart & 3; \
                    f32x4 v[2][2]; \
                    _Pragma("unroll") for (int bj = 0; bj < 2; ++bj) _Pragma("unroll") for (int n = 0; n < 2; ++n) { f32x4 a = (f32x4){0.f, 0.f, 0.f, 0.f}; \
                        const f32x4* pp = (const f32x4*)(KPART + (size_t)(jpart * 8) * (32 * 512 * 4)) + (size_t)((((ai * 2 + bj) * 4 + m) * 2 + n) * 512 + tid); \
                        _Pragma("unroll") for (int qq = 0; qq < 8; ++qq) a += pp[(size_t)qq * (32 * 512)]; \
                        v[bj][n] = a; } \
                    E.slice(v, u, ai, m, wave >> 2, wave & 3, lane & 15, lane >> 4); } } while (0)
            if (p == 0) MOE_DOWN(false); else MOE_DOWN(true);
#undef MOE_DOWN
        }
        if (p == 0) SEAM(16);
    }
#undef IN
#undef SEAM
}


constexpr int N_PHASES = 19;
extern "C" void kernel_launch(void* const* d_in, const int* in_sizes, int n_in, void* d_out, int out_size, void* d_ws, size_t ws_size, hipStream_t stream) {
    static int grid = 0;
    if (grid == 0) {
        if (n_in != 28 || in_sizes[0] != M * D || out_size != M * D || ws_size < WS_TOTAL) { fprintf(stderr, "kernel_launch: unexpected problem shape (n_in %d, out %d, ws %zu)\n", n_in, out_size, ws_size); grid = -1; return; }
        int dev = 0, cus = 0, per_cu = 0;
        if (hipGetDevice(&dev) != hipSuccess || hipDeviceGetAttribute(&cus, hipDeviceAttributeMultiprocessorCount, dev) != hipSuccess) { grid = -1; return; }
        if (hipFuncSetAttribute((const void*)mk_fwd, hipFuncAttributeMaxDynamicSharedMemorySize, LDS_BYTES) != hipSuccess) { fprintf(stderr, "kernel_launch: hipFuncSetAttribute failed\n"); grid = -1; return; }
        if (hipOccupancyMaxActiveBlocksPerMultiprocessor(&per_cu, (const void*)mk_fwd, NWAVES * 64, LDS_BYTES) != hipSuccess || per_cu < 1) { fprintf(stderr, "kernel_launch: occupancy query reports %d\n", per_cu); }
        (void)hipGetLastError();
        grid = cus;
        if (grid < 128) { fprintf(stderr, "kernel_launch: built for a >= 128-CU device (64 GLA scan workgroups + weight-copy workgroups); got %d\n", grid); grid = -1; return; }
    }
    if (grid < 0) return;
    if (hipMemsetAsync((char*)d_ws + WS_CTL, 0, CTL_ZERO_BYTES, stream) != hipSuccess) return;
    Args a{};
    const float** ap = (const float**)&a;
    for (int i = 0; i < 28; ++i) ap[i] = (const float*)d_in[i];
    a.out = (float*)d_out; a.ws = (unsigned char*)d_ws;
    if (MK_N_LAUNCHES == 1) { a.ph_lo = 0; a.ph_hi = N_PHASES; hipLaunchKernelGGL(mk_fwd, dim3(grid), dim3(NWAVES * 64), LDS_BYTES, stream, a); }
    else { for (int p = 0; p < N_PHASES; ++p) { a.ph_lo = p; a.ph_hi = p + 1; hipLaunchKernelGGL(mk_fwd, dim3(grid), dim3(NWAVES * 64), LDS_BYTES, stream, a); } }
}
```

```cpp
#include <hip/hip_runtime.h>
#include <cstdio>
#include <cstdint>

#ifndef PROBE_DUP
#define PROBE_DUP -1
#endif
#ifndef MK_N_LAUNCHES
#define MK_N_LAUNCHES 1
#endif

#define LAS __attribute__((address_space(3)))
#define GAS __attribute__((address_space(1)))
typedef unsigned short bf16;
typedef short bf16x8 __attribute__((ext_vector_type(8)));
typedef short s16x4 __attribute__((ext_vector_type(4)));
typedef float f32x4 __attribute__((ext_vector_type(4)));
typedef float f32x2 __attribute__((ext_vector_type(2)));
typedef float f32x16 __attribute__((ext_vector_type(16)));
typedef unsigned u32x4 __attribute__((ext_vector_type(4)));
typedef unsigned u32x2 __attribute__((ext_vector_type(2)));

constexpr int D = 1024, BATCH = 16, SEQ = 4096, M = BATCH * SEQ;
constexpr int FFN = 2816, NEXP = 8, EXPD = 3584;
constexpr int GLA_N = 3584;
constexpr float EPS = 1e-6f;
constexpr float LOG2E = 1.4426950408889634f;
constexpr int NWAVES = 8;
constexpr int MAXSLOT = M + NEXP * 256;

constexpr size_t MiB = 1u << 20;
constexpr size_t WS_CTL = 0, CTL_ZERO_BYTES = 64 * 1024;
constexpr size_t WS_MOD = 256 * 1024;
constexpr size_t WS_LCNT = 1 * MiB + 256 * 1024;
constexpr size_t WS_META = 1 * MiB + 512 * 1024;
constexpr size_t WS_ROUTE = 2 * MiB;
constexpr size_t WS_TOKSLOT = 4 * MiB;
constexpr size_t WS_GSLOT = 5 * MiB;
constexpr size_t WS_W_DAIN = 8 * MiB, WS_W_DAOUT = 14 * MiB, WS_W_FFN13 = 16 * MiB, WS_W_FFN2 = 27 * MiB;
constexpr size_t WS_W_GLAIN = 33 * MiB, WS_W_GLAOUT = 40 * MiB, WS_W_MOE13 = 42 * MiB, WS_W_MOE2 = 154 * MiB;
constexpr size_t WS_H = 210 * MiB;
constexpr size_t WS_Q = 338 * MiB;
constexpr size_t WS_END = WS_Q + 464 * MiB;
constexpr size_t WS_XB = WS_END;
constexpr size_t WS_TOTAL = WS_XB + (size_t)M * D * 2;
constexpr size_t GA_UNIT = 43008;
static_assert(4096 * GA_UNIT <= (size_t)M * D * 4, "the GLA per-chunk operands are parked in d_out (free until the last phase writes the result)");
static_assert(WS_TOKSLOT + 2 * MAXSLOT * 4 <= WS_GSLOT && WS_GSLOT + 2 * MAXSLOT * 4 <= WS_W_DAIN, "ws map");
static_assert(WS_W_FFN2 + (size_t)D * FFN * 2 <= WS_W_GLAIN && WS_W_GLAIN + (size_t)GLA_N * D * 2 <= WS_W_GLAOUT, "ws map");
static_assert(WS_W_MOE13 + (size_t)NEXP * 2 * EXPD * D * 2 <= WS_W_MOE2 && WS_W_MOE2 + (size_t)NEXP * D * EXPD * 2 <= WS_H, "ws map");
static_assert((size_t)MAXSLOT * EXPD * 2 <= 464 * MiB && (size_t)M * 3072 * 2 + (size_t)M * 512 * 2 <= 464 * MiB, "ws map");
constexpr int CW_BAR = 4096, CW_KCNT = 8192;

constexpr int RING_BYTES = 131072;
constexpr int TAB_OFF = RING_BYTES;
constexpr int MISC_OFF = 155648;
constexpr int LDS_BYTES = MISC_OFF + 1024;

__device__ __forceinline__ unsigned f2bf(float f) { unsigned u = __builtin_bit_cast(unsigned, f); return (u + 0x7fffu + ((u >> 16) & 1u)) >> 16; }
__device__ __forceinline__ unsigned pk2(float lo, float hi) { return f2bf(lo) | (f2bf(hi) << 16); }
__device__ __forceinline__ float bf2f(unsigned short b) { return __builtin_bit_cast(float, ((unsigned)b) << 16); }
__device__ __forceinline__ unsigned cvt_pk_bf16(float lo, float hi) { unsigned r; asm volatile("v_cvt_pk_bf16_f32 %0, %1, %2" : "=v"(r) : "v"(lo), "v"(hi)); return r; }
__device__ __forceinline__ float wave_sum(float v) {
#pragma unroll
    for (int o = 1; o < 64; o <<= 1) v += __shfl_xor(v, o);
    return v;
}
__device__ __forceinline__ float wave_max(float v) {
#pragma unroll
    for (int o = 1; o < 64; o <<= 1) v = fmaxf(v, __shfl_xor(v, o));
    return v;
}
typedef int v8i __attribute__((ext_vector_type(8)));
typedef int v4i __attribute__((ext_vector_type(4)));
constexpr bool FFN_UP8 = false, FFN_DN8 = true, MOE_UP8 = true, MOE_DN8 = true;
constexpr float W8_SCALE = 64.0f, H8_SCALE = 8.0f, A8_SCALE = 4.0f;
__device__ __forceinline__ float clamp448(float x) { return fminf(fmaxf(x, -448.0f), 448.0f); }
__device__ __forceinline__ unsigned pk_fp8x4(float a, float b, float c, float d) {
    unsigned w = 0u; w = __builtin_amdgcn_cvt_pk_fp8_f32(clamp448(a), clamp448(b), w, false); w = __builtin_amdgcn_cvt_pk_fp8_f32(clamp448(c), clamp448(d), w, true); return w; }
__device__ __forceinline__ f32x4 ld_bf16x4(const bf16* p) { const u32x2 w = *(const u32x2*)p; return (f32x4){__builtin_bit_cast(float, w[0] << 16), __builtin_bit_cast(float, w[0] & 0xffff0000u), __builtin_bit_cast(float, w[1] << 16), __builtin_bit_cast(float, w[1] & 0xffff0000u)}; }
__device__ __forceinline__ void st_bf16x4(bf16* p, f32x4 v) { *(u32x2*)p = (u32x2){cvt_pk_bf16(v[0], v[1]), cvt_pk_bf16(v[2], v[3])}; }
__device__ __forceinline__ float fast_silu(float a) { return a * __builtin_amdgcn_rcpf(1.0f + __builtin_amdgcn_exp2f(-a * LOG2E)); }

namespace pg8 {
constexpr int BM = 256, BK = 64, HALF = 128, HTB = HALF * BK * 2, STAGE_BYTES = 8 * HTB, NXCD = 8, WGM = 8;
__host__ __device__ __forceinline__ int lds_byte(int r, int c) { const int st = (r >> 4) * 2 + (c >> 5), rr = r & 15, cc = c & 31, ob = rr * 64 + cc * 2; return st * 1024 + (ob ^ (((ob >> 9) & 1) << 5)); }
__host__ __device__ __forceinline__ void stage_rc(int b, int& R, int& C) { const int st = b / 1024, sb = b % 1024, swz = sb ^ (((sb >> 9) & 1) << 5); R = (st >> 1) * 16 + swz / 64; C = (st & 1) * 32 + (swz % 64) / 2; }
__host__ __device__ __forceinline__ int perm32(int rho) { const int n = rho >> 4, i = rho & 15; return 8 * (i >> 2) + 4 * n + (i & 3); }

struct Unit { int pm, pn, k0, nk, part; };
struct TileOrder {
    int nM, nN, nwg, G, c;
    __device__ void init(int nM_, int nN_, int G_, int c_) { nM = nM_; nN = nN_; nwg = nM * nN; G = G_; c = c_; }
    __device__ bool next(int i, Unit& u) const { return at((long)i * G + c, u); }
    __device__ bool at(const long L, Unit& u) const {
        if (L >= nwg) return false;
        int wgid = (int)L; { const int q = nwg / NXCD, r = nwg % NXCD, xcd = wgid % NXCD, off = wgid / NXCD; wgid = (xcd < r ? xcd * (q + 1) : r * (q + 1) + (xcd - r) * q) + off; }
        const int nig = WGM * nN, gid = wgid / nig, fm = gid * WGM, gsz = (nM - fm) < WGM ? (nM - fm) : WGM;
        u.pm = fm + ((wgid % nig) % gsz); u.pn = (wgid % nig) / gsz; return true;
    }
};
struct DenseSched : TileOrder {
    const char* A; const char* Bt; size_t tstep;
    __device__ __forceinline__ const char* a_base(const Unit& u) const { return A + (size_t)u.pm * tstep; }
    __device__ __forceinline__ const char* b_base(const Unit& u) const { return Bt + (size_t)u.pn * tstep; }
    __device__ __forceinline__ unsigned row_off(const Unit&, int) const { return 0u; }
};
struct MoeSched : TileOrder {
    const char* A; const char* Bt; size_t a_tstep, b_tstep, b_estride; const int* tokslot; unsigned rowbytes; int g1, g2, g3, g4, g5, g6, g7;
    __device__ __forceinline__ int expert(int pm) const { const int r = pm * 256; return (r >= g1) + (r >= g2) + (r >= g3) + (r >= g4) + (r >= g5) + (r >= g6) + (r >= g7); }
    __device__ __forceinline__ const char* a_base(const Unit& u) const { return A + (size_t)u.pm * a_tstep; }
    __device__ __forceinline__ const char* b_base(const Unit& u) const { return Bt + (size_t)expert(u.pm) * b_estride + (size_t)u.pn * b_tstep; }
    __device__ __forceinline__ unsigned row_off(const Unit& u, int r) const { int t = tokslot[u.pm * 256 + r]; t = t < 0 ? 0 : t; return (unsigned)t * rowbytes; }
};
struct MoeSchedTail : MoeSched {
    int pmT, pnT, k0T, nkT;
    __device__ bool next(int i, Unit& u) const { if (i != 0) return false; u.pm = pmT; u.pn = pnT; u.k0 = k0T; u.nk = nkT; u.part = 1; return true; }
};

struct EpiQKV {
    static constexpr bool PERM = true;
    bf16* Q; size_t tstride; const float* qg; const float* kg; float qscale;
    __device__ __forceinline__ void operator()(const f32x4 (&acc)[2][2][4][2], const Unit& u, int wr, int wc, int fr, int fq) const {
        const int t = u.pn >> 2;
        bf16* base = Q + (size_t)t * tstride;
        const int lc0 = 256 * (u.pn & 3) + 64 * wc + 8 * fq;
        const int row0 = u.pm * BM + wr * 64 + fr;
        if (t < 2) {
            const float* g = qg; if (t == 1) g = kg;
            g += 64 * (wc & 1) + 8 * fq;
            f32x4 gv[2][2];
#pragma unroll
            for (int bj = 0; bj < 2; ++bj)
#pragma unroll
                for (int n = 0; n < 2; ++n) gv[bj][n] = *(const f32x4*)(g + 32 * bj + 4 * n);
            float sc = 1.0f; if (t == 0) sc = qscale;
#pragma unroll
            for (int ai = 0; ai < 2; ++ai)
#pragma unroll
                for (int m = 0; m < 4; ++m) {
                    float ss = 0.f;
#pragma unroll
                    for (int bj = 0; bj < 2; ++bj)
#pragma unroll
                        for (int n = 0; n < 2; ++n) { const f32x4 x = acc[ai][bj][m][n]; ss += (x[0] * x[0] + x[1] * x[1]) + (x[2] * x[2] + x[3] * x[3]); }
                    ss += __shfl_xor(ss, 16); ss += __shfl_xor(ss, 32);
                    const float rs = __builtin_amdgcn_rsqf(ss * (1.0f / 64.0f) + EPS) * sc;
                    const int R = row0 + ai * HALF + m * 16;
                    bf16* rowp = base + (size_t)R * D + lc0;
#pragma unroll
                    for (int bj = 0; bj < 2; ++bj) { const f32x4 v0 = acc[ai][bj][m][0] * rs * gv[bj][0], v1 = acc[ai][bj][m][1] * rs * gv[bj][1];
                        u32x4 w; w.x = cvt_pk_bf16(v0[0], v0[1]); w.y = cvt_pk_bf16(v0[2], v0[3]); w.z = cvt_pk_bf16(v1[0], v1[1]); w.w = cvt_pk_bf16(v1[2], v1[3]);
                        if (t == 1) {
                            const int col = lc0 + 32 * bj, hh_ = col >> 7, cg = (col & 127) >> 3, b_ = R >> 12, s_ = R & 4095;
                            *(u32x4*)(base + ((((size_t)(b_ * 8 + hh_) * 64 + (s_ >> 6)) * 16 + cg) * 64 + (s_ & 63)) * 8) = w; }
                        else *(u32x4*)(rowp + 32 * bj) = w; }
                }
        } else {
#pragma unroll
            for (int ai = 0; ai < 2; ++ai)
#pragma unroll
                for (int m = 0; m < 4; ++m) { const int R = row0 + ai * HALF + m * 16, b_ = R >> 12, s_ = R & 4095;
#pragma unroll
                    for (int bj = 0; bj < 2; ++bj) { const f32x4 v0 = acc[ai][bj][m][0], v1 = acc[ai][bj][m][1];
                        u32x4 w; w.x = cvt_pk_bf16(v0[0], v0[1]); w.y = cvt_pk_bf16(v0[2], v0[3]); w.z = cvt_pk_bf16(v1[0], v1[1]); w.w = cvt_pk_bf16(v1[2], v1[3]);
                        const int col = lc0 + 32 * bj, hh_ = col >> 7, c_ = col & 127, p_ = (c_ >> 5) * 4 + ((s_ & 63) >> 4), li = ((s_ & 15) << 2) + ((c_ & 31) >> 3);
                        *(u32x4*)(base + ((((size_t)(b_ * 8 + hh_) * 64 + (s_ >> 6)) * 16 + p_) * 64 + li) * 8) = w; } }
        }
    }
};
template <bool BASE16, bool OUT16> struct EpiResid {
    static constexpr bool PERM = false;
    const void* base; void* out; const float* gate; float descale;
    __device__ __forceinline__ void operator()(const f32x4 (&acc)[2][2][4][2], const Unit& u, int wr, int wc, int fr, int fq) const {
        const int row0 = u.pm * BM + wr * 64 + fr, col0 = u.pn * BM + wc * 32 + 4 * fq, b = u.pm >> 4;
        f32x4 gv[2][2];
#pragma unroll
        for (int bj = 0; bj < 2; ++bj)
#pragma unroll
            for (int n = 0; n < 2; ++n) gv[bj][n] = *(const f32x4*)(gate + (size_t)b * 6144 + col0 + bj * HALF + n * 16) * descale;
#pragma unroll
        for (int ai = 0; ai < 2; ++ai)
#pragma unroll
            for (int m = 0; m < 4; ++m) { const size_t off = (size_t)(row0 + ai * HALF + m * 16) * D + col0;
#pragma unroll
                for (int bj = 0; bj < 2; ++bj)
#pragma unroll
                    for (int n = 0; n < 2; ++n) { const size_t o = off + bj * HALF + n * 16;
                        const f32x4 bs = BASE16 ? ld_bf16x4((const bf16*)base + o) : *(const f32x4*)((const float*)base + o);
                        const f32x4 r = bs + gv[bj][n] * acc[ai][bj][m][n];
                        if constexpr (OUT16) st_bf16x4((bf16*)out + o, r); else *(f32x4*)((float*)out + o) = r; }
                asm volatile("" ::: "memory"); }
    }
};
template <bool OUT8> struct EpiSwiGLU {
    static constexpr bool PERM = true;
    void* O; int ldo; float descale;
    __device__ __forceinline__ void operator()(const f32x4 (&acc)[2][2][4][2], const Unit& u, int wr, int wc, int fr, int fq) const {
        const int row0 = u.pm * BM + wr * 64 + fr, col0 = u.pn * HALF + wc * 32 + 8 * fq;
#pragma unroll
        for (int ai = 0; ai < 2; ++ai)
#pragma unroll
            for (int m = 0; m < 4; ++m) { const unsigned eo = (unsigned)(row0 + ai * HALF + m * 16) * (unsigned)ldo + (unsigned)col0;
                f32x4 v0, v1;
#pragma unroll
                for (int i = 0; i < 4; ++i) { v0[i] = fast_silu(acc[ai][0][m][0][i] * descale) * (acc[ai][1][m][0][i] * descale); v1[i] = fast_silu(acc[ai][0][m][1][i] * descale) * (acc[ai][1][m][1][i] * descale); }
                if constexpr (OUT8) { v0 = v0 * A8_SCALE; v1 = v1 * A8_SCALE; *(u32x2*)((unsigned char*)O + eo) = (u32x2){pk_fp8x4(v0[0], v0[1], v0[2], v0[3]), pk_fp8x4(v1[0], v1[1], v1[2], v1[3])}; }
                else { u32x4 w; w.x = cvt_pk_bf16(v0[0], v0[1]); w.y = cvt_pk_bf16(v0[2], v0[3]); w.z = cvt_pk_bf16(v1[0], v1[1]); w.w = cvt_pk_bf16(v1[2], v1[3]); *(u32x4*)((bf16*)O + eo) = w; } }
    }
};
struct EpiGLA {
    static constexpr bool PERM = true;
    bf16* P; bf16* LA; const float* ba; const float* og;
    __device__ __forceinline__ void operator()(const f32x4 (&acc)[2][2][4][2], const Unit& u, int wr, int wc, int fr, int fq) const {
        const int row0 = u.pm * BM + wr * 64 + fr;
        if (u.pn < 12) {
            const int col0 = u.pn * BM + wc * 32 + 8 * fq; const bool isr = u.pn >= 8;
            f32x4 gv[2][2];
#pragma unroll
            for (int bj = 0; bj < 2; ++bj)
#pragma unroll
                for (int n = 0; n < 2; ++n) gv[bj][n] = isr ? *(const f32x4*)(og + wc * 32 + 8 * fq + bj * HALF + 4 * n) : (f32x4){1.f, 1.f, 1.f, 1.f};
#pragma unroll
            for (int ai = 0; ai < 2; ++ai)
#pragma unroll
                for (int m = 0; m < 4; ++m) { bf16* rowp = P + (size_t)(row0 + ai * HALF + m * 16) * 3072 + col0;
#pragma unroll
                    for (int bj = 0; bj < 2; ++bj) { f32x4 v0 = acc[ai][bj][m][0], v1 = acc[ai][bj][m][1];
                        if (isr) {
#pragma unroll
                            for (int i = 0; i < 4; ++i) { v0[i] = gv[bj][0][i] * fast_silu(v0[i]); v1[i] = gv[bj][1][i] * fast_silu(v1[i]); } }
                        u32x4 w; w.x = cvt_pk_bf16(v0[0], v0[1]); w.y = cvt_pk_bf16(v0[2], v0[3]); w.z = cvt_pk_bf16(v1[0], v1[1]); w.w = cvt_pk_bf16(v1[2], v1[3]);
                        *(u32x4*)(rowp + bj * HALF) = w; } }
        } else {
            const int col0 = (u.pn - 12) * BM + wc * 32 + 8 * fq;
            f32x4 bv[2][2];
#pragma unroll
            for (int bj = 0; bj < 2; ++bj)
#pragma unroll
                for (int n = 0; n < 2; ++n) bv[bj][n] = *(const f32x4*)(ba + col0 + bj * HALF + 4 * n);
#pragma unroll
            for (int ai = 0; ai < 2; ++ai)
#pragma unroll
                for (int m = 0; m < 4; ++m) { bf16* rowp = LA + (size_t)(row0 + ai * HALF + m * 16) * 512 + col0;
#pragma unroll
                    for (int bj = 0; bj < 2; ++bj) { f32x4 v[2];
#pragma unroll
                        for (int n = 0; n < 2; ++n)
#pragma unroll
                            for (int i = 0; i < 4; ++i) { const float z = acc[ai][bj][m][n][i] + bv[bj][n][i];
                                v[n][i] = (fminf(z, 0.f) - __logf(1.0f + __expf(-fabsf(z)))) * (1.0f / 16.0f); }
                        u32x4 w; w.x = cvt_pk_bf16(v[0][0], v[0][1]); w.y = cvt_pk_bf16(v[0][2], v[0][3]); w.z = cvt_pk_bf16(v[1][0], v[1][1]); w.w = cvt_pk_bf16(v[1][2], v[1][3]);
                        *(u32x4*)(rowp + bj * HALF) = w; } }
        }
    }
};
template <bool FINAL> struct EpiMoeDown {
    static constexpr bool PERM = false;
    const int* tokslot; const float* gslot; bf16* xb; float* outf; const float* gate; float descale;
    __device__ __forceinline__ void operator()(const f32x4 (&acc)[2][2][4][2], const Unit& u, int wr, int wc, int fr, int fq) const {
        const int srow0 = u.pm * BM + wr * 64 + fr, col0 = u.pn * BM + wc * 32 + 4 * fq;
#pragma unroll
        for (int ai = 0; ai < 2; ++ai)
#pragma unroll
            for (int m = 0; m < 4; ++m) { const int srow = srow0 + ai * HALF + m * 16; const int tok = tokslot[srow];
                if (tok >= 0) { const float g = gslot[srow] * descale; const float* gp = gate + (size_t)(tok >> 12) * 6144 + col0; const size_t ro = (size_t)tok * D + col0;
#pragma unroll
                    for (int bj = 0; bj < 2; ++bj)
#pragma unroll
                        for (int n = 0; n < 2; ++n) { const f32x4 gv = *(const f32x4*)(gp + bj * HALF + n * 16); const f32x4 bs = ld_bf16x4(xb + ro + bj * HALF + n * 16);
                            const f32x4 r = bs + gv * g * acc[ai][bj][m][n];
                            if constexpr (FINAL) *(f32x4*)(outf + ro + bj * HALF + n * 16) = r; else st_bf16x4(xb + ro + bj * HALF + n * 16, r); } }
                asm volatile("" ::: "memory"); }
    }
    __device__ __forceinline__ void slice(const f32x4 (&v)[2][2], const Unit& u, int ai, int m, int wr, int wc, int fr, int fq) const {
        const int srow = u.pm * BM + wr * 64 + fr + ai * HALF + m * 16, col0 = u.pn * BM + wc * 32 + 4 * fq; const int tok = tokslot[srow];
        if (tok >= 0) { const float g = gslot[srow] * descale; const float* gp = gate + (size_t)(tok >> 12) * 6144 + col0; const size_t ro = (size_t)tok * D + col0;
#pragma unroll
            for (int bj = 0; bj < 2; ++bj)
#pragma unroll
                for (int n = 0; n < 2; ++n) { const f32x4 gv = *(const f32x4*)(gp + bj * HALF + n * 16); const f32x4 bs = ld_bf16x4(xb + ro + bj * HALF + n * 16);
                    const f32x4 r = bs + gv * g * v[bj][n];
                    if constexpr (FINAL) *(f32x4*)(outf + ro + bj * HALF + n * 16) = r; else st_bf16x4(xb + ro + bj * HALF + n * 16, r); } }
    }
};
struct EpiPartStore {
    static constexpr bool PERM = false;
    float* part;
    __device__ __forceinline__ void operator()(const f32x4 (&acc)[2][2][4][2], const Unit&, int wr, int wc, int fr, int fq) const {
        f32x4* p = (f32x4*)part + ((wr * 4 + wc) * 64 + fq * 16 + fr);
#pragma unroll
        for (int ai = 0; ai < 2; ++ai)
#pragma unroll
            for (int bj = 0; bj < 2; ++bj)
#pragma unroll
                for (int m = 0; m < 4; ++m)
#pragma unroll
                    for (int n = 0; n < 2; ++n) { *p = acc[ai][bj][m][n]; p += 512; asm volatile("" : "+v"(p)); }
    }
};

template <class Epi, class Sched, bool ALIGN_EPI, bool GATHER, bool FP8 = false, bool KSPLIT = false>
__device__ __forceinline__ void gemm_phase(LAS unsigned char* lds, const int RB, const Sched& S, const Epi& E) {
    const int tid = threadIdx.x, wid = __builtin_amdgcn_readfirstlane(tid >> 6), lane = tid & 63, wr = wid >> 2, wc = wid & 3, fr = lane & 15, fq = lane >> 4;
    const int nt = RB / 128;
    unsigned voffB0, voffA0;
    const size_t kstep = (size_t)(BK * 2);
    const size_t hstep = (size_t)HALF * RB;
    const size_t qstep = (size_t)64 * RB;
    { int R, C; stage_rc(tid * 16, R, C); const int Rb = Epi::PERM ? ((R & ~31) + perm32(R & 31)) : R;
        voffB0 = (unsigned)(Rb * RB + C * 2); voffA0 = (unsigned)(R * RB + C * 2); }
    LAS unsigned* mytab = (LAS unsigned*)(lds + STAGE_BYTES) + tid;
#define PG8_TABFILL(par, U) do { _Pragma("unroll") for (int _h = 0; _h < 2; ++_h) _Pragma("unroll") for (int _i = 0; _i < 2; ++_i) { int _R, _C; stage_rc(tid * 16 + _i * 8192, _R, _C); \
        mytab[((par) * 4 + _h * 2 + _i) * 512] = S.row_off(U, _h * HALF + _R) + (unsigned)_C * 2u; } } while (0)
    const unsigned ldsw = (unsigned)wid * 1024u;
    const int aoff = lds_byte(wr * 64 + fr, fq * 8), boff = lds_byte(wc * 32 + fr, fq * 8);
#define PG8_SA(b, h) (((b) * 2 + (h)) * HTB)
#define PG8_SB(b, h) ((4 + (b) * 2 + (h)) * HTB)
#define PG8_STAGE_B(bufoff, gbase) do { _Pragma("unroll") for (int _i = 0; _i < 2; ++_i) \
        __builtin_amdgcn_global_load_lds((const unsigned*)((const char*)(gbase) + _i * qstep + voffB0), (LAS unsigned*)(lds + (bufoff) + ldsw + _i * 8192), 16, 0, 0); } while (0)
#define PG8_STAGE_A(bufoff, gbase, va, h) do { _Pragma("unroll") for (int _i = 0; _i < 2; ++_i) \
        __builtin_amdgcn_global_load_lds((const unsigned*)((const char*)(gbase) + (GATHER ? (size_t)0 : (size_t)(h) * hstep + _i * qstep) + (GATHER ? (va)[h][_i] : voffA0)), (LAS unsigned*)(lds + (bufoff) + ldsw + _i * 8192), 16, 0, 0); } while (0)
#define PG8_LDA(dst, b, h) do { _Pragma("unroll") for (int m = 0; m < 4; ++m) { if constexpr (FP8) dst##8[m] = __builtin_shufflevector(*(const LAS v4i*)(lds + PG8_SA(b, h) + aoff + m * 2048), *(const LAS v4i*)(lds + PG8_SA(b, h) + aoff + m * 2048 + 1024), 0, 1, 2, 3, 4, 5, 6, 7); \
        else { _Pragma("unroll") for (int k = 0; k < 2; ++k) dst[m][k] = *(const LAS bf16x8*)(lds + PG8_SA(b, h) + aoff + m * 2048 + k * 1024); } } } while (0)
#define PG8_LDB(dst, b, h) do { _Pragma("unroll") for (int n = 0; n < 2; ++n) { if constexpr (FP8) dst##8[n] = __builtin_shufflevector(*(const LAS v4i*)(lds + PG8_SB(b, h) + boff + n * 2048), *(const LAS v4i*)(lds + PG8_SB(b, h) + boff + n * 2048 + 1024), 0, 1, 2, 3, 4, 5, 6, 7); \
        else { _Pragma("unroll") for (int k = 0; k < 2; ++k) dst[n][k] = *(const LAS bf16x8*)(lds + PG8_SB(b, h) + boff + n * 2048 + k * 1024); } } } while (0)
#define PG8_CAT(x0, x1) __builtin_shufflevector(__builtin_bit_cast(v4i, x0), __builtin_bit_cast(v4i, x1), 0, 1, 2, 3, 4, 5, 6, 7)
#define PG8_MMA(ai, bj, At, Bt) do { __builtin_amdgcn_s_setprio(1); _Pragma("unroll") for (int m = 0; m < 4; ++m) _Pragma("unroll") for (int n = 0; n < 2; ++n) { \
        if constexpr (FP8) asm volatile("v_mfma_scale_f32_16x16x128_f8f6f4 %0, %1, %2, %0, %3, %3 op_sel_hi:[0,0,0]" : "+v"(acc[ai][bj][m][n]) : "v"(Bt##8[n]), "v"(At##8[m]), "v"(sc8));   \
        else { _Pragma("unroll") for (int k = 0; k < 2; ++k) acc[ai][bj][m][n] = __builtin_amdgcn_mfma_f32_16x16x32_bf16(Bt[n][k], At[m][k], acc[ai][bj][m][n], 0, 0, 0); } } \
        __builtin_amdgcn_s_setprio(0); } while (0)
#define PG8_WAIT_V(n) asm volatile("s_waitcnt vmcnt(" #n ")" ::: "memory")
#define PG8_WAIT_L(n) asm volatile("s_waitcnt lgkmcnt(" #n ")" ::: "memory")
#define PG8_BAR __builtin_amdgcn_s_barrier()
#define PG8_SCHED __builtin_amdgcn_sched_barrier(0)
    Unit cur, nxt; int ui = 0;
    if (!S.next(0, cur)) return;
    f32x4 acc[2][2][4][2];
#pragma unroll
    for (int a = 0; a < 2; ++a)
#pragma unroll
        for (int b = 0; b < 2; ++b)
#pragma unroll
            for (int m = 0; m < 4; ++m)
#pragma unroll
                for (int n = 0; n < 2; ++n) acc[a][b][m][n] = (f32x4){0.f, 0.f, 0.f, 0.f};
    const int sc8 = 0x7f7f7f7f;
    bf16x8 At[4][2], B0[2][2], B1[2][2]; v8i At8[4], B08[2], B18[2];
    const char* cA = S.a_base(cur); const char* cB = S.b_base(cur);
    if constexpr (KSPLIT) { cA += (size_t)cur.k0 * kstep; cB += (size_t)cur.k0 * kstep; }
    unsigned cvA[2][2] = {{0u, 0u}, {0u, 0u}};
    if constexpr (GATHER) {
        PG8_TABFILL(0, cur);
#pragma unroll
        for (int h = 0; h < 2; ++h)
#pragma unroll
            for (int i = 0; i < 2; ++i) cvA[h][i] = mytab[(h * 2 + i) * 512];
    }
    PG8_STAGE_B(PG8_SB(0, 0), cB); PG8_STAGE_B(PG8_SB(0, 1), cB + hstep); PG8_STAGE_A(PG8_SA(0, 0), cA, cvA, 0); PG8_STAGE_A(PG8_SA(0, 1), cA, cvA, 1);
    if (wr == 1) PG8_BAR;
    PG8_WAIT_V(2); PG8_BAR;
    PG8_STAGE_B(PG8_SB(1, 0), cB + kstep); PG8_STAGE_A(PG8_SA(1, 0), cA + kstep, cvA, 0); PG8_STAGE_B(PG8_SB(1, 1), cB + hstep + kstep);
    PG8_WAIT_V(6); PG8_BAR;
    for (;;) {
        const bool has_next = S.next(ui + 1, nxt);
        const char* nA = has_next ? S.a_base(nxt) : cA; const char* nB = has_next ? S.b_base(nxt) : cB;
        if constexpr (KSPLIT) { if (has_next) { nA += (size_t)nxt.k0 * kstep; nB += (size_t)nxt.k0 * kstep; } }
        if constexpr (GATHER) { if (has_next) PG8_TABFILL((ui + 1) & 1, nxt); }
        const int ntc = KSPLIT ? cur.nk : nt;
#pragma unroll 1
        for (int t = 0; t < ntc; t += 2) {
            const bool last = (t == ntc - 2);
            const char* a1 = cA + (size_t)(t + 1) * kstep;
            const char* a2 = last ? nA : cA + (size_t)(t + 2) * kstep; const char* b2 = last ? nB : cB + (size_t)(t + 2) * kstep;
            const char* a3 = a2 + kstep; const char* b3 = b2 + kstep;
            unsigned wA[2][2] = {{0u, 0u}, {0u, 0u}};
            if constexpr (GATHER) {
                const int pc = ui & 1, pw = (last && has_next) ? (pc ^ 1) : pc;
#pragma unroll
                for (int i = 0; i < 2; ++i) { cvA[1][i] = mytab[(pc * 4 + 2 + i) * 512]; wA[0][i] = mytab[(pw * 4 + i) * 512]; wA[1][i] = mytab[(pw * 4 + 2 + i) * 512]; }
            }
            PG8_LDB(B0, 0, 0); PG8_LDB(B1, 0, 1); PG8_SCHED; PG8_LDA(At, 0, 0); PG8_STAGE_A(PG8_SA(1, 1), a1, cvA, 1);
            PG8_WAIT_V(8); PG8_WAIT_L(0); PG8_BAR; PG8_MMA(0, 0, At, B0); PG8_MMA(0, 1, At, B1); PG8_BAR; PG8_SCHED;
            PG8_LDA(At, 0, 1); PG8_STAGE_B(PG8_SB(0, 0), b2); PG8_STAGE_B(PG8_SB(0, 1), b2 + hstep); PG8_STAGE_A(PG8_SA(0, 0), a2, wA, 0);
            PG8_WAIT_V(8); PG8_WAIT_L(0); PG8_BAR; PG8_MMA(1, 0, At, B0); PG8_MMA(1, 1, At, B1); PG8_BAR; PG8_SCHED;
            PG8_LDB(B0, 1, 0); PG8_LDB(B1, 1, 1); PG8_SCHED; PG8_LDA(At, 1, 0); PG8_STAGE_A(PG8_SA(0, 1), a2, wA, 1);
            PG8_WAIT_V(8); PG8_WAIT_L(0); PG8_BAR; PG8_MMA(0, 0, At, B0); PG8_MMA(0, 1, At, B1); PG8_BAR; PG8_SCHED;
            PG8_LDA(At, 1, 1); PG8_STAGE_B(PG8_SB(1, 0), b3); PG8_STAGE_B(PG8_SB(1, 1), b3 + hstep); PG8_STAGE_A(PG8_SA(1, 0), a3, wA, 0);
            PG8_WAIT_V(8); PG8_WAIT_L(0); PG8_BAR; PG8_MMA(1, 0, At, B0); PG8_MMA(1, 1, At, B1); PG8_BAR; PG8_SCHED;
        }
        if constexpr (ALIGN_EPI) { if (wr == 0) PG8_BAR; }
        if constexpr (FP8) asm volatile("s_nop 15\n\ts_nop 15" ::: "memory");
        { int el; asm volatile("v_mbcnt_lo_u32_b32 %0, -1, 0\n\tv_mbcnt_hi_u32_b32 %0, -1, %0" : "=v"(el));
          E(acc, cur, wr, wc, el & 15, el >> 4); }
        if (!has_next) break;
#pragma unroll
        for (int a = 0; a < 2; ++a)
#pragma unroll
            for (int b = 0; b < 2; ++b)
#pragma unroll
                for (int m = 0; m < 4; ++m)
#pragma unroll
                    for (int n = 0; n < 2; ++n) acc[a][b][m][n] = (f32x4){0.f, 0.f, 0.f, 0.f};
        cur = nxt; cA = nA; cB = nB; ++ui;
        if constexpr (ALIGN_EPI) { if (wr == 1) PG8_BAR; }
    }
    PG8_WAIT_V(0);
    if constexpr (!ALIGN_EPI) { if (wr == 0) PG8_BAR; }
    PG8_BAR;
#undef PG8_SA
#undef PG8_SB
#undef PG8_STAGE_A
#undef PG8_TABFILL
#undef PG8_STAGE_B
#undef PG8_LDA
#undef PG8_LDB
#undef PG8_MMA
#undef PG8_CAT
#undef PG8_WAIT_V
#undef PG8_WAIT_L
#undef PG8_BAR
#undef PG8_SCHED
}
}

#define XB_TMO      128
#define XB_XCNT(j)  (256  + 64 * (j))
#define XB_XSUB(j)  (1280 + 64 * (j))
#define XB_XGEN(j)  (2304 + 64 * (j))
#define XB_TOP      3328
#define XB_TOPGEN   3392
#define XCD_BAR_WORDS 3456
#define XB_SPIN_CAP (1u << 18)
__device__ __forceinline__ unsigned xb_ld(unsigned* p)              { return __hip_atomic_load(p, __ATOMIC_RELAXED, __HIP_MEMORY_SCOPE_AGENT); }
__device__ __forceinline__ unsigned xb_add(unsigned* p, unsigned v) { return __hip_atomic_fetch_add(p, v, __ATOMIC_RELAXED, __HIP_MEMORY_SCOPE_AGENT); }
__device__ __forceinline__ unsigned xb_xcc_id() { return (unsigned)__builtin_amdgcn_s_getreg((3 << 11) | 20) & 0xFu; }
#define XB_SPIN(cond, bar) do { unsigned _sp = 0; while (cond) { __builtin_amdgcn_s_sleep(1); \
    if ((++_sp & 255u) == 0u) { if (xb_ld(&(bar)[XB_TMO])) break; if (_sp > XB_SPIN_CAP) { atomicAdd(&(bar)[XB_TMO], 1u); break; } } } } while (0)
struct XcdBarrier { unsigned* bar; unsigned x; volatile LAS unsigned* st; };
__device__ __forceinline__ XcdBarrier xcd_barrier_post(unsigned* bar, volatile LAS unsigned* st) {
    XcdBarrier b; b.bar = bar; b.x = xb_xcc_id(); b.st = st;
    if (threadIdx.x == 0) (void)xb_add(&bar[XB_XCNT(b.x)], 1u);
    return b;
}
__device__ __forceinline__ void xcd_barrier_complete(unsigned* bar, unsigned x, unsigned& nloc, unsigned& nx) {
    const unsigned G = gridDim.x * gridDim.y * gridDim.z;
    unsigned sum, cnt, mine, sp = 0u;
    for (;;) {
        sum = 0u; cnt = 0u; mine = 0u;
#pragma unroll
        for (unsigned j = 0; j < 16; ++j) { const unsigned c = xb_ld(&bar[XB_XCNT(j)]); sum += c; cnt += (c > 0u) ? 1u : 0u; mine = (j == x) ? c : mine; }
        if (sum == G) break;
        __builtin_amdgcn_s_sleep(1);
        if ((++sp & 255u) == 0u) { if (xb_ld(&bar[XB_TMO])) break; if (sp > XB_SPIN_CAP) { atomicAdd(&bar[XB_TMO], 1u); break; } }
    }
    nloc = mine > 0u ? mine : 1u; nx = cnt > 0u ? cnt : 1u;
}
__device__ __forceinline__ void xcd_barrier(const XcdBarrier& b) {
    asm volatile("s_waitcnt vmcnt(0)" ::: "memory");
    __syncthreads();
    if (threadIdx.x == 0) {
        unsigned* bar = b.bar;
        __builtin_amdgcn_s_waitcnt(0);
        unsigned nloc = b.st[0], nx = b.st[1];
        if (nloc == 0u) { xcd_barrier_complete(bar, b.x, nloc, nx); b.st[0] = nloc; b.st[1] = nx; }
        const unsigned old = xb_add(&bar[XB_XSUB(b.x)], 1u);
        const unsigned gen = old / nloc;
        if (old + 1u == (gen + 1u) * nloc) {
            __builtin_amdgcn_fence(__ATOMIC_RELEASE, "agent");
            asm volatile("s_waitcnt vmcnt(0)" ::: "memory");
            const unsigned og = xb_add(&bar[XB_TOP], 1u);
            const unsigned tg = og / nx;
            if (og + 1u == (tg + 1u) * nx) xb_add(&bar[XB_TOPGEN], 1u);
            else XB_SPIN(xb_ld(&bar[XB_TOPGEN]) == tg, bar);
            __builtin_amdgcn_fence(__ATOMIC_ACQUIRE, "agent");
            xb_add(&bar[XB_XGEN(b.x)], 1u);
            asm volatile("s_waitcnt vmcnt(0)" ::: "memory");
        } else {
            XB_SPIN(xb_ld(&bar[XB_XGEN(b.x)]) == gen, bar);
            __builtin_amdgcn_fence(__ATOMIC_ACQUIRE, "agent");
            asm volatile("s_waitcnt vmcnt(0)" ::: "memory");
        }
    }
    __syncthreads();
}

struct Args {
    const float* x; const float* c; const float* ada_w; const float* ada_b; const float* norm1_g; const float* norm2_g;
    const float* da_w_in; const float* da_q_gain; const float* da_k_gain; const float* da_lam_q1; const float* da_lam_k1; const float* da_lam_q2; const float* da_lam_k2;
    const float* da_subln_g; const float* da_w_out;
    const float* gla_w_in; const float* gla_w_a1; const float* gla_w_a2; const float* gla_b_a; const float* gla_out_g; const float* gla_w_out;
    const float* ffn_w1; const float* ffn_w3; const float* ffn_w2;
    const float* moe_router; const float* moe_w1; const float* moe_w3; const float* moe_w2;
    float* out; unsigned char* ws; int ph_lo, ph_hi;
};

__device__ __forceinline__ void p0_transpose_item(const float* W, int ldw, int k0, int n0, bf16* WT, int dst_row0, int Kp, LAS float* scr, int lane) {
#pragma unroll 8
    for (int i = 0; i < 32; ++i) { const int kk = 2 * i + (lane >> 5); scr[kk * 33 + (lane & 31)] = W[(size_t)(k0 + kk) * ldw + n0 + (lane & 31)]; }
    asm volatile("s_waitcnt lgkmcnt(0)" ::: "memory");
    const int c = lane & 7;
#pragma unroll
    for (int j = 0; j < 4; ++j) { const int n = (lane >> 3) + 8 * j; const LAS float* s = scr + (8 * c) * 33 + n;
        u32x4 o; o.x = pk2(s[0 * 33], s[1 * 33]); o.y = pk2(s[2 * 33], s[3 * 33]); o.z = pk2(s[4 * 33], s[5 * 33]); o.w = pk2(s[6 * 33], s[7 * 33]);
        *(u32x4*)(WT + (size_t)(dst_row0 + n) * Kp + k0 + 8 * c) = o; }
    asm volatile("s_waitcnt lgkmcnt(0)" ::: "memory");
}

__device__ __forceinline__ void p0_transpose_item8(const float* W, int ldw, int k0, int n0, unsigned char* WT8, int dst_row0, int Kp, LAS float* scr, int lane) {
#pragma unroll 8
    for (int i = 0; i < 32; ++i) { const int kk = 2 * i + (lane >> 5); scr[kk * 33 + (lane & 31)] = W[(size_t)(k0 + kk) * ldw + n0 + (lane & 31)]; }
    asm volatile("s_waitcnt lgkmcnt(0)" ::: "memory");
    const int c = lane & 7;
#pragma unroll
    for (int j = 0; j < 4; ++j) { const int n = (lane >> 3) + 8 * j; const LAS float* sp = scr + (8 * c) * 33 + n;
        const u32x2 o = (u32x2){pk_fp8x4(sp[0 * 33] * W8_SCALE, sp[1 * 33] * W8_SCALE, sp[2 * 33] * W8_SCALE, sp[3 * 33] * W8_SCALE), pk_fp8x4(sp[4 * 33] * W8_SCALE, sp[5 * 33] * W8_SCALE, sp[6 * 33] * W8_SCALE, sp[7 * 33] * W8_SCALE)};
        *(u32x2*)(WT8 + (size_t)(dst_row0 + n) * Kp + k0 + 8 * c) = o; }
    asm volatile("s_waitcnt lgkmcnt(0)" ::: "memory");
}

namespace att {
__device__ __forceinline__ int crow(int r, int hi) { return (r & 3) + 8 * (r >> 2) + 4 * hi; }
__host__ __device__ constexpr int dwin(int h) { return (int)(150.0 / (1.4426950408889634 / (double)(1 << (h + 1)))); }
__host__ __device__ constexpr int tstart(int h, int jq) { const int q0 = 128 * jq, d = dwin(h); return q0 > d ? (q0 - d) / 64 : 0; }
struct Plan { unsigned char n[16]; unsigned char u[16][48]; };
constexpr Plan make_plan() {
    Plan p{}; int load[16] = {};
    for (int w = 0; w < 16; ++w) p.n[w] = 0;
    for (int h = 7; h >= 0; --h) {
        int cost[32] = {}, ord[32] = {};
        for (int j = 0; j < 32; ++j) { cost[j] = 2 * j + 2 - tstart(h, j); ord[j] = j; }
        for (int a = 1; a < 32; ++a) { const int x = ord[a]; int b = a - 1; while (b >= 0 && cost[ord[b]] < cost[x]) { ord[b + 1] = ord[b]; --b; } ord[b + 1] = x; }
        for (int a = 0; a < 32; ++a) { int best = 0; for (int w = 1; w < 16; ++w) if (load[w] < load[best]) best = w;
            p.u[best][p.n[best]++] = (unsigned char)(h * 32 + ord[a]); load[best] += cost[ord[a]]; }
    }
    return p;
}
__device__ const Plan PLAN = make_plan();
constexpr int BUFB = 32768, NBUF = 3, KOFF = 0, VOFF = 16384, WSF_OFF = NBUF * BUFB;
__device__ __forceinline__ s16x4 vtr(const LAS unsigned char* p) { return __builtin_bit_cast(s16x4, __builtin_amdgcn_ds_read_tr16_b64_v4i16((LAS s16x4*)p)); }

__device__ __forceinline__ void attn_unit(LAS unsigned char* lds, const bf16* Q, const bf16* K, const bf16* V, bf16* O, int b, int h, int jq,
                                          float sl2, float mref0, float mref1, float lam, const float* subg) {
    const int tid = threadIdx.x, lane = tid & 63, r32 = lane & 31, hi = lane >> 5; const int wid = __builtin_amdgcn_readfirstlane(tid >> 6);
    const int mp = wid >> 2, w4 = wid & 3;
    const size_t rowbase = (size_t)b * SEQ; const int q0 = jq * 128;
    const int nT = (q0 >> 6) + 2, myc = (q0 + 32 * w4) >> 6, t0 = tstart(h, jq);
    const bf16* Qw = Q + (rowbase + q0 + 32 * w4 + r32) * D + h * 128 + mp * 64 + hi * 8;
    bf16x8 qr[4];
#pragma unroll
    for (int d0 = 0; d0 < 4; ++d0) qr[d0] = *(const bf16x8*)(Qw + d0 * 16);
    const bf16* ksrc = K + ((size_t)(b * 8 + h) * 64 * 16 + wid) * 512 + lane * 8;
    const int p0 = wid, p1 = wid + 8;
    const bf16* vsrc0 = V + ((size_t)(b * 8 + h) * 64 * 16 + p0) * 512 + lane * 8;
    const bf16* vsrc1 = V + ((size_t)(b * 8 + h) * 64 * 16 + p1) * 512 + lane * 8;
#define ATT_DMA1(gp_, la_) asm volatile("s_mov_b32 m0, %0\n\ts_nop 0\n\tglobal_load_lds_dwordx4 %1, off" :: "s"(la_), "v"(gp_) : "memory", "m0")
#define ATT_DMA(t, bs) do { const unsigned bb_ = (unsigned)__builtin_amdgcn_readfirstlane((int)(ldsu + (unsigned)((bs) * BUFB))); \
        ATT_DMA1(ksrc + (size_t)(t) * 8192, bb_ + (unsigned)(KOFF + wid * 1024)); \
        ATT_DMA1(ksrc + (size_t)(t) * 8192 + 4096, bb_ + (unsigned)(KOFF + 8192 + wid * 1024)); \
        ATT_DMA1(vsrc0 + (size_t)(t) * 8192, bb_ + (unsigned)(VOFF + p0 * 1024)); \
        ATT_DMA1(vsrc1 + (size_t)(t) * 8192, bb_ + (unsigned)(VOFF + p1 * 1024)); } while (0)
    const unsigned ldsu = (unsigned)(unsigned long long)lds;
    const float qpos = (float)(q0 + 32 * w4 + r32);
    const float mref = mp ? mref1 : mref0;
    const float baseL = -sl2 * qpos - mref, sl8 = 8.0f * sl2, sl32 = 32.0f * sl2;
    float lsum = 0.f; f32x16 o[4];
#pragma unroll
    for (int d0 = 0; d0 < 4; ++d0)
#pragma unroll
        for (int r = 0; r < 16; ++r) o[d0][r] = 0.f;
    ATT_DMA(t0, 0);
    if (t0 + 1 < nT) ATT_DMA(t0 + 1, 1);
    asm volatile("" :: "v"(qr[0]), "v"(qr[1]), "v"(qr[2]), "v"(qr[3]) : "memory");
    int slot = 0;
    for (int t = t0; t < nT; ++t) {
        if (t + 1 < nT) asm volatile("s_waitcnt vmcnt(4)" ::: "memory"); else asm volatile("s_waitcnt vmcnt(0)" ::: "memory");
        asm volatile("s_waitcnt lgkmcnt(0)" ::: "memory"); __builtin_amdgcn_s_barrier(); asm volatile("" ::: "memory");
        if (t + 2 < nT) { const int s2 = slot >= 1 ? slot - 1 : 2; ATT_DMA(t + 2, s2); }
        if (t <= myc) {
            const LAS unsigned char* bb = lds + slot * BUFB;
            f32x16 c0, c1;
            if (t < myc) {
                const float kb = baseL + sl2 * (float)(64 * t + 4 * hi);
#pragma unroll
                for (int r = 0; r < 16; ++r) { c0[r] = (r == 0) ? kb : ((r & 3) ? c0[r - 1] + sl2 : c0[r - 4] + sl8); c1[r] = c0[r] + sl32; }
            } else {
                const float qk = qpos - (float)(64 * t + 4 * hi);
                float x[16];
#pragma unroll
                for (int r = 0; r < 16; ++r) { x[r] = (r == 0) ? qk : ((r & 3) ? x[r - 1] - 1.0f : x[r - 4] - 8.0f); c0[r] = -sl2 * fabsf(x[r]) - mref; c1[r] = -sl2 * fabsf(x[r] - 32.0f) - mref; }
            }
            const LAS unsigned char* kb_ = bb + KOFF + mp * 8192 + hi * 1024 + r32 * 16;
#define ATT_SB() __builtin_amdgcn_sched_barrier(0)
            bf16x8 kf[8];
#pragma unroll
            for (int d0 = 0; d0 < 4; ++d0) { kf[2 * d0] = *(const LAS bf16x8*)(kb_ + d0 * 2048); kf[2 * d0 + 1] = *(const LAS bf16x8*)(kb_ + d0 * 2048 + 512); }
            const LAS unsigned char* vp = bb + VOFF + ((lane >> 4) & 1) * 32 + (lane & 3) * 8 + (4 * hi + ((lane & 15) >> 2)) * 64;
            s16x4 vlo[16], vhi[16];
#pragma unroll
            for (int ks = 0; ks < 2; ++ks)
#pragma unroll
                for (int d0 = 0; d0 < 4; ++d0) { vlo[d0 * 4 + ks] = vtr(vp + d0 * 4096 + ks * 1024); vhi[d0 * 4 + ks] = vtr(vp + d0 * 4096 + ks * 1024 + 512); }
            ATT_SB();
#pragma unroll
            for (int d0 = 0; d0 < 4; ++d0) c0 = __builtin_amdgcn_mfma_f32_32x32x16_bf16(kf[2 * d0], qr[d0], c0, 0, 0, 0);
            ATT_SB();
            float sacc = 0.f;
#pragma unroll
            for (int d0 = 0; d0 < 4; ++d0) {
                c1 = __builtin_amdgcn_mfma_f32_32x32x16_bf16(kf[2 * d0 + 1], qr[d0], c1, 0, 0, 0);
                ATT_SB();
#pragma unroll
                for (int e = 0; e < 4; ++e) { c0[4 * d0 + e] = __builtin_amdgcn_exp2f(c0[4 * d0 + e]); sacc += c0[4 * d0 + e]; }
                ATT_SB();
            }
            u32x4 pw[4];
#pragma unroll
            for (int g = 0; g < 4; ++g) { pw[0][g] = cvt_pk_bf16(c0[2 * g], c0[2 * g + 1]); pw[1][g] = cvt_pk_bf16(c0[8 + 2 * g], c0[8 + 2 * g + 1]); }
#pragma unroll
            for (int ks = 2; ks < 4; ++ks)
#pragma unroll
                for (int d0 = 0; d0 < 4; ++d0) { vlo[d0 * 4 + ks] = vtr(vp + d0 * 4096 + ks * 1024); vhi[d0 * 4 + ks] = vtr(vp + d0 * 4096 + ks * 1024 + 512); }
            ATT_SB();
#pragma unroll
            for (int j = 0; j < 8; ++j) { const int ks = j >> 2, d0 = j & 3;
                { const s16x4 lo = vlo[d0 * 4 + ks], hh = vhi[d0 * 4 + ks];
                  const bf16x8 vf = (bf16x8){lo[0], lo[1], lo[2], lo[3], hh[0], hh[1], hh[2], hh[3]};
                  o[d0] = __builtin_amdgcn_mfma_f32_32x32x16_bf16(__builtin_bit_cast(bf16x8, pw[ks]), vf, o[d0], 0, 0, 0); }
                ATT_SB();
                c1[2 * j] = __builtin_amdgcn_exp2f(c1[2 * j]); c1[2 * j + 1] = __builtin_amdgcn_exp2f(c1[2 * j + 1]); sacc += c1[2 * j] + c1[2 * j + 1];
                ATT_SB();
            }
            lsum += sacc;
#pragma unroll
            for (int g = 0; g < 4; ++g) { pw[2][g] = cvt_pk_bf16(c1[2 * g], c1[2 * g + 1]); pw[3][g] = cvt_pk_bf16(c1[8 + 2 * g], c1[8 + 2 * g + 1]); }
            ATT_SB();
#pragma unroll
            for (int j = 8; j < 16; ++j) { const int ks = j >> 2, d0 = j & 3;
                const s16x4 lo = vlo[d0 * 4 + ks], hh = vhi[d0 * 4 + ks];
                const bf16x8 vf = (bf16x8){lo[0], lo[1], lo[2], lo[3], hh[0], hh[1], hh[2], hh[3]};
                o[d0] = __builtin_amdgcn_mfma_f32_32x32x16_bf16(__builtin_bit_cast(bf16x8, pw[ks]), vf, o[d0], 0, 0, 0); }
#undef ATT_SB
        }
        slot = slot == 2 ? 0 : slot + 1;
    }
#undef ATT_DMA
#undef ATT_DMA1
    int el; asm volatile("v_mbcnt_lo_u32_b32 %0, -1, 0\n\tv_mbcnt_hi_u32_b32 %0, -1, %0" : "=v"(el));
    const int r32e = el & 31, hie = el >> 5;
    lsum += __shfl_xor(lsum, 32);
    LAS float* wsf = (LAS float*)(lds + WSF_OFF) + wid * 32;
    if (hie == 0) wsf[r32e] = lsum;
    asm volatile("s_waitcnt lgkmcnt(0)" ::: "memory");
    float rl[16];
#pragma unroll
    for (int r = 0; r < 16; ++r) rl[r] = __builtin_amdgcn_rcpf(wsf[crow(r, hie)]);
#pragma unroll
    for (int d0 = 0; d0 < 4; ++d0)
#pragma unroll
        for (int r = 0; r < 16; ++r) o[d0][r] *= rl[r];
    __syncthreads();
    LAS float* X = (LAS float*)lds + w4 * 4096;
    if (mp == 1) {
#pragma unroll
        for (int d0 = 0; d0 < 4; ++d0)
#pragma unroll
            for (int r = 0; r < 16; ++r) X[(d0 * 16 + r) * 64 + el] = o[d0][r];
    }
    __syncthreads();
    if (mp == 0) {
        float ss[16];
#pragma unroll
        for (int r = 0; r < 16; ++r) ss[r] = 0.f;
#pragma unroll
        for (int d0 = 0; d0 < 4; ++d0)
#pragma unroll
            for (int r = 0; r < 16; ++r) { const float dd = o[d0][r] - lam * X[(d0 * 16 + r) * 64 + el]; o[d0][r] = dd; ss[r] += dd * dd; }
#pragma unroll
        for (int r = 0; r < 16; ++r) {
            float s = ss[r];
#pragma unroll
            for (int of = 1; of < 32; of <<= 1) s += __shfl_xor(s, of);
            ss[r] = __builtin_amdgcn_rsqf(s * (1.0f / 128.0f) + EPS) * 0.8f;
        }
        bf16* Ow = O + (rowbase + q0 + 32 * w4) * D + h * 128 + r32e;
#pragma unroll
        for (int d0 = 0; d0 < 4; ++d0) { const float gcol = subg[32 * d0 + r32e];
#pragma unroll
            for (int r = 0; r < 16; ++r) Ow[(size_t)crow(r, hie) * D + 32 * d0] = (bf16)f2bf(o[d0][r] * ss[r] * gcol); }
    }
    __syncthreads();
}
}

__global__ void __launch_bounds__(NWAVES * 64, 2) mk_fwd(Args args) {
    extern __shared__ __attribute__((aligned(16))) unsigned char lds_raw[];
    LAS unsigned char* lds = (LAS unsigned char*)lds_raw;
    volatile LAS unsigned* MISC = (volatile LAS unsigned*)(lds + MISC_OFF);
    const int tid = threadIdx.x, lane = tid & 63, wave = __builtin_amdgcn_readfirstlane(tid >> 6);
    const int G = gridDim.x; const int bx = blockIdx.x;
    const int vcu = (G % 8 == 0) ? (bx % 8) * (G / 8) + bx / 8 : bx;
    unsigned char* ws = args.ws;
    unsigned* ctl = (unsigned*)(ws + WS_CTL);
    float* MOD = (float*)(ws + WS_MOD);
    unsigned* LCNT = (unsigned*)(ws + WS_LCNT);
    int* META = (int*)(ws + WS_META);
    u32x4* ROUTE = (u32x4*)(ws + WS_ROUTE);
    int* TOKSLOT = (int*)(ws + WS_TOKSLOT);
    float* GSLOT = (float*)(ws + WS_GSLOT);
    bf16* W_DAIN = (bf16*)(ws + WS_W_DAIN); bf16* W_DAOUT = (bf16*)(ws + WS_W_DAOUT); bf16* W_FFN13 = (bf16*)(ws + WS_W_FFN13); bf16* W_FFN2 = (bf16*)(ws + WS_W_FFN2);
    bf16* W_GLAIN = (bf16*)(ws + WS_W_GLAIN); bf16* W_GLAOUT = (bf16*)(ws + WS_W_GLAOUT); bf16* W_MOE13 = (bf16*)(ws + WS_W_MOE13); bf16* W_MOE2 = (bf16*)(ws + WS_W_MOE2);
    bf16* HB = (bf16*)(ws + WS_H);
    bf16* QB = (bf16*)(ws + WS_Q);
    bf16* KB = QB + (size_t)M * D; bf16* VB = KB + (size_t)M * D;
    bf16* ACTB = QB;
    bf16* GP = QB;
    bf16* GLAB = QB + (size_t)M * 3072;
    float* out = args.out;
    bf16* XB = (bf16*)(ws + WS_XB);
    float* KPART = (float*)(ws + WS_Q + 320 * MiB);
    static_assert(MOE_DN8 && (size_t)MAXSLOT * EXPD <= 320 * MiB && 320 * MiB + 256 * (size_t)(32 * 512 * 16) <= 464 * MiB, "K-split partials do not fit behind the MoE activations");

    for (int u = tid; u < 256; u += NWAVES * 64) ((LAS unsigned*)(lds + MISC_OFF))[u] = 0u;
    __syncthreads();
    XcdBarrier bar; bar.bar = ctl + CW_BAR; bar.x = 0; bar.st = nullptr;
    if (MK_N_LAUNCHES == 1) bar = xcd_barrier_post(ctl + CW_BAR, MISC + 8);
    const int lo = args.ph_lo, hi = args.ph_hi;
#define IN(k) (lo <= (k) && (k) < hi)
#define SEAM(k) do { if (IN(k) && IN((k) + 1)) xcd_barrier(bar); } while (0)
    const int gw = vcu * NWAVES + wave, NGW = G * NWAVES;

    if (IN(0)) {
        if (bx < 192) {
            LAS float* cact = (LAS float*)lds;
            for (int e = tid; e < 16 * 1024; e += 512) { const int b = e >> 10, k = e & 1023; const float v = args.c[e]; cact[k * 16 + b] = v / (1.0f + __expf(-v)); }
            __syncthreads();
            const int col = tid & 63, ks = tid >> 6, n = bx * 64 + col, layer = n / 6144, nn = n % 6144;
            const float* wp = args.ada_w + (size_t)layer * 1024 * 6144 + nn;
            float a[16];
#pragma unroll
            for (int b = 0; b < 16; ++b) a[b] = 0.f;
            for (int k = ks * 128; k < ks * 128 + 128; ++k) { const float w = wp[(size_t)k * 6144];
#pragma unroll
                for (int q = 0; q < 4; ++q) { const f32x4 cv = *(const LAS f32x4*)(cact + k * 16 + 4 * q); a[4 * q] += cv[0] * w; a[4 * q + 1] += cv[1] * w; a[4 * q + 2] += cv[2] * w; a[4 * q + 3] += cv[3] * w; } }
            LAS float* red = (LAS float*)(lds + 65536);
#pragma unroll
            for (int b = 0; b < 16; ++b) red[(ks * 16 + b) * 64 + col] = a[b];
            __syncthreads();
            for (int e = tid; e < 1024; e += 512) { const int b = e >> 6, cc = e & 63; float s = 0.f;
#pragma unroll
                for (int k8 = 0; k8 < 8; ++k8) s += red[(k8 * 16 + b) * 64 + cc];
                const int n2 = bx * 64 + cc, l2 = n2 / 6144, nn2 = n2 % 6144;
                MOD[((size_t)l2 * 16 + b) * 6144 + nn2] = s + args.ada_b[l2 * 6144 + nn2]; }
            __syncthreads();
        }
        for (int i = bx * 512 + tid; i < 2 * MAXSLOT; i += G * 512) TOKSLOT[i] = -1;
        LAS float* scr = (LAS float*)(lds + wave * 16384);
        constexpr int I_DAIN = 16 * 96, I_SQ = 16 * 32, I_F13 = 16 * 88, I_F2 = 44 * 32, I_GLAIN = 16 * 96, I_GA = 512;
        constexpr int NITEMS = I_DAIN + I_SQ + 2 * I_F13 + I_F2 + I_GLAIN + I_SQ + I_GA;
        for (int it = gw; it < NITEMS; it += NGW) {
            int r = it;
            if (r < I_DAIN) { const int kb = r / 96, nb = r % 96, n0 = 32 * nb, l = n0 & 255;
                p0_transpose_item(args.da_w_in, 3072, 64 * kb, n0, W_DAIN, (n0 & ~255) + 128 * ((l >> 5) & 1) + 32 * (l >> 6), D, scr, lane); continue; } r -= I_DAIN;
            if (r < I_SQ) { const int kb = r / 32, nb = r % 32; p0_transpose_item(args.da_w_out, D, 64 * kb, 32 * nb, W_DAOUT, 32 * nb, D, scr, lane); continue; } r -= I_SQ;
            if (r < 2 * I_F13) { const int w = r / I_F13, q = r % I_F13, kb = q / 88, nb = q % 88, n0 = 32 * nb;
                if (FFN_UP8) p0_transpose_item8(w ? args.ffn_w3 : args.ffn_w1, FFN, 64 * kb, n0, (unsigned char*)W_FFN13, (n0 >> 7) * 256 + w * 128 + (n0 & 127), D, scr, lane);
                else p0_transpose_item(w ? args.ffn_w3 : args.ffn_w1, FFN, 64 * kb, n0, W_FFN13, (n0 >> 7) * 256 + w * 128 + (n0 & 127), D, scr, lane); continue; } r -= 2 * I_F13;
            if (r < I_F2) { const int kb = r / 32, nb = r % 32; if (FFN_DN8) p0_transpose_item8(args.ffn_w2, D, 64 * kb, 32 * nb, (unsigned char*)W_FFN2, 32 * nb, FFN, scr, lane); else p0_transpose_item(args.ffn_w2, D, 64 * kb, 32 * nb, W_FFN2, 32 * nb, FFN, scr, lane); continue; } r -= I_F2;
            if (r < I_GLAIN) { const int kb = r / 96, nb = r % 96; p0_transpose_item(args.gla_w_in, 3072, 64 * kb, 32 * nb, W_GLAIN, 32 * nb, D, scr, lane); continue; } r -= I_GLAIN;
            if (r < I_SQ) { const int kb = r / 32, nb = r % 32; p0_transpose_item(args.gla_w_out, D, 64 * kb, 32 * nb, W_GLAOUT, 32 * nb, D, scr, lane); continue; } r -= I_SQ;
            if (r < I_GA) {
                const int j = r; float a2[16];
#pragma unroll
                for (int q = 0; q < 16; ++q) a2[q] = args.gla_w_a2[q * 512 + j];
                bf16* dst = W_GLAIN + (size_t)(3072 + j) * D + lane * 16;
                unsigned pk[8];
#pragma unroll
                for (int kk = 0; kk < 16; kk += 2) { float s0 = 0.f, s1 = 0.f; const float* w1p = args.gla_w_a1 + (size_t)(lane * 16 + kk) * 16;
#pragma unroll
                    for (int q = 0; q < 16; ++q) { s0 += w1p[q] * a2[q]; s1 += w1p[16 + q] * a2[q]; }
                    pk[kk >> 1] = pk2(s0, s1); }
                *(u32x4*)dst = (u32x4){pk[0], pk[1], pk[2], pk[3]}; *(u32x4*)(dst + 8) = (u32x4){pk[4], pk[5], pk[6], pk[7]};
                continue; }
        }
    }
    SEAM(0);

#define NORM_LOAD(XSRC, SRC16, m_, v_, s_) do { s_ = 0.f; \
            _Pragma("unroll") for (int j = 0; j < 4; ++j) { v_[j] = (SRC16) ? ld_bf16x4((const bf16*)(XSRC) + (size_t)(m_) * D + 4 * lane + 256 * j) : *((const f32x4*)((const float*)(XSRC) + (size_t)(m_) * D) + lane + 64 * j); s_ += (v_[j][0] * v_[j][0] + v_[j][1] * v_[j][1]) + (v_[j][2] * v_[j][2] + v_[j][3] * v_[j][3]); } } while (0)
#define NORM_ROW(GVEC, MODROW, ROUTER, OUT8, m_, v_, s_) do { const int m = (m_); const int b = m >> 12; f32x4 (&v)[4] = v_; \
            const float* mrow = (MODROW) + (size_t)b * 6144; \
            const float rstd = __builtin_amdgcn_rsqf(wave_sum(s_) * (1.0f / D) + EPS); \
            _Pragma("unroll") for (int j = 0; j < 4; ++j) { const f32x4 gg = *((const f32x4*)(GVEC) + lane + 64 * j), sh = *((const f32x4*)mrow + lane + 64 * j), sc = *((const f32x4*)(mrow + 1024) + lane + 64 * j); \
                v[j] = v[j] * rstd * gg * (sc + 1.0f) + sh; } \
            if (OUT8) { unsigned* o4 = (unsigned*)((unsigned char*)HB + (size_t)m * D) + lane; \
                _Pragma("unroll") for (int j = 0; j < 4; ++j) o4[64 * j] = pk_fp8x4(v[j][0] * H8_SCALE, v[j][1] * H8_SCALE, v[j][2] * H8_SCALE, v[j][3] * H8_SCALE); } \
            else { u32x2* o8 = (u32x2*)(HB + (size_t)m * D) + lane; \
                _Pragma("unroll") for (int j = 0; j < 4; ++j) o8[64 * j] = (u32x2){pk2(v[j][0], v[j][1]), pk2(v[j][2], v[j][3])}; } \
            if (ROUTER) { ROUTER_BODY } } while (0)
#define NORM_PHASE(XSRC, SRC16, GVEC, MODROW, ROUTER, OUT8) do { \
        const int rpw = (M + NGW - 1) / NGW; const int r_lo = (ROUTER ? (bx * NWAVES + wave) : gw) * rpw; \
        for (int rr = 0; rr < rpw; rr += 2) { const int m0 = r_lo + rr; if (m0 >= M) break; const bool two = (rr + 1 < rpw) && (m0 + 1 < M); \
            f32x4 va[4], vb[4]; float sa, sb = 0.f; \
            NORM_LOAD(XSRC, SRC16, m0, va, sa); if (two) NORM_LOAD(XSRC, SRC16, m0 + 1, vb, sb); \
            NORM_ROW(GVEC, MODROW, ROUTER, OUT8, m0, va, sa); if (two) NORM_ROW(GVEC, MODROW, ROUTER, OUT8, m0 + 1, vb, sb); } } while (0)
#define ROUTER_BODY
    if (IN(1)) { NORM_PHASE(args.x, false, args.norm1_g, MOD, 0, false); }
    SEAM(1);

    if (IN(2)) {
        pg8::DenseSched S; S.init(M / 256, 12, G, bx); S.A = (const char*)HB; S.Bt = (const char*)W_DAIN; S.tstep = (size_t)256 * D * 2;
        pg8::EpiQKV E{QB, (size_t)M * D, args.da_q_gain, args.da_k_gain, 0.125f * LOG2E};
        pg8::gemm_phase<pg8::EpiQKV, pg8::DenseSched, true, false>(lds, 2 * D, S, E);
    }
    SEAM(2);

    if (IN(3)) {
        float a1 = args.da_lam_q1[lane] * args.da_lam_k1[lane], a2 = args.da_lam_q2[lane] * args.da_lam_k2[lane];
        const float lam = __expf(wave_sum(a1)) - __expf(wave_sum(a2)) + 0.2f;
        const float gq0 = wave_max(fabsf(args.da_q_gain[lane])), gq1 = wave_max(fabsf(args.da_q_gain[64 + lane]));
        const float gk0 = wave_max(fabsf(args.da_k_gain[lane])), gk1 = wave_max(fabsf(args.da_k_gain[64 + lane]));
        const float mref0 = 8.0f * LOG2E * gq0 * gk0 * 1.01f, mref1 = 8.0f * LOG2E * gq1 * gk1 * 1.01f;
        for (int rep = 0; rep < (PROBE_DUP == 3 ? 2 : 1); ++rep)
        for (int bb = vcu >> 4; bb < BATCH; bb += (G >= 16 ? (G >> 4) : 1)) {
            const int w16 = vcu & 15, nu = att::PLAN.n[w16];
            for (int i = 0; i < nu; ++i) { const int hj = att::PLAN.u[w16][i], h = hj >> 5, jq = hj & 31;
                const float sl2 = LOG2E * exp2f(-(float)(h + 1));
                att::attn_unit(lds, QB, KB, VB, HB, bb, h, jq, sl2, mref0, mref1, lam, args.da_subln_g); }
        }
    }
    SEAM(3);

    if (IN(4)) {
        pg8::DenseSched S; S.init(M / 256, 4, G, bx); S.A = (const char*)HB; S.Bt = (const char*)W_DAOUT; S.tstep = (size_t)256 * D * 2;
        pg8::EpiResid<false, true> E{args.x, XB, MOD + 2048, 1.0f};
        pg8::gemm_phase<pg8::EpiResid<false, true>, pg8::DenseSched, true, false>(lds, 2 * D, S, E);
    }
    SEAM(4);
    if (IN(5)) { NORM_PHASE(XB, true, args.norm2_g, MOD + 3072, 0, FFN_UP8); }
    SEAM(5);

    if (IN(6)) {
        pg8::DenseSched S; S.init(M / 256, 2 * FFN / 256, G, bx); S.A = (const char*)HB; S.Bt = (const char*)W_FFN13; S.tstep = (size_t)256 * D * (FFN_UP8 ? 1 : 2);
        pg8::EpiSwiGLU<FFN_DN8> E{ACTB, FFN, FFN_UP8 ? 1.0f / (H8_SCALE * W8_SCALE) : 1.0f};
        pg8::gemm_phase<pg8::EpiSwiGLU<FFN_DN8>, pg8::DenseSched, true, false, FFN_UP8>(lds, D * (FFN_UP8 ? 1 : 2), S, E);
    }
    SEAM(6);
    if (IN(7)) {
        pg8::DenseSched S; S.init(M / 256, 4, G, bx); S.A = (const char*)ACTB; S.Bt = (const char*)W_FFN2; S.tstep = (size_t)256 * FFN * (FFN_DN8 ? 1 : 2);
        pg8::EpiResid<true, true> E{XB, XB, MOD + 5 * 1024, FFN_DN8 ? 1.0f / (A8_SCALE * W8_SCALE) : 1.0f};
        pg8::gemm_phase<pg8::EpiResid<true, true>, pg8::DenseSched, true, false, FFN_DN8>(lds, FFN * (FFN_DN8 ? 1 : 2), S, E);
    }
    SEAM(7);

    float* MOD1 = MOD + 16 * 6144;
    if (IN(8)) { NORM_PHASE(XB, true, args.norm1_g + D, MOD1, 0, false); }
    SEAM(8);
    if (IN(9)) {
        pg8::DenseSched S; S.init(M / 256, GLA_N / 256, G, bx); S.A = (const char*)HB; S.Bt = (const char*)W_GLAIN; S.tstep = (size_t)256 * D * 2;
        pg8::EpiGLA E{GP, GLAB, args.gla_b_a, args.gla_out_g};
        pg8::gemm_phase<pg8::EpiGLA, pg8::DenseSched, true, false>(lds, 2 * D, S, E);
    }
    SEAM(9);

    unsigned char* GA = (unsigned char*)out;
    static_assert(4096 * GA_UNIT <= 192 * MiB && 256 * MiB <= (size_t)M * D * 4 && (size_t)M * 512 * 2 >= 64 * MiB, "o-fragment parking");
#define OFRAG(b_, n_, h_) (((b_) < 8 ? (unsigned char*)GLAB : (unsigned char*)out + 192 * MiB) + (size_t)(((((b_) & 7) * 64 + (n_)) * 4) + (h_)) * 32768)
    if (IN(10)) {
        LAS unsigned char* QDp = lds; LAS unsigned char* KDTc = lds + 16384; LAS unsigned char* ATc = lds + 32768; LAS float* DV = (LAS float*)(lds + 40960);
        LAS bf16* KI = (LAS bf16*)(lds + 43008); LAS float* QT = (LAS float*)(lds + 60416);
        const int fr = lane & 15, fq = lane >> 4;
        const int j = tid & 127, tq = tid >> 7;
        const int cq = j >> 4, wq = j & 15, hq = (wq >> 2) & 1, jq2 = ((wq >> 3) << 2) | (wq & 3);
        for (int rep = 0; rep < (PROBE_DUP == 10 ? 2 : 1); ++rep)
        for (int u = bx; u < 4096; u += G) {
            const int h = u & 3, n = (u >> 2) & 63, b = u >> 8;
            const size_t R0 = (size_t)b * SEQ + 64 * n;
            float la[16], qv[16], kv[16];
#pragma unroll
            for (int i = 0; i < 16; ++i) { const size_t row = R0 + 16 * tq + i; la[i] = bf2f(GLAB[row * 512 + h * 128 + j]); qv[i] = bf2f(GP[row * 3072 + h * 128 + j]); kv[i] = bf2f(GP[row * 3072 + 512 + h * 128 + j]); }
#pragma unroll
            for (int i = 1; i < 16; ++i) la[i] += la[i - 1];
            QT[tq * 128 + j] = la[15];
            __syncthreads();
            float pre = 0.f, tot = 0.f;
#pragma unroll
            for (int q = 0; q < 4; ++q) { const float v = QT[q * 128 + j]; tot += v; pre += (q < tq) ? v : 0.f; }
            unsigned kdp[8];
#pragma unroll
            for (int i = 0; i < 16; ++i) { const float bb = pre + la[i]; const int t = 16 * tq + i;
                *(LAS bf16*)(QDp + (((cq * 2 + hq) * 64 + t) * 16) + jq2 * 2) = (bf16)f2bf(qv[i] * 0.08838834764831845f * __expf(bb));
                KI[t * 136 + j] = (bf16)f2bf(kv[i] * __expf(-bb));
                const float kd = kv[i] * __expf(tot - bb);
                if (i & 1) kdp[i >> 1] |= f2bf(kd) << 16; else kdp[i >> 1] = f2bf(kd); }
            *(LAS u32x4*)(KDTc + ((2 * tq) * 128 + j) * 16) = (u32x4){kdp[0], kdp[1], kdp[2], kdp[3]};
            *(LAS u32x4*)(KDTc + ((2 * tq + 1) * 128 + j) * 16) = (u32x4){kdp[4], kdp[5], kdp[6], kdp[7]};
            if (tq == 0) DV[j] = __expf(tot);
            __syncthreads();
#pragma unroll
            for (int q = 0; q < 2; ++q) { const int idx = 2 * wave + q, ti = idx >> 2, si = idx & 3;
                f32x4 c = (f32x4){0.f, 0.f, 0.f, 0.f};
                if (si <= ti) {
#pragma unroll
                    for (int ks = 0; ks < 4; ++ks) { const int cc = 2 * ks + (fq >> 1), jb = 4 * (fq & 1), t = 16 * ti + fr;
                        const u32x2 alo = *(const LAS u32x2*)(QDp + (((cc * 2 + 0) * 64 + t) * 16) + jb * 2), ahi = *(const LAS u32x2*)(QDp + (((cc * 2 + 1) * 64 + t) * 16) + jb * 2);
                        const u32x4 af = (u32x4){alo[0], alo[1], ahi[0], ahi[1]};
                        const bf16x8 bfr = *(const LAS bf16x8*)(KI + (16 * si + fr) * 136 + 32 * ks + 8 * fq);
                        c = __builtin_amdgcn_mfma_f32_16x16x32_bf16(__builtin_bit_cast(bf16x8, af), bfr, c, 0, 0, 0); }
                }
#pragma unroll
                for (int r = 0; r < 4; ++r) { const int t = 16 * ti + 4 * fq + r, sx = 16 * si + fr; *(LAS bf16*)(ATc + (((sx >> 3) * 64 + t) * 16) + (sx & 7) * 2) = (bf16)f2bf(sx <= t ? c[r] : 0.f); } }
            __syncthreads();
            { u32x4* dst = (u32x4*)(GA + (size_t)u * GA_UNIT);
              for (int v = tid; v < 41472 / 16; v += 512) dst[v] = *(const LAS u32x4*)(lds + v * 16); }
            __syncthreads();
        }
    }
    SEAM(10);

    const int sstride = G >= 256 ? 4 : (G >= 128 ? 2 : 1);
    const bool is_scan = (vcu % sstride == 0) && (vcu / sstride < 64);
    const int scan_id = vcu / sstride;
    const int copy_id = vcu < 64 * sstride ? (vcu / sstride) * (sstride - 1) + (vcu % sstride) - 1 : 64 * (sstride - 1) + (vcu - 64 * sstride);
    if (IN(11) && !is_scan) {
        LAS float* scr = (LAS float*)(lds + wave * 16384);
        constexpr int I_M13 = 16 * 112, I_M2 = 56 * 32, NIT = NEXP * 2 * I_M13 + NEXP * I_M2;
        const int nwv = (G - 64) * NWAVES;
        for (int rep = 0; rep < (PROBE_DUP == 20 ? 2 : 1); ++rep)
        for (int it = copy_id * NWAVES + wave; it < NIT; it += nwv) {
            int r = it;
            if (r < NEXP * 2 * I_M13) { const int e = r / (2 * I_M13), q2 = r % (2 * I_M13), w = q2 / I_M13, q = q2 % I_M13, kb = q / 112, nb = q % 112, n0 = 32 * nb;
                if (MOE_UP8) p0_transpose_item8((w ? args.moe_w3 : args.moe_w1) + (size_t)e * D * EXPD, EXPD, 64 * kb, n0, (unsigned char*)W_MOE13 + (size_t)e * 2 * EXPD * D, (n0 >> 7) * 256 + w * 128 + (n0 & 127), D, scr, lane);
                else p0_transpose_item((w ? args.moe_w3 : args.moe_w1) + (size_t)e * D * EXPD, EXPD, 64 * kb, n0, W_MOE13 + (size_t)e * 2 * EXPD * D, (n0 >> 7) * 256 + w * 128 + (n0 & 127), D, scr, lane); continue; }
            r -= NEXP * 2 * I_M13;
            { const int e = r / I_M2, q = r % I_M2, kb = q / 32, nb = q % 32;
                if (MOE_DN8) p0_transpose_item8(args.moe_w2 + (size_t)e * EXPD * D, D, 64 * kb, 32 * nb, (unsigned char*)W_MOE2 + (size_t)e * D * EXPD, 32 * nb, EXPD, scr, lane);
                else p0_transpose_item(args.moe_w2 + (size_t)e * EXPD * D, D, 64 * kb, 32 * nb, W_MOE2 + (size_t)e * D * EXPD, 32 * nb, EXPD, scr, lane); }
        }
    }
    if (IN(11) && is_scan) {
        const int b = scan_id >> 2, h = scan_id & 3;
        constexpr int BUFB = 74752, VOFF = 41984, GO_OFF = 2 * BUFB;
        LAS float* GO = (LAS float*)(lds + GO_OFF);
        if (tid < 256) GO[tid] = args.gla_out_g[tid];
        const int r32 = lane & 31, hh = lane >> 5;
        const int c0 = 32 * wave;
        const unsigned char* gabase = GA + ((size_t)b * 256 + h) * GA_UNIT;
        const bf16* vsrc = GP + ((size_t)b * SEQ + (lane >> 2)) * 3072 + 1024 + h * 256 + 32 * wave + (lane & 3) * 8;
#define GLA_DMA(n_, bs_) do { LAS unsigned char* bb_ = lds + (bs_) * BUFB; const unsigned char* ga_ = gabase + (size_t)(n_) * 4 * GA_UNIT; \
        _Pragma("unroll") for (int k_ = 0; k_ < 6; ++k_) { int p_ = wave + 8 * k_; p_ = p_ > 40 ? 40 : p_; \
            __builtin_amdgcn_global_load_lds((const unsigned*)(ga_ + p_ * 1024 + lane * 16), (LAS unsigned*)(bb_ + p_ * 1024), 16, 0, 0); } \
        _Pragma("unroll") for (int ks_ = 0; ks_ < 4; ++ks_) \
            __builtin_amdgcn_global_load_lds((const unsigned*)(vsrc + ((size_t)(n_) * 64 + 16 * ks_) * 3072), (LAS unsigned*)(bb_ + VOFF + (ks_ * 8 + wave) * 1024), 16, 0, 0); } while (0)
#define GLA_BAR() do { asm volatile("s_waitcnt lgkmcnt(0)" ::: "memory"); __builtin_amdgcn_s_barrier(); asm volatile("" ::: "memory"); } while (0)
        for (int rep = 0; rep < (PROBE_DUP == 11 ? 2 : 1); ++rep) {
        f32x16 Sacc[4];
#pragma unroll
        for (int kt = 0; kt < 4; ++kt)
#pragma unroll
            for (int r = 0; r < 16; ++r) Sacc[kt][r] = 0.f;
        GLA_DMA(0, 0);
        asm volatile("s_waitcnt vmcnt(0)" ::: "memory");
        for (int n = 0; n < 64; ++n) {
            const size_t R0 = (size_t)b * SEQ + 64 * n;
            asm volatile("s_waitcnt vmcnt(4)" ::: "memory");
            GLA_BAR();
            if (n + 1 < 64) GLA_DMA(n + 1, (n + 1) & 1);
            LAS unsigned char* bb = lds + (n & 1) * BUFB;
            const LAS unsigned char* QDp = bb; const LAS unsigned char* KDTc = bb + 16384; const LAS unsigned char* ATc = bb + 32768; const LAS float* DV = (const LAS float*)(bb + 40960);
            bf16x8 vf[4];
#pragma unroll
            for (int ks = 0; ks < 4; ++ks) { const LAS unsigned char* vp = bb + VOFF + (ks * 8 + wave) * 1024 + ((lane >> 4) & 1) * 32 + (lane & 3) * 8 + (8 * hh + ((lane & 15) >> 2)) * 64;
                const s16x4 lo = att::vtr(vp), hi4 = att::vtr(vp + 256); vf[ks] = (bf16x8){lo[0], lo[1], lo[2], lo[3], hi4[0], hi4[1], hi4[2], hi4[3]}; }
            f32x16 o[2];
#pragma unroll
            for (int tt = 0; tt < 2; ++tt)
#pragma unroll
                for (int r = 0; r < 16; ++r) o[tt][r] = 0.f;
            bf16x8 qa[16], aa[6];
#pragma unroll
            for (int kt = 0; kt < 4; ++kt)
#pragma unroll
                for (int sx = 0; sx < 2; ++sx)
#pragma unroll
                    for (int tt = 0; tt < 2; ++tt) qa[(kt * 2 + sx) * 2 + tt] = *(const LAS bf16x8*)(QDp + ((((kt * 2 + sx) * 2 + hh) * 64 + 32 * tt + r32) * 16));
#pragma unroll
            for (int i = 0; i < 6; ++i) { const int tt = i < 2 ? 0 : 1, ks = i < 2 ? i : i - 2;
                aa[i] = *(const LAS bf16x8*)(ATc + (((2 * ks + hh) * 64 + 32 * tt + r32) * 16)); }
            __builtin_amdgcn_sched_barrier(0);
#pragma unroll
            for (int kt = 0; kt < 4; ++kt)
#pragma unroll
                for (int sx = 0; sx < 2; ++sx) {
                    u32x4 sb;
#pragma unroll
                    for (int g = 0; g < 4; ++g) sb[g] = cvt_pk_bf16(Sacc[kt][8 * sx + 2 * g], Sacc[kt][8 * sx + 2 * g + 1]);
#pragma unroll
                    for (int tt = 0; tt < 2; ++tt) o[tt] = __builtin_amdgcn_mfma_f32_32x32x16_bf16(qa[(kt * 2 + sx) * 2 + tt], __builtin_bit_cast(bf16x8, sb), o[tt], 0, 0, 0);
                }
#pragma unroll
            for (int i = 0; i < 6; ++i) { const int tt = i < 2 ? 0 : 1, ks = i < 2 ? i : i - 2;
                o[tt] = __builtin_amdgcn_mfma_f32_32x32x16_bf16(aa[i], vf[ks], o[tt], 0, 0, 0); }
            __builtin_amdgcn_sched_barrier(0);
            { u32x4* dst = (u32x4*)(OFRAG(b, n, h)) + (wave * 4) * 64 + lane;
#pragma unroll
              for (int tt = 0; tt < 2; ++tt)
#pragma unroll
                  for (int q = 0; q < 2; ++q) { u32x4 w;
#pragma unroll
                      for (int g = 0; g < 4; ++g) w[g] = cvt_pk_bf16(o[tt][8 * q + 2 * g], o[tt][8 * q + 2 * g + 1]);
                      dst[(tt * 2 + q) * 64] = w; } }
            __builtin_amdgcn_sched_barrier(0);
            f32x4 dvv[16]; bf16x8 ka[16];
#pragma unroll
            for (int kt = 0; kt < 4; ++kt)
#pragma unroll
                for (int g = 0; g < 4; ++g) dvv[kt * 4 + g] = *(const LAS f32x4*)(DV + 32 * kt + 8 * g + 4 * hh);
#pragma unroll
            for (int ks = 0; ks < 4; ++ks)
#pragma unroll
                for (int kt = 0; kt < 4; ++kt) ka[ks * 4 + kt] = *(const LAS bf16x8*)(KDTc + (((2 * ks + hh) * 128 + 32 * kt + r32) * 16));
            __builtin_amdgcn_sched_barrier(0);
#pragma unroll
            for (int kt = 0; kt < 4; ++kt)
#pragma unroll
                for (int g = 0; g < 4; ++g)
#pragma unroll
                    for (int e = 0; e < 4; ++e) Sacc[kt][4 * g + e] *= dvv[kt * 4 + g][e];
#pragma unroll
            for (int ks = 0; ks < 4; ++ks)
#pragma unroll
                for (int kt = 0; kt < 4; ++kt) Sacc[kt] = __builtin_amdgcn_mfma_f32_32x32x16_bf16(ka[ks * 4 + kt], vf[ks], Sacc[kt], 0, 0, 0);
        }
        asm volatile("s_waitcnt vmcnt(0)" ::: "memory");
        GLA_BAR();
        }
#undef GLA_DMA
#undef GLA_BAR
    }
    if (IN(11)) {
        static_assert(MK_N_LAUNCHES == 1, "the scan follow-up sits behind an in-phase grid barrier");
        xcd_barrier(bar);
        LAS float* OS = (LAS float*)lds;
        const int r32 = lane & 31, hh = lane >> 5, c0 = 32 * wave;
        u32x4 fr[4], rwv[4];
#define P10C_LOAD(u_) do { const int b_ = (u_) >> 8, n_ = ((u_) >> 2) & 63, h_ = (u_) & 3; const u32x4* src_ = (const u32x4*)(OFRAG(b_, n_, h_)) + (wave * 4) * 64 + lane; \
            _Pragma("unroll") for (int k_ = 0; k_ < 4; ++k_) fr[k_] = src_[k_ * 64]; \
            const bf16* rp0_ = GP + ((size_t)b_ * SEQ + 64 * n_ + (tid >> 3)) * 3072 + 2048 + h_ * 256 + 32 * (tid & 7); \
            _Pragma("unroll") for (int i_ = 0; i_ < 4; ++i_) rwv[i_] = *(const u32x4*)(rp0_ + 8 * i_); } while (0)
        int u = bx;
        if (u < 4096) P10C_LOAD(u);
        for (; u < 4096; u += G) {
            const int b = u >> 8, n = (u >> 2) & 63, h = u & 3; const size_t R0 = (size_t)b * SEQ + 64 * n;
            u32x4 rw_c[4];
#pragma unroll
            for (int i = 0; i < 4; ++i) rw_c[i] = rwv[i];
            __syncthreads();
#pragma unroll
            for (int tt = 0; tt < 2; ++tt)
#pragma unroll
                for (int q = 0; q < 2; ++q)
#pragma unroll
                    for (int g = 0; g < 4; ++g) { const unsigned w = fr[tt * 2 + q][g]; const int r = 8 * q + 2 * g;
                        OS[(32 * tt + att::crow(r, hh)) * 260 + c0 + r32] = __builtin_bit_cast(float, w << 16);
                        OS[(32 * tt + att::crow(r + 1, hh)) * 260 + c0 + r32] = __builtin_bit_cast(float, w & 0xffff0000u); }
            __syncthreads();
            if (u + G < 4096) P10C_LOAD(u + G);
            { const int t = tid >> 3, seg = tid & 7; f32x4 ov[8]; float ss = 0.f;
#pragma unroll
              for (int i = 0; i < 8; ++i) { ov[i] = *(const LAS f32x4*)(OS + t * 260 + 32 * seg + 4 * i); ss += (ov[i][0] * ov[i][0] + ov[i][1] * ov[i][1]) + (ov[i][2] * ov[i][2] + ov[i][3] * ov[i][3]); }
              ss += __shfl_xor(ss, 1); ss += __shfl_xor(ss, 2); ss += __shfl_xor(ss, 4);
              const float rs = __builtin_amdgcn_rsqf(ss * (1.0f / 256.0f) + EPS);
              bf16* op = HB + (R0 + t) * D + h * 256 + 32 * seg;
#pragma unroll
              for (int i = 0; i < 4; ++i) { const u32x4 rw = rw_c[i]; u32x4 w;
#pragma unroll
                  for (int e = 0; e < 4; ++e) { const float r0 = __builtin_bit_cast(float, rw[e] << 16), r1 = __builtin_bit_cast(float, rw[e] & 0xffff0000u);
                      const int cidx = 8 * i + 2 * e;
                      const float v0 = ov[(cidx) >> 2][(cidx) & 3] * rs * r0, v1 = ov[(cidx + 1) >> 2][(cidx + 1) & 3] * rs * r1;
                      w[e] = pk2(v0, v1); }
                  *(u32x4*)(op + 8 * i) = w; } }
        }
#undef P10C_LOAD
    }
    SEAM(11);


    if (IN(12)) {
        pg8::DenseSched S; S.init(M / 256, 4, G, bx); S.A = (const char*)HB; S.Bt = (const char*)W_GLAOUT; S.tstep = (size_t)256 * D * 2;
        pg8::EpiResid<true, true> E{XB, XB, MOD1 + 2048, 1.0f};
        pg8::gemm_phase<pg8::EpiResid<true, true>, pg8::DenseSched, true, false>(lds, 2 * D, S, E);
    }
    SEAM(12);

    if (IN(13)) {
        LAS float* RW = (LAS float*)lds;
        LAS unsigned* EL = (LAS unsigned*)(lds + 32768);
        LAS float* GL = (LAS float*)(lds + 32768 + 4096);
        for (int e = tid; e < 8192; e += 512) { const int k = e >> 3, ex = e & 7;
            RW[((((k >> 8) * 4 + (k & 3)) * 2 + (ex >> 2)) * 64 + ((k & 255) >> 2)) * 4 + (ex & 3)] = args.moe_router[e]; }
        __syncthreads();
#undef ROUTER_BODY
#define ROUTER_BODY { float lg[8]; \
            _Pragma("unroll") for (int e = 0; e < 8; ++e) lg[e] = 0.f; \
            _Pragma("unroll") for (int j = 0; j < 4; ++j) _Pragma("unroll") for (int i = 0; i < 4; ++i) { const f32x4 w0 = *((const LAS f32x4*)RW + ((j * 4 + i) * 2) * 64 + lane), w1 = *((const LAS f32x4*)RW + ((j * 4 + i) * 2 + 1) * 64 + lane); const float hv = v[j][i]; \
                lg[0] += hv * w0[0]; lg[1] += hv * w0[1]; lg[2] += hv * w0[2]; lg[3] += hv * w0[3]; lg[4] += hv * w1[0]; lg[5] += hv * w1[1]; lg[6] += hv * w1[2]; lg[7] += hv * w1[3]; } \
            _Pragma("unroll") for (int e = 0; e < 8; ++e) lg[e] = wave_sum(lg[e]); \
            float v1 = lg[0]; \
            _Pragma("unroll") for (int e = 1; e < 8; ++e) v1 = fmaxf(v1, lg[e]); \
            int e1 = 7; \
            _Pragma("unroll") for (int e = 6; e >= 0; --e) e1 = (lg[e] == v1) ? e : e1; \
            float v2 = -3.0e38f; \
            _Pragma("unroll") for (int e = 0; e < 8; ++e) v2 = fmaxf(v2, (e == e1) ? -3.0e38f : lg[e]); \
            int e2 = -1; \
            _Pragma("unroll") for (int e = 7; e >= 0; --e) e2 = (e != e1 && lg[e] == v2) ? e : e2; \
            if (lane == 0) { EL[m - wg_row0] = (unsigned)e1 | ((unsigned)e2 << 8); GL[m - wg_row0] = v1 - v2; } }
        const int rpw12 = (M + NGW - 1) / NGW, rows_wg12 = rpw12 * NWAVES, wg_row0 = bx * rows_wg12;
        NORM_PHASE(XB, true, args.norm2_g + D, MOD1 + 3072, 1, MOE_UP8);
        __syncthreads();
        {
            int nrows = M - wg_row0; nrows = nrows > rows_wg12 ? rows_wg12 : nrows;
            for (int r = tid; r < nrows; r += 512) { const unsigned ew = EL[r]; const unsigned e1 = ew & 255u, e2 = ew >> 8; unsigned l1 = 0, l2 = 0;
                for (int q = 0; q < r; ++q) { const unsigned w = EL[q]; l1 += ((w & 255u) == e1) ? 1u : 0u; l2 += ((w >> 8) == e2) ? 1u : 0u; }
                ROUTE[wg_row0 + r] = (u32x4){ew, __builtin_bit_cast(unsigned, GL[r]), l1, l2}; }
            if (tid < 16) { const unsigned e = tid & 7; unsigned cnt = 0; for (int q = 0; q < nrows; ++q) { const unsigned w = EL[q]; cnt += ((tid < 8 ? (w & 255u) : (w >> 8)) == e) ? 1u : 0u; } LCNT[bx * 16 + tid] = cnt; }
        }
    }
    SEAM(13);

    if (IN(14)) {
        LAS int* PRE = (LAS int*)lds;
        LAS int* GOFF = (LAS int*)(lds + 256);
        if (tid < 16) { int pre = 0, tot = 0; for (int w = 0; w < G; ++w) { const int v = (int)LCNT[w * 16 + tid]; tot += v; pre += (w < bx) ? v : 0; } PRE[tid] = pre; ((LAS int*)(lds + 512))[tid] = (tot + 255) & ~255; }
        __syncthreads();
        if (tid < 2) { int acc = 0; for (int e = 0; e < 8; ++e) { GOFF[tid * 9 + e] = acc; acc += ((LAS int*)(lds + 512))[tid * 8 + e]; } GOFF[tid * 9 + 8] = acc;
            if (bx == 0) { for (int e = 0; e < 9; ++e) META[tid * 16 + e] = GOFF[tid * 9 + e]; } }
        __syncthreads();
        const int rpw = (M + NGW - 1) / NGW, rows_wg = rpw * NWAVES;
        for (int r = tid; r < rows_wg; r += 512) { const int m = bx * rows_wg + r; if (m >= M) break;
            const u32x4 rt = ROUTE[m]; const int e1 = rt[0] & 255, e2 = (rt[0] >> 8) & 255; const unsigned gbits = rt[1]; const float gap = __builtin_bit_cast(float, gbits); const float g1 = 1.0f / (1.0f + expf(-gap));
            const int s1 = GOFF[e1] + PRE[e1] + (int)rt[2], s2 = GOFF[9 + e2] + PRE[8 + e2] + (int)rt[3];
            TOKSLOT[s1] = m; GSLOT[s1] = g1; TOKSLOT[MAXSLOT + s2] = m; GSLOT[MAXSLOT + s2] = 1.0f - g1; }
    }
    SEAM(14);

#define MOE_SCHED(S, p) do { const int* mt = META + (p) * 16; S.g1 = mt[1]; S.g2 = mt[2]; S.g3 = mt[3]; S.g4 = mt[4]; S.g5 = mt[5]; S.g6 = mt[6]; S.g7 = mt[7]; } while (0)
#pragma unroll
    for (int p = 0; p < 2; ++p) {
        if (IN(15 + 2 * p)) {
            pg8::MoeSched S; MOE_SCHED(S, p); const int nP = META[p * 16 + 8] >> 8;
            S.init(nP, 2 * EXPD / 256, G, bx); S.A = (const char*)HB; S.a_tstep = 0; S.Bt = (const char*)W_MOE13; S.b_tstep = (size_t)256 * D * (MOE_UP8 ? 1 : 2); S.b_estride = (size_t)2 * EXPD * D * (MOE_UP8 ? 1 : 2);
            S.tokslot = TOKSLOT + p * MAXSLOT; S.rowbytes = D * (MOE_UP8 ? 1 : 2);
            pg8::EpiSwiGLU<MOE_DN8> E{ACTB, EXPD, MOE_UP8 ? 1.0f / (H8_SCALE * W8_SCALE) : 1.0f};
            pg8::gemm_phase<pg8::EpiSwiGLU<MOE_DN8>, pg8::MoeSched, true, true, MOE_UP8>(lds, D * (MOE_UP8 ? 1 : 2), S, E);
        }
        SEAM(15 + 2 * p);
        if (IN(16 + 2 * p)) {
            pg8::MoeSched S; MOE_SCHED(S, p); const int nP = META[p * 16 + 8] >> 8;
            constexpr int RBD = EXPD * (MOE_DN8 ? 1 : 2), NTD = RBD / 128;
            int nPm = nP, jpart = -1; const int qpart = bx & 7;
            { const int nwg = nP * 4, nfull = nwg / G, nrem = nwg - nfull * G; if (nrem > 0 && 8 * nrem <= G && (nfull * G) % 4 == 0 && NTD >= 16) { nPm = nfull * G / 4; if (bx < 8 * nrem) jpart = bx >> 3; } }
            S.init(nPm, 4, G, bx); S.A = (const char*)ACTB; S.a_tstep = (size_t)256 * RBD; S.Bt = (const char*)W_MOE2; S.b_tstep = (size_t)256 * RBD; S.b_estride = (size_t)D * RBD;
            S.tokslot = TOKSLOT + p * MAXSLOT; S.rowbytes = 0;
#define MOE_DOWN(FINAL_) do { pg8::EpiMoeDown<FINAL_> E{TOKSLOT + p * MAXSLOT, GSLOT + p * MAXSLOT, XB, out, MOD1 + 5 * 1024, MOE_DN8 ? 1.0f / (A8_SCALE * W8_SCALE) : 1.0f}; \
                if (nPm > 0) pg8::gemm_phase<pg8::EpiMoeDown<FINAL_>, pg8::MoeSched, true, false, MOE_DN8>(lds, RBD, S, E); \
                if (jpart >= 0) {       \
                    const int gsz = nP - nPm; pg8::Unit u; u.pm = nPm + jpart % gsz; u.pn = jpart / gsz; \
                    { pg8::MoeSchedTail T; MOE_SCHED(T, p); T.init(nP, 4, G, bx); T.A = S.A; T.a_tstep = S.a_tstep; T.Bt = S.Bt; T.b_tstep = S.b_tstep; T.b_estride = S.b_estride; T.tokslot = S.tokslot; T.rowbytes = 0; \
                      constexpr int P = NTD / 2, base = P / 8, extra = P % 8; T.pmT = u.pm; T.pnT = u.pn; T.k0T = 2 * (qpart * base + (qpart < extra ? qpart : extra)); T.nkT = 2 * (base + (qpart < extra ? 1 : 0)); \
                      pg8::EpiPartStore EP{KPART + (size_t)bx * (32 * 512 * 4)}; \
                      pg8::gemm_phase<pg8::EpiPartStore, pg8::MoeSchedTail, true, false, MOE_DN8, true>(lds, RBD, T, EP); } \
                    unsigned* kc = ctl + CW_KCNT + p * 64 + jpart; \
                    asm volatile("s_waitcnt vmcnt(0)" ::: "memory"); __syncthreads(); \
                    if (tid == 0) { __builtin_amdgcn_fence(__ATOMIC_RELEASE, "agent"); asm volatile("s_waitcnt vmcnt(0)" ::: "memory"); (void)xb_add(kc, 1u); \
                        XB_SPIN(xb_ld(kc) < 8u, ctl + CW_BAR); __builtin_amdgcn_fence(__ATOMIC_ACQUIRE, "agent"); asm volatile("s_waitcnt vmcnt(0)" ::: "memory"); } \
                    __syncthreads(); \
                    const int ai = qpart >> 2, m = qpart & 3; \
                    f32x4 v[2][2]; \
                    _Pragma("unroll") for (int bj = 0; bj < 2; ++bj) _Pragma("unroll") for (int n = 0; n < 2; ++n) { f32x4 a = (f32x4){0.f, 0.f, 0.f, 0.f}; \
                        const f32x4* pp = (const f32x4*)(KPART + (size_t)(jpart * 8) * (32 * 512 * 4)) + (size_t)((((ai * 2 + bj) * 4 + m) * 2 + n) * 512 + tid); \
                        _Pragma("unroll") for (int qq = 0; qq < 8; ++qq) a += pp[(size_t)qq * (32 * 512)]; \
                        v[bj][n] = a; } \
                    E.slice(v, u, ai, m, wave >> 2, wave & 3, lane & 15, lane >> 4); } } while (0)
            if (p == 0) MOE_DOWN(false); else MOE_DOWN(true);
#undef MOE_DOWN
        }
        if (p == 0) SEAM(16);
    }
#undef IN
#undef SEAM
}


constexpr int N_PHASES = 19;
extern "C" void kernel_launch(void* const* d_in, const int* in_sizes, int n_in, void* d_out, int out_size, void* d_ws, size_t ws_size, hipStream_t stream) {
    static int grid = 0;
    if (grid == 0) {
        if (n_in != 28 || in_sizes[0] != M * D || out_size != M * D || ws_size < WS_TOTAL) { fprintf(stderr, "kernel_launch: unexpected problem shape (n_in %d, out %d, ws %zu)\n", n_in, out_size, ws_size); grid = -1; return; }
        int dev = 0, cus = 0, per_cu = 0;
        if (hipGetDevice(&dev) != hipSuccess || hipDeviceGetAttribute(&cus, hipDeviceAttributeMultiprocessorCount, dev) != hipSuccess) { grid = -1; return; }
        if (hipFuncSetAttribute((const void*)mk_fwd, hipFuncAttributeMaxDynamicSharedMemorySize, LDS_BYTES) != hipSuccess) { fprintf(stderr, "kernel_launch: hipFuncSetAttribute failed\n"); grid = -1; return; }
        if (hipOccupancyMaxActiveBlocksPerMultiprocessor(&per_cu, (const void*)mk_fwd, NWAVES * 64, LDS_BYTES) != hipSuccess || per_cu < 1) { fprintf(stderr, "kernel_launch: occupancy query reports %d\n", per_cu); }
        (void)hipGetLastError();
        grid = cus;
        if (grid < 128) { fprintf(stderr, "kernel_launch: built for a >= 128-CU device (64 GLA scan workgroups + weight-copy workgroups); got %d\n", grid); grid = -1; return; }
    }
    if (grid < 0) return;
    if (hipMemsetAsync((char*)d_ws + WS_CTL, 0, CTL_ZERO_BYTES, stream) != hipSuccess) return;
    Args a{};
    const float** ap = (const float**)&a;
    for (int i = 0; i < 28; ++i) ap[i] = (const float*)d_in[i];
    a.out = (float*)d_out; a.ws = (unsigned char*)d_ws;
    if (MK_N_LAUNCHES == 1) { a.ph_lo = 0; a.ph_hi = N_PHASES; hipLaunchKernelGGL(mk_fwd, dim3(grid), dim3(NWAVES * 64), LDS_BYTES, stream, a); }
    else { for (int p = 0; p < N_PHASES; ++p) { a.ph_lo = p; a.ph_hi = p + 1; hipLaunchKernelGGL(mk_fwd, dim3(grid), dim3(NWAVES * 64), LDS_BYTES, stream, a); } }
}
```

```cpp
#include <hip/hip_runtime.h>
#include <cstdio>
#include <cstdint>

#ifndef PROBE_DUP
#define PROBE_DUP -1
#endif
#ifndef MK_N_LAUNCHES
#define MK_N_LAUNCHES 1
#endif

#define LAS __attribute__((address_space(3)))
#define GAS __attribute__((address_space(1)))
typedef unsigned short bf16;
typedef short bf16x8 __attribute__((ext_vector_type(8)));
typedef short s16x4 __attribute__((ext_vector_type(4)));
typedef float f32x4 __attribute__((ext_vector_type(4)));
typedef float f32x2 __attribute__((ext_vector_type(2)));
typedef float f32x16 __attribute__((ext_vector_type(16)));
typedef unsigned u32x4 __attribute__((ext_vector_type(4)));
typedef unsigned u32x2 __attribute__((ext_vector_type(2)));

constexpr int D = 1024, BATCH = 16, SEQ = 4096, M = BATCH * SEQ;
constexpr int FFN = 2816, NEXP = 8, EXPD = 3584;
constexpr int GLA_N = 3584;
constexpr float EPS = 1e-6f;
constexpr float LOG2E = 1.4426950408889634f;
constexpr int NWAVES = 8;
constexpr int MAXSLOT = M + NEXP * 256;

constexpr size_t MiB = 1u << 20;
constexpr size_t WS_CTL = 0, CTL_ZERO_BYTES = 64 * 1024;
constexpr size_t WS_MOD = 256 * 1024;
constexpr size_t WS_LCNT = 1 * MiB + 256 * 1024;
constexpr size_t WS_META = 1 * MiB + 512 * 1024;
constexpr size_t WS_ROUTE = 2 * MiB;
constexpr size_t WS_TOKSLOT = 4 * MiB;
constexpr size_t WS_GSLOT = 5 * MiB;
constexpr size_t WS_W_DAIN = 8 * MiB, WS_W_DAOUT = 14 * MiB, WS_W_FFN13 = 16 * MiB, WS_W_FFN2 = 27 * MiB;
constexpr size_t WS_W_GLAIN = 33 * MiB, WS_W_GLAOUT = 40 * MiB, WS_W_MOE13 = 42 * MiB, WS_W_MOE2 = 154 * MiB;
constexpr size_t WS_H = 210 * MiB;
constexpr size_t WS_Q = 338 * MiB;
constexpr size_t WS_END = WS_Q + 464 * MiB;
constexpr size_t WS_XB = WS_END;
constexpr size_t WS_TOTAL = WS_XB + (size_t)M * D * 2;
constexpr size_t GA_UNIT = 43008;
static_assert(4096 * GA_UNIT <= (size_t)M * D * 4, "the GLA per-chunk operands are parked in d_out (free until the last phase writes the result)");
static_assert(WS_TOKSLOT + 2 * MAXSLOT * 4 <= WS_GSLOT && WS_GSLOT + 2 * MAXSLOT * 4 <= WS_W_DAIN, "ws map");
static_assert(WS_W_FFN2 + (size_t)D * FFN * 2 <= WS_W_GLAIN && WS_W_GLAIN + (size_t)GLA_N * D * 2 <= WS_W_GLAOUT, "ws map");
static_assert(WS_W_MOE13 + (size_t)NEXP * 2 * EXPD * D * 2 <= WS_W_MOE2 && WS_W_MOE2 + (size_t)NEXP * D * EXPD * 2 <= WS_H, "ws map");
static_assert((size_t)MAXSLOT * EXPD * 2 <= 464 * MiB && (size_t)M * 3072 * 2 + (size_t)M * 512 * 2 <= 464 * MiB, "ws map");
constexpr int CW_BAR = 4096, CW_KCNT = 8192;

constexpr int RING_BYTES = 131072;
constexpr int TAB_OFF = RING_BYTES;
constexpr int MISC_OFF = 155648;
constexpr int LDS_BYTES = MISC_OFF + 1024;

__device__ __forceinline__ unsigned f2bf(float f) { unsigned u = __builtin_bit_cast(unsigned, f); return (u + 0x7fffu + ((u >> 16) & 1u)) >> 16; }
__device__ __forceinline__ unsigned pk2(float lo, float hi) { return f2bf(lo) | (f2bf(hi) << 16); }
__device__ __forceinline__ float bf2f(unsigned short b) { return __builtin_bit_cast(float, ((unsigned)b) << 16); }
__device__ __forceinline__ unsigned cvt_pk_bf16(float lo, float hi) { unsigned r; asm volatile("v_cvt_pk_bf16_f32 %0, %1, %2" : "=v"(r) : "v"(lo), "v"(hi)); return r; }
__device__ __forceinline__ float wave_sum(float v) {
#pragma unroll
    for (int o = 1; o < 64; o <<= 1) v += __shfl_xor(v, o);
    return v;
}
__device__ __forceinline__ float wave_max(float v) {
#pragma unroll
    for (int o = 1; o < 64; o <<= 1) v = fmaxf(v, __shfl_xor(v, o));
    return v;
}
typedef int v8i __attribute__((ext_vector_type(8)));
typedef int v4i __attribute__((ext_vector_type(4)));
constexpr bool FFN_UP8 = false, FFN_DN8 = true, MOE_UP8 = true, MOE_DN8 = true;
constexpr float W8_SCALE = 64.0f, H8_SCALE = 8.0f, A8_SCALE = 4.0f;
__device__ __forceinline__ float clamp448(float x) { return fminf(fmaxf(x, -448.0f), 448.0f); }
__device__ __forceinline__ unsigned pk_fp8x4(float a, float b, float c, float d) {
    unsigned w = 0u; w = __builtin_amdgcn_cvt_pk_fp8_f32(clamp448(a), clamp448(b), w, false); w = __builtin_amdgcn_cvt_pk_fp8_f32(clamp448(c), clamp448(d), w, true); return w; }
__device__ __forceinline__ f32x4 ld_bf16x4(const bf16* p) { const u32x2 w = *(const u32x2*)p; return (f32x4){__builtin_bit_cast(float, w[0] << 16), __builtin_bit_cast(float, w[0] & 0xffff0000u), __builtin_bit_cast(float, w[1] << 16), __builtin_bit_cast(float, w[1] & 0xffff0000u)}; }
__device__ __forceinline__ void st_bf16x4(bf16* p, f32x4 v) { *(u32x2*)p = (u32x2){cvt_pk_bf16(v[0], v[1]), cvt_pk_bf16(v[2], v[3])}; }
__device__ __forceinline__ float fast_silu(float a) { return a * __builtin_amdgcn_rcpf(1.0f + __builtin_amdgcn_exp2f(-a * LOG2E)); }

namespace pg8 {
constexpr int BM = 256, BK = 64, HALF = 128, HTB = HALF * BK * 2, STAGE_BYTES = 8 * HTB, NXCD = 8, WGM = 8;
__host__ __device__ __forceinline__ int lds_byte(int r, int c) { const int rr = r & 7, ch = (c >> 3) ^ rr; return (r >> 3) * 1024 + (rr * 8 + ch) * 16 + (c & 7) * 2; }
__host__ __device__ __forceinline__ void stage_rc(int b, int& R, int& C) { const int piece = b / 1024, slot = (b % 1024) / 16, rr = slot >> 3, ch = (slot & 7) ^ rr; R = piece * 8 + rr; C = ch * 8; }
__host__ __device__ __forceinline__ int perm32(int rho) { const int n = rho >> 4, i = rho & 15; return 8 * (i >> 2) + 4 * n + (i & 3); }

struct Unit { int pm, pn, k0, nk, part; };
struct TileOrder {
    int nM, nN, nwg, G, c;
    __device__ void init(int nM_, int nN_, int G_, int c_) { nM = nM_; nN = nN_; nwg = nM * nN; G = G_; c = c_; }
    __device__ bool next(int i, Unit& u) const { return at((long)i * G + c, u); }
    __device__ bool at(const long L, Unit& u) const {
        if (L >= nwg) return false;
        int wgid = (int)L; { const int q = nwg / NXCD, r = nwg % NXCD, xcd = wgid % NXCD, off = wgid / NXCD; wgid = (xcd < r ? xcd * (q + 1) : r * (q + 1) + (xcd - r) * q) + off; }
        const int nig = WGM * nN, gid = wgid / nig, fm = gid * WGM, gsz = (nM - fm) < WGM ? (nM - fm) : WGM;
        u.pm = fm + ((wgid % nig) % gsz); u.pn = (wgid % nig) / gsz; return true;
    }
};
struct DenseSched : TileOrder {
    const char* A; const char* Bt; size_t tstep;
    __device__ __forceinline__ const char* a_base(const Unit& u) const { return A + (size_t)u.pm * tstep; }
    __device__ __forceinline__ const char* b_base(const Unit& u) const { return Bt + (size_t)u.pn * tstep; }
    __device__ __forceinline__ unsigned row_off(const Unit&, int) const { return 0u; }
};
struct MoeSched : TileOrder {
    const char* A; const char* Bt; size_t a_tstep, b_tstep, b_estride; const int* tokslot; unsigned rowbytes; int g1, g2, g3, g4, g5, g6, g7;
    __device__ __forceinline__ int expert(int pm) const { const int r = pm * 256; return (r >= g1) + (r >= g2) + (r >= g3) + (r >= g4) + (r >= g5) + (r >= g6) + (r >= g7); }
    __device__ __forceinline__ const char* a_base(const Unit& u) const { return A + (size_t)u.pm * a_tstep; }
    __device__ __forceinline__ const char* b_base(const Unit& u) const { return Bt + (size_t)expert(u.pm) * b_estride + (size_t)u.pn * b_tstep; }
    __device__ __forceinline__ unsigned row_off(const Unit& u, int r) const { int t = tokslot[u.pm * 256 + r]; t = t < 0 ? 0 : t; return (unsigned)t * rowbytes; }
};
struct MoeSchedTail : MoeSched {
    int pmT, pnT, k0T, nkT;
    __device__ bool next(int i, Unit& u) const { if (i != 0) return false; u.pm = pmT; u.pn = pnT; u.k0 = k0T; u.nk = nkT; u.part = 1; return true; }
};

struct EpiQKV {
    static constexpr bool PERM = true;
    bf16* Q; size_t tstride; const float* qg; const float* kg; float qscale;
    __device__ __forceinline__ void operator()(const f32x4 (&acc)[2][2][4][2], const Unit& u, int wr, int wc, int fr, int fq) const {
        const int t = u.pn >> 2;
        bf16* base = Q + (size_t)t * tstride;
        const int lc0 = 256 * (u.pn & 3) + 64 * wc + 8 * fq;
        const int row0 = u.pm * BM + wr * 64 + fr;
        if (t < 2) {
            const float* g = qg; if (t == 1) g = kg;
            g += 64 * (wc & 1) + 8 * fq;
            f32x4 gv[2][2];
#pragma unroll
            for (int bj = 0; bj < 2; ++bj)
#pragma unroll
                for (int n = 0; n < 2; ++n) gv[bj][n] = *(const f32x4*)(g + 32 * bj + 4 * n);
            float sc = 1.0f; if (t == 0) sc = qscale;
#pragma unroll
            for (int ai = 0; ai < 2; ++ai)
#pragma unroll
                for (int m = 0; m < 4; ++m) {
                    float ss = 0.f;
#pragma unroll
                    for (int bj = 0; bj < 2; ++bj)
#pragma unroll
                        for (int n = 0; n < 2; ++n) { const f32x4 x = acc[ai][bj][m][n]; ss += (x[0] * x[0] + x[1] * x[1]) + (x[2] * x[2] + x[3] * x[3]); }
                    ss += __shfl_xor(ss, 16); ss += __shfl_xor(ss, 32);
                    const float rs = __builtin_amdgcn_rsqf(ss * (1.0f / 64.0f) + EPS) * sc;
                    const int R = row0 + ai * HALF + m * 16;
                    bf16* rowp = base + (size_t)R * D + lc0;
#pragma unroll
                    for (int bj = 0; bj < 2; ++bj) { const f32x4 v0 = acc[ai][bj][m][0] * rs * gv[bj][0], v1 = acc[ai][bj][m][1] * rs * gv[bj][1];
                        u32x4 w; w.x = cvt_pk_bf16(v0[0], v0[1]); w.y = cvt_pk_bf16(v0[2], v0[3]); w.z = cvt_pk_bf16(v1[0], v1[1]); w.w = cvt_pk_bf16(v1[2], v1[3]);
                        if (t == 1) {
                            const int col = lc0 + 32 * bj, hh_ = col >> 7, cg = (col & 127) >> 3, b_ = R >> 12, s_ = R & 4095;
                            *(u32x4*)(base + ((((size_t)(b_ * 8 + hh_) * 64 + (s_ >> 6)) * 16 + cg) * 64 + (s_ & 63)) * 8) = w; }
                        else *(u32x4*)(rowp + 32 * bj) = w; }
                }
        } else {
#pragma unroll
            for (int ai = 0; ai < 2; ++ai)
#pragma unroll
                for (int m = 0; m < 4; ++m) { const int R = row0 + ai * HALF + m * 16, b_ = R >> 12, s_ = R & 4095;
#pragma unroll
                    for (int bj = 0; bj < 2; ++bj) { const f32x4 v0 = acc[ai][bj][m][0], v1 = acc[ai][bj][m][1];
                        u32x4 w; w.x = cvt_pk_bf16(v0[0], v0[1]); w.y = cvt_pk_bf16(v0[2], v0[3]); w.z = cvt_pk_bf16(v1[0], v1[1]); w.w = cvt_pk_bf16(v1[2], v1[3]);
                        const int col = lc0 + 32 * bj, hh_ = col >> 7, c_ = col & 127, p_ = (c_ >> 5) * 4 + ((s_ & 63) >> 4), li = ((s_ & 15) << 2) + ((c_ & 31) >> 3);
                        *(u32x4*)(base + ((((size_t)(b_ * 8 + hh_) * 64 + (s_ >> 6)) * 16 + p_) * 64 + li) * 8) = w; } }
        }
    }
};
template <bool BASE16, bool OUT16> struct EpiResid {
    static constexpr bool PERM = false;
    const void* base; void* out; const float* gate; float descale;
    __device__ __forceinline__ void operator()(const f32x4 (&acc)[2][2][4][2], const Unit& u, int wr, int wc, int fr, int fq) const {
        const int row0 = u.pm * BM + wr * 64 + fr, col0 = u.pn * BM + wc * 32 + 4 * fq, b = u.pm >> 4;
        f32x4 gv[2][2];
#pragma unroll
        for (int bj = 0; bj < 2; ++bj)
#pragma unroll
            for (int n = 0; n < 2; ++n) gv[bj][n] = *(const f32x4*)(gate + (size_t)b * 6144 + col0 + bj * HALF + n * 16) * descale;
#pragma unroll
        for (int ai = 0; ai < 2; ++ai)
#pragma unroll
            for (int m = 0; m < 4; ++m) { const size_t off = (size_t)(row0 + ai * HALF + m * 16) * D + col0;
#pragma unroll
                for (int bj = 0; bj < 2; ++bj)
#pragma unroll
                    for (int n = 0; n < 2; ++n) { const size_t o = off + bj * HALF + n * 16;
                        const f32x4 bs = BASE16 ? ld_bf16x4((const bf16*)base + o) : *(const f32x4*)((const float*)base + o);
                        const f32x4 r = bs + gv[bj][n] * acc[ai][bj][m][n];
                        if constexpr (OUT16) st_bf16x4((bf16*)out + o, r); else *(f32x4*)((float*)out + o) = r; }
                asm volatile("" ::: "memory"); }
    }
};
template <bool OUT8> struct EpiSwiGLU {
    static constexpr bool PERM = true;
    void* O; int ldo; float descale;
    __device__ __forceinline__ void operator()(const f32x4 (&acc)[2][2][4][2], const Unit& u, int wr, int wc, int fr, int fq) const {
        const int row0 = u.pm * BM + wr * 64 + fr, col0 = u.pn * HALF + wc * 32 + 8 * fq;
#pragma unroll
        for (int ai = 0; ai < 2; ++ai)
#pragma unroll
            for (int m = 0; m < 4; ++m) { const unsigned eo = (unsigned)(row0 + ai * HALF + m * 16) * (unsigned)ldo + (unsigned)col0;
                f32x4 v0, v1;
#pragma unroll
                for (int i = 0; i < 4; ++i) { v0[i] = fast_silu(acc[ai][0][m][0][i] * descale) * (acc[ai][1][m][0][i] * descale); v1[i] = fast_silu(acc[ai][0][m][1][i] * descale) * (acc[ai][1][m][1][i] * descale); }
                if constexpr (OUT8) { v0 = v0 * A8_SCALE; v1 = v1 * A8_SCALE; *(u32x2*)((unsigned char*)O + eo) = (u32x2){pk_fp8x4(v0[0], v0[1], v0[2], v0[3]), pk_fp8x4(v1[0], v1[1], v1[2], v1[3])}; }
                else { u32x4 w; w.x = cvt_pk_bf16(v0[0], v0[1]); w.y = cvt_pk_bf16(v0[2], v0[3]); w.z = cvt_pk_bf16(v1[0], v1[1]); w.w = cvt_pk_bf16(v1[2], v1[3]); *(u32x4*)((bf16*)O + eo) = w; } }
    }
};
struct EpiGLA {
    static constexpr bool PERM = true;
    bf16* P; bf16* LA; const float* ba; const float* og;
    __device__ __forceinline__ void operator()(const f32x4 (&acc)[2][2][4][2], const Unit& u, int wr, int wc, int fr, int fq) const {
        const int row0 = u.pm * BM + wr * 64 + fr;
        if (u.pn < 12) {
            const int col0 = u.pn * BM + wc * 32 + 8 * fq; const bool isr = u.pn >= 8;
            f32x4 gv[2][2];
#pragma unroll
            for (int bj = 0; bj < 2; ++bj)
#pragma unroll
                for (int n = 0; n < 2; ++n) gv[bj][n] = isr ? *(const f32x4*)(og + wc * 32 + 8 * fq + bj * HALF + 4 * n) : (f32x4){1.f, 1.f, 1.f, 1.f};
#pragma unroll
            for (int ai = 0; ai < 2; ++ai)
#pragma unroll
                for (int m = 0; m < 4; ++m) { bf16* rowp = P + (size_t)(row0 + ai * HALF + m * 16) * 3072 + col0;
#pragma unroll
                    for (int bj = 0; bj < 2; ++bj) { f32x4 v0 = acc[ai][bj][m][0], v1 = acc[ai][bj][m][1];
                        if (isr) {
#pragma unroll
                            for (int i = 0; i < 4; ++i) { v0[i] = gv[bj][0][i] * fast_silu(v0[i]); v1[i] = gv[bj][1][i] * fast_silu(v1[i]); } }
                        u32x4 w; w.x = cvt_pk_bf16(v0[0], v0[1]); w.y = cvt_pk_bf16(v0[2], v0[3]); w.z = cvt_pk_bf16(v1[0], v1[1]); w.w = cvt_pk_bf16(v1[2], v1[3]);
                        *(u32x4*)(rowp + bj * HALF) = w; } }
        } else {
            const int col0 = (u.pn - 12) * BM + wc * 32 + 8 * fq;
            f32x4 bv[2][2];
#pragma unroll
            for (int bj = 0; bj < 2; ++bj)
#pragma unroll
                for (int n = 0; n < 2; ++n) bv[bj][n] = *(const f32x4*)(ba + col0 + bj * HALF + 4 * n);
#pragma unroll
            for (int ai = 0; ai < 2; ++ai)
#pragma unroll
                for (int m = 0; m < 4; ++m) { bf16* rowp = LA + (size_t)(row0 + ai * HALF + m * 16) * 512 + col0;
#pragma unroll
                    for (int bj = 0; bj < 2; ++bj) { f32x4 v[2];
#pragma unroll
                        for (int n = 0; n < 2; ++n)
#pragma unroll
                            for (int i = 0; i < 4; ++i) { const float z = acc[ai][bj][m][n][i] + bv[bj][n][i];
                                v[n][i] = (fminf(z, 0.f) - __logf(1.0f + __expf(-fabsf(z)))) * (1.0f / 16.0f); }
                        u32x4 w; w.x = cvt_pk_bf16(v[0][0], v[0][1]); w.y = cvt_pk_bf16(v[0][2], v[0][3]); w.z = cvt_pk_bf16(v[1][0], v[1][1]); w.w = cvt_pk_bf16(v[1][2], v[1][3]);
                        *(u32x4*)(rowp + bj * HALF) = w; } }
        }
    }
};
template <bool FINAL> struct EpiMoeDown {
    static constexpr bool PERM = false;
    const int* tokslot; const float* gslot; bf16* xb; float* outf; const float* gate; float descale;
    __device__ __forceinline__ void operator()(const f32x4 (&acc)[2][2][4][2], const Unit& u, int wr, int wc, int fr, int fq) const {
        const int srow0 = u.pm * BM + wr * 64 + fr, col0 = u.pn * BM + wc * 32 + 4 * fq;
#pragma unroll
        for (int ai = 0; ai < 2; ++ai)
#pragma unroll
            for (int m = 0; m < 4; ++m) { const int srow = srow0 + ai * HALF + m * 16; const int tok = tokslot[srow];
                if (tok >= 0) { const float g = gslot[srow] * descale; const float* gp = gate + (size_t)(tok >> 12) * 6144 + col0; const size_t ro = (size_t)tok * D + col0;
#pragma unroll
                    for (int bj = 0; bj < 2; ++bj)
#pragma unroll
                        for (int n = 0; n < 2; ++n) { const f32x4 gv = *(const f32x4*)(gp + bj * HALF + n * 16); const f32x4 bs = ld_bf16x4(xb + ro + bj * HALF + n * 16);
                            const f32x4 r = bs + gv * g * acc[ai][bj][m][n];
                            if constexpr (FINAL) *(f32x4*)(outf + ro + bj * HALF + n * 16) = r; else st_bf16x4(xb + ro + bj * HALF + n * 16, r); } }
                asm volatile("" ::: "memory"); }
    }
    __device__ __forceinline__ void slice(const f32x4 (&v)[2][2], const Unit& u, int ai, int m, int wr, int wc, int fr, int fq) const {
        const int srow = u.pm * BM + wr * 64 + fr + ai * HALF + m * 16, col0 = u.pn * BM + wc * 32 + 4 * fq; const int tok = tokslot[srow];
        if (tok >= 0) { const float g = gslot[srow] * descale; const float* gp = gate + (size_t)(tok >> 12) * 6144 + col0; const size_t ro = (size_t)tok * D + col0;
#pragma unroll
            for (int bj = 0; bj < 2; ++bj)
#pragma unroll
                for (int n = 0; n < 2; ++n) { const f32x4 gv = *(const f32x4*)(gp + bj * HALF + n * 16); const f32x4 bs = ld_bf16x4(xb + ro + bj * HALF + n * 16);
                    const f32x4 r = bs + gv * g * v[bj][n];
                    if constexpr (FINAL) *(f32x4*)(outf + ro + bj * HALF + n * 16) = r; else st_bf16x4(xb + ro + bj * HALF + n * 16, r); } }
    }
};
struct EpiPartStore {
    static constexpr bool PERM = false;
    float* part;
    __device__ __forceinline__ void operator()(const f32x4 (&acc)[2][2][4][2], const Unit&, int wr, int wc, int fr, int fq) const {
        f32x4* p = (f32x4*)part + ((wr * 4 + wc) * 64 + fq * 16 + fr);
#pragma unroll
        for (int ai = 0; ai < 2; ++ai)
#pragma unroll
            for (int bj = 0; bj < 2; ++bj)
#pragma unroll
                for (int m = 0; m < 4; ++m)
#pragma unroll
                    for (int n = 0; n < 2; ++n) { *p = acc[ai][bj][m][n]; p += 512; asm volatile("" : "+v"(p)); }
    }
};

template <class Epi, class Sched, bool ALIGN_EPI, bool GATHER, bool FP8 = false, bool KSPLIT = false>
__device__ __forceinline__ void gemm_phase(LAS unsigned char* lds, const int RB, const Sched& S, const Epi& E) {
    const int tid = threadIdx.x, wid = __builtin_amdgcn_readfirstlane(tid >> 6), lane = tid & 63, wr = wid >> 2, wc = wid & 3, fr = lane & 15, fq = lane >> 4;
    const int nt = RB / 128;
    unsigned voffB0, voffA0;
    const size_t kstep = (size_t)(BK * 2);
    const size_t hstep = (size_t)HALF * RB;
    const size_t qstep = (size_t)64 * RB;
    { int R, C; stage_rc(tid * 16, R, C); const int Rb = Epi::PERM ? ((R & ~31) + perm32(R & 31)) : R;
        voffB0 = (unsigned)(Rb * RB + C * 2); voffA0 = (unsigned)(R * RB + C * 2); }
    LAS unsigned* mytab = (LAS unsigned*)(lds + STAGE_BYTES) + tid;
#define PG8_TABFILL(par, U) do { _Pragma("unroll") for (int _h = 0; _h < 2; ++_h) _Pragma("unroll") for (int _i = 0; _i < 2; ++_i) { int _R, _C; stage_rc(tid * 16 + _i * 8192, _R, _C); \
        mytab[((par) * 4 + _h * 2 + _i) * 512] = S.row_off(U, _h * HALF + _R) + (unsigned)_C * 2u; } } while (0)
    const unsigned ldsw = (unsigned)wid * 1024u;
    const int aoff = lds_byte(wr * 64 + fr, fq * 8), boff = lds_byte(wc * 32 + fr, fq * 8), aoff1 = aoff ^ 64, boff1 = boff ^ 64;
#define PG8_SA(b, h) (((b) * 2 + (h)) * HTB)
#define PG8_SB(b, h) ((4 + (b) * 2 + (h)) * HTB)
#define PG8_STAGE_B(bufoff, gbase) do { _Pragma("unroll") for (int _i = 0; _i < 2; ++_i) \
        __builtin_amdgcn_global_load_lds((const unsigned*)((const char*)(gbase) + _i * qstep + voffB0), (LAS unsigned*)(lds + (bufoff) + ldsw + _i * 8192), 16, 0, 0); } while (0)
#define PG8_STAGE_A(bufoff, gbase, va, h) do { _Pragma("unroll") for (int _i = 0; _i < 2; ++_i) \
        __builtin_amdgcn_global_load_lds((const unsigned*)((const char*)(gbase) + (GATHER ? (size_t)0 : (size_t)(h) * hstep + _i * qstep) + (GATHER ? (va)[h][_i] : voffA0)), (LAS unsigned*)(lds + (bufoff) + ldsw + _i * 8192), 16, 0, 0); } while (0)
#define PG8_LDA(dst, b, h) do { _Pragma("unroll") for (int m = 0; m < 4; ++m) { if constexpr (FP8) dst##8[m] = __builtin_shufflevector(*(const LAS v4i*)(lds + PG8_SA(b, h) + aoff + m * 2048), *(const LAS v4i*)(lds + PG8_SA(b, h) + aoff1 + m * 2048), 0, 1, 2, 3, 4, 5, 6, 7); \
        else { dst[m][0] = *(const LAS bf16x8*)(lds + PG8_SA(b, h) + aoff + m * 2048); dst[m][1] = *(const LAS bf16x8*)(lds + PG8_SA(b, h) + aoff1 + m * 2048); } } } while (0)
#define PG8_LDB(dst, b, h) do { _Pragma("unroll") for (int n = 0; n < 2; ++n) { if constexpr (FP8) dst##8[n] = __builtin_shufflevector(*(const LAS v4i*)(lds + PG8_SB(b, h) + boff + n * 2048), *(const LAS v4i*)(lds + PG8_SB(b, h) + boff1 + n * 2048), 0, 1, 2, 3, 4, 5, 6, 7); \
        else { dst[n][0] = *(const LAS bf16x8*)(lds + PG8_SB(b, h) + boff + n * 2048); dst[n][1] = *(const LAS bf16x8*)(lds + PG8_SB(b, h) + boff1 + n * 2048); } } } while (0)
#define PG8_CAT(x0, x1) __builtin_shufflevector(__builtin_bit_cast(v4i, x0), __builtin_bit_cast(v4i, x1), 0, 1, 2, 3, 4, 5, 6, 7)
#define PG8_MMA(ai, bj, At, Bt) do { __builtin_amdgcn_s_setprio(1); _Pragma("unroll") for (int m = 0; m < 4; ++m) _Pragma("unroll") for (int n = 0; n < 2; ++n) { \
        if constexpr (FP8) asm volatile("v_mfma_scale_f32_16x16x128_f8f6f4 %0, %1, %2, %0, %3, %3 op_sel_hi:[0,0,0]" : "+v"(acc[ai][bj][m][n]) : "v"(Bt##8[n]), "v"(At##8[m]), "v"(sc8));   \
        else { _Pragma("unroll") for (int k = 0; k < 2; ++k) acc[ai][bj][m][n] = __builtin_amdgcn_mfma_f32_16x16x32_bf16(Bt[n][k], At[m][k], acc[ai][bj][m][n], 0, 0, 0); } } \
        __builtin_amdgcn_s_setprio(0); } while (0)
#define PG8_WAIT_V(n) asm volatile("s_waitcnt vmcnt(" #n ")" ::: "memory")
#define PG8_WAIT_L(n) asm volatile("s_waitcnt lgkmcnt(" #n ")" ::: "memory")
#define PG8_BAR __builtin_amdgcn_s_barrier()
#define PG8_SCHED __builtin_amdgcn_sched_barrier(0)
    Unit cur, nxt; int ui = 0;
    if (!S.next(0, cur)) return;
    f32x4 acc[2][2][4][2];
#pragma unroll
    for (int a = 0; a < 2; ++a)
#pragma unroll
        for (int b = 0; b < 2; ++b)
#pragma unroll
            for (int m = 0; m < 4; ++m)
#pragma unroll
                for (int n = 0; n < 2; ++n) acc[a][b][m][n] = (f32x4){0.f, 0.f, 0.f, 0.f};
    const int sc8 = 0x7f7f7f7f;
    bf16x8 At[4][2], B0[2][2], B1[2][2]; v8i At8[4], B08[2], B18[2];
    const char* cA = S.a_base(cur); const char* cB = S.b_base(cur);
    if constexpr (KSPLIT) { cA += (size_t)cur.k0 * kstep; cB += (size_t)cur.k0 * kstep; }
    unsigned cvA[2][2] = {{0u, 0u}, {0u, 0u}};
    if constexpr (GATHER) {
        PG8_TABFILL(0, cur);
#pragma unroll
        for (int h = 0; h < 2; ++h)
#pragma unroll
            for (int i = 0; i < 2; ++i) cvA[h][i] = mytab[(h * 2 + i) * 512];
    }
    PG8_STAGE_B(PG8_SB(0, 0), cB); PG8_STAGE_B(PG8_SB(0, 1), cB + hstep); PG8_STAGE_A(PG8_SA(0, 0), cA, cvA, 0); PG8_STAGE_A(PG8_SA(0, 1), cA, cvA, 1);
    if (wr == 1) PG8_BAR;
    PG8_WAIT_V(2); PG8_BAR;
    PG8_STAGE_B(PG8_SB(1, 0), cB + kstep); PG8_STAGE_A(PG8_SA(1, 0), cA + kstep, cvA, 0); PG8_STAGE_B(PG8_SB(1, 1), cB + hstep + kstep);
    PG8_WAIT_V(6); PG8_BAR;
    for (;;) {
        const bool has_next = S.next(ui + 1, nxt);
        const char* nA = has_next ? S.a_base(nxt) : cA; const char* nB = has_next ? S.b_base(nxt) : cB;
        if constexpr (KSPLIT) { if (has_next) { nA += (size_t)nxt.k0 * kstep; nB += (size_t)nxt.k0 * kstep; } }
        if constexpr (GATHER) { if (has_next) PG8_TABFILL((ui + 1) & 1, nxt); }
        const int ntc = KSPLIT ? cur.nk : nt;
#pragma unroll 1
        for (int t = 0; t < ntc; t += 2) {
            const bool last = (t == ntc - 2);
            const char* a1 = cA + (size_t)(t + 1) * kstep;
            const char* a2 = last ? nA : cA + (size_t)(t + 2) * kstep; const char* b2 = last ? nB : cB + (size_t)(t + 2) * kstep;
            const char* a3 = a2 + kstep; const char* b3 = b2 + kstep;
            unsigned wA[2][2] = {{0u, 0u}, {0u, 0u}};
            if constexpr (GATHER) {
                const int pc = ui & 1, pw = (last && has_next) ? (pc ^ 1) : pc;
#pragma unroll
                for (int i = 0; i < 2; ++i) { cvA[1][i] = mytab[(pc * 4 + 2 + i) * 512]; wA[0][i] = mytab[(pw * 4 + i) * 512]; wA[1][i] = mytab[(pw * 4 + 2 + i) * 512]; }
            }
            PG8_LDB(B0, 0, 0); PG8_LDB(B1, 0, 1); PG8_SCHED; PG8_LDA(At, 0, 0); PG8_STAGE_A(PG8_SA(1, 1), a1, cvA, 1);
            PG8_WAIT_V(8); PG8_WAIT_L(0); PG8_BAR; PG8_MMA(0, 0, At, B0); PG8_MMA(0, 1, At, B1); PG8_BAR; PG8_SCHED;
            PG8_LDA(At, 0, 1); PG8_STAGE_B(PG8_SB(0, 0), b2); PG8_STAGE_B(PG8_SB(0, 1), b2 + hstep); PG8_STAGE_A(PG8_SA(0, 0), a2, wA, 0);
            PG8_WAIT_V(8); PG8_WAIT_L(0); PG8_BAR; PG8_MMA(1, 0, At, B0); PG8_MMA(1, 1, At, B1); PG8_BAR; PG8_SCHED;
            PG8_LDB(B0, 1, 0); PG8_LDB(B1, 1, 1); PG8_SCHED; PG8_LDA(At, 1, 0); PG8_STAGE_A(PG8_SA(0, 1), a2, wA, 1);
            PG8_WAIT_V(8); PG8_WAIT_L(0); PG8_BAR; PG8_MMA(0, 0, At, B0); PG8_MMA(0, 1, At, B1); PG8_BAR; PG8_SCHED;
            PG8_LDA(At, 1, 1); PG8_STAGE_B(PG8_SB(1, 0), b3); PG8_STAGE_B(PG8_SB(1, 1), b3 + hstep); PG8_STAGE_A(PG8_SA(1, 0), a3, wA, 0);
            PG8_WAIT_V(8); PG8_WAIT_L(0); PG8_BAR; PG8_MMA(1, 0, At, B0); PG8_MMA(1, 1, At, B1); PG8_BAR; PG8_SCHED;
        }
        if constexpr (ALIGN_EPI) { if (wr == 0) PG8_BAR; }
        if constexpr (FP8) asm volatile("s_nop 15\n\ts_nop 15" ::: "memory");
        { int el; asm volatile("v_mbcnt_lo_u32_b32 %0, -1, 0\n\tv_mbcnt_hi_u32_b32 %0, -1, %0" : "=v"(el));
          E(acc, cur, wr, wc, el & 15, el >> 4); }
        if (!has_next) break;
#pragma unroll
        for (int a = 0; a < 2; ++a)
#pragma unroll
            for (int b = 0; b < 2; ++b)
#pragma unroll
                for (int m = 0; m < 4; ++m)
#pragma unroll
                    for (int n = 0; n < 2; ++n) acc[a][b][m][n] = (f32x4){0.f, 0.f, 0.f, 0.f};
        cur = nxt; cA = nA; cB = nB; ++ui;
        if constexpr (ALIGN_EPI) { if (wr == 1) PG8_BAR; }
    }
    PG8_WAIT_V(0);
    if constexpr (!ALIGN_EPI) { if (wr == 0) PG8_BAR; }
    PG8_BAR;
#undef PG8_SA
#undef PG8_SB
#undef PG8_STAGE_A
#undef PG8_TABFILL
#undef PG8_STAGE_B
#undef PG8_LDA
#undef PG8_LDB
#undef PG8_MMA
#undef PG8_CAT
#undef PG8_WAIT_V
#undef PG8_WAIT_L
#undef PG8_BAR
#undef PG8_SCHED
}
}

#define XB_TMO      128
#define XB_XCNT(j)  (256  + 64 * (j))
#define XB_XSUB(j)  (1280 + 64 * (j))
#define XB_XGEN(j)  (2304 + 64 * (j))
#define XB_TOP      3328
#define XB_TOPGEN   3392
#define XCD_BAR_WORDS 3456
#define XB_SPIN_CAP (1u << 18)
__device__ __forceinline__ unsigned xb_ld(unsigned* p)              { return __hip_atomic_load(p, __ATOMIC_RELAXED, __HIP_MEMORY_SCOPE_AGENT); }
__device__ __forceinline__ unsigned xb_add(unsigned* p, unsigned v) { return __hip_atomic_fetch_add(p, v, __ATOMIC_RELAXED, __HIP_MEMORY_SCOPE_AGENT); }
__device__ __forceinline__ unsigned xb_xcc_id() { return (unsigned)__builtin_amdgcn_s_getreg((3 << 11) | 20) & 0xFu; }
#define XB_SPIN(cond, bar) do { unsigned _sp = 0; while (cond) { __builtin_amdgcn_s_sleep(1); \
    if ((++_sp & 255u) == 0u) { if (xb_ld(&(bar)[XB_TMO])) break; if (_sp > XB_SPIN_CAP) { atomicAdd(&(bar)[XB_TMO], 1u); break; } } } } while (0)
struct XcdBarrier { unsigned* bar; unsigned x; volatile LAS unsigned* st; };
__device__ __forceinline__ XcdBarrier xcd_barrier_post(unsigned* bar, volatile LAS unsigned* st) {
    XcdBarrier b; b.bar = bar; b.x = xb_xcc_id(); b.st = st;
    if (threadIdx.x == 0) (void)xb_add(&bar[XB_XCNT(b.x)], 1u);
    return b;
}
__device__ __forceinline__ void xcd_barrier_complete(unsigned* bar, unsigned x, unsigned& nloc, unsigned& nx) {
    const unsigned G = gridDim.x * gridDim.y * gridDim.z;
    unsigned sum, cnt, mine, sp = 0u;
    for (;;) {
        sum = 0u; cnt = 0u; mine = 0u;
#pragma unroll
        for (unsigned j = 0; j < 16; ++j) { const unsigned c = xb_ld(&bar[XB_XCNT(j)]); sum += c; cnt += (c > 0u) ? 1u : 0u; mine = (j == x) ? c : mine; }
        if (sum == G) break;
        __builtin_amdgcn_s_sleep(1);
        if ((++sp & 255u) == 0u) { if (xb_ld(&bar[XB_TMO])) break; if (sp > XB_SPIN_CAP) { atomicAdd(&bar[XB_TMO], 1u); break; } }
    }
    nloc = mine > 0u ? mine : 1u; nx = cnt > 0u ? cnt : 1u;
}
__device__ __forceinline__ void xcd_barrier(const XcdBarrier& b) {
    asm volatile("s_waitcnt vmcnt(0)" ::: "memory");
    __syncthreads();
    if (threadIdx.x == 0) {
        unsigned* bar = b.bar;
        __builtin_amdgcn_s_waitcnt(0);
        unsigned nloc = b.st[0], nx = b.st[1];
        if (nloc == 0u) { xcd_barrier_complete(bar, b.x, nloc, nx); b.st[0] = nloc; b.st[1] = nx; }
        const unsigned old = xb_add(&bar[XB_XSUB(b.x)], 1u);
        const unsigned gen = old / nloc;
        if (old + 1u == (gen + 1u) * nloc) {
            __builtin_amdgcn_fence(__ATOMIC_RELEASE, "agent");
            asm volatile("s_waitcnt vmcnt(0)" ::: "memory");
            const unsigned og = xb_add(&bar[XB_TOP], 1u);
            const unsigned tg = og / nx;
            if (og + 1u == (tg + 1u) * nx) xb_add(&bar[XB_TOPGEN], 1u);
            else XB_SPIN(xb_ld(&bar[XB_TOPGEN]) == tg, bar);
            __builtin_amdgcn_fence(__ATOMIC_ACQUIRE, "agent");
            xb_add(&bar[XB_XGEN(b.x)], 1u);
            asm volatile("s_waitcnt vmcnt(0)" ::: "memory");
        } else {
            XB_SPIN(xb_ld(&bar[XB_XGEN(b.x)]) == gen, bar);
            __builtin_amdgcn_fence(__ATOMIC_ACQUIRE, "agent");
            asm volatile("s_waitcnt vmcnt(0)" ::: "memory");
        }
    }
    __syncthreads();
}

struct Args {
    const float* x; const float* c; const float* ada_w; const float* ada_b; const float* norm1_g; const float* norm2_g;
    const float* da_w_in; const float* da_q_gain; const float* da_k_gain; const float* da_lam_q1; const float* da_lam_k1; const float* da_lam_q2; const float* da_lam_k2;
    const float* da_subln_g; const float* da_w_out;
    const float* gla_w_in; const float* gla_w_a1; const float* gla_w_a2; const float* gla_b_a; const float* gla_out_g; const float* gla_w_out;
    const float* ffn_w1; const float* ffn_w3; const float* ffn_w2;
    const float* moe_router; const float* moe_w1; const float* moe_w3; const float* moe_w2;
    float* out; unsigned char* ws; int ph_lo, ph_hi;
};

__device__ __forceinline__ void p0_transpose_item(const float* W, int ldw, int k0, int n0, bf16* WT, int dst_row0, int Kp, LAS float* scr, int lane) {
#pragma unroll 8
    for (int i = 0; i < 32; ++i) { const int kk = 2 * i + (lane >> 5); scr[kk * 33 + (lane & 31)] = W[(size_t)(k0 + kk) * ldw + n0 + (lane & 31)]; }
    asm volatile("s_waitcnt lgkmcnt(0)" ::: "memory");
    const int c = lane & 7;
#pragma unroll
    for (int j = 0; j < 4; ++j) { const int n = (lane >> 3) + 8 * j; const LAS float* s = scr + (8 * c) * 33 + n;
        u32x4 o; o.x = pk2(s[0 * 33], s[1 * 33]); o.y = pk2(s[2 * 33], s[3 * 33]); o.z = pk2(s[4 * 33], s[5 * 33]); o.w = pk2(s[6 * 33], s[7 * 33]);
        *(u32x4*)(WT + (size_t)(dst_row0 + n) * Kp + k0 + 8 * c) = o; }
    asm volatile("s_waitcnt lgkmcnt(0)" ::: "memory");
}

__device__ __forceinline__ void p0_transpose_item8(const float* W, int ldw, int k0, int n0, unsigned char* WT8, int dst_row0, int Kp, LAS float* scr, int lane) {
#pragma unroll 8
    for (int i = 0; i < 32; ++i) { const int kk = 2 * i + (lane >> 5); scr[kk * 33 + (lane & 31)] = W[(size_t)(k0 + kk) * ldw + n0 + (lane & 31)]; }
    asm volatile("s_waitcnt lgkmcnt(0)" ::: "memory");
    const int c = lane & 7;
#pragma unroll
    for (int j = 0; j < 4; ++j) { const int n = (lane >> 3) + 8 * j; const LAS float* sp = scr + (8 * c) * 33 + n;
        const u32x2 o = (u32x2){pk_fp8x4(sp[0 * 33] * W8_SCALE, sp[1 * 33] * W8_SCALE, sp[2 * 33] * W8_SCALE, sp[3 * 33] * W8_SCALE), pk_fp8x4(sp[4 * 33] * W8_SCALE, sp[5 * 33] * W8_SCALE, sp[6 * 33] * W8_SCALE, sp[7 * 33] * W8_SCALE)};
        *(u32x2*)(WT8 + (size_t)(dst_row0 + n) * Kp + k0 + 8 * c) = o; }
    asm volatile("s_waitcnt lgkmcnt(0)" ::: "memory");
}

namespace att {
__device__ __forceinline__ int crow(int r, int hi) { return (r & 3) + 8 * (r >> 2) + 4 * hi; }
__host__ __device__ constexpr int dwin(int h) { return (int)(150.0 / (1.4426950408889634 / (double)(1 << (h + 1)))); }
__host__ __device__ constexpr int tstart(int h, int jq) { const int q0 = 128 * jq, d = dwin(h); return q0 > d ? (q0 - d) / 64 : 0; }
struct Plan { unsigned char n[16]; unsigned char u[16][48]; };
constexpr Plan make_plan() {
    Plan p{}; int load[16] = {};
    for (int w = 0; w < 16; ++w) p.n[w] = 0;
    for (int h = 7; h >= 0; --h) {
        int cost[32] = {}, ord[32] = {};
        for (int j = 0; j < 32; ++j) { cost[j] = 2 * j + 2 - tstart(h, j); ord[j] = j; }
        for (int a = 1; a < 32; ++a) { const int x = ord[a]; int b = a - 1; while (b >= 0 && cost[ord[b]] < cost[x]) { ord[b + 1] = ord[b]; --b; } ord[b + 1] = x; }
        for (int a = 0; a < 32; ++a) { int best = 0; for (int w = 1; w < 16; ++w) if (load[w] < load[best]) best = w;
            p.u[best][p.n[best]++] = (unsigned char)(h * 32 + ord[a]); load[best] += cost[ord[a]]; }
    }
    return p;
}
__device__ const Plan PLAN = make_plan();
constexpr int BUFB = 32768, NBUF = 3, KOFF = 0, VOFF = 16384, WSF_OFF = NBUF * BUFB;
__device__ __forceinline__ s16x4 vtr(const LAS unsigned char* p) { return __builtin_bit_cast(s16x4, __builtin_amdgcn_ds_read_tr16_b64_v4i16((LAS s16x4*)p)); }

__device__ __forceinline__ void attn_unit(LAS unsigned char* lds, const bf16* Q, const bf16* K, const bf16* V, bf16* O, int b, int h, int jq,
                                          float sl2, float mref0, float mref1, float lam, const float* subg) {
    const int tid = threadIdx.x, lane = tid & 63, r32 = lane & 31, hi = lane >> 5; const int wid = __builtin_amdgcn_readfirstlane(tid >> 6);
    const int mp = wid >> 2, w4 = wid & 3;
    const size_t rowbase = (size_t)b * SEQ; const int q0 = jq * 128;
    const int nT = (q0 >> 6) + 2, myc = (q0 + 32 * w4) >> 6, t0 = tstart(h, jq);
    const bf16* Qw = Q + (rowbase + q0 + 32 * w4 + r32) * D + h * 128 + mp * 64 + hi * 8;
    bf16x8 qr[4];
#pragma unroll
    for (int d0 = 0; d0 < 4; ++d0) qr[d0] = *(const bf16x8*)(Qw + d0 * 16);
    const bf16* ksrc = K + ((size_t)(b * 8 + h) * 64 * 16 + wid) * 512 + lane * 8;
    const int p0 = wid, p1 = wid + 8;
    const bf16* vsrc0 = V + ((size_t)(b * 8 + h) * 64 * 16 + p0) * 512 + lane * 8;
    const bf16* vsrc1 = V + ((size_t)(b * 8 + h) * 64 * 16 + p1) * 512 + lane * 8;
#define ATT_DMA1(gp_, la_) asm volatile("s_mov_b32 m0, %0\n\ts_nop 0\n\tglobal_load_lds_dwordx4 %1, off" :: "s"(la_), "v"(gp_) : "memory", "m0")
#define ATT_DMA(t, bs) do { const unsigned bb_ = (unsigned)__builtin_amdgcn_readfirstlane((int)(ldsu + (unsigned)((bs) * BUFB))); \
        ATT_DMA1(ksrc + (size_t)(t) * 8192, bb_ + (unsigned)(KOFF + wid * 1024)); \
        ATT_DMA1(ksrc + (size_t)(t) * 8192 + 4096, bb_ + (unsigned)(KOFF + 8192 + wid * 1024)); \
        ATT_DMA1(vsrc0 + (size_t)(t) * 8192, bb_ + (unsigned)(VOFF + p0 * 1024)); \
        ATT_DMA1(vsrc1 + (size_t)(t) * 8192, bb_ + (unsigned)(VOFF + p1 * 1024)); } while (0)
    const unsigned ldsu = (unsigned)(unsigned long long)lds;
    const float qpos = (float)(q0 + 32 * w4 + r32);
    const float mref = mp ? mref1 : mref0;
    const float baseL = -sl2 * qpos - mref, sl8 = 8.0f * sl2, sl32 = 32.0f * sl2;
    float lsum = 0.f; f32x16 o[4];
#pragma unroll
    for (int d0 = 0; d0 < 4; ++d0)
#pragma unroll
        for (int r = 0; r < 16; ++r) o[d0][r] = 0.f;
    ATT_DMA(t0, 0);
    if (t0 + 1 < nT) ATT_DMA(t0 + 1, 1);
    asm volatile("" :: "v"(qr[0]), "v"(qr[1]), "v"(qr[2]), "v"(qr[3]) : "memory");
    int slot = 0;
    for (int t = t0; t < nT; ++t) {
        if (t + 1 < nT) asm volatile("s_waitcnt vmcnt(4)" ::: "memory"); else asm volatile("s_waitcnt vmcnt(0)" ::: "memory");
        asm volatile("s_waitcnt lgkmcnt(0)" ::: "memory"); __builtin_amdgcn_s_barrier(); asm volatile("" ::: "memory");
        if (t + 2 < nT) { const int s2 = slot >= 1 ? slot - 1 : 2; ATT_DMA(t + 2, s2); }
        if (t <= myc) {
            const LAS unsigned char* bb = lds + slot * BUFB;
            f32x16 c0, c1;
            if (t < myc) {
                const float kb = baseL + sl2 * (float)(64 * t + 4 * hi);
#pragma unroll
                for (int r = 0; r < 16; ++r) { c0[r] = (r == 0) ? kb : ((r & 3) ? c0[r - 1] + sl2 : c0[r - 4] + sl8); c1[r] = c0[r] + sl32; }
            } else {
                const float qk = qpos - (float)(64 * t + 4 * hi);
                float x[16];
#pragma unroll
                for (int r = 0; r < 16; ++r) { x[r] = (r == 0) ? qk : ((r & 3) ? x[r - 1] - 1.0f : x[r - 4] - 8.0f); c0[r] = -sl2 * fabsf(x[r]) - mref; c1[r] = -sl2 * fabsf(x[r] - 32.0f) - mref; }
            }
            const LAS unsigned char* kb_ = bb + KOFF + mp * 8192 + hi * 1024 + r32 * 16;
#define ATT_SB() __builtin_amdgcn_sched_barrier(0)
            bf16x8 kf[8];
#pragma unroll
            for (int d0 = 0; d0 < 4; ++d0) { kf[2 * d0] = *(const LAS bf16x8*)(kb_ + d0 * 2048); kf[2 * d0 + 1] = *(const LAS bf16x8*)(kb_ + d0 * 2048 + 512); }
            const LAS unsigned char* vp = bb + VOFF + ((lane >> 4) & 1) * 32 + (lane & 3) * 8 + (4 * hi + ((lane & 15) >> 2)) * 64;
            s16x4 vlo[16], vhi[16];
#pragma unroll
            for (int ks = 0; ks < 2; ++ks)
#pragma unroll
                for (int d0 = 0; d0 < 4; ++d0) { vlo[d0 * 4 + ks] = vtr(vp + d0 * 4096 + ks * 1024); vhi[d0 * 4 + ks] = vtr(vp + d0 * 4096 + ks * 1024 + 512); }
            ATT_SB();
#pragma unroll
            for (int d0 = 0; d0 < 4; ++d0) c0 = __builtin_amdgcn_mfma_f32_32x32x16_bf16(kf[2 * d0], qr[d0], c0, 0, 0, 0);
            ATT_SB();
            float sacc = 0.f;
#pragma unroll
            for (int d0 = 0; d0 < 4; ++d0) {
                c1 = __builtin_amdgcn_mfma_f32_32x32x16_bf16(kf[2 * d0 + 1], qr[d0], c1, 0, 0, 0);
                ATT_SB();
#pragma unroll
                for (int e = 0; e < 4; ++e) { c0[4 * d0 + e] = __builtin_amdgcn_exp2f(c0[4 * d0 + e]); sacc += c0[4 * d0 + e]; }
                ATT_SB();
            }
            u32x4 pw[4];
#pragma unroll
            for (int g = 0; g < 4; ++g) { pw[0][g] = cvt_pk_bf16(c0[2 * g], c0[2 * g + 1]); pw[1][g] = cvt_pk_bf16(c0[8 + 2 * g], c0[8 + 2 * g + 1]); }
#pragma unroll
            for (int ks = 2; ks < 4; ++ks)
#pragma unroll
                for (int d0 = 0; d0 < 4; ++d0) { vlo[d0 * 4 + ks] = vtr(vp + d0 * 4096 + ks * 1024); vhi[d0 * 4 + ks] = vtr(vp + d0 * 4096 + ks * 1024 + 512); }
            ATT_SB();
#pragma unroll
            for (int j = 0; j < 8; ++j) { const int ks = j >> 2, d0 = j & 3;
                { const s16x4 lo = vlo[d0 * 4 + ks], hh = vhi[d0 * 4 + ks];
                  const bf16x8 vf = (bf16x8){lo[0], lo[1], lo[2], lo[3], hh[0], hh[1], hh[2], hh[3]};
                  o[d0] = __builtin_amdgcn_mfma_f32_32x32x16_bf16(__builtin_bit_cast(bf16x8, pw[ks]), vf, o[d0], 0, 0, 0); }
                ATT_SB();
                c1[2 * j] = __builtin_amdgcn_exp2f(c1[2 * j]); c1[2 * j + 1] = __builtin_amdgcn_exp2f(c1[2 * j + 1]); sacc += c1[2 * j] + c1[2 * j + 1];
                ATT_SB();
            }
            lsum += sacc;
#pragma unroll
            for (int g = 0; g < 4; ++g) { pw[2][g] = cvt_pk_bf16(c1[2 * g], c1[2 * g + 1]); pw[3][g] = cvt_pk_bf16(c1[8 + 2 * g], c1[8 + 2 * g + 1]); }
            ATT_SB();
#pragma unroll
            for (int j = 8; j < 16; ++j) { const int ks = j >> 2, d0 = j & 3;
                const s16x4 lo = vlo[d0 * 4 + ks], hh = vhi[d0 * 4 + ks];
                const bf16x8 vf = (bf16x8){lo[0], lo[1], lo[2], lo[3], hh[0], hh[1], hh[2], hh[3]};
                o[d0] = __builtin_amdgcn_mfma_f32_32x32x16_bf16(__builtin_bit_cast(bf16x8, pw[ks]), vf, o[d0], 0, 0, 0); }
#undef ATT_SB
        }
        slot = slot == 2 ? 0 : slot + 1;
    }
#undef ATT_DMA
#undef ATT_DMA1
    int el; asm volatile("v_mbcnt_lo_u32_b32 %0, -1, 0\n\tv_mbcnt_hi_u32_b32 %0, -1, %0" : "=v"(el));
    const int r32e = el & 31, hie = el >> 5;
    lsum += __shfl_xor(lsum, 32);
    LAS float* wsf = (LAS float*)(lds + WSF_OFF) + wid * 32;
    if (hie == 0) wsf[r32e] = lsum;
    asm volatile("s_waitcnt lgkmcnt(0)" ::: "memory");
    float rl[16];
#pragma unroll
    for (int r = 0; r < 16; ++r) rl[r] = __builtin_amdgcn_rcpf(wsf[crow(r, hie)]);
#pragma unroll
    for (int d0 = 0; d0 < 4; ++d0)
#pragma unroll
        for (int r = 0; r < 16; ++r) o[d0][r] *= rl[r];
    __syncthreads();
    LAS float* X = (LAS float*)lds + w4 * 4096;
    if (mp == 1) {
#pragma unroll
        for (int d0 = 0; d0 < 4; ++d0)
#pragma unroll
            for (int r = 0; r < 16; ++r) X[(d0 * 16 + r) * 64 + el] = o[d0][r];
    }
    __syncthreads();
    if (mp == 0) {
        float ss[16];
#pragma unroll
        for (int r = 0; r < 16; ++r) ss[r] = 0.f;
#pragma unroll
        for (int d0 = 0; d0 < 4; ++d0)
#pragma unroll
            for (int r = 0; r < 16; ++r) { const float dd = o[d0][r] - lam * X[(d0 * 16 + r) * 64 + el]; o[d0][r] = dd; ss[r] += dd * dd; }
#pragma unroll
        for (int r = 0; r < 16; ++r) {
            float s = ss[r];
#pragma unroll
            for (int of = 1; of < 32; of <<= 1) s += __shfl_xor(s, of);
            ss[r] = __builtin_amdgcn_rsqf(s * (1.0f / 128.0f) + EPS) * 0.8f;
        }
        bf16* Ow = O + (rowbase + q0 + 32 * w4) * D + h * 128 + r32e;
#pragma unroll
        for (int d0 = 0; d0 < 4; ++d0) { const float gcol = subg[32 * d0 + r32e];
#pragma unroll
            for (int r = 0; r < 16; ++r) Ow[(size_t)crow(r, hie) * D + 32 * d0] = (bf16)f2bf(o[d0][r] * ss[r] * gcol); }
    }
    __syncthreads();
}
}

__global__ void __launch_bounds__(NWAVES * 64, 2) mk_fwd(Args args) {
    extern __shared__ __attribute__((aligned(16))) unsigned char lds_raw[];
    LAS unsigned char* lds = (LAS unsigned char*)lds_raw;
    volatile LAS unsigned* MISC = (volatile LAS unsigned*)(lds + MISC_OFF);
    const int tid = threadIdx.x, lane = tid & 63, wave = __builtin_amdgcn_readfirstlane(tid >> 6);
    const int G = gridDim.x; const int bx = blockIdx.x;
    const int vcu = (G % 8 == 0) ? (bx % 8) * (G / 8) + bx / 8 : bx;
    unsigned char* ws = args.ws;
    unsigned* ctl = (unsigned*)(ws + WS_CTL);
    float* MOD = (float*)(ws + WS_MOD);
    unsigned* LCNT = (unsigned*)(ws + WS_LCNT);
    int* META = (int*)(ws + WS_META);
    u32x4* ROUTE = (u32x4*)(ws + WS_ROUTE);
    int* TOKSLOT = (int*)(ws + WS_TOKSLOT);
    float* GSLOT = (float*)(ws + WS_GSLOT);
    bf16* W_DAIN = (bf16*)(ws + WS_W_DAIN); bf16* W_DAOUT = (bf16*)(ws + WS_W_DAOUT); bf16* W_FFN13 = (bf16*)(ws + WS_W_FFN13); bf16* W_FFN2 = (bf16*)(ws + WS_W_FFN2);
    bf16* W_GLAIN = (bf16*)(ws + WS_W_GLAIN); bf16* W_GLAOUT = (bf16*)(ws + WS_W_GLAOUT); bf16* W_MOE13 = (bf16*)(ws + WS_W_MOE13); bf16* W_MOE2 = (bf16*)(ws + WS_W_MOE2);
    bf16* HB = (bf16*)(ws + WS_H);
    bf16* QB = (bf16*)(ws + WS_Q);
    bf16* KB = QB + (size_t)M * D; bf16* VB = KB + (size_t)M * D;
    bf16* ACTB = QB;
    bf16* GP = QB;
    bf16* GLAB = QB + (size_t)M * 3072;
    float* out = args.out;
    bf16* XB = (bf16*)(ws + WS_XB);
    float* KPART = (float*)(ws + WS_Q + 320 * MiB);
    static_assert(MOE_DN8 && (size_t)MAXSLOT * EXPD <= 320 * MiB && 320 * MiB + 256 * (size_t)(32 * 512 * 16) <= 464 * MiB, "K-split partials do not fit behind the MoE activations");

    for (int u = tid; u < 256; u += NWAVES * 64) ((LAS unsigned*)(lds + MISC_OFF))[u] = 0u;
    __syncthreads();
    XcdBarrier bar; bar.bar = ctl + CW_BAR; bar.x = 0; bar.st = nullptr;
    if (MK_N_LAUNCHES == 1) bar = xcd_barrier_post(ctl + CW_BAR, MISC + 8);
    const int lo = args.ph_lo, hi = args.ph_hi;
#define IN(k) (lo <= (k) && (k) < hi)
#define SEAM(k) do { if (IN(k) && IN((k) + 1)) xcd_barrier(bar); } while (0)
    const int gw = vcu * NWAVES + wave, NGW = G * NWAVES;

    if (IN(0)) {
        if (bx < 192) {
            LAS float* cact = (LAS float*)lds;
            for (int e = tid; e < 16 * 1024; e += 512) { const int b = e >> 10, k = e & 1023; const float v = args.c[e]; cact[k * 16 + b] = v / (1.0f + __expf(-v)); }
            __syncthreads();
            const int col = tid & 63, ks = tid >> 6, n = bx * 64 + col, layer = n / 6144, nn = n % 6144;
            const float* wp = args.ada_w + (size_t)layer * 1024 * 6144 + nn;
            float a[16];
#pragma unroll
            for (int b = 0; b < 16; ++b) a[b] = 0.f;
            for (int k = ks * 128; k < ks * 128 + 128; ++k) { const float w = wp[(size_t)k * 6144];
#pragma unroll
                for (int q = 0; q < 4; ++q) { const f32x4 cv = *(const LAS f32x4*)(cact + k * 16 + 4 * q); a[4 * q] += cv[0] * w; a[4 * q + 1] += cv[1] * w; a[4 * q + 2] += cv[2] * w; a[4 * q + 3] += cv[3] * w; } }
            LAS float* red = (LAS float*)(lds + 65536);
#pragma unroll
            for (int b = 0; b < 16; ++b) red[(ks * 16 + b) * 64 + col] = a[b];
            __syncthreads();
            for (int e = tid; e < 1024; e += 512) { const int b = e >> 6, cc = e & 63; float s = 0.f;
#pragma unroll
                for (int k8 = 0; k8 < 8; ++k8) s += red[(k8 * 16 + b) * 64 + cc];
                const int n2 = bx * 64 + cc, l2 = n2 / 6144, nn2 = n2 % 6144;
                MOD[((size_t)l2 * 16 + b) * 6144 + nn2] = s + args.ada_b[l2 * 6144 + nn2]; }
            __syncthreads();
        }
        for (int i = bx * 512 + tid; i < 2 * MAXSLOT; i += G * 512) TOKSLOT[i] = -1;
        LAS float* scr = (LAS float*)(lds + wave * 16384);
        constexpr int I_DAIN = 16 * 96, I_SQ = 16 * 32, I_F13 = 16 * 88, I_F2 = 44 * 32, I_GLAIN = 16 * 96, I_GA = 512;
        constexpr int NITEMS = I_DAIN + I_SQ + 2 * I_F13 + I_F2 + I_GLAIN + I_SQ + I_GA;
        for (int it = gw; it < NITEMS; it += NGW) {
            int r = it;
            if (r < I_DAIN) { const int kb = r / 96, nb = r % 96, n0 = 32 * nb, l = n0 & 255;
                p0_transpose_item(args.da_w_in, 3072, 64 * kb, n0, W_DAIN, (n0 & ~255) + 128 * ((l >> 5) & 1) + 32 * (l >> 6), D, scr, lane); continue; } r -= I_DAIN;
            if (r < I_SQ) { const int kb = r / 32, nb = r % 32; p0_transpose_item(args.da_w_out, D, 64 * kb, 32 * nb, W_DAOUT, 32 * nb, D, scr, lane); continue; } r -= I_SQ;
            if (r < 2 * I_F13) { const int w = r / I_F13, q = r % I_F13, kb = q / 88, nb = q % 88, n0 = 32 * nb;
                if (FFN_UP8) p0_transpose_item8(w ? args.ffn_w3 : args.ffn_w1, FFN, 64 * kb, n0, (unsigned char*)W_FFN13, (n0 >> 7) * 256 + w * 128 + (n0 & 127), D, scr, lane);
                else p0_transpose_item(w ? args.ffn_w3 : args.ffn_w1, FFN, 64 * kb, n0, W_FFN13, (n0 >> 7) * 256 + w * 128 + (n0 & 127), D, scr, lane); continue; } r -= 2 * I_F13;
            if (r < I_F2) { const int kb = r / 32, nb = r % 32; if (FFN_DN8) p0_transpose_item8(args.ffn_w2, D, 64 * kb, 32 * nb, (unsigned char*)W_FFN2, 32 * nb, FFN, scr, lane); else p0_transpose_item(args.ffn_w2, D, 64 * kb, 32 * nb, W_FFN2, 32 * nb, FFN, scr, lane); continue; } r -= I_F2;
            if (r < I_GLAIN) { const int kb = r / 96, nb = r % 96; p0_transpose_item(args.gla_w_in, 3072, 64 * kb, 32 * nb, W_GLAIN, 32 * nb, D, scr, lane); continue; } r -= I_GLAIN;
            if (r < I_SQ) { const int kb = r / 32, nb = r % 32; p0_transpose_item(args.gla_w_out, D, 64 * kb, 32 * nb, W_GLAOUT, 32 * nb, D, scr, lane); continue; } r -= I_SQ;
            if (r < I_GA) {
                const int j = r; float a2[16];
#pragma unroll
                for (int q = 0; q < 16; ++q) a2[q] = args.gla_w_a2[q * 512 + j];
                bf16* dst = W_GLAIN + (size_t)(3072 + j) * D + lane * 16;
                unsigned pk[8];
#pragma unroll
                for (int kk = 0; kk < 16; kk += 2) { float s0 = 0.f, s1 = 0.f; const float* w1p = args.gla_w_a1 + (size_t)(lane * 16 + kk) * 16;
#pragma unroll
                    for (int q = 0; q < 16; ++q) { s0 += w1p[q] * a2[q]; s1 += w1p[16 + q] * a2[q]; }
                    pk[kk >> 1] = pk2(s0, s1); }
                *(u32x4*)dst = (u32x4){pk[0], pk[1], pk[2], pk[3]}; *(u32x4*)(dst + 8) = (u32x4){pk[4], pk[5], pk[6], pk[7]};
                continue; }
        }
    }
    SEAM(0);

#define NORM_LOAD(XSRC, SRC16, m_, v_, s_) do { s_ = 0.f; \
            _Pragma("unroll") for (int j = 0; j < 4; ++j) { v_[j] = (SRC16) ? ld_bf16x4((const bf16*)(XSRC) + (size_t)(m_) * D + 4 * lane + 256 * j) : *((const f32x4*)((const float*)(XSRC) + (size_t)(m_) * D) + lane + 64 * j); s_ += (v_[j][0] * v_[j][0] + v_[j][1] * v_[j][1]) + (v_[j][2] * v_[j][2] + v_[j][3] * v_[j][3]); } } while (0)
#define NORM_ROW(GVEC, MODROW, ROUTER, OUT8, m_, v_, s_) do { const int m = (m_); const int b = m >> 12; f32x4 (&v)[4] = v_; \
            const float* mrow = (MODROW) + (size_t)b * 6144; \
            const float rstd = __builtin_amdgcn_rsqf(wave_sum(s_) * (1.0f / D) + EPS); \
            _Pragma("unroll") for (int j = 0; j < 4; ++j) { const f32x4 gg = *((const f32x4*)(GVEC) + lane + 64 * j), sh = *((const f32x4*)mrow + lane + 64 * j), sc = *((const f32x4*)(mrow + 1024) + lane + 64 * j); \
                v[j] = v[j] * rstd * gg * (sc + 1.0f) + sh; } \
            if (OUT8) { unsigned* o4 = (unsigned*)((unsigned char*)HB + (size_t)m * D) + lane; \
                _Pragma("unroll") for (int j = 0; j < 4; ++j) o4[64 * j] = pk_fp8x4(v[j][0] * H8_SCALE, v[j][1] * H8_SCALE, v[j][2] * H8_SCALE, v[j][3] * H8_SCALE); } \
            else { u32x2* o8 = (u32x2*)(HB + (size_t)m * D) + lane; \
                _Pragma("unroll") for (int j = 0; j < 4; ++j) o8[64 * j] = (u32x2){pk2(v[j][0], v[j][1]), pk2(v[j][2], v[j][3])}; } \
            if (ROUTER) { ROUTER_BODY } } while (0)
#define NORM_PHASE(XSRC, SRC16, GVEC, MODROW, ROUTER, OUT8) do { \
        const int rpw = (M + NGW - 1) / NGW; const int r_lo = (ROUTER ? (bx * NWAVES + wave) : gw) * rpw; \
        for (int rr = 0; rr < rpw; rr += 2) { const int m0 = r_lo + rr; if (m0 >= M) break; const bool two = (rr + 1 < rpw) && (m0 + 1 < M); \
            f32x4 va[4], vb[4]; float sa, sb = 0.f; \
            NORM_LOAD(XSRC, SRC16, m0, va, sa); if (two) NORM_LOAD(XSRC, SRC16, m0 + 1, vb, sb); \
            NORM_ROW(GVEC, MODROW, ROUTER, OUT8, m0, va, sa); if (two) NORM_ROW(GVEC, MODROW, ROUTER, OUT8, m0 + 1, vb, sb); } } while (0)
#define ROUTER_BODY
    if (IN(1)) { NORM_PHASE(args.x, false, args.norm1_g, MOD, 0, false); }
    SEAM(1);

    if (IN(2)) {
        pg8::DenseSched S; S.init(M / 256, 12, G, bx); S.A = (const char*)HB; S.Bt = (const char*)W_DAIN; S.tstep = (size_t)256 * D * 2;
        pg8::EpiQKV E{QB, (size_t)M * D, args.da_q_gain, args.da_k_gain, 0.125f * LOG2E};
        pg8::gemm_phase<pg8::EpiQKV, pg8::DenseSched, true, false>(lds, 2 * D, S, E);
    }
    SEAM(2);

    if (IN(3)) {
        float a1 = args.da_lam_q1[lane] * args.da_lam_k1[lane], a2 = args.da_lam_q2[lane] * args.da_lam_k2[lane];
        const float lam = __expf(wave_sum(a1)) - __expf(wave_sum(a2)) + 0.2f;
        const float gq0 = wave_max(fabsf(args.da_q_gain[lane])), gq1 = wave_max(fabsf(args.da_q_gain[64 + lane]));
        const float gk0 = wave_max(fabsf(args.da_k_gain[lane])), gk1 = wave_max(fabsf(args.da_k_gain[64 + lane]));
        const float mref0 = 8.0f * LOG2E * gq0 * gk0 * 1.01f, mref1 = 8.0f * LOG2E * gq1 * gk1 * 1.01f;
        for (int rep = 0; rep < (PROBE_DUP == 3 ? 2 : 1); ++rep)
        for (int bb = vcu >> 4; bb < BATCH; bb += (G >= 16 ? (G >> 4) : 1)) {
            const int w16 = vcu & 15, nu = att::PLAN.n[w16];
            for (int i = 0; i < nu; ++i) { const int hj = att::PLAN.u[w16][i], h = hj >> 5, jq = hj & 31;
                const float sl2 = LOG2E * exp2f(-(float)(h + 1));
                att::attn_unit(lds, QB, KB, VB, HB, bb, h, jq, sl2, mref0, mref1, lam, args.da_subln_g); }
        }
    }
    SEAM(3);

    if (IN(4)) {
        pg8::DenseSched S; S.init(M / 256, 4, G, bx); S.A = (const char*)HB; S.Bt = (const char*)W_DAOUT; S.tstep = (size_t)256 * D * 2;
        pg8::EpiResid<false, true> E{args.x, XB, MOD + 2048, 1.0f};
        pg8::gemm_phase<pg8::EpiResid<false, true>, pg8::DenseSched, true, false>(lds, 2 * D, S, E);
    }
    SEAM(4);
    if (IN(5)) { NORM_PHASE(XB, true, args.norm2_g, MOD + 3072, 0, FFN_UP8); }
    SEAM(5);

    if (IN(6)) {
        pg8::DenseSched S; S.init(M / 256, 2 * FFN / 256, G, bx); S.A = (const char*)HB; S.Bt = (const char*)W_FFN13; S.tstep = (size_t)256 * D * (FFN_UP8 ? 1 : 2);
        pg8::EpiSwiGLU<FFN_DN8> E{ACTB, FFN, FFN_UP8 ? 1.0f / (H8_SCALE * W8_SCALE) : 1.0f};
        pg8::gemm_phase<pg8::EpiSwiGLU<FFN_DN8>, pg8::DenseSched, true, false, FFN_UP8>(lds, D * (FFN_UP8 ? 1 : 2), S, E);
    }
    SEAM(6);
    if (IN(7)) {
        pg8::DenseSched S; S.init(M / 256, 4, G, bx); S.A = (const char*)ACTB; S.Bt = (const char*)W_FFN2; S.tstep = (size_t)256 * FFN * (FFN_DN8 ? 1 : 2);
        pg8::EpiResid<true, true> E{XB, XB, MOD + 5 * 1024, FFN_DN8 ? 1.0f / (A8_SCALE * W8_SCALE) : 1.0f};
        pg8::gemm_phase<pg8::EpiResid<true, true>, pg8::DenseSched, true, false, FFN_DN8>(lds, FFN * (FFN_DN8 ? 1 : 2), S, E);
    }
    SEAM(7);

    float* MOD1 = MOD + 16 * 6144;
    if (IN(8)) { NORM_PHASE(XB, true, args.norm1_g + D, MOD1, 0, false); }
    SEAM(8);
    if (IN(9)) {
        pg8::DenseSched S; S.init(M / 256, GLA_N / 256, G, bx); S.A = (const char*)HB; S.Bt = (const char*)W_GLAIN; S.tstep = (size_t)256 * D * 2;
        pg8::EpiGLA E{GP, GLAB, args.gla_b_a, args.gla_out_g};
        pg8::gemm_phase<pg8::EpiGLA, pg8::DenseSched, true, false>(lds, 2 * D, S, E);
    }
    SEAM(9);

    unsigned char* GA = (unsigned char*)out;
    static_assert(4096 * GA_UNIT <= 192 * MiB && 256 * MiB <= (size_t)M * D * 4 && (size_t)M * 512 * 2 >= 64 * MiB, "o-fragment parking");
#define OFRAG(b_, n_, h_) (((b_) < 8 ? (unsigned char*)GLAB : (unsigned char*)out + 192 * MiB) + (size_t)(((((b_) & 7) * 64 + (n_)) * 4) + (h_)) * 32768)
    if (IN(10)) {
        LAS unsigned char* QDp = lds; LAS unsigned char* KDTc = lds + 16384; LAS unsigned char* ATc = lds + 32768; LAS float* DV = (LAS float*)(lds + 40960);
        LAS bf16* KI = (LAS bf16*)(lds + 43008); LAS float* QT = (LAS float*)(lds + 60416);
        const int fr = lane & 15, fq = lane >> 4;
        const int j = tid & 127, tq = tid >> 7;
        const int cq = j >> 4, wq = j & 15, hq = (wq >> 2) & 1, jq2 = ((wq >> 3) << 2) | (wq & 3);
        for (int rep = 0; rep < (PROBE_DUP == 10 ? 2 : 1); ++rep)
        for (int u = bx; u < 4096; u += G) {
            const int h = u & 3, n = (u >> 2) & 63, b = u >> 8;
            const size_t R0 = (size_t)b * SEQ + 64 * n;
            float la[16], qv[16], kv[16];
#pragma unroll
            for (int i = 0; i < 16; ++i) { const size_t row = R0 + 16 * tq + i; la[i] = bf2f(GLAB[row * 512 + h * 128 + j]); qv[i] = bf2f(GP[row * 3072 + h * 128 + j]); kv[i] = bf2f(GP[row * 3072 + 512 + h * 128 + j]); }
#pragma unroll
            for (int i = 1; i < 16; ++i) la[i] += la[i - 1];
            QT[tq * 128 + j] = la[15];
            __syncthreads();
            float pre = 0.f, tot = 0.f;
#pragma unroll
            for (int q = 0; q < 4; ++q) { const float v = QT[q * 128 + j]; tot += v; pre += (q < tq) ? v : 0.f; }
            unsigned kdp[8];
#pragma unroll
            for (int i = 0; i < 16; ++i) { const float bb = pre + la[i]; const int t = 16 * tq + i;
                *(LAS bf16*)(QDp + (((cq * 2 + hq) * 64 + t) * 16) + jq2 * 2) = (bf16)f2bf(qv[i] * 0.08838834764831845f * __expf(bb));
                KI[t * 136 + j] = (bf16)f2bf(kv[i] * __expf(-bb));
                const float kd = kv[i] * __expf(tot - bb);
                if (i & 1) kdp[i >> 1] |= f2bf(kd) << 16; else kdp[i >> 1] = f2bf(kd); }
            *(LAS u32x4*)(KDTc + ((2 * tq) * 128 + j) * 16) = (u32x4){kdp[0], kdp[1], kdp[2], kdp[3]};
            *(LAS u32x4*)(KDTc + ((2 * tq + 1) * 128 + j) * 16) = (u32x4){kdp[4], kdp[5], kdp[6], kdp[7]};
            if (tq == 0) DV[j] = __expf(tot);
            __syncthreads();
#pragma unroll
            for (int q = 0; q < 2; ++q) { const int idx = 2 * wave + q, ti = idx >> 2, si = idx & 3;
                f32x4 c = (f32x4){0.f, 0.f, 0.f, 0.f};
                if (si <= ti) {
#pragma unroll
                    for (int ks = 0; ks < 4; ++ks) { const int cc = 2 * ks + (fq >> 1), jb = 4 * (fq & 1), t = 16 * ti + fr;
                        const u32x2 alo = *(const LAS u32x2*)(QDp + (((cc * 2 + 0) * 64 + t) * 16) + jb * 2), ahi = *(const LAS u32x2*)(QDp + (((cc * 2 + 1) * 64 + t) * 16) + jb * 2);
                        const u32x4 af = (u32x4){alo[0], alo[1], ahi[0], ahi[1]};
                        const bf16x8 bfr = *(const LAS bf16x8*)(KI + (16 * si + fr) * 136 + 32 * ks + 8 * fq);
                        c = __builtin_amdgcn_mfma_f32_16x16x32_bf16(__builtin_bit_cast(bf16x8, af), bfr, c, 0, 0, 0); }
                }
#pragma unroll
                for (int r = 0; r < 4; ++r) { const int t = 16 * ti + 4 * fq + r, sx = 16 * si + fr; *(LAS bf16*)(ATc + (((sx >> 3) * 64 + t) * 16) + (sx & 7) * 2) = (bf16)f2bf(sx <= t ? c[r] : 0.f); } }
            __syncthreads();
            { u32x4* dst = (u32x4*)(GA + (size_t)u * GA_UNIT);
              for (int v = tid; v < 41472 / 16; v += 512) dst[v] = *(const LAS u32x4*)(lds + v * 16); }
            __syncthreads();
        }
    }
    SEAM(10);

    const int sstride = G >= 256 ? 4 : (G >= 128 ? 2 : 1);
    const bool is_scan = (vcu % sstride == 0) && (vcu / sstride < 64);
    const int scan_id = vcu / sstride;
    const int copy_id = vcu < 64 * sstride ? (vcu / sstride) * (sstride - 1) + (vcu % sstride) - 1 : 64 * (sstride - 1) + (vcu - 64 * sstride);
    if (IN(11) && !is_scan) {
        LAS float* scr = (LAS float*)(lds + wave * 16384);
        constexpr int I_M13 = 16 * 112, I_M2 = 56 * 32, NIT = NEXP * 2 * I_M13 + NEXP * I_M2;
        const int nwv = (G - 64) * NWAVES;
        for (int rep = 0; rep < (PROBE_DUP == 20 ? 2 : 1); ++rep)
        for (int it = copy_id * NWAVES + wave; it < NIT; it += nwv) {
            int r = it;
            if (r < NEXP * 2 * I_M13) { const int e = r / (2 * I_M13), q2 = r % (2 * I_M13), w = q2 / I_M13, q = q2 % I_M13, kb = q / 112, nb = q % 112, n0 = 32 * nb;
                if (MOE_UP8) p0_transpose_item8((w ? args.moe_w3 : args.moe_w1) + (size_t)e * D * EXPD, EXPD, 64 * kb, n0, (unsigned char*)W_MOE13 + (size_t)e * 2 * EXPD * D, (n0 >> 7) * 256 + w * 128 + (n0 & 127), D, scr, lane);
                else p0_transpose_item((w ? args.moe_w3 : args.moe_w1) + (size_t)e * D * EXPD, EXPD, 64 * kb, n0, W_MOE13 + (size_t)e * 2 * EXPD * D, (n0 >> 7) * 256 + w * 128 + (n0 & 127), D, scr, lane); continue; }
            r -= NEXP * 2 * I_M13;
            { const int e = r / I_M2, q = r % I_M2, kb = q / 32, nb = q % 32;
                if (MOE_DN8) p0_transpose_item8(args.moe_w2 + (size_t)e * EXPD * D, D, 64 * kb, 32 * nb, (unsigned char*)W_MOE2 + (size_t)e * D * EXPD, 32 * nb, EXPD, scr, lane);
                else p0_transpose_item(args.moe_w2 + (size_t)e * EXPD * D, D, 64 * kb, 32 * nb, W_MOE2 + (size_t)e * D * EXPD, 32 * nb, EXPD, scr, lane); }
        }
    }
    if (IN(11) && is_scan) {
        const int b = scan_id >> 2, h = scan_id & 3;
        constexpr int BUFB = 74752, VOFF = 41984, GO_OFF = 2 * BUFB;
        LAS float* GO = (LAS float*)(lds + GO_OFF);
        if (tid < 256) GO[tid] = args.gla_out_g[tid];
        const int r32 = lane & 31, hh = lane >> 5;
        const int c0 = 32 * wave;
        const unsigned char* gabase = GA + ((size_t)b * 256 + h) * GA_UNIT;
        const bf16* vsrc = GP + ((size_t)b * SEQ + (lane >> 2)) * 3072 + 1024 + h * 256 + 32 * wave + (lane & 3) * 8;
#define GLA_DMA(n_, bs_) do { LAS unsigned char* bb_ = lds + (bs_) * BUFB; const unsigned char* ga_ = gabase + (size_t)(n_) * 4 * GA_UNIT; \
        _Pragma("unroll") for (int k_ = 0; k_ < 6; ++k_) { int p_ = wave + 8 * k_; p_ = p_ > 40 ? 40 : p_; \
            __builtin_amdgcn_global_load_lds((const unsigned*)(ga_ + p_ * 1024 + lane * 16), (LAS unsigned*)(bb_ + p_ * 1024), 16, 0, 0); } \
        _Pragma("unroll") for (int ks_ = 0; ks_ < 4; ++ks_) \
            __builtin_amdgcn_global_load_lds((const unsigned*)(vsrc + ((size_t)(n_) * 64 + 16 * ks_) * 3072), (LAS unsigned*)(bb_ + VOFF + (ks_ * 8 + wave) * 1024), 16, 0, 0); } while (0)
#define GLA_BAR() do { asm volatile("s_waitcnt lgkmcnt(0)" ::: "memory"); __builtin_amdgcn_s_barrier(); asm volatile("" ::: "memory"); } while (0)
        for (int rep = 0; rep < (PROBE_DUP == 11 ? 2 : 1); ++rep) {
        f32x16 Sacc[4];
#pragma unroll
        for (int kt = 0; kt < 4; ++kt)
#pragma unroll
            for (int r = 0; r < 16; ++r) Sacc[kt][r] = 0.f;
        GLA_DMA(0, 0);
        asm volatile("s_waitcnt vmcnt(0)" ::: "memory");
        for (int n = 0; n < 64; ++n) {
            const size_t R0 = (size_t)b * SEQ + 64 * n;
            asm volatile("s_waitcnt vmcnt(4)" ::: "memory");
            GLA_BAR();
            if (n + 1 < 64) GLA_DMA(n + 1, (n + 1) & 1);
            LAS unsigned char* bb = lds + (n & 1) * BUFB;
            const LAS unsigned char* QDp = bb; const LAS unsigned char* KDTc = bb + 16384; const LAS unsigned char* ATc = bb + 32768; const LAS float* DV = (const LAS float*)(bb + 40960);
            bf16x8 vf[4];
#pragma unroll
            for (int ks = 0; ks < 4; ++ks) { const LAS unsigned char* vp = bb + VOFF + (ks * 8 + wave) * 1024 + ((lane >> 4) & 1) * 32 + (lane & 3) * 8 + (8 * hh + ((lane & 15) >> 2)) * 64;
                const s16x4 lo = att::vtr(vp), hi4 = att::vtr(vp + 256); vf[ks] = (bf16x8){lo[0], lo[1], lo[2], lo[3], hi4[0], hi4[1], hi4[2], hi4[3]}; }
            f32x16 o[2];
#pragma unroll
            for (int tt = 0; tt < 2; ++tt)
#pragma unroll
                for (int r = 0; r < 16; ++r) o[tt][r] = 0.f;
            bf16x8 qa[16], aa[6];
#pragma unroll
            for (int kt = 0; kt < 4; ++kt)
#pragma unroll
                for (int sx = 0; sx < 2; ++sx)
#pragma unroll
                    for (int tt = 0; tt < 2; ++tt) qa[(kt * 2 + sx) * 2 + tt] = *(const LAS bf16x8*)(QDp + ((((kt * 2 + sx) * 2 + hh) * 64 + 32 * tt + r32) * 16));
#pragma unroll
            for (int i = 0; i < 6; ++i) { const int tt = i < 2 ? 0 : 1, ks = i < 2 ? i : i - 2;
                aa[i] = *(const LAS bf16x8*)(ATc + (((2 * ks + hh) * 64 + 32 * tt + r32) * 16)); }
            __builtin_amdgcn_sched_barrier(0);
#pragma unroll
            for (int kt = 0; kt < 4; ++kt)
#pragma unroll
                for (int sx = 0; sx < 2; ++sx) {
                    u32x4 sb;
#pragma unroll
                    for (int g = 0; g < 4; ++g) sb[g] = cvt_pk_bf16(Sacc[kt][8 * sx + 2 * g], Sacc[kt][8 * sx + 2 * g + 1]);
#pragma unroll
                    for (int tt = 0; tt < 2; ++tt) o[tt] = __builtin_amdgcn_mfma_f32_32x32x16_bf16(qa[(kt * 2 + sx) * 2 + tt], __builtin_bit_cast(bf16x8, sb), o[tt], 0, 0, 0);
                }
#pragma unroll
            for (int i = 0; i < 6; ++i) { const int tt = i < 2 ? 0 : 1, ks = i < 2 ? i : i - 2;
                o[tt] = __builtin_amdgcn_mfma_f32_32x32x16_bf16(aa[i], vf[ks], o[tt], 0, 0, 0); }
            __builtin_amdgcn_sched_barrier(0);
            { u32x4* dst = (u32x4*)(OFRAG(b, n, h)) + (wave * 4) * 64 + lane;
#pragma unroll
              for (int tt = 0; tt < 2; ++tt)
#pragma unroll
                  for (int q = 0; q < 2; ++q) { u32x4 w;
#pragma unroll
                      for (int g = 0; g < 4; ++g) w[g] = cvt_pk_bf16(o[tt][8 * q + 2 * g], o[tt][8 * q + 2 * g + 1]);
                      dst[(tt * 2 + q) * 64] = w; } }
            __builtin_amdgcn_sched_barrier(0);
            f32x4 dvv[16]; bf16x8 ka[16];
#pragma unroll
            for (int kt = 0; kt < 4; ++kt)
#pragma unroll
                for (int g = 0; g < 4; ++g) dvv[kt * 4 + g] = *(const LAS f32x4*)(DV + 32 * kt + 8 * g + 4 * hh);
#pragma unroll
            for (int ks = 0; ks < 4; ++ks)
#pragma unroll
                for (int kt = 0; kt < 4; ++kt) ka[ks * 4 + kt] = *(const LAS bf16x8*)(KDTc + (((2 * ks + hh) * 128 + 32 * kt + r32) * 16));
            __builtin_amdgcn_sched_barrier(0);
#pragma unroll
            for (int kt = 0; kt < 4; ++kt)
#pragma unroll
                for (int g = 0; g < 4; ++g)
#pragma unroll
                    for (int e = 0; e < 4; ++e) Sacc[kt][4 * g + e] *= dvv[kt * 4 + g][e];
#pragma unroll
            for (int ks = 0; ks < 4; ++ks)
#pragma unroll
                for (int kt = 0; kt < 4; ++kt) Sacc[kt] = __builtin_amdgcn_mfma_f32_32x32x16_bf16(ka[ks * 4 + kt], vf[ks], Sacc[kt], 0, 0, 0);
        }
        asm volatile("s_waitcnt vmcnt(0)" ::: "memory");
        GLA_BAR();
        }
#undef GLA_DMA
#undef GLA_BAR
    }
    if (IN(11)) {
        static_assert(MK_N_LAUNCHES == 1, "the scan follow-up sits behind an in-phase grid barrier");
        xcd_barrier(bar);
        LAS float* OS = (LAS float*)lds;
        const int r32 = lane & 31, hh = lane >> 5, c0 = 32 * wave;
        u32x4 fr[4], rwv[4];
#define P10C_LOAD(u_) do { const int b_ = (u_) >> 8, n_ = ((u_) >> 2) & 63, h_ = (u_) & 3; const u32x4* src_ = (const u32x4*)(OFRAG(b_, n_, h_)) + (wave * 4) * 64 + lane; \
            _Pragma("unroll") for (int k_ = 0; k_ < 4; ++k_) fr[k_] = src_[k_ * 64]; \
            const bf16* rp0_ = GP + ((size_t)b_ * SEQ + 64 * n_ + (tid >> 3)) * 3072 + 2048 + h_ * 256 + 32 * (tid & 7); \
            _Pragma("unroll") for (int i_ = 0; i_ < 4; ++i_) rwv[i_] = *(const u32x4*)(rp0_ + 8 * i_); } while (0)
        int u = bx;
        if (u < 4096) P10C_LOAD(u);
        for (; u < 4096; u += G) {
            const int b = u >> 8, n = (u >> 2) & 63, h = u & 3; const size_t R0 = (size_t)b * SEQ + 64 * n;
            u32x4 rw_c[4];
#pragma unroll
            for (int i = 0; i < 4; ++i) rw_c[i] = rwv[i];
            __syncthreads();
#pragma unroll
            for (int tt = 0; tt < 2; ++tt)
#pragma unroll
                for (int q = 0; q < 2; ++q)
#pragma unroll
                    for (int g = 0; g < 4; ++g) { const unsigned w = fr[tt * 2 + q][g]; const int r = 8 * q + 2 * g;
                        OS[(32 * tt + att::crow(r, hh)) * 260 + c0 + r32] = __builtin_bit_cast(float, w << 16);
                        OS[(32 * tt + att::crow(r + 1, hh)) * 260 + c0 + r32] = __builtin_bit_cast(float, w & 0xffff0000u); }
            __syncthreads();
            if (u + G < 4096) P10C_LOAD(u + G);
            { const int t = tid >> 3, seg = tid & 7; f32x4 ov[8]; float ss = 0.f;
#pragma unroll
              for (int i = 0; i < 8; ++i) { ov[i] = *(const LAS f32x4*)(OS + t * 260 + 32 * seg + 4 * i); ss += (ov[i][0] * ov[i][0] + ov[i][1] * ov[i][1]) + (ov[i][2] * ov[i][2] + ov[i][3] * ov[i][3]); }
              ss += __shfl_xor(ss, 1); ss += __shfl_xor(ss, 2); ss += __shfl_xor(ss, 4);
              const float rs = __builtin_amdgcn_rsqf(ss * (1.0f / 256.0f) + EPS);
              bf16* op = HB + (R0 + t) * D + h * 256 + 32 * seg;
#pragma unroll
              for (int i = 0; i < 4; ++i) { const u32x4 rw = rw_c[i]; u32x4 w;
#pragma unroll
                  for (int e = 0; e < 4; ++e) { const float r0 = __builtin_bit_cast(float, rw[e] << 16), r1 = __builtin_bit_cast(float, rw[e] & 0xffff0000u);
                      const int cidx = 8 * i + 2 * e;
                      const float v0 = ov[(cidx) >> 2][(cidx) & 3] * rs * r0, v1 = ov[(cidx + 1) >> 2][(cidx + 1) & 3] * rs * r1;
                      w[e] = pk2(v0, v1); }
                  *(u32x4*)(op + 8 * i) = w; } }
        }
#undef P10C_LOAD
    }
    SEAM(11);


    if (IN(12)) {
        pg8::DenseSched S; S.init(M / 256, 4, G, bx); S.A = (const char*)HB; S.Bt = (const char*)W_GLAOUT; S.tstep = (size_t)256 * D * 2;
        pg8::EpiResid<true, true> E{XB, XB, MOD1 + 2048, 1.0f};
        pg8::gemm_phase<pg8::EpiResid<true, true>, pg8::DenseSched, true, false>(lds, 2 * D, S, E);
    }
    SEAM(12);

    if (IN(13)) {
        LAS float* RW = (LAS float*)lds;
        LAS unsigned* EL = (LAS unsigned*)(lds + 32768);
        LAS float* GL = (LAS float*)(lds + 32768 + 4096);
        for (int e = tid; e < 8192; e += 512) { const int k = e >> 3, ex = e & 7;
            RW[((((k >> 8) * 4 + (k & 3)) * 2 + (ex >> 2)) * 64 + ((k & 255) >> 2)) * 4 + (ex & 3)] = args.moe_router[e]; }
        __syncthreads();
#undef ROUTER_BODY
#define ROUTER_BODY { float lg[8]; \
            _Pragma("unroll") for (int e = 0; e < 8; ++e) lg[e] = 0.f; \
            _Pragma("unroll") for (int j = 0; j < 4; ++j) _Pragma("unroll") for (int i = 0; i < 4; ++i) { const f32x4 w0 = *((const LAS f32x4*)RW + ((j * 4 + i) * 2) * 64 + lane), w1 = *((const LAS f32x4*)RW + ((j * 4 + i) * 2 + 1) * 64 + lane); const float hv = v[j][i]; \
                lg[0] += hv * w0[0]; lg[1] += hv * w0[1]; lg[2] += hv * w0[2]; lg[3] += hv * w0[3]; lg[4] += hv * w1[0]; lg[5] += hv * w1[1]; lg[6] += hv * w1[2]; lg[7] += hv * w1[3]; } \
            _Pragma("unroll") for (int e = 0; e < 8; ++e) lg[e] = wave_sum(lg[e]); \
            float v1 = lg[0]; \
            _Pragma("unroll") for (int e = 1; e < 8; ++e) v1 = fmaxf(v1, lg[e]); \
            int e1 = 7; \
            _Pragma("unroll") for (int e = 6; e >= 0; --e) e1 = (lg[e] == v1) ? e : e1; \
            float v2 = -3.0e38f; \
            _Pragma("unroll") for (int e = 0; e < 8; ++e) v2 = fmaxf(v2, (e == e1) ? -3.0e38f : lg[e]); \
            int e2 = -1; \
            _Pragma("unroll") for (int e = 7; e >= 0; --e) e2 = (e != e1 && lg[e] == v2) ? e : e2; \
            if (lane == 0) { EL[m - wg_row0] = (unsigned)e1 | ((unsigned)e2 << 8); GL[m - wg_row0] = v1 - v2; } }
        const int rpw12 = (M + NGW - 1) / NGW, rows_wg12 = rpw12 * NWAVES, wg_row0 = bx * rows_wg12;
        NORM_PHASE(XB, true, args.norm2_g + D, MOD1 + 3072, 1, MOE_UP8);
        __syncthreads();
        {
            int nrows = M - wg_row0; nrows = nrows > rows_wg12 ? rows_wg12 : nrows;
            for (int r = tid; r < nrows; r += 512) { const unsigned ew = EL[r]; const unsigned e1 = ew & 255u, e2 = ew >> 8; unsigned l1 = 0, l2 = 0;
                for (int q = 0; q < r; ++q) { const unsigned w = EL[q]; l1 += ((w & 255u) == e1) ? 1u : 0u; l2 += ((w >> 8) == e2) ? 1u : 0u; }
                ROUTE[wg_row0 + r] = (u32x4){ew, __builtin_bit_cast(unsigned, GL[r]), l1, l2}; }
            if (tid < 16) { const unsigned e = tid & 7; unsigned cnt = 0; for (int q = 0; q < nrows; ++q) { const unsigned w = EL[q]; cnt += ((tid < 8 ? (w & 255u) : (w >> 8)) == e) ? 1u : 0u; } LCNT[bx * 16 + tid] = cnt; }
        }
    }
    SEAM(13);

    if (IN(14)) {
        LAS int* PRE = (LAS int*)lds;
        LAS int* GOFF = (LAS int*)(lds + 256);
        if (tid < 16) { int pre = 0, tot = 0; for (int w = 0; w < G; ++w) { const int v = (int)LCNT[w * 16 + tid]; tot += v; pre += (w < bx) ? v : 0; } PRE[tid] = pre; ((LAS int*)(lds + 512))[tid] = (tot + 255) & ~255; }
        __syncthreads();
        if (tid < 2) { int acc = 0; for (int e = 0; e < 8; ++e) { GOFF[tid * 9 + e] = acc; acc += ((LAS int*)(lds + 512))[tid * 8 + e]; } GOFF[tid * 9 + 8] = acc;
            if (bx == 0) { for (int e = 0; e < 9; ++e) META[tid * 16 + e] = GOFF[tid * 9 + e]; } }
        __syncthreads();
        const int rpw = (M + NGW - 1) / NGW, rows_wg = rpw * NWAVES;
        for (int r = tid; r < rows_wg; r += 512) { const int m = bx * rows_wg + r; if (m >= M) break;
            const u32x4 rt = ROUTE[m]; const int e1 = rt[0] & 255, e2 = (rt[0] >> 8) & 255; const unsigned gbits = rt[1]; const float gap = __builtin_bit_cast(float, gbits); const float g1 = 1.0f / (1.0f + expf(-gap));
            const int s1 = GOFF[e1] + PRE[e1] + (int)rt[2], s2 = GOFF[9 + e2] + PRE[8 + e2] + (int)rt[3];
            TOKSLOT[s1] = m; GSLOT[s1] = g1; TOKSLOT[MAXSLOT + s2] = m; GSLOT[MAXSLOT + s2] = 1.0f - g1; }
    }
    SEAM(14);

#define MOE_SCHED(S, p) do { const int* mt = META + (p) * 16; S.g1 = mt[1]; S.g2 = mt[2]; S.g3 = mt[3]; S.g4 = mt[4]; S.g5 = mt[5]; S.g6 = mt[6]; S.g7 = mt[7]; } while (0)
#pragma unroll
    for (int p = 0; p < 2; ++p) {
        if (IN(15 + 2 * p)) {
            pg8::MoeSched S; MOE_SCHED(S, p); const int nP = META[p * 16 + 8] >> 8;
            S.init(nP, 2 * EXPD / 256, G, bx); S.A = (const char*)HB; S.a_tstep = 0; S.Bt = (const char*)W_MOE13; S.b_tstep = (size_t)256 * D * (MOE_UP8 ? 1 : 2); S.b_estride = (size_t)2 * EXPD * D * (MOE_UP8 ? 1 : 2);
            S.tokslot = TOKSLOT + p * MAXSLOT; S.rowbytes = D * (MOE_UP8 ? 1 : 2);
            pg8::EpiSwiGLU<MOE_DN8> E{ACTB, EXPD, MOE_UP8 ? 1.0f / (H8_SCALE * W8_SCALE) : 1.0f};
            pg8::gemm_phase<pg8::EpiSwiGLU<MOE_DN8>, pg8::MoeSched, true, true, MOE_UP8>(lds, D * (MOE_UP8 ? 1 : 2), S, E);
        }
        SEAM(15 + 2 * p);
        if (IN(16 + 2 * p)) {
            pg8::MoeSched S; MOE_SCHED(S, p); const int nP = META[p * 16 + 8] >> 8;
            constexpr int RBD = EXPD * (MOE_DN8 ? 1 : 2), NTD = RBD / 128;
            int nPm = nP, jpart = -1; const int qpart = bx & 7;
            { const int nwg = nP * 4, nfull = nwg / G, nrem = nwg - nfull * G; if (nrem > 0 && 8 * nrem <= G && (nfull * G) % 4 == 0 && NTD >= 16) { nPm = nfull * G / 4; if (bx < 8 * nrem) jpart = bx >> 3; } }
            S.init(nPm, 4, G, bx); S.A = (const char*)ACTB; S.a_tstep = (size_t)256 * RBD; S.Bt = (const char*)W_MOE2; S.b_tstep = (size_t)256 * RBD; S.b_estride = (size_t)D * RBD;
            S.tokslot = TOKSLOT + p * MAXSLOT; S.rowbytes = 0;
#define MOE_DOWN(FINAL_) do { pg8::EpiMoeDown<FINAL_> E{TOKSLOT + p * MAXSLOT, GSLOT + p * MAXSLOT, XB, out, MOD1 + 5 * 1024, MOE_DN8 ? 1.0f / (A8_SCALE * W8_SCALE) : 1.0f}; \
                if (nPm > 0) pg8::gemm_phase<pg8::EpiMoeDown<FINAL_>, pg8::MoeSched, true, false, MOE_DN8>(lds, RBD, S, E); \
                if (jpart >= 0) {       \
                    const int gsz = nP - nPm; pg8::Unit u; u.pm = nPm + jpart % gsz; u.pn = jpart / gsz; \
                    { pg8::MoeSchedTail T; MOE_SCHED(T, p); T.init(nP, 4, G, bx); T.A = S.A; T.a_tstep = S.a_tstep; T.Bt = S.Bt; T.b_tstep = S.b_tstep; T.b_estride = S.b_estride; T.tokslot = S.tokslot; T.rowbytes = 0; \
                      constexpr int P = NTD / 2, base = P / 8, extra = P % 8; T.pmT = u.pm; T.pnT = u.pn; T.k0T = 2 * (qpart * base + (qpart < extra ? qpart : extra)); T.nkT = 2 * (base + (qpart < extra ? 1 : 0)); \
                      pg8::EpiPartStore EP{KPART + (size_t)bx * (32 * 512 * 4)}; \
                      pg8::gemm_phase<pg8::EpiPartStore, pg8::MoeSchedTail, true, false, MOE_DN8, true>(lds, RBD, T, EP); } \
                    unsigned* kc = ctl + CW_KCNT + p * 64 + jpart; \
                    asm volatile("s_waitcnt vmcnt(0)" ::: "memory"); __syncthreads(); \
                    if (tid == 0) { __builtin_amdgcn_fence(__ATOMIC_RELEASE, "agent"); asm volatile("s_waitcnt vmcnt(0)" ::: "memory"); (void)xb_add(kc, 1u); \
                        XB_SPIN(xb_ld(kc) < 8u, ctl + CW_BAR); __builtin_amdgcn_fence(__ATOMIC_ACQUIRE, "agent"); asm volatile("s_waitcnt vmcnt(0)" ::: "memory"); } \
                    __syncthreads(); \
                    const int ai = qpart >> 2, m = qpart & 3; \
                    f32x4 v[2][2]; \
                    _Pragma("unroll") for (int bj = 0; bj < 2; ++bj) _Pragma("unroll") for (int n = 0; n < 2; ++n) { f32x4 a = (f32x4){0.f, 0.f, 0.f, 0.f}; \
                        const f32x4* pp = (const f32x4*)(KPART + (size_t)(jpart * 8) * (32 * 512 * 4)) + (size_t)((((ai * 2 + bj) * 4 + m) * 2 + n) * 512 + tid); \
                        _Pragma("unroll") for (int qq = 0; qq < 8; ++qq) a += pp[(size_t)qq * (32 * 512)]; \
                        v[bj][n] = a; } \
                    E.slice(v, u, ai, m, wave >> 2, wave & 3, lane & 15, lane >> 4); } } while (0)
            if (p == 0) MOE_DOWN(false); else MOE_DOWN(true);
#undef MOE_DOWN
        }
        if (p == 0) SEAM(16);
    }
#undef IN
#undef SEAM
}


constexpr int N_PHASES = 19;
extern "C" void kernel_launch(void* const* d_in, const int* in_sizes, int n_in, void* d_out, int out_size, void* d_ws, size_t ws_size, hipStream_t stream) {
    static int grid = 0;
    if (grid == 0) {
        if (n_in != 28 || in_sizes[0] != M * D || out_size != M * D || ws_size < WS_TOTAL) { fprintf(stderr, "kernel_launch: unexpected problem shape (n_in %d, out %d, ws %zu)\n", n_in, out_size, ws_size); grid = -1; return; }
        int dev = 0, cus = 0, per_cu = 0;
        if (hipGetDevice(&dev) != hipSuccess || hipDeviceGetAttribute(&cus, hipDeviceAttributeMultiprocessorCount, dev) != hipSuccess) { grid = -1; return; }
        if (hipFuncSetAttribute((const void*)mk_fwd, hipFuncAttributeMaxDynamicSharedMemorySize, LDS_BYTES) != hipSuccess) { fprintf(stderr, "kernel_launch: hipFuncSetAttribute failed\n"); grid = -1; return; }
        if (hipOccupancyMaxActiveBlocksPerMultiprocessor(&per_cu, (const void*)mk_fwd, NWAVES * 64, LDS_BYTES) != hipSuccess || per_cu < 1) { fprintf(stderr, "kernel_launch: occupancy query reports %d\n", per_cu); }
        (void)hipGetLastError();
        grid = cus;
        if (grid < 128) { fprintf(stderr, "kernel_launch: built for a >= 128-CU device (64 GLA scan workgroups + weight-copy workgroups); got %d\n", grid); grid = -1; return; }
    }
    if (grid < 0) return;
    if (hipMemsetAsync((char*)d_ws + WS_CTL, 0, CTL_ZERO_BYTES, stream) != hipSuccess) return;
    Args a{};
    const float** ap = (const float**)&a;
    for (int i = 0; i < 28; ++i) ap[i] = (const float*)d_in[i];
    a.out = (float*)d_out; a.ws = (unsigned char*)d_ws;
    if (MK_N_LAUNCHES == 1) { a.ph_lo = 0; a.ph_hi = N_PHASES; hipLaunchKernelGGL(mk_fwd, dim3(grid), dim3(NWAVES * 64), LDS_BYTES, stream, a); }
    else { for (int p = 0; p < N_PHASES; ++p) { a.ph_lo = p; a.ph_hi = p + 1; hipLaunchKernelGGL(mk_fwd, dim3(grid), dim3(NWAVES * 64), LDS_BYTES, stream, a); } }
}
```

```cpp
#include <hip/hip_runtime.h>
#include <cstdio>
#include <cstdint>

#ifndef PROBE_DUP
#define PROBE_DUP -1
#endif
#ifndef MK_N_LAUNCHES
#define MK_N_LAUNCHES 1
#endif

#define LAS __attribute__((address_space(3)))
#define GAS __attribute__((address_space(1)))
typedef unsigned short bf16;
typedef short bf16x8 __attribute__((ext_vector_type(8)));
typedef short s16x4 __attribute__((ext_vector_type(4)));
typedef float f32x4 __attribute__((ext_vector_type(4)));
typedef float f32x2 __attribute__((ext_vector_type(2)));
typedef float f32x16 __attribute__((ext_vector_type(16)));
typedef unsigned u32x4 __attribute__((ext_vector_type(4)));
typedef unsigned u32x2 __attribute__((ext_vector_type(2)));

constexpr int D = 1024, BATCH = 16, SEQ = 4096, M = BATCH * SEQ;
constexpr int FFN = 2816, NEXP = 8, EXPD = 3584;
constexpr int GLA_N = 3584;
constexpr float EPS = 1e-6f;
constexpr float LOG2E = 1.4426950408889634f;
constexpr int NWAVES = 8;
constexpr int MAXSLOT = M + NEXP * 256;

constexpr size_t MiB = 1u << 20;
constexpr size_t WS_CTL = 0, CTL_ZERO_BYTES = 64 * 1024;
constexpr size_t WS_MOD = 256 * 1024;
constexpr size_t WS_LCNT = 1 * MiB + 256 * 1024;
constexpr size_t WS_META = 1 * MiB + 512 * 1024;
constexpr size_t WS_ROUTE = 2 * MiB;
constexpr size_t WS_TOKSLOT = 4 * MiB;
constexpr size_t WS_GSLOT = 5 * MiB;
constexpr size_t WS_W_DAIN = 8 * MiB, WS_W_DAOUT = 14 * MiB, WS_W_FFN13 = 16 * MiB, WS_W_FFN2 = 27 * MiB;
constexpr size_t WS_W_GLAIN = 33 * MiB, WS_W_GLAOUT = 40 * MiB, WS_W_MOE13 = 42 * MiB, WS_W_MOE2 = 154 * MiB;
constexpr size_t WS_H = 210 * MiB;
constexpr size_t WS_Q = 338 * MiB;
constexpr size_t WS_END = WS_Q + 464 * MiB;
constexpr size_t WS_XB = WS_END;
constexpr size_t WS_TOTAL = WS_XB + (size_t)M * D * 2;
constexpr size_t GA_UNIT = 43008;
static_assert(4096 * GA_UNIT <= (size_t)M * D * 4, "the GLA per-chunk operands are parked in d_out (free until the last phase writes the result)");
static_assert(WS_TOKSLOT + 2 * MAXSLOT * 4 <= WS_GSLOT && WS_GSLOT + 2 * MAXSLOT * 4 <= WS_W_DAIN, "ws map");
static_assert(WS_W_FFN2 + (size_t)D * FFN * 2 <= WS_W_GLAIN && WS_W_GLAIN + (size_t)GLA_N * D * 2 <= WS_W_GLAOUT, "ws map");
static_assert(WS_W_MOE13 + (size_t)NEXP * 2 * EXPD * D * 2 <= WS_W_MOE2 && WS_W_MOE2 + (size_t)NEXP * D * EXPD * 2 <= WS_H, "ws map");
static_assert((size_t)MAXSLOT * EXPD * 2 <= 464 * MiB && (size_t)M * 3072 * 2 + (size_t)M * 512 * 2 <= 464 * MiB, "ws map");
constexpr int CW_BAR = 4096, CW_KCNT = 8192;

constexpr int RING_BYTES = 131072;
constexpr int TAB_OFF = RING_BYTES;
constexpr int MISC_OFF = 155648;
constexpr int LDS_BYTES = MISC_OFF + 1024;

__device__ __forceinline__ unsigned f2bf(float f) { unsigned u = __builtin_bit_cast(unsigned, f); return (u + 0x7fffu + ((u >> 16) & 1u)) >> 16; }
__device__ __forceinline__ unsigned pk2(float lo, float hi) { return f2bf(lo) | (f2bf(hi) << 16); }
__device__ __forceinline__ float bf2f(unsigned short b) { return __builtin_bit_cast(float, ((unsigned)b) << 16); }
__device__ __forceinline__ unsigned cvt_pk_bf16(float lo, float hi) { unsigned r; asm volatile("v_cvt_pk_bf16_f32 %0, %1, %2" : "=v"(r) : "v"(lo), "v"(hi)); return r; }
__device__ __forceinline__ float wave_sum(float v) {
#pragma unroll
    for (int o = 1; o < 64; o <<= 1) v += __shfl_xor(v, o);
    return v;
}
__device__ __forceinline__ float wave_max(float v) {
#pragma unroll
    for (int o = 1; o < 64; o <<= 1) v = fmaxf(v, __shfl_xor(v, o));
    return v;
}
typedef int v8i __attribute__((ext_vector_type(8)));
typedef int v4i __attribute__((ext_vector_type(4)));
constexpr bool FFN_UP8 = false, FFN_DN8 = true, MOE_UP8 = true, MOE_DN8 = true;
constexpr float W8_SCALE = 64.0f, H8_SCALE = 8.0f, A8_SCALE = 4.0f;
__device__ __forceinline__ float clamp448(float x) { return fminf(fmaxf(x, -448.0f), 448.0f); }
__device__ __forceinline__ unsigned pk_fp8x4(float a, float b, float c, float d) {
    unsigned w = 0u; w = __builtin_amdgcn_cvt_pk_fp8_f32(clamp448(a), clamp448(b), w, false); w = __builtin_amdgcn_cvt_pk_fp8_f32(clamp448(c), clamp448(d), w, true); return w; }
__device__ __forceinline__ f32x4 ld_bf16x4(const bf16* p) { const u32x2 w = *(const u32x2*)p; return (f32x4){__builtin_bit_cast(float, w[0] << 16), __builtin_bit_cast(float, w[0] & 0xffff0000u), __builtin_bit_cast(float, w[1] << 16), __builtin_bit_cast(float, w[1] & 0xffff0000u)}; }
__device__ __forceinline__ void st_bf16x4(bf16* p, f32x4 v) { *(u32x2*)p = (u32x2){cvt_pk_bf16(v[0], v[1]), cvt_pk_bf16(v[2], v[3])}; }
__device__ __forceinline__ float fast_silu(float a) { return a * __builtin_amdgcn_rcpf(1.0f + __builtin_amdgcn_exp2f(-a * LOG2E)); }

namespace pg8 {
constexpr int BM = 256, BK = 64, HALF = 128, HTB = HALF * BK * 2, STAGE_BYTES = 8 * HTB, NXCD = 8, WGM = 8;
__host__ __device__ __forceinline__ int lds_byte(int r, int c) { const int rr = r & 7, ch = (c >> 3) ^ rr; return (r >> 3) * 1024 + (rr * 8 + ch) * 16 + (c & 7) * 2; }
__host__ __device__ __forceinline__ void stage_rc(int b, int& R, int& C) { const int piece = b / 1024, slot = (b % 1024) / 16, rr = slot >> 3, ch = (slot & 7) ^ rr; R = piece * 8 + rr; C = ch * 8; }
__host__ __device__ __forceinline__ int perm32(int rho) { const int n = rho >> 4, i = rho & 15; return 8 * (i >> 2) + 4 * n + (i & 3); }

struct Unit { int pm, pn, k0, nk, part; };
struct TileOrder {
    int nM, nN, nwg, G, c;
    __device__ void init(int nM_, int nN_, int G_, int c_) { nM = nM_; nN = nN_; nwg = nM * nN; G = G_; c = c_; }
    __device__ bool next(int i, Unit& u) const { return at((long)i * G + c, u); }
    __device__ bool at(const long L, Unit& u) const {
        if (L >= nwg) return false;
        int wgid = (int)L; { const int q = nwg / NXCD, r = nwg % NXCD, xcd = wgid % NXCD, off = wgid / NXCD; wgid = (xcd < r ? xcd * (q + 1) : r * (q + 1) + (xcd - r) * q) + off; }
        const int nig = WGM * nN, gid = wgid / nig, fm = gid * WGM, gsz = (nM - fm) < WGM ? (nM - fm) : WGM;
        u.pm = fm + ((wgid % nig) % gsz); u.pn = (wgid % nig) / gsz; return true;
    }
};
struct DenseSched : TileOrder {
    const char* A; const char* Bt; size_t tstep;
    __device__ __forceinline__ const char* a_base(const Unit& u) const { return A + (size_t)u.pm * tstep; }
    __device__ __forceinline__ const char* b_base(const Unit& u) const { return Bt + (size_t)u.pn * tstep; }
    __device__ __forceinline__ unsigned row_off(const Unit&, int) const { return 0u; }
};
struct MoeSched : TileOrder {
    const char* A; const char* Bt; size_t a_tstep, b_tstep, b_estride; const int* tokslot; unsigned rowbytes; int g1, g2, g3, g4, g5, g6, g7;
    __device__ __forceinline__ int expert(int pm) const { const int r = pm * 256; return (r >= g1) + (r >= g2) + (r >= g3) + (r >= g4) + (r >= g5) + (r >= g6) + (r >= g7); }
    __device__ __forceinline__ const char* a_base(const Unit& u) const { return A + (size_t)u.pm * a_tstep; }
    __device__ __forceinline__ const char* b_base(const Unit& u) const { return Bt + (size_t)expert(u.pm) * b_estride + (size_t)u.pn * b_tstep; }
    __device__ __forceinline__ unsigned row_off(const Unit& u, int r) const { int t = tokslot[u.pm * 256 + r]; t = t < 0 ? 0 : t; return (unsigned)t * rowbytes; }
};
struct MoeSchedTail : MoeSched {
    int pmT, pnT, k0T, nkT;
    __device__ bool next(int i, Unit& u) const { if (i != 0) return false; u.pm = pmT; u.pn = pnT; u.k0 = k0T; u.nk = nkT; u.part = 1; return true; }
};

struct EpiQKV {
    static constexpr bool PERM = true;
    bf16* Q; size_t tstride; const float* qg; const float* kg; float qscale;
    __device__ __forceinline__ void operator()(const f32x4 (&acc)[2][2][4][2], const Unit& u, int wr, int wc, int fr, int fq) const {
        const int t = u.pn >> 2;
        bf16* base = Q + (size_t)t * tstride;
        const int lc0 = 256 * (u.pn & 3) + 64 * wc + 8 * fq;
        const int row0 = u.pm * BM + wr * 64 + fr;
        if (t < 2) {
            const float* g = qg; if (t == 1) g = kg;
            g += 64 * (wc & 1) + 8 * fq;
            f32x4 gv[2][2];
#pragma unroll
            for (int bj = 0; bj < 2; ++bj)
#pragma unroll
                for (int n = 0; n < 2; ++n) gv[bj][n] = *(const f32x4*)(g + 32 * bj + 4 * n);
            float sc = 1.0f; if (t == 0) sc = qscale;
#pragma unroll
            for (int ai = 0; ai < 2; ++ai)
#pragma unroll
                for (int m = 0; m < 4; ++m) {
                    float ss = 0.f;
#pragma unroll
                    for (int bj = 0; bj < 2; ++bj)
#pragma unroll
                        for (int n = 0; n < 2; ++n) { const f32x4 x = acc[ai][bj][m][n]; ss += (x[0] * x[0] + x[1] * x[1]) + (x[2] * x[2] + x[3] * x[3]); }
                    ss += __shfl_xor(ss, 16); ss += __shfl_xor(ss, 32);
                    const float rs = __builtin_amdgcn_rsqf(ss * (1.0f / 64.0f) + EPS) * sc;
                    const int R = row0 + ai * HALF + m * 16;
                    bf16* rowp = base + (size_t)R * D + lc0;
#pragma unroll
                    for (int bj = 0; bj < 2; ++bj) { const f32x4 v0 = acc[ai][bj][m][0] * rs * gv[bj][0], v1 = acc[ai][bj][m][1] * rs * gv[bj][1];
                        u32x4 w; w.x = cvt_pk_bf16(v0[0], v0[1]); w.y = cvt_pk_bf16(v0[2], v0[3]); w.z = cvt_pk_bf16(v1[0], v1[1]); w.w = cvt_pk_bf16(v1[2], v1[3]);
                        if (t == 1) {
                            const int col = lc0 + 32 * bj, hh_ = col >> 7, cg = (col & 127) >> 3, b_ = R >> 12, s_ = R & 4095;
                            *(u32x4*)(base + ((((size_t)(b_ * 8 + hh_) * 64 + (s_ >> 6)) * 16 + cg) * 64 + (s_ & 63)) * 8) = w; }
                        else *(u32x4*)(rowp + 32 * bj) = w; }
                }
        } else {
#pragma unroll
            for (int ai = 0; ai < 2; ++ai)
#pragma unroll
                for (int m = 0; m < 4; ++m) { const int R = row0 + ai * HALF + m * 16, b_ = R >> 12, s_ = R & 4095;
#pragma unroll
                    for (int bj = 0; bj < 2; ++bj) { const f32x4 v0 = acc[ai][bj][m][0], v1 = acc[ai][bj][m][1];
                        u32x4 w; w.x = cvt_pk_bf16(v0[0], v0[1]); w.y = cvt_pk_bf16(v0[2], v0[3]); w.z = cvt_pk_bf16(v1[0], v1[1]); w.w = cvt_pk_bf16(v1[2], v1[3]);
                        const int col = lc0 + 32 * bj, hh_ = col >> 7, c_ = col & 127, p_ = (c_ >> 5) * 4 + ((s_ & 63) >> 4), li = ((s_ & 15) << 2) + ((c_ & 31) >> 3);
                        *(u32x4*)(base + ((((size_t)(b_ * 8 + hh_) * 64 + (s_ >> 6)) * 16 + p_) * 64 + li) * 8) = w; } }
        }
    }
};
template <bool BASE16, bool OUT16> struct EpiResid {
    static constexpr bool PERM = true;
    const void* base; void* out; const float* gate; float descale;
    __device__ __forceinline__ void operator()(const f32x4 (&acc)[2][2][4][2], const Unit& u, int wr, int wc, int fr, int fq) const {
        const int row0 = u.pm * BM + wr * 64 + fr, col0 = u.pn * BM + wc * 32 + 8 * fq, b = u.pm >> 4;
        f32x4 gv[2][2];
#pragma unroll
        for (int bj = 0; bj < 2; ++bj)
#pragma unroll
            for (int n = 0; n < 2; ++n) gv[bj][n] = *(const f32x4*)(gate + (size_t)b * 6144 + col0 + bj * HALF + 4 * n) * descale;
#pragma unroll
        for (int ai = 0; ai < 2; ++ai)
#pragma unroll
            for (int m = 0; m < 4; ++m) { const size_t off = (size_t)(row0 + ai * HALF + m * 16) * D + col0;
#pragma unroll
                for (int bj = 0; bj < 2; ++bj) { const size_t o = off + bj * HALF;
                    f32x4 b0, b1;
                    if constexpr (BASE16) { const u32x4 w = *(const u32x4*)((const bf16*)base + o);
                        b0 = (f32x4){__builtin_bit_cast(float, w[0] << 16), __builtin_bit_cast(float, w[0] & 0xffff0000u), __builtin_bit_cast(float, w[1] << 16), __builtin_bit_cast(float, w[1] & 0xffff0000u)};
                        b1 = (f32x4){__builtin_bit_cast(float, w[2] << 16), __builtin_bit_cast(float, w[2] & 0xffff0000u), __builtin_bit_cast(float, w[3] << 16), __builtin_bit_cast(float, w[3] & 0xffff0000u)}; }
                    else { b0 = *(const f32x4*)((const float*)base + o); b1 = *(const f32x4*)((const float*)base + o + 4); }
                    const f32x4 r0 = b0 + gv[bj][0] * acc[ai][bj][m][0], r1 = b1 + gv[bj][1] * acc[ai][bj][m][1];
                    if constexpr (OUT16) *(u32x4*)((bf16*)out + o) = (u32x4){cvt_pk_bf16(r0[0], r0[1]), cvt_pk_bf16(r0[2], r0[3]), cvt_pk_bf16(r1[0], r1[1]), cvt_pk_bf16(r1[2], r1[3])};
                    else { *(f32x4*)((float*)out + o) = r0; *(f32x4*)((float*)out + o + 4) = r1; } }
                asm volatile("" ::: "memory"); }
    }
};
template <bool OUT8> struct EpiSwiGLU {
    static constexpr bool PERM = true;
    void* O; int ldo; float descale;
    __device__ __forceinline__ void operator()(const f32x4 (&acc)[2][2][4][2], const Unit& u, int wr, int wc, int fr, int fq) const {
        const int row0 = u.pm * BM + wr * 64 + fr, col0 = u.pn * HALF + wc * 32 + 8 * fq;
#pragma unroll
        for (int ai = 0; ai < 2; ++ai)
#pragma unroll
            for (int m = 0; m < 4; ++m) { const unsigned eo = (unsigned)(row0 + ai * HALF + m * 16) * (unsigned)ldo + (unsigned)col0;
                f32x4 v0, v1;
#pragma unroll
                for (int i = 0; i < 4; ++i) { v0[i] = fast_silu(acc[ai][0][m][0][i] * descale) * (acc[ai][1][m][0][i] * descale); v1[i] = fast_silu(acc[ai][0][m][1][i] * descale) * (acc[ai][1][m][1][i] * descale); }
                if constexpr (OUT8) { v0 = v0 * A8_SCALE; v1 = v1 * A8_SCALE; *(u32x2*)((unsigned char*)O + eo) = (u32x2){pk_fp8x4(v0[0], v0[1], v0[2], v0[3]), pk_fp8x4(v1[0], v1[1], v1[2], v1[3])}; }
                else { u32x4 w; w.x = cvt_pk_bf16(v0[0], v0[1]); w.y = cvt_pk_bf16(v0[2], v0[3]); w.z = cvt_pk_bf16(v1[0], v1[1]); w.w = cvt_pk_bf16(v1[2], v1[3]); *(u32x4*)((bf16*)O + eo) = w; } }
    }
};
struct EpiGLA {
    static constexpr bool PERM = true;
    bf16* P; bf16* LA; const float* ba; const float* og;
    __device__ __forceinline__ void operator()(const f32x4 (&acc)[2][2][4][2], const Unit& u, int wr, int wc, int fr, int fq) const {
        const int row0 = u.pm * BM + wr * 64 + fr;
        if (u.pn < 12) {
            const int col0 = u.pn * BM + wc * 32 + 8 * fq; const bool isr = u.pn >= 8;
            f32x4 gv[2][2];
#pragma unroll
            for (int bj = 0; bj < 2; ++bj)
#pragma unroll
                for (int n = 0; n < 2; ++n) gv[bj][n] = isr ? *(const f32x4*)(og + wc * 32 + 8 * fq + bj * HALF + 4 * n) : (f32x4){1.f, 1.f, 1.f, 1.f};
#pragma unroll
            for (int ai = 0; ai < 2; ++ai)
#pragma unroll
                for (int m = 0; m < 4; ++m) { bf16* rowp = P + (size_t)(row0 + ai * HALF + m * 16) * 3072 + col0;
#pragma unroll
                    for (int bj = 0; bj < 2; ++bj) { f32x4 v0 = acc[ai][bj][m][0], v1 = acc[ai][bj][m][1];
                        if (isr) {
#pragma unroll
                            for (int i = 0; i < 4; ++i) { v0[i] = gv[bj][0][i] * fast_silu(v0[i]); v1[i] = gv[bj][1][i] * fast_silu(v1[i]); } }
                        u32x4 w; w.x = cvt_pk_bf16(v0[0], v0[1]); w.y = cvt_pk_bf16(v0[2], v0[3]); w.z = cvt_pk_bf16(v1[0], v1[1]); w.w = cvt_pk_bf16(v1[2], v1[3]);
                        *(u32x4*)(rowp + bj * HALF) = w; } }
        } else {
            const int col0 = (u.pn - 12) * BM + wc * 32 + 8 * fq;
            f32x4 bv[2][2];
#pragma unroll
            for (int bj = 0; bj < 2; ++bj)
#pragma unroll
                for (int n = 0; n < 2; ++n) bv[bj][n] = *(const f32x4*)(ba + col0 + bj * HALF + 4 * n);
#pragma unroll
            for (int ai = 0; ai < 2; ++ai)
#pragma unroll
                for (int m = 0; m < 4; ++m) { bf16* rowp = LA + (size_t)(row0 + ai * HALF + m * 16) * 512 + col0;
#pragma unroll
                    for (int bj = 0; bj < 2; ++bj) { f32x4 v[2];
#pragma unroll
                        for (int n = 0; n < 2; ++n)
#pragma unroll
                            for (int i = 0; i < 4; ++i) { const float z = acc[ai][bj][m][n][i] + bv[bj][n][i];
                                v[n][i] = (fminf(z, 0.f) - __logf(1.0f + __expf(-fabsf(z)))) * (1.0f / 16.0f); }
                        u32x4 w; w.x = cvt_pk_bf16(v[0][0], v[0][1]); w.y = cvt_pk_bf16(v[0][2], v[0][3]); w.z = cvt_pk_bf16(v[1][0], v[1][1]); w.w = cvt_pk_bf16(v[1][2], v[1][3]);
                        *(u32x4*)(rowp + bj * HALF) = w; } }
        }
    }
};
template <bool FINAL> struct EpiMoeDown {
    static constexpr bool PERM = true;
    const int* tokslot; const float* gslot; bf16* xb; float* outf; const float* gate; float descale;
    __device__ __forceinline__ void row(const f32x4 (&v)[2][2], int srow, int col0) const {
        const int tok = tokslot[srow];
        if (tok >= 0) { const float g = gslot[srow] * descale; const float* gp = gate + (size_t)(tok >> 12) * 6144 + col0; const size_t ro = (size_t)tok * D + col0;
#pragma unroll
            for (int bj = 0; bj < 2; ++bj) { const f32x4 g0 = *(const f32x4*)(gp + bj * HALF), g1 = *(const f32x4*)(gp + bj * HALF + 4); const u32x4 w = *(const u32x4*)(xb + ro + bj * HALF);
                const f32x4 b0 = (f32x4){__builtin_bit_cast(float, w[0] << 16), __builtin_bit_cast(float, w[0] & 0xffff0000u), __builtin_bit_cast(float, w[1] << 16), __builtin_bit_cast(float, w[1] & 0xffff0000u)};
                const f32x4 b1 = (f32x4){__builtin_bit_cast(float, w[2] << 16), __builtin_bit_cast(float, w[2] & 0xffff0000u), __builtin_bit_cast(float, w[3] << 16), __builtin_bit_cast(float, w[3] & 0xffff0000u)};
                const f32x4 r0 = b0 + g0 * g * v[bj][0], r1 = b1 + g1 * g * v[bj][1];
                if constexpr (FINAL) { *(f32x4*)(outf + ro + bj * HALF) = r0; *(f32x4*)(outf + ro + bj * HALF + 4) = r1; }
                else *(u32x4*)(xb + ro + bj * HALF) = (u32x4){cvt_pk_bf16(r0[0], r0[1]), cvt_pk_bf16(r0[2], r0[3]), cvt_pk_bf16(r1[0], r1[1]), cvt_pk_bf16(r1[2], r1[3])}; } }
    }
    __device__ __forceinline__ void operator()(const f32x4 (&acc)[2][2][4][2], const Unit& u, int wr, int wc, int fr, int fq) const {
        const int srow0 = u.pm * BM + wr * 64 + fr, col0 = u.pn * BM + wc * 32 + 8 * fq;
#pragma unroll
        for (int ai = 0; ai < 2; ++ai)
#pragma unroll
            for (int m = 0; m < 4; ++m) { const f32x4 v[2][2] = {{acc[ai][0][m][0], acc[ai][0][m][1]}, {acc[ai][1][m][0], acc[ai][1][m][1]}};
                row(v, srow0 + ai * HALF + m * 16, col0);
                asm volatile("" ::: "memory"); }
    }
    __device__ __forceinline__ void slice(const f32x4 (&v)[2][2], const Unit& u, int ai, int m, int wr, int wc, int fr, int fq) const {
        row(v, u.pm * BM + wr * 64 + fr + ai * HALF + m * 16, u.pn * BM + wc * 32 + 8 * fq);
    }
};
struct EpiPartStore {
    static constexpr bool PERM = true;
    float* part;
    __device__ __forceinline__ void operator()(const f32x4 (&acc)[2][2][4][2], const Unit&, int wr, int wc, int fr, int fq) const {
        f32x4* p = (f32x4*)part + ((wr * 4 + wc) * 64 + fq * 16 + fr);
#pragma unroll
        for (int ai = 0; ai < 2; ++ai)
#pragma unroll
            for (int bj = 0; bj < 2; ++bj)
#pragma unroll
                for (int m = 0; m < 4; ++m)
#pragma unroll
                    for (int n = 0; n < 2; ++n) { *p = acc[ai][bj][m][n]; p += 512; asm volatile("" : "+v"(p)); }
    }
};

template <class Epi, class Sched, bool ALIGN_EPI, bool GATHER, bool FP8 = false, bool KSPLIT = false>
__device__ __forceinline__ void gemm_phase(LAS unsigned char* lds, const int RB, const Sched& S, const Epi& E) {
    const int tid = threadIdx.x, wid = __builtin_amdgcn_readfirstlane(tid >> 6), lane = tid & 63, wr = wid >> 2, wc = wid & 3, fr = lane & 15, fq = lane >> 4;
    const int nt = RB / 128;
    unsigned voffB0, voffA0;
    const size_t kstep = (size_t)(BK * 2);
    const size_t hstep = (size_t)HALF * RB;
    const size_t qstep = (size_t)64 * RB;
    { int R, C; stage_rc(tid * 16, R, C); const int Rb = Epi::PERM ? ((R & ~31) + perm32(R & 31)) : R;
        voffB0 = (unsigned)(Rb * RB + C * 2); voffA0 = (unsigned)(R * RB + C * 2); }
    LAS unsigned* mytab = (LAS unsigned*)(lds + STAGE_BYTES) + tid;
#define PG8_TABFILL(par, U) do { _Pragma("unroll") for (int _h = 0; _h < 2; ++_h) _Pragma("unroll") for (int _i = 0; _i < 2; ++_i) { int _R, _C; stage_rc(tid * 16 + _i * 8192, _R, _C); \
        mytab[((par) * 4 + _h * 2 + _i) * 512] = S.row_off(U, _h * HALF + _R) + (unsigned)_C * 2u; } } while (0)
    const unsigned ldsw = (unsigned)wid * 1024u;
    const int aoff = lds_byte(wr * 64 + fr, fq * 8), boff = lds_byte(wc * 32 + fr, fq * 8), aoff1 = aoff ^ 64, boff1 = boff ^ 64;
#define PG8_SA(b, h) (((b) * 2 + (h)) * HTB)
#define PG8_SB(b, h) ((4 + (b) * 2 + (h)) * HTB)
#define PG8_STAGE_B(bufoff, gbase) do { _Pragma("unroll") for (int _i = 0; _i < 2; ++_i) \
        __builtin_amdgcn_global_load_lds((const unsigned*)((const char*)(gbase) + _i * qstep + voffB0), (LAS unsigned*)(lds + (bufoff) + ldsw + _i * 8192), 16, 0, 0); } while (0)
#define PG8_STAGE_A(bufoff, gbase, va, h) do { _Pragma("unroll") for (int _i = 0; _i < 2; ++_i) \
        __builtin_amdgcn_global_load_lds((const unsigned*)((const char*)(gbase) + (GATHER ? (size_t)0 : (size_t)(h) * hstep + _i * qstep) + (GATHER ? (va)[h][_i] : voffA0)), (LAS unsigned*)(lds + (bufoff) + ldsw + _i * 8192), 16, 0, 0); } while (0)
#define PG8_LDA(dst, b, h) do { _Pragma("unroll") for (int m = 0; m < 4; ++m) { if constexpr (FP8) dst##8[m] = __builtin_shufflevector(*(const LAS v4i*)(lds + PG8_SA(b, h) + aoff + m * 2048), *(const LAS v4i*)(lds + PG8_SA(b, h) + aoff1 + m * 2048), 0, 1, 2, 3, 4, 5, 6, 7); \
        else { dst[m][0] = *(const LAS bf16x8*)(lds + PG8_SA(b, h) + aoff + m * 2048); dst[m][1] = *(const LAS bf16x8*)(lds + PG8_SA(b, h) + aoff1 + m * 2048); } } } while (0)
#define PG8_LDB(dst, b, h) do { _Pragma("unroll") for (int n = 0; n < 2; ++n) { if constexpr (FP8) dst##8[n] = __builtin_shufflevector(*(const LAS v4i*)(lds + PG8_SB(b, h) + boff + n * 2048), *(const LAS v4i*)(lds + PG8_SB(b, h) + boff1 + n * 2048), 0, 1, 2, 3, 4, 5, 6, 7); \
        else { dst[n][0] = *(const LAS bf16x8*)(lds + PG8_SB(b, h) + boff + n * 2048); dst[n][1] = *(const LAS bf16x8*)(lds + PG8_SB(b, h) + boff1 + n * 2048); } } } while (0)
#define PG8_CAT(x0, x1) __builtin_shufflevector(__builtin_bit_cast(v4i, x0), __builtin_bit_cast(v4i, x1), 0, 1, 2, 3, 4, 5, 6, 7)
#define PG8_MMA(ai, bj, At, Bt) do { __builtin_amdgcn_s_setprio(1); _Pragma("unroll") for (int m = 0; m < 4; ++m) _Pragma("unroll") for (int n = 0; n < 2; ++n) { \
        if constexpr (FP8) asm volatile("v_mfma_scale_f32_16x16x128_f8f6f4 %0, %1, %2, %0, %3, %3 op_sel_hi:[0,0,0]" : "+v"(acc[ai][bj][m][n]) : "v"(Bt##8[n]), "v"(At##8[m]), "v"(sc8));   \
        else { _Pragma("unroll") for (int k = 0; k < 2; ++k) acc[ai][bj][m][n] = __builtin_amdgcn_mfma_f32_16x16x32_bf16(Bt[n][k], At[m][k], acc[ai][bj][m][n], 0, 0, 0); } } \
        __builtin_amdgcn_s_setprio(0); } while (0)
#define PG8_WAIT_V(n) asm volatile("s_waitcnt vmcnt(" #n ")" ::: "memory")
#define PG8_WAIT_L(n) asm volatile("s_waitcnt lgkmcnt(" #n ")" ::: "memory")
#define PG8_BAR __builtin_amdgcn_s_barrier()
#define PG8_SCHED __builtin_amdgcn_sched_barrier(0)
    Unit cur, nxt; int ui = 0;
    if (!S.next(0, cur)) return;
    f32x4 acc[2][2][4][2];
#pragma unroll
    for (int a = 0; a < 2; ++a)
#pragma unroll
        for (int b = 0; b < 2; ++b)
#pragma unroll
            for (int m = 0; m < 4; ++m)
#pragma unroll
                for (int n = 0; n < 2; ++n) acc[a][b][m][n] = (f32x4){0.f, 0.f, 0.f, 0.f};
    const int sc8 = 0x7f7f7f7f;
    bf16x8 At[4][2], B0[2][2], B1[2][2]; v8i At8[4], B08[2], B18[2];
    const char* cA = S.a_base(cur); const char* cB = S.b_base(cur);
    if constexpr (KSPLIT) { cA += (size_t)cur.k0 * kstep; cB += (size_t)cur.k0 * kstep; }
    unsigned cvA[2][2] = {{0u, 0u}, {0u, 0u}};
    if constexpr (GATHER) {
        PG8_TABFILL(0, cur);
#pragma unroll
        for (int h = 0; h < 2; ++h)
#pragma unroll
            for (int i = 0; i < 2; ++i) cvA[h][i] = mytab[(h * 2 + i) * 512];
    }
    PG8_STAGE_B(PG8_SB(0, 0), cB); PG8_STAGE_B(PG8_SB(0, 1), cB + hstep); PG8_STAGE_A(PG8_SA(0, 0), cA, cvA, 0); PG8_STAGE_A(PG8_SA(0, 1), cA, cvA, 1);
    if (wr == 1) PG8_BAR;
    PG8_WAIT_V(2); PG8_BAR;
    PG8_STAGE_B(PG8_SB(1, 0), cB + kstep); PG8_STAGE_A(PG8_SA(1, 0), cA + kstep, cvA, 0); PG8_STAGE_B(PG8_SB(1, 1), cB + hstep + kstep);
    PG8_WAIT_V(6); PG8_BAR;
    for (;;) {
        const bool has_next = S.next(ui + 1, nxt);
        const char* nA = has_next ? S.a_base(nxt) : cA; const char* nB = has_next ? S.b_base(nxt) : cB;
        if constexpr (KSPLIT) { if (has_next) { nA += (size_t)nxt.k0 * kstep; nB += (size_t)nxt.k0 * kstep; } }
        if constexpr (GATHER) { if (has_next) PG8_TABFILL((ui + 1) & 1, nxt); }
        const int ntc = KSPLIT ? cur.nk : nt;
#pragma unroll 1
        for (int t = 0; t < ntc; t += 2) {
            const bool last = (t == ntc - 2);
            const char* a1 = cA + (size_t)(t + 1) * kstep;
            const char* a2 = last ? nA : cA + (size_t)(t + 2) * kstep; const char* b2 = last ? nB : cB + (size_t)(t + 2) * kstep;
            const char* a3 = a2 + kstep; const char* b3 = b2 + kstep;
            unsigned wA[2][2] = {{0u, 0u}, {0u, 0u}};
            if constexpr (GATHER) {
                const int pc = ui & 1, pw = (last && has_next) ? (pc ^ 1) : pc;
#pragma unroll
                for (int i = 0; i < 2; ++i) { cvA[1][i] = mytab[(pc * 4 + 2 + i) * 512]; wA[0][i] = mytab[(pw * 4 + i) * 512]; wA[1][i] = mytab[(pw * 4 + 2 + i) * 512]; }
            }
            PG8_LDB(B0, 0, 0); PG8_LDB(B1, 0, 1); PG8_SCHED; PG8_LDA(At, 0, 0); PG8_STAGE_A(PG8_SA(1, 1), a1, cvA, 1);
            PG8_WAIT_V(8); PG8_WAIT_L(0); PG8_BAR; PG8_MMA(0, 0, At, B0); PG8_MMA(0, 1, At, B1); PG8_BAR; PG8_SCHED;
            PG8_LDA(At, 0, 1); PG8_STAGE_B(PG8_SB(0, 0), b2); PG8_STAGE_B(PG8_SB(0, 1), b2 + hstep); PG8_STAGE_A(PG8_SA(0, 0), a2, wA, 0);
            PG8_WAIT_V(8); PG8_WAIT_L(0); PG8_BAR; PG8_MMA(1, 0, At, B0); PG8_MMA(1, 1, At, B1); PG8_BAR; PG8_SCHED;
            PG8_LDB(B0, 1, 0); PG8_LDB(B1, 1, 1); PG8_SCHED; PG8_LDA(At, 1, 0); PG8_STAGE_A(PG8_SA(0, 1), a2, wA, 1);
            PG8_WAIT_V(8); PG8_WAIT_L(0); PG8_BAR; PG8_MMA(0, 0, At, B0); PG8_MMA(0, 1, At, B1); PG8_BAR; PG8_SCHED;
            PG8_LDA(At, 1, 1); PG8_STAGE_B(PG8_SB(1, 0), b3); PG8_STAGE_B(PG8_SB(1, 1), b3 + hstep); PG8_STAGE_A(PG8_SA(1, 0), a3, wA, 0);
            PG8_WAIT_V(8); PG8_WAIT_L(0); PG8_BAR; PG8_MMA(1, 0, At, B0); PG8_MMA(1, 1, At, B1); PG8_BAR; PG8_SCHED;
        }
        if constexpr (ALIGN_EPI) { if (wr == 0) PG8_BAR; }
        if constexpr (FP8) asm volatile("s_nop 15\n\ts_nop 15" ::: "memory");
        { int el; asm volatile("v_mbcnt_lo_u32_b32 %0, -1, 0\n\tv_mbcnt_hi_u32_b32 %0, -1, %0" : "=v"(el));
          E(acc, cur, wr, wc, el & 15, el >> 4); }
        if (!has_next) break;
#pragma unroll
        for (int a = 0; a < 2; ++a)
#pragma unroll
            for (int b = 0; b < 2; ++b)
#pragma unroll
                for (int m = 0; m < 4; ++m)
#pragma unroll
                    for (int n = 0; n < 2; ++n) acc[a][b][m][n] = (f32x4){0.f, 0.f, 0.f, 0.f};
        cur = nxt; cA = nA; cB = nB; ++ui;
        if constexpr (ALIGN_EPI) { if (wr == 1) PG8_BAR; }
    }
    PG8_WAIT_V(0);
    if constexpr (!ALIGN_EPI) { if (wr == 0) PG8_BAR; }
    PG8_BAR;
#undef PG8_SA
#undef PG8_SB
#undef PG8_STAGE_A
#undef PG8_TABFILL
#undef PG8_STAGE_B
#undef PG8_LDA
#undef PG8_LDB
#undef PG8_MMA
#undef PG8_CAT
#undef PG8_WAIT_V
#undef PG8_WAIT_L
#undef PG8_BAR
#undef PG8_SCHED
}
}

#define XB_TMO      128
#define XB_XCNT(j)  (256  + 64 * (j))
#define XB_XSUB(j)  (1280 + 64 * (j))
#define XB_XGEN(j)  (2304 + 64 * (j))
#define XB_TOP      3328
#define XB_TOPGEN   3392
#define XCD_BAR_WORDS 3456
#define XB_SPIN_CAP (1u << 18)
__device__ __forceinline__ unsigned xb_ld(unsigned* p)              { return __hip_atomic_load(p, __ATOMIC_RELAXED, __HIP_MEMORY_SCOPE_AGENT); }
__device__ __forceinline__ unsigned xb_add(unsigned* p, unsigned v) { return __hip_atomic_fetch_add(p, v, __ATOMIC_RELAXED, __HIP_MEMORY_SCOPE_AGENT); }
__device__ __forceinline__ unsigned xb_xcc_id() { return (unsigned)__builtin_amdgcn_s_getreg((3 << 11) | 20) & 0xFu; }
#define XB_SPIN(cond, bar) do { unsigned _sp = 0; while (cond) { __builtin_amdgcn_s_sleep(1); \
    if ((++_sp & 255u) == 0u) { if (xb_ld(&(bar)[XB_TMO])) break; if (_sp > XB_SPIN_CAP) { atomicAdd(&(bar)[XB_TMO], 1u); break; } } } } while (0)
struct XcdBarrier { unsigned* bar; unsigned x; volatile LAS unsigned* st; };
__device__ __forceinline__ XcdBarrier xcd_barrier_post(unsigned* bar, volatile LAS unsigned* st) {
    XcdBarrier b; b.bar = bar; b.x = xb_xcc_id(); b.st = st;
    if (threadIdx.x == 0) (void)xb_add(&bar[XB_XCNT(b.x)], 1u);
    return b;
}
__device__ __forceinline__ void xcd_barrier_complete(unsigned* bar, unsigned x, unsigned& nloc, unsigned& nx) {
    const unsigned G = gridDim.x * gridDim.y * gridDim.z;
    unsigned sum, cnt, mine, sp = 0u;
    for (;;) {
        sum = 0u; cnt = 0u; mine = 0u;
#pragma unroll
        for (unsigned j = 0; j < 16; ++j) { const unsigned c = xb_ld(&bar[XB_XCNT(j)]); sum += c; cnt += (c > 0u) ? 1u : 0u; mine = (j == x) ? c : mine; }
        if (sum == G) break;
        __builtin_amdgcn_s_sleep(1);
        if ((++sp & 255u) == 0u) { if (xb_ld(&bar[XB_TMO])) break; if (sp > XB_SPIN_CAP) { atomicAdd(&bar[XB_TMO], 1u); break; } }
    }
    nloc = mine > 0u ? mine : 1u; nx = cnt > 0u ? cnt : 1u;
}
__device__ __forceinline__ void xcd_barrier(const XcdBarrier& b) {
    asm volatile("s_waitcnt vmcnt(0)" ::: "memory");
    __syncthreads();
    if (threadIdx.x == 0) {
        unsigned* bar = b.bar;
        __builtin_amdgcn_s_waitcnt(0);
        unsigned nloc = b.st[0], nx = b.st[1];
        if (nloc == 0u) { xcd_barrier_complete(bar, b.x, nloc, nx); b.st[0] = nloc; b.st[1] = nx; }
        const unsigned old = xb_add(&bar[XB_XSUB(b.x)], 1u);
        const unsigned gen = old / nloc;
        if (old + 1u == (gen + 1u) * nloc) {
            __builtin_amdgcn_fence(__ATOMIC_RELEASE, "agent");
            asm volatile("s_waitcnt vmcnt(0)" ::: "memory");
            const unsigned og = xb_add(&bar[XB_TOP], 1u);
            const unsigned tg = og / nx;
            if (og + 1u == (tg + 1u) * nx) xb_add(&bar[XB_TOPGEN], 1u);
            else XB_SPIN(xb_ld(&bar[XB_TOPGEN]) == tg, bar);
            __builtin_amdgcn_fence(__ATOMIC_ACQUIRE, "agent");
            xb_add(&bar[XB_XGEN(b.x)], 1u);
            asm volatile("s_waitcnt vmcnt(0)" ::: "memory");
        } else {
            XB_SPIN(xb_ld(&bar[XB_XGEN(b.x)]) == gen, bar);
            __builtin_amdgcn_fence(__ATOMIC_ACQUIRE, "agent");
            asm volatile("s_waitcnt vmcnt(0)" ::: "memory");
        }
    }
    __syncthreads();
}

struct Args {
    const float* x; const float* c; const float* ada_w; const float* ada_b; const float* norm1_g; const float* norm2_g;
    const float* da_w_in; const float* da_q_gain; const float* da_k_gain; const float* da_lam_q1; const float* da_lam_k1; const float* da_lam_q2; const float* da_lam_k2;
    const float* da_subln_g; const float* da_w_out;
    const float* gla_w_in; const float* gla_w_a1; const float* gla_w_a2; const float* gla_b_a; const float* gla_out_g; const float* gla_w_out;
    const float* ffn_w1; const float* ffn_w3; const float* ffn_w2;
    const float* moe_router; const float* moe_w1; const float* moe_w3; const float* moe_w2;
    float* out; unsigned char* ws; int ph_lo, ph_hi;
};

__device__ __forceinline__ void p0_transpose_item(const float* W, int ldw, int k0, int n0, bf16* WT, int dst_row0, int Kp, LAS float* scr, int lane) {
#pragma unroll 8
    for (int i = 0; i < 32; ++i) { const int kk = 2 * i + (lane >> 5); scr[kk * 33 + (lane & 31)] = W[(size_t)(k0 + kk) * ldw + n0 + (lane & 31)]; }
    asm volatile("s_waitcnt lgkmcnt(0)" ::: "memory");
    const int c = lane & 7;
#pragma unroll
    for (int j = 0; j < 4; ++j) { const int n = (lane >> 3) + 8 * j; const LAS float* s = scr + (8 * c) * 33 + n;
        u32x4 o; o.x = pk2(s[0 * 33], s[1 * 33]); o.y = pk2(s[2 * 33], s[3 * 33]); o.z = pk2(s[4 * 33], s[5 * 33]); o.w = pk2(s[6 * 33], s[7 * 33]);
        *(u32x4*)(WT + (size_t)(dst_row0 + n) * Kp + k0 + 8 * c) = o; }
    asm volatile("s_waitcnt lgkmcnt(0)" ::: "memory");
}

__device__ __forceinline__ void p0_transpose_item8(const float* W, int ldw, int k0, int n0, unsigned char* WT8, int dst_row0, int Kp, LAS float* scr, int lane) {
#pragma unroll 8
    for (int i = 0; i < 32; ++i) { const int kk = 2 * i + (lane >> 5); scr[kk * 33 + (lane & 31)] = W[(size_t)(k0 + kk) * ldw + n0 + (lane & 31)]; }
    asm volatile("s_waitcnt lgkmcnt(0)" ::: "memory");
    const int c = lane & 7;
#pragma unroll
    for (int j = 0; j < 4; ++j) { const int n = (lane >> 3) + 8 * j; const LAS float* sp = scr + (8 * c) * 33 + n;
        const u32x2 o = (u32x2){pk_fp8x4(sp[0 * 33] * W8_SCALE, sp[1 * 33] * W8_SCALE, sp[2 * 33] * W8_SCALE, sp[3 * 33] * W8_SCALE), pk_fp8x4(sp[4 * 33] * W8_SCALE, sp[5 * 33] * W8_SCALE, sp[6 * 33] * W8_SCALE, sp[7 * 33] * W8_SCALE)};
        *(u32x2*)(WT8 + (size_t)(dst_row0 + n) * Kp + k0 + 8 * c) = o; }
    asm volatile("s_waitcnt lgkmcnt(0)" ::: "memory");
}

namespace att {
__device__ __forceinline__ int crow(int r, int hi) { return (r & 3) + 8 * (r >> 2) + 4 * hi; }
__host__ __device__ constexpr int dwin(int h) { return (int)(150.0 / (1.4426950408889634 / (double)(1 << (h + 1)))); }
__host__ __device__ constexpr int tstart(int h, int jq) { const int q0 = 128 * jq, d = dwin(h); return q0 > d ? (q0 - d) / 64 : 0; }
struct Plan { unsigned char n[16]; unsigned char u[16][48]; };
constexpr Plan make_plan() {
    Plan p{}; int load[16] = {};
    for (int w = 0; w < 16; ++w) p.n[w] = 0;
    for (int h = 7; h >= 0; --h) {
        int cost[32] = {}, ord[32] = {};
        for (int j = 0; j < 32; ++j) { cost[j] = 2 * j + 2 - tstart(h, j); ord[j] = j; }
        for (int a = 1; a < 32; ++a) { const int x = ord[a]; int b = a - 1; while (b >= 0 && cost[ord[b]] < cost[x]) { ord[b + 1] = ord[b]; --b; } ord[b + 1] = x; }
        for (int a = 0; a < 32; ++a) { int best = 0; for (int w = 1; w < 16; ++w) if (load[w] < load[best]) best = w;
            p.u[best][p.n[best]++] = (unsigned char)(h * 32 + ord[a]); load[best] += cost[ord[a]]; }
    }
    return p;
}
__device__ const Plan PLAN = make_plan();
constexpr int BUFB = 32768, NBUF = 3, KOFF = 0, VOFF = 16384, WSF_OFF = NBUF * BUFB;
__device__ __forceinline__ s16x4 vtr(const LAS unsigned char* p) { return __builtin_bit_cast(s16x4, __builtin_amdgcn_ds_read_tr16_b64_v4i16((LAS s16x4*)p)); }

__device__ __forceinline__ void attn_unit(LAS unsigned char* lds, const bf16* Q, const bf16* K, const bf16* V, bf16* O, int b, int h, int jq,
                                          float sl2, float mref0, float mref1, float lam, const float* subg) {
    const int tid = threadIdx.x, lane = tid & 63, r32 = lane & 31, hi = lane >> 5; const int wid = __builtin_amdgcn_readfirstlane(tid >> 6);
    const int mp = wid >> 2, w4 = wid & 3;
    const size_t rowbase = (size_t)b * SEQ; const int q0 = jq * 128;
    const int nT = (q0 >> 6) + 2, myc = (q0 + 32 * w4) >> 6, t0 = tstart(h, jq);
    const bf16* Qw = Q + (rowbase + q0 + 32 * w4 + r32) * D + h * 128 + mp * 64 + hi * 8;
    bf16x8 qr[4];
#pragma unroll
    for (int d0 = 0; d0 < 4; ++d0) qr[d0] = *(const bf16x8*)(Qw + d0 * 16);
    const bf16* ksrc = K + ((size_t)(b * 8 + h) * 64 * 16 + wid) * 512 + lane * 8;
    const int p0 = wid, p1 = wid + 8;
    const bf16* vsrc0 = V + ((size_t)(b * 8 + h) * 64 * 16 + p0) * 512 + lane * 8;
    const bf16* vsrc1 = V + ((size_t)(b * 8 + h) * 64 * 16 + p1) * 512 + lane * 8;
#define ATT_DMA1(gp_, la_) asm volatile("s_mov_b32 m0, %0\n\ts_nop 0\n\tglobal_load_lds_dwordx4 %1, off" :: "s"(la_), "v"(gp_) : "memory", "m0")
#define ATT_DMA(t, bs) do { const unsigned bb_ = (unsigned)__builtin_amdgcn_readfirstlane((int)(ldsu + (unsigned)((bs) * BUFB))); \
        ATT_DMA1(ksrc + (size_t)(t) * 8192, bb_ + (unsigned)(KOFF + wid * 1024)); \
        ATT_DMA1(ksrc + (size_t)(t) * 8192 + 4096, bb_ + (unsigned)(KOFF + 8192 + wid * 1024)); \
        ATT_DMA1(vsrc0 + (size_t)(t) * 8192, bb_ + (unsigned)(VOFF + p0 * 1024)); \
        ATT_DMA1(vsrc1 + (size_t)(t) * 8192, bb_ + (unsigned)(VOFF + p1 * 1024)); } while (0)
    const unsigned ldsu = (unsigned)(unsigned long long)lds;
    const float qpos = (float)(q0 + 32 * w4 + r32);
    const float mref = mp ? mref1 : mref0;
    const float baseL = -sl2 * qpos - mref, sl8 = 8.0f * sl2, sl32 = 32.0f * sl2;
    float lsum = 0.f; f32x16 o[4];
#pragma unroll
    for (int d0 = 0; d0 < 4; ++d0)
#pragma unroll
        for (int r = 0; r < 16; ++r) o[d0][r] = 0.f;
    ATT_DMA(t0, 0);
    if (t0 + 1 < nT) ATT_DMA(t0 + 1, 1);
    asm volatile("" :: "v"(qr[0]), "v"(qr[1]), "v"(qr[2]), "v"(qr[3]) : "memory");
    int slot = 0;
    for (int t = t0; t < nT; ++t) {
        if (t + 1 < nT) asm volatile("s_waitcnt vmcnt(4)" ::: "memory"); else asm volatile("s_waitcnt vmcnt(0)" ::: "memory");
        asm volatile("s_waitcnt lgkmcnt(0)" ::: "memory"); __builtin_amdgcn_s_barrier(); asm volatile("" ::: "memory");
        if (t + 2 < nT) { const int s2 = slot >= 1 ? slot - 1 : 2; ATT_DMA(t + 2, s2); }
        if (t <= myc) {
            const LAS unsigned char* bb = lds + slot * BUFB;
            f32x16 c0, c1;
            if (t < myc) {
                const float kb = baseL + sl2 * (float)(64 * t + 4 * hi);
#pragma unroll
                for (int r = 0; r < 16; ++r) { c0[r] = (r == 0) ? kb : ((r & 3) ? c0[r - 1] + sl2 : c0[r - 4] + sl8); c1[r] = c0[r] + sl32; }
            } else {
                const float qk = qpos - (float)(64 * t + 4 * hi);
                float x[16];
#pragma unroll
                for (int r = 0; r < 16; ++r) { x[r] = (r == 0) ? qk : ((r & 3) ? x[r - 1] - 1.0f : x[r - 4] - 8.0f); c0[r] = -sl2 * fabsf(x[r]) - mref; c1[r] = -sl2 * fabsf(x[r] - 32.0f) - mref; }
            }
            const LAS unsigned char* kb_ = bb + KOFF + mp * 8192 + hi * 1024 + r32 * 16;
#define ATT_SB() __builtin_amdgcn_sched_barrier(0)
            bf16x8 kf[8];
#pragma unroll
            for (int d0 = 0; d0 < 4; ++d0) { kf[2 * d0] = *(const LAS bf16x8*)(kb_ + d0 * 2048); kf[2 * d0 + 1] = *(const LAS bf16x8*)(kb_ + d0 * 2048 + 512); }
            const LAS unsigned char* vp = bb + VOFF + ((lane >> 4) & 1) * 32 + (lane & 3) * 8 + (4 * hi + ((lane & 15) >> 2)) * 64;
            s16x4 vlo[16], vhi[16];
#pragma unroll
            for (int ks = 0; ks < 2; ++ks)
#pragma unroll
                for (int d0 = 0; d0 < 4; ++d0) { vlo[d0 * 4 + ks] = vtr(vp + d0 * 4096 + ks * 1024); vhi[d0 * 4 + ks] = vtr(vp + d0 * 4096 + ks * 1024 + 512); }
            ATT_SB();
#pragma unroll
            for (int d0 = 0; d0 < 4; ++d0) c0 = __builtin_amdgcn_mfma_f32_32x32x16_bf16(kf[2 * d0], qr[d0], c0, 0, 0, 0);
            ATT_SB();
            float sacc = 0.f;
#pragma unroll
            for (int d0 = 0; d0 < 4; ++d0) {
                c1 = __builtin_amdgcn_mfma_f32_32x32x16_bf16(kf[2 * d0 + 1], qr[d0], c1, 0, 0, 0);
                ATT_SB();
#pragma unroll
                for (int e = 0; e < 4; ++e) { c0[4 * d0 + e] = __builtin_amdgcn_exp2f(c0[4 * d0 + e]); sacc += c0[4 * d0 + e]; }
                ATT_SB();
            }
            u32x4 pw[4];
#pragma unroll
            for (int g = 0; g < 4; ++g) { pw[0][g] = cvt_pk_bf16(c0[2 * g], c0[2 * g + 1]); pw[1][g] = cvt_pk_bf16(c0[8 + 2 * g], c0[8 + 2 * g + 1]); }
#pragma unroll
            for (int ks = 2; ks < 4; ++ks)
#pragma unroll
                for (int d0 = 0; d0 < 4; ++d0) { vlo[d0 * 4 + ks] = vtr(vp + d0 * 4096 + ks * 1024); vhi[d0 * 4 + ks] = vtr(vp + d0 * 4096 + ks * 1024 + 512); }
            ATT_SB();
#pragma unroll
            for (int j = 0; j < 8; ++j) { const int ks = j >> 2, d0 = j & 3;
                { const s16x4 lo = vlo[d0 * 4 + ks], hh = vhi[d0 * 4 + ks];
                  const bf16x8 vf = (bf16x8){lo[0], lo[1], lo[2], lo[3], hh[0], hh[1], hh[2], hh[3]};
                  o[d0] = __builtin_amdgcn_mfma_f32_32x32x16_bf16(__builtin_bit_cast(bf16x8, pw[ks]), vf, o[d0], 0, 0, 0); }
                ATT_SB();
                c1[2 * j] = __builtin_amdgcn_exp2f(c1[2 * j]); c1[2 * j + 1] = __builtin_amdgcn_exp2f(c1[2 * j + 1]); sacc += c1[2 * j] + c1[2 * j + 1];
                ATT_SB();
            }
            lsum += sacc;
#pragma unroll
            for (int g = 0; g < 4; ++g) { pw[2][g] = cvt_pk_bf16(c1[2 * g], c1[2 * g + 1]); pw[3][g] = cvt_pk_bf16(c1[8 + 2 * g], c1[8 + 2 * g + 1]); }
            ATT_SB();
#pragma unroll
            for (int j = 8; j < 16; ++j) { const int ks = j >> 2, d0 = j & 3;
                const s16x4 lo = vlo[d0 * 4 + ks], hh = vhi[d0 * 4 + ks];
                const bf16x8 vf = (bf16x8){lo[0], lo[1], lo[2], lo[3], hh[0], hh[1], hh[2], hh[3]};
                o[d0] = __builtin_amdgcn_mfma_f32_32x32x16_bf16(__builtin_bit_cast(bf16x8, pw[ks]), vf, o[d0], 0, 0, 0); }
#undef ATT_SB
        }
        slot = slot == 2 ? 0 : slot + 1;
    }
#undef ATT_DMA
#undef ATT_DMA1
    int el; asm volatile("v_mbcnt_lo_u32_b32 %0, -1, 0\n\tv_mbcnt_hi_u32_b32 %0, -1, %0" : "=v"(el));
    const int r32e = el & 31, hie = el >> 5;
    lsum += __shfl_xor(lsum, 32);
    LAS float* wsf = (LAS float*)(lds + WSF_OFF) + wid * 32;
    if (hie == 0) wsf[r32e] = lsum;
    asm volatile("s_waitcnt lgkmcnt(0)" ::: "memory");
    float rl[16];
#pragma unroll
    for (int r = 0; r < 16; ++r) rl[r] = __builtin_amdgcn_rcpf(wsf[crow(r, hie)]);
#pragma unroll
    for (int d0 = 0; d0 < 4; ++d0)
#pragma unroll
        for (int r = 0; r < 16; ++r) o[d0][r] *= rl[r];
    __syncthreads();
    LAS float* X = (LAS float*)lds + w4 * 4096;
    if (mp == 1) {
#pragma unroll
        for (int d0 = 0; d0 < 4; ++d0)
#pragma unroll
            for (int r = 0; r < 16; ++r) X[(d0 * 16 + r) * 64 + el] = o[d0][r];
    }
    __syncthreads();
    if (mp == 0) {
        float ss[16];
#pragma unroll
        for (int r = 0; r < 16; ++r) ss[r] = 0.f;
#pragma unroll
        for (int d0 = 0; d0 < 4; ++d0)
#pragma unroll
            for (int r = 0; r < 16; ++r) { const float dd = o[d0][r] - lam * X[(d0 * 16 + r) * 64 + el]; o[d0][r] = dd; ss[r] += dd * dd; }
#pragma unroll
        for (int r = 0; r < 16; ++r) {
            float s = ss[r];
#pragma unroll
            for (int of = 1; of < 32; of <<= 1) s += __shfl_xor(s, of);
            ss[r] = __builtin_amdgcn_rsqf(s * (1.0f / 128.0f) + EPS) * 0.8f;
        }
        bf16* Ow = O + (rowbase + q0 + 32 * w4) * D + h * 128 + r32e;
#pragma unroll
        for (int d0 = 0; d0 < 4; ++d0) { const float gcol = subg[32 * d0 + r32e];
#pragma unroll
            for (int r = 0; r < 16; ++r) Ow[(size_t)crow(r, hie) * D + 32 * d0] = (bf16)f2bf(o[d0][r] * ss[r] * gcol); }
    }
    __syncthreads();
}
}

__global__ void __launch_bounds__(NWAVES * 64, 2) mk_fwd(Args args) {
    extern __shared__ __attribute__((aligned(16))) unsigned char lds_raw[];
    LAS unsigned char* lds = (LAS unsigned char*)lds_raw;
    volatile LAS unsigned* MISC = (volatile LAS unsigned*)(lds + MISC_OFF);
    const int tid = threadIdx.x, lane = tid & 63, wave = __builtin_amdgcn_readfirstlane(tid >> 6);
    const int G = gridDim.x; const int bx = blockIdx.x;
    const int vcu = (G % 8 == 0) ? (bx % 8) * (G / 8) + bx / 8 : bx;
    unsigned char* ws = args.ws;
    unsigned* ctl = (unsigned*)(ws + WS_CTL);
    float* MOD = (float*)(ws + WS_MOD);
    unsigned* LCNT = (unsigned*)(ws + WS_LCNT);
    int* META = (int*)(ws + WS_META);
    u32x4* ROUTE = (u32x4*)(ws + WS_ROUTE);
    int* TOKSLOT = (int*)(ws + WS_TOKSLOT);
    float* GSLOT = (float*)(ws + WS_GSLOT);
    bf16* W_DAIN = (bf16*)(ws + WS_W_DAIN); bf16* W_DAOUT = (bf16*)(ws + WS_W_DAOUT); bf16* W_FFN13 = (bf16*)(ws + WS_W_FFN13); bf16* W_FFN2 = (bf16*)(ws + WS_W_FFN2);
    bf16* W_GLAIN = (bf16*)(ws + WS_W_GLAIN); bf16* W_GLAOUT = (bf16*)(ws + WS_W_GLAOUT); bf16* W_MOE13 = (bf16*)(ws + WS_W_MOE13); bf16* W_MOE2 = (bf16*)(ws + WS_W_MOE2);
    bf16* HB = (bf16*)(ws + WS_H);
    bf16* QB = (bf16*)(ws + WS_Q);
    bf16* KB = QB + (size_t)M * D; bf16* VB = KB + (size_t)M * D;
    bf16* ACTB = QB;
    bf16* GP = QB;
    bf16* GLAB = QB + (size_t)M * 3072;
    float* out = args.out;
    bf16* XB = (bf16*)(ws + WS_XB);
    float* KPART = (float*)(ws + WS_Q + 320 * MiB);
    static_assert(MOE_DN8 && (size_t)MAXSLOT * EXPD <= 320 * MiB && 320 * MiB + 256 * (size_t)(32 * 512 * 16) <= 464 * MiB, "K-split partials do not fit behind the MoE activations");

    for (int u = tid; u < 256; u += NWAVES * 64) ((LAS unsigned*)(lds + MISC_OFF))[u] = 0u;
    __syncthreads();
    XcdBarrier bar; bar.bar = ctl + CW_BAR; bar.x = 0; bar.st = nullptr;
    if (MK_N_LAUNCHES == 1) bar = xcd_barrier_post(ctl + CW_BAR, MISC + 8);
    const int lo = args.ph_lo, hi = args.ph_hi;
#define IN(k) (lo <= (k) && (k) < hi)
#define SEAM(k) do { if (IN(k) && IN((k) + 1)) xcd_barrier(bar); } while (0)
    const int gw = vcu * NWAVES + wave, NGW = G * NWAVES;

    if (IN(0)) {
        if (bx < 192) {
            LAS float* cact = (LAS float*)lds;
            for (int e = tid; e < 16 * 1024; e += 512) { const int b = e >> 10, k = e & 1023; const float v = args.c[e]; cact[k * 16 + b] = v / (1.0f + __expf(-v)); }
            __syncthreads();
            const int col = tid & 63, ks = tid >> 6, n = bx * 64 + col, layer = n / 6144, nn = n % 6144;
            const float* wp = args.ada_w + (size_t)layer * 1024 * 6144 + nn;
            float a[16];
#pragma unroll
            for (int b = 0; b < 16; ++b) a[b] = 0.f;
            for (int k = ks * 128; k < ks * 128 + 128; ++k) { const float w = wp[(size_t)k * 6144];
#pragma unroll
                for (int q = 0; q < 4; ++q) { const f32x4 cv = *(const LAS f32x4*)(cact + k * 16 + 4 * q); a[4 * q] += cv[0] * w; a[4 * q + 1] += cv[1] * w; a[4 * q + 2] += cv[2] * w; a[4 * q + 3] += cv[3] * w; } }
            LAS float* red = (LAS float*)(lds + 65536);
#pragma unroll
            for (int b = 0; b < 16; ++b) red[(ks * 16 + b) * 64 + col] = a[b];
            __syncthreads();
            for (int e = tid; e < 1024; e += 512) { const int b = e >> 6, cc = e & 63; float s = 0.f;
#pragma unroll
                for (int k8 = 0; k8 < 8; ++k8) s += red[(k8 * 16 + b) * 64 + cc];
                const int n2 = bx * 64 + cc, l2 = n2 / 6144, nn2 = n2 % 6144;
                MOD[((size_t)l2 * 16 + b) * 6144 + nn2] = s + args.ada_b[l2 * 6144 + nn2]; }
            __syncthreads();
        }
        for (int i = bx * 512 + tid; i < 2 * MAXSLOT; i += G * 512) TOKSLOT[i] = -1;
        LAS float* scr = (LAS float*)(lds + wave * 16384);
        constexpr int I_DAIN = 16 * 96, I_SQ = 16 * 32, I_F13 = 16 * 88, I_F2 = 44 * 32, I_GLAIN = 16 * 96, I_GA = 512;
        constexpr int NITEMS = I_DAIN + I_SQ + 2 * I_F13 + I_F2 + I_GLAIN + I_SQ + I_GA;
        for (int it = gw; it < NITEMS; it += NGW) {
            int r = it;
            if (r < I_DAIN) { const int kb = r / 96, nb = r % 96, n0 = 32 * nb, l = n0 & 255;
                p0_transpose_item(args.da_w_in, 3072, 64 * kb, n0, W_DAIN, (n0 & ~255) + 128 * ((l >> 5) & 1) + 32 * (l >> 6), D, scr, lane); continue; } r -= I_DAIN;
            if (r < I_SQ) { const int kb = r / 32, nb = r % 32; p0_transpose_item(args.da_w_out, D, 64 * kb, 32 * nb, W_DAOUT, 32 * nb, D, scr, lane); continue; } r -= I_SQ;
            if (r < 2 * I_F13) { const int w = r / I_F13, q = r % I_F13, kb = q / 88, nb = q % 88, n0 = 32 * nb;
                if (FFN_UP8) p0_transpose_item8(w ? args.ffn_w3 : args.ffn_w1, FFN, 64 * kb, n0, (unsigned char*)W_FFN13, (n0 >> 7) * 256 + w * 128 + (n0 & 127), D, scr, lane);
                else p0_transpose_item(w ? args.ffn_w3 : args.ffn_w1, FFN, 64 * kb, n0, W_FFN13, (n0 >> 7) * 256 + w * 128 + (n0 & 127), D, scr, lane); continue; } r -= 2 * I_F13;
            if (r < I_F2) { const int kb = r / 32, nb = r % 32; if (FFN_DN8) p0_transpose_item8(args.ffn_w2, D, 64 * kb, 32 * nb, (unsigned char*)W_FFN2, 32 * nb, FFN, scr, lane); else p0_transpose_item(args.ffn_w2, D, 64 * kb, 32 * nb, W_FFN2, 32 * nb, FFN, scr, lane); continue; } r -= I_F2;
            if (r < I_GLAIN) { const int kb = r / 96, nb = r % 96; p0_transpose_item(args.gla_w_in, 3072, 64 * kb, 32 * nb, W_GLAIN, 32 * nb, D, scr, lane); continue; } r -= I_GLAIN;
            if (r < I_SQ) { const int kb = r / 32, nb = r % 32; p0_transpose_item(args.gla_w_out, D, 64 * kb, 32 * nb, W_GLAOUT, 32 * nb, D, scr, lane); continue; } r -= I_SQ;
            if (r < I_GA) {
                const int j = r; float a2[16];
#pragma unroll
                for (int q = 0; q < 16; ++q) a2[q] = args.gla_w_a2[q * 512 + j];
                bf16* dst = W_GLAIN + (size_t)(3072 + j) * D + lane * 16;
                unsigned pk[8];
#pragma unroll
                for (int kk = 0; kk < 16; kk += 2) { float s0 = 0.f, s1 = 0.f; const float* w1p = args.gla_w_a1 + (size_t)(lane * 16 + kk) * 16;
#pragma unroll
                    for (int q = 0; q < 16; ++q) { s0 += w1p[q] * a2[q]; s1 += w1p[16 + q] * a2[q]; }
                    pk[kk >> 1] = pk2(s0, s1); }
                *(u32x4*)dst = (u32x4){pk[0], pk[1], pk[2], pk[3]}; *(u32x4*)(dst + 8) = (u32x4){pk[4], pk[5], pk[6], pk[7]};
                continue; }
        }
    }
    SEAM(0);

#define NORM_LOAD(XSRC, SRC16, m_, v_, s_) do { s_ = 0.f; \
            _Pragma("unroll") for (int j = 0; j < 4; ++j) { v_[j] = (SRC16) ? ld_bf16x4((const bf16*)(XSRC) + (size_t)(m_) * D + 4 * lane + 256 * j) : *((const f32x4*)((const float*)(XSRC) + (size_t)(m_) * D) + lane + 64 * j); s_ += (v_[j][0] * v_[j][0] + v_[j][1] * v_[j][1]) + (v_[j][2] * v_[j][2] + v_[j][3] * v_[j][3]); } } while (0)
#define NORM_ROW(GVEC, MODROW, ROUTER, OUT8, m_, v_, s_) do { const int m = (m_); const int b = m >> 12; f32x4 (&v)[4] = v_; \
            const float* mrow = (MODROW) + (size_t)b * 6144; \
            const float rstd = __builtin_amdgcn_rsqf(wave_sum(s_) * (1.0f / D) + EPS); \
            _Pragma("unroll") for (int j = 0; j < 4; ++j) { const f32x4 gg = *((const f32x4*)(GVEC) + lane + 64 * j), sh = *((const f32x4*)mrow + lane + 64 * j), sc = *((const f32x4*)(mrow + 1024) + lane + 64 * j); \
                v[j] = v[j] * rstd * gg * (sc + 1.0f) + sh; } \
            if (OUT8) { unsigned* o4 = (unsigned*)((unsigned char*)HB + (size_t)m * D) + lane; \
                _Pragma("unroll") for (int j = 0; j < 4; ++j) o4[64 * j] = pk_fp8x4(v[j][0] * H8_SCALE, v[j][1] * H8_SCALE, v[j][2] * H8_SCALE, v[j][3] * H8_SCALE); } \
            else { u32x2* o8 = (u32x2*)(HB + (size_t)m * D) + lane; \
                _Pragma("unroll") for (int j = 0; j < 4; ++j) o8[64 * j] = (u32x2){pk2(v[j][0], v[j][1]), pk2(v[j][2], v[j][3])}; } \
            if (ROUTER) { ROUTER_BODY } } while (0)
#define NORM_PHASE(XSRC, SRC16, GVEC, MODROW, ROUTER, OUT8) do { \
        const int rpw = (M + NGW - 1) / NGW; const int r_lo = (ROUTER ? (bx * NWAVES + wave) : gw) * rpw; \
        for (int rr = 0; rr < rpw; rr += 2) { const int m0 = r_lo + rr; if (m0 >= M) break; const bool two = (rr + 1 < rpw) && (m0 + 1 < M); \
            f32x4 va[4], vb[4]; float sa, sb = 0.f; \
            NORM_LOAD(XSRC, SRC16, m0, va, sa); if (two) NORM_LOAD(XSRC, SRC16, m0 + 1, vb, sb); \
            NORM_ROW(GVEC, MODROW, ROUTER, OUT8, m0, va, sa); if (two) NORM_ROW(GVEC, MODROW, ROUTER, OUT8, m0 + 1, vb, sb); } } while (0)
#define ROUTER_BODY
    if (IN(1)) { NORM_PHASE(args.x, false, args.norm1_g, MOD, 0, false); }
    SEAM(1);

    if (IN(2)) {
        pg8::DenseSched S; S.init(M / 256, 12, G, bx); S.A = (const char*)HB; S.Bt = (const char*)W_DAIN; S.tstep = (size_t)256 * D * 2;
        pg8::EpiQKV E{QB, (size_t)M * D, args.da_q_gain, args.da_k_gain, 0.125f * LOG2E};
        pg8::gemm_phase<pg8::EpiQKV, pg8::DenseSched, true, false>(lds, 2 * D, S, E);
    }
    SEAM(2);

    if (IN(3)) {
        float a1 = args.da_lam_q1[lane] * args.da_lam_k1[lane], a2 = args.da_lam_q2[lane] * args.da_lam_k2[lane];
        const float lam = __expf(wave_sum(a1)) - __expf(wave_sum(a2)) + 0.2f;
        const float gq0 = wave_max(fabsf(args.da_q_gain[lane])), gq1 = wave_max(fabsf(args.da_q_gain[64 + lane]));
        const float gk0 = wave_max(fabsf(args.da_k_gain[lane])), gk1 = wave_max(fabsf(args.da_k_gain[64 + lane]));
        const float mref0 = 8.0f * LOG2E * gq0 * gk0 * 1.01f, mref1 = 8.0f * LOG2E * gq1 * gk1 * 1.01f;
        for (int rep = 0; rep < (PROBE_DUP == 3 ? 2 : 1); ++rep)
        for (int bb = vcu >> 4; bb < BATCH; bb += (G >= 16 ? (G >> 4) : 1)) {
            const int w16 = vcu & 15, nu = att::PLAN.n[w16];
            for (int i = 0; i < nu; ++i) { const int hj = att::PLAN.u[w16][i], h = hj >> 5, jq = hj & 31;
                const float sl2 = LOG2E * exp2f(-(float)(h + 1));
                att::attn_unit(lds, QB, KB, VB, HB, bb, h, jq, sl2, mref0, mref1, lam, args.da_subln_g); }
        }
    }
    SEAM(3);

    if (IN(4)) {
        pg8::DenseSched S; S.init(M / 256, 4, G, bx); S.A = (const char*)HB; S.Bt = (const char*)W_DAOUT; S.tstep = (size_t)256 * D * 2;
        pg8::EpiResid<false, true> E{args.x, XB, MOD + 2048, 1.0f};
        pg8::gemm_phase<pg8::EpiResid<false, true>, pg8::DenseSched, true, false>(lds, 2 * D, S, E);
    }
    SEAM(4);
    if (IN(5)) { NORM_PHASE(XB, true, args.norm2_g, MOD + 3072, 0, FFN_UP8); }
    SEAM(5);

    if (IN(6)) {
        pg8::DenseSched S; S.init(M / 256, 2 * FFN / 256, G, bx); S.A = (const char*)HB; S.Bt = (const char*)W_FFN13; S.tstep = (size_t)256 * D * (FFN_UP8 ? 1 : 2);
        pg8::EpiSwiGLU<FFN_DN8> E{ACTB, FFN, FFN_UP8 ? 1.0f / (H8_SCALE * W8_SCALE) : 1.0f};
        pg8::gemm_phase<pg8::EpiSwiGLU<FFN_DN8>, pg8::DenseSched, true, false, FFN_UP8>(lds, D * (FFN_UP8 ? 1 : 2), S, E);
    }
    SEAM(6);
    if (IN(7)) {
        pg8::DenseSched S; S.init(M / 256, 4, G, bx); S.A = (const char*)ACTB; S.Bt = (const char*)W_FFN2; S.tstep = (size_t)256 * FFN * (FFN_DN8 ? 1 : 2);
        pg8::EpiResid<true, true> E{XB, XB, MOD + 5 * 1024, FFN_DN8 ? 1.0f / (A8_SCALE * W8_SCALE) : 1.0f};
        pg8::gemm_phase<pg8::EpiResid<true, true>, pg8::DenseSched, true, false, FFN_DN8>(lds, FFN * (FFN_DN8 ? 1 : 2), S, E);
    }
    SEAM(7);

    float* MOD1 = MOD + 16 * 6144;
    if (IN(8)) { NORM_PHASE(XB, true, args.norm1_g + D, MOD1, 0, false); }
    SEAM(8);
    if (IN(9)) {
        pg8::DenseSched S; S.init(M / 256, GLA_N / 256, G, bx); S.A = (const char*)HB; S.Bt = (const char*)W_GLAIN; S.tstep = (size_t)256 * D * 2;
        pg8::EpiGLA E{GP, GLAB, args.gla_b_a, args.gla_out_g};
        pg8::gemm_phase<pg8::EpiGLA, pg8::DenseSched, true, false>(lds, 2 * D, S, E);
    }
    SEAM(9);

    unsigned char* GA = (unsigned char*)out;
    static_assert(4096 * GA_UNIT <= 192 * MiB && 256 * MiB <= (size_t)M * D * 4 && (size_t)M * 512 * 2 >= 64 * MiB, "o-fragment parking");
#define OFRAG(b_, n_, h_) (((b_) < 8 ? (unsigned char*)GLAB : (unsigned char*)out + 192 * MiB) + (size_t)(((((b_) & 7) * 64 + (n_)) * 4) + (h_)) * 32768)
    if (IN(10)) {
        LAS unsigned char* QDp = lds; LAS unsigned char* KDTc = lds + 16384; LAS unsigned char* ATc = lds + 32768; LAS float* DV = (LAS float*)(lds + 40960);
        LAS bf16* KI = (LAS bf16*)(lds + 43008); LAS float* QT = (LAS float*)(lds + 60416);
        const int fr = lane & 15, fq = lane >> 4;
        const int j = tid & 127, tq = tid >> 7;
        const int cq = j >> 4, wq = j & 15, hq = (wq >> 2) & 1, jq2 = ((wq >> 3) << 2) | (wq & 3);
        for (int rep = 0; rep < (PROBE_DUP == 10 ? 2 : 1); ++rep)
        for (int u = bx; u < 4096; u += G) {
            const int h = u & 3, n = (u >> 2) & 63, b = u >> 8;
            const size_t R0 = (size_t)b * SEQ + 64 * n;
            float la[16], qv[16], kv[16];
#pragma unroll
            for (int i = 0; i < 16; ++i) { const size_t row = R0 + 16 * tq + i; la[i] = bf2f(GLAB[row * 512 + h * 128 + j]); qv[i] = bf2f(GP[row * 3072 + h * 128 + j]); kv[i] = bf2f(GP[row * 3072 + 512 + h * 128 + j]); }
#pragma unroll
            for (int i = 1; i < 16; ++i) la[i] += la[i - 1];
            QT[tq * 128 + j] = la[15];
            __syncthreads();
            float pre = 0.f, tot = 0.f;
#pragma unroll
            for (int q = 0; q < 4; ++q) { const float v = QT[q * 128 + j]; tot += v; pre += (q < tq) ? v : 0.f; }
            unsigned kdp[8];
#pragma unroll
            for (int i = 0; i < 16; ++i) { const float bb = pre + la[i]; const int t = 16 * tq + i;
                *(LAS bf16*)(QDp + (((cq * 2 + hq) * 64 + t) * 16) + jq2 * 2) = (bf16)f2bf(qv[i] * 0.08838834764831845f * __expf(bb));
                KI[t * 136 + j] = (bf16)f2bf(kv[i] * __expf(-bb));
                const float kd = kv[i] * __expf(tot - bb);
                if (i & 1) kdp[i >> 1] |= f2bf(kd) << 16; else kdp[i >> 1] = f2bf(kd); }
            *(LAS u32x4*)(KDTc + ((2 * tq) * 128 + j) * 16) = (u32x4){kdp[0], kdp[1], kdp[2], kdp[3]};
            *(LAS u32x4*)(KDTc + ((2 * tq + 1) * 128 + j) * 16) = (u32x4){kdp[4], kdp[5], kdp[6], kdp[7]};
            if (tq == 0) DV[j] = __expf(tot);
            __syncthreads();
#pragma unroll
            for (int q = 0; q < 2; ++q) { const int idx = 2 * wave + q, ti = idx >> 2, si = idx & 3;
                f32x4 c = (f32x4){0.f, 0.f, 0.f, 0.f};
                if (si <= ti) {
#pragma unroll
                    for (int ks = 0; ks < 4; ++ks) { const int cc = 2 * ks + (fq >> 1), jb = 4 * (fq & 1), t = 16 * ti + fr;
                        const u32x2 alo = *(const LAS u32x2*)(QDp + (((cc * 2 + 0) * 64 + t) * 16) + jb * 2), ahi = *(const LAS u32x2*)(QDp + (((cc * 2 + 1) * 64 + t) * 16) + jb * 2);
                        const u32x4 af = (u32x4){alo[0], alo[1], ahi[0], ahi[1]};
                        const bf16x8 bfr = *(const LAS bf16x8*)(KI + (16 * si + fr) * 136 + 32 * ks + 8 * fq);
                        c = __builtin_amdgcn_mfma_f32_16x16x32_bf16(__builtin_bit_cast(bf16x8, af), bfr, c, 0, 0, 0); }
                }
#pragma unroll
                for (int r = 0; r < 4; ++r) { const int t = 16 * ti + 4 * fq + r, sx = 16 * si + fr; *(LAS bf16*)(ATc + (((sx >> 3) * 64 + t) * 16) + (sx & 7) * 2) = (bf16)f2bf(sx <= t ? c[r] : 0.f); } }
            __syncthreads();
            { u32x4* dst = (u32x4*)(GA + (size_t)u * GA_UNIT);
              for (int v = tid; v < 41472 / 16; v += 512) dst[v] = *(const LAS u32x4*)(lds + v * 16); }
            __syncthreads();
        }
    }
    SEAM(10);

    const int sstride = G >= 256 ? 4 : (G >= 128 ? 2 : 1);
    const bool is_scan = (vcu % sstride == 0) && (vcu / sstride < 64);
    const int scan_id = vcu / sstride;
    const int copy_id = vcu < 64 * sstride ? (vcu / sstride) * (sstride - 1) + (vcu % sstride) - 1 : 64 * (sstride - 1) + (vcu - 64 * sstride);
    if (IN(11) && !is_scan) {
        LAS float* scr = (LAS float*)(lds + wave * 16384);
        constexpr int I_M13 = 16 * 112, I_M2 = 56 * 32, NIT = NEXP * 2 * I_M13 + NEXP * I_M2;
        const int nwv = (G - 64) * NWAVES;
        for (int rep = 0; rep < (PROBE_DUP == 20 ? 2 : 1); ++rep)
        for (int it = copy_id * NWAVES + wave; it < NIT; it += nwv) {
            int r = it;
            if (r < NEXP * 2 * I_M13) { const int e = r / (2 * I_M13), q2 = r % (2 * I_M13), w = q2 / I_M13, q = q2 % I_M13, kb = q / 112, nb = q % 112, n0 = 32 * nb;
                if (MOE_UP8) p0_transpose_item8((w ? args.moe_w3 : args.moe_w1) + (size_t)e * D * EXPD, EXPD, 64 * kb, n0, (unsigned char*)W_MOE13 + (size_t)e * 2 * EXPD * D, (n0 >> 7) * 256 + w * 128 + (n0 & 127), D, scr, lane);
                else p0_transpose_item((w ? args.moe_w3 : args.moe_w1) + (size_t)e * D * EXPD, EXPD, 64 * kb, n0, W_MOE13 + (size_t)e * 2 * EXPD * D, (n0 >> 7) * 256 + w * 128 + (n0 & 127), D, scr, lane); continue; }
            r -= NEXP * 2 * I_M13;
            { const int e = r / I_M2, q = r % I_M2, kb = q / 32, nb = q % 32;
                if (MOE_DN8) p0_transpose_item8(args.moe_w2 + (size_t)e * EXPD * D, D, 64 * kb, 32 * nb, (unsigned char*)W_MOE2 + (size_t)e * D * EXPD, 32 * nb, EXPD, scr, lane);
                else p0_transpose_item(args.moe_w2 + (size_t)e * EXPD * D, D, 64 * kb, 32 * nb, W_MOE2 + (size_t)e * D * EXPD, 32 * nb, EXPD, scr, lane); }
        }
    }
    if (IN(11) && is_scan) {
        const int b = scan_id >> 2, h = scan_id & 3;
        constexpr int BUFB = 74752, VOFF = 41984, GO_OFF = 2 * BUFB;
        LAS float* GO = (LAS float*)(lds + GO_OFF);
        if (tid < 256) GO[tid] = args.gla_out_g[tid];
        const int r32 = lane & 31, hh = lane >> 5;
        const int c0 = 32 * wave;
        const unsigned char* gabase = GA + ((size_t)b * 256 + h) * GA_UNIT;
        const bf16* vsrc = GP + ((size_t)b * SEQ + (lane >> 2)) * 3072 + 1024 + h * 256 + 32 * wave + (lane & 3) * 8;
#define GLA_DMA(n_, bs_) do { LAS unsigned char* bb_ = lds + (bs_) * BUFB; const unsigned char* ga_ = gabase + (size_t)(n_) * 4 * GA_UNIT; \
        _Pragma("unroll") for (int k_ = 0; k_ < 6; ++k_) { int p_ = wave + 8 * k_; p_ = p_ > 40 ? 40 : p_; \
            __builtin_amdgcn_global_load_lds((const unsigned*)(ga_ + p_ * 1024 + lane * 16), (LAS unsigned*)(bb_ + p_ * 1024), 16, 0, 0); } \
        _Pragma("unroll") for (int ks_ = 0; ks_ < 4; ++ks_) \
            __builtin_amdgcn_global_load_lds((const unsigned*)(vsrc + ((size_t)(n_) * 64 + 16 * ks_) * 3072), (LAS unsigned*)(bb_ + VOFF + (ks_ * 8 + wave) * 1024), 16, 0, 0); } while (0)
#define GLA_BAR() do { asm volatile("s_waitcnt lgkmcnt(0)" ::: "memory"); __builtin_amdgcn_s_barrier(); asm volatile("" ::: "memory"); } while (0)
        for (int rep = 0; rep < (PROBE_DUP == 11 ? 2 : 1); ++rep) {
        f32x16 Sacc[4];
#pragma unroll
        for (int kt = 0; kt < 4; ++kt)
#pragma unroll
            for (int r = 0; r < 16; ++r) Sacc[kt][r] = 0.f;
        GLA_DMA(0, 0);
        asm volatile("s_waitcnt vmcnt(0)" ::: "memory");
        for (int n = 0; n < 64; ++n) {
            const size_t R0 = (size_t)b * SEQ + 64 * n;
            asm volatile("s_waitcnt vmcnt(4)" ::: "memory");
            GLA_BAR();
            if (n + 1 < 64) GLA_DMA(n + 1, (n + 1) & 1);
            LAS unsigned char* bb = lds + (n & 1) * BUFB;
            const LAS unsigned char* QDp = bb; const LAS unsigned char* KDTc = bb + 16384; const LAS unsigned char* ATc = bb + 32768; const LAS float* DV = (const LAS float*)(bb + 40960);
            bf16x8 vf[4];
#pragma unroll
            for (int ks = 0; ks < 4; ++ks) { const LAS unsigned char* vp = bb + VOFF + (ks * 8 + wave) * 1024 + ((lane >> 4) & 1) * 32 + (lane & 3) * 8 + (8 * hh + ((lane & 15) >> 2)) * 64;
                const s16x4 lo = att::vtr(vp), hi4 = att::vtr(vp + 256); vf[ks] = (bf16x8){lo[0], lo[1], lo[2], lo[3], hi4[0], hi4[1], hi4[2], hi4[3]}; }
            f32x16 o[2];
#pragma unroll
            for (int tt = 0; tt < 2; ++tt)
#pragma unroll
                for (int r = 0; r < 16; ++r) o[tt][r] = 0.f;
            bf16x8 qa[16], aa[6];
#pragma unroll
            for (int kt = 0; kt < 4; ++kt)
#pragma unroll
                for (int sx = 0; sx < 2; ++sx)
#pragma unroll
                    for (int tt = 0; tt < 2; ++tt) qa[(kt * 2 + sx) * 2 + tt] = *(const LAS bf16x8*)(QDp + ((((kt * 2 + sx) * 2 + hh) * 64 + 32 * tt + r32) * 16));
#pragma unroll
            for (int i = 0; i < 6; ++i) { const int tt = i < 2 ? 0 : 1, ks = i < 2 ? i : i - 2;
                aa[i] = *(const LAS bf16x8*)(ATc + (((2 * ks + hh) * 64 + 32 * tt + r32) * 16)); }
            __builtin_amdgcn_sched_barrier(0);
#pragma unroll
            for (int kt = 0; kt < 4; ++kt)
#pragma unroll
                for (int sx = 0; sx < 2; ++sx) {
                    u32x4 sb;
#pragma unroll
                    for (int g = 0; g < 4; ++g) sb[g] = cvt_pk_bf16(Sacc[kt][8 * sx + 2 * g], Sacc[kt][8 * sx + 2 * g + 1]);
#pragma unroll
                    for (int tt = 0; tt < 2; ++tt) o[tt] = __builtin_amdgcn_mfma_f32_32x32x16_bf16(qa[(kt * 2 + sx) * 2 + tt], __builtin_bit_cast(bf16x8, sb), o[tt], 0, 0, 0);
                }
#pragma unroll
            for (int i = 0; i < 6; ++i) { const int tt = i < 2 ? 0 : 1, ks = i < 2 ? i : i - 2;
                o[tt] = __builtin_amdgcn_mfma_f32_32x32x16_bf16(aa[i], vf[ks], o[tt], 0, 0, 0); }
            __builtin_amdgcn_sched_barrier(0);
            { u32x4* dst = (u32x4*)(OFRAG(b, n, h)) + (wave * 4) * 64 + lane;
#pragma unroll
              for (int tt = 0; tt < 2; ++tt)
#pragma unroll
                  for (int q = 0; q < 2; ++q) { u32x4 w;
#pragma unroll
                      for (int g = 0; g < 4; ++g) w[g] = cvt_pk_bf16(o[tt][8 * q + 2 * g], o[tt][8 * q + 2 * g + 1]);
                      dst[(tt * 2 + q) * 64] = w; } }
            __builtin_amdgcn_sched_barrier(0);
            f32x4 dvv[16]; bf16x8 ka[16];
#pragma unroll
            for (int kt = 0; kt < 4; ++kt)
#pragma unroll
                for (int g = 0; g < 4; ++g) dvv[kt * 4 + g] = *(const LAS f32x4*)(DV + 32 * kt + 8 * g + 4 * hh);
#pragma unroll
            for (int ks = 0; ks < 4; ++ks)
#pragma unroll
                for (int kt = 0; kt < 4; ++kt) ka[ks * 4 + kt] = *(const LAS bf16x8*)(KDTc + (((2 * ks + hh) * 128 + 32 * kt + r32) * 16));
            __builtin_amdgcn_sched_barrier(0);
#pragma unroll
            for (int kt = 0; kt < 4; ++kt)
#pragma unroll
                for (int g = 0; g < 4; ++g)
#pragma unroll
                    for (int e = 0; e < 4; ++e) Sacc[kt][4 * g + e] *= dvv[kt * 4 + g][e];
#pragma unroll
            for (int ks = 0; ks < 4; ++ks)
#pragma unroll
                for (int kt = 0; kt < 4; ++kt) Sacc[kt] = __builtin_amdgcn_mfma_f32_32x32x16_bf16(ka[ks * 4 + kt], vf[ks], Sacc[kt], 0, 0, 0);
        }
        asm volatile("s_waitcnt vmcnt(0)" ::: "memory");
        GLA_BAR();
        }
#undef GLA_DMA
#undef GLA_BAR
    }
    if (IN(11)) {
        static_assert(MK_N_LAUNCHES == 1, "the scan follow-up sits behind an in-phase grid barrier");
        xcd_barrier(bar);
        LAS float* OS = (LAS float*)lds;
        const int r32 = lane & 31, hh = lane >> 5, c0 = 32 * wave;
        u32x4 fr[4], rwv[4];
#define P10C_LOAD(u_) do { const int b_ = (u_) >> 8, n_ = ((u_) >> 2) & 63, h_ = (u_) & 3; const u32x4* src_ = (const u32x4*)(OFRAG(b_, n_, h_)) + (wave * 4) * 64 + lane; \
            _Pragma("unroll") for (int k_ = 0; k_ < 4; ++k_) fr[k_] = src_[k_ * 64]; \
            const bf16* rp0_ = GP + ((size_t)b_ * SEQ + 64 * n_ + (tid >> 3)) * 3072 + 2048 + h_ * 256 + 32 * (tid & 7); \
            _Pragma("unroll") for (int i_ = 0; i_ < 4; ++i_) rwv[i_] = *(const u32x4*)(rp0_ + 8 * i_); } while (0)
        int u = bx;
        if (u < 4096) P10C_LOAD(u);
        for (; u < 4096; u += G) {
            const int b = u >> 8, n = (u >> 2) & 63, h = u & 3; const size_t R0 = (size_t)b * SEQ + 64 * n;
            u32x4 rw_c[4];
#pragma unroll
            for (int i = 0; i < 4; ++i) rw_c[i] = rwv[i];
            __syncthreads();
#pragma unroll
            for (int tt = 0; tt < 2; ++tt)
#pragma unroll
                for (int q = 0; q < 2; ++q)
#pragma unroll
                    for (int g = 0; g < 4; ++g) { const unsigned w = fr[tt * 2 + q][g]; const int r = 8 * q + 2 * g;
                        OS[(32 * tt + att::crow(r, hh)) * 260 + c0 + r32] = __builtin_bit_cast(float, w << 16);
                        OS[(32 * tt + att::crow(r + 1, hh)) * 260 + c0 + r32] = __builtin_bit_cast(float, w & 0xffff0000u); }
            __syncthreads();
            if (u + G < 4096) P10C_LOAD(u + G);
            { const int t = tid >> 3, seg = tid & 7; f32x4 ov[8]; float ss = 0.f;
#pragma unroll
              for (int i = 0; i < 8; ++i) { ov[i] = *(const LAS f32x4*)(OS + t * 260 + 32 * seg + 4 * i); ss += (ov[i][0] * ov[i][0] + ov[i][1] * ov[i][1]) + (ov[i][2] * ov[i][2] + ov[i][3] * ov[i][3]); }
              ss += __shfl_xor(ss, 1); ss += __shfl_xor(ss, 2); ss += __shfl_xor(ss, 4);
              const float rs = __builtin_amdgcn_rsqf(ss * (1.0f / 256.0f) + EPS);
              bf16* op = HB + (R0 + t) * D + h * 256 + 32 * seg;
#pragma unroll
              for (int i = 0; i < 4; ++i) { const u32x4 rw = rw_c[i]; u32x4 w;
#pragma unroll
                  for (int e = 0; e < 4; ++e) { const float r0 = __builtin_bit_cast(float, rw[e] << 16), r1 = __builtin_bit_cast(float, rw[e] & 0xffff0000u);
                      const int cidx = 8 * i + 2 * e;
                      const float v0 = ov[(cidx) >> 2][(cidx) & 3] * rs * r0, v1 = ov[(cidx + 1) >> 2][(cidx + 1) & 3] * rs * r1;
                      w[e] = pk2(v0, v1); }
                  *(u32x4*)(op + 8 * i) = w; } }
        }
#undef P10C_LOAD
    }
    SEAM(11);


    if (IN(12)) {
        pg8::DenseSched S; S.init(M / 256, 4, G, bx); S.A = (const char*)HB; S.Bt = (const char*)W_GLAOUT; S.tstep = (size_t)256 * D * 2;
        pg8::EpiResid<true, true> E{XB, XB, MOD1 + 2048, 1.0f};
        pg8::gemm_phase<pg8::EpiResid<true, true>, pg8::DenseSched, true, false>(lds, 2 * D, S, E);
    }
    SEAM(12);

    if (IN(13)) {
        LAS float* RW = (LAS float*)lds;
        LAS unsigned* EL = (LAS unsigned*)(lds + 32768);
        LAS float* GL = (LAS float*)(lds + 32768 + 4096);
        for (int e = tid; e < 8192; e += 512) { const int k = e >> 3, ex = e & 7;
            RW[((((k >> 8) * 4 + (k & 3)) * 2 + (ex >> 2)) * 64 + ((k & 255) >> 2)) * 4 + (ex & 3)] = args.moe_router[e]; }
        __syncthreads();
#undef ROUTER_BODY
#define ROUTER_BODY { float lg[8]; \
            _Pragma("unroll") for (int e = 0; e < 8; ++e) lg[e] = 0.f; \
            _Pragma("unroll") for (int j = 0; j < 4; ++j) _Pragma("unroll") for (int i = 0; i < 4; ++i) { const f32x4 w0 = *((const LAS f32x4*)RW + ((j * 4 + i) * 2) * 64 + lane), w1 = *((const LAS f32x4*)RW + ((j * 4 + i) * 2 + 1) * 64 + lane); const float hv = v[j][i]; \
                lg[0] += hv * w0[0]; lg[1] += hv * w0[1]; lg[2] += hv * w0[2]; lg[3] += hv * w0[3]; lg[4] += hv * w1[0]; lg[5] += hv * w1[1]; lg[6] += hv * w1[2]; lg[7] += hv * w1[3]; } \
            _Pragma("unroll") for (int e = 0; e < 8; ++e) lg[e] = wave_sum(lg[e]); \
            float v1 = lg[0]; \
            _Pragma("unroll") for (int e = 1; e < 8; ++e) v1 = fmaxf(v1, lg[e]); \
            int e1 = 7; \
            _Pragma("unroll") for (int e = 6; e >= 0; --e) e1 = (lg[e] == v1) ? e : e1; \
            float v2 = -3.0e38f; \
            _Pragma("unroll") for (int e = 0; e < 8; ++e) v2 = fmaxf(v2, (e == e1) ? -3.0e38f : lg[e]); \
            int e2 = -1; \
            _Pragma("unroll") for (int e = 7; e >= 0; --e) e2 = (e != e1 && lg[e] == v2) ? e : e2; \
            if (lane == 0) { EL[m - wg_row0] = (unsigned)e1 | ((unsigned)e2 << 8); GL[m - wg_row0] = v1 - v2; } }
        const int rpw12 = (M + NGW - 1) / NGW, rows_wg12 = rpw12 * NWAVES, wg_row0 = bx * rows_wg12;
        NORM_PHASE(XB, true, args.norm2_g + D, MOD1 + 3072, 1, MOE_UP8);
        __syncthreads();
        {
            int nrows = M - wg_row0; nrows = nrows > rows_wg12 ? rows_wg12 : nrows;
            for (int r = tid; r < nrows; r += 512) { const unsigned ew = EL[r]; const unsigned e1 = ew & 255u, e2 = ew >> 8; unsigned l1 = 0, l2 = 0;
                for (int q = 0; q < r; ++q) { const unsigned w = EL[q]; l1 += ((w & 255u) == e1) ? 1u : 0u; l2 += ((w >> 8) == e2) ? 1u : 0u; }
                ROUTE[wg_row0 + r] = (u32x4){ew, __builtin_bit_cast(unsigned, GL[r]), l1, l2}; }
            if (tid < 16) { const unsigned e = tid & 7; unsigned cnt = 0; for (int q = 0; q < nrows; ++q) { const unsigned w = EL[q]; cnt += ((tid < 8 ? (w & 255u) : (w >> 8)) == e) ? 1u : 0u; } LCNT[bx * 16 + tid] = cnt; }
        }
    }
    SEAM(13);

    if (IN(14)) {
        LAS int* PRE = (LAS int*)lds;
        LAS int* GOFF = (LAS int*)(lds + 256);
        if (tid < 16) { int pre = 0, tot = 0; for (int w = 0; w < G; ++w) { const int v = (int)LCNT[w * 16 + tid]; tot += v; pre += (w < bx) ? v : 0; } PRE[tid] = pre; ((LAS int*)(lds + 512))[tid] = (tot + 255) & ~255; }
        __syncthreads();
        if (tid < 2) { int acc = 0; for (int e = 0; e < 8; ++e) { GOFF[tid * 9 + e] = acc; acc += ((LAS int*)(lds + 512))[tid * 8 + e]; } GOFF[tid * 9 + 8] = acc;
            if (bx == 0) { for (int e = 0; e < 9; ++e) META[tid * 16 + e] = GOFF[tid * 9 + e]; } }
        __syncthreads();
        const int rpw = (M + NGW - 1) / NGW, rows_wg = rpw * NWAVES;
        for (int r = tid; r < rows_wg; r += 512) { const int m = bx * rows_wg + r; if (m >= M) break;
            const u32x4 rt = ROUTE[m]; const int e1 = rt[0] & 255, e2 = (rt[0] >> 8) & 255; const unsigned gbits = rt[1]; const float gap = __builtin_bit_cast(float, gbits); const float g1 = 1.0f / (1.0f + expf(-gap));
            const int s1 = GOFF[e1] + PRE[e1] + (int)rt[2], s2 = GOFF[9 + e2] + PRE[8 + e2] + (int)rt[3];
            TOKSLOT[s1] = m; GSLOT[s1] = g1; TOKSLOT[MAXSLOT + s2] = m; GSLOT[MAXSLOT + s2] = 1.0f - g1; }
    }
    SEAM(14);

#define MOE_SCHED(S, p) do { const int* mt = META + (p) * 16; S.g1 = mt[1]; S.g2 = mt[2]; S.g3 = mt[3]; S.g4 = mt[4]; S.g5 = mt[5]; S.g6 = mt[6]; S.g7 = mt[7]; } while (0)
#pragma unroll
    for (int p = 0; p < 2; ++p) {
        if (IN(15 + 2 * p)) {
            pg8::MoeSched S; MOE_SCHED(S, p); const int nP = META[p * 16 + 8] >> 8;
            S.init(nP, 2 * EXPD / 256, G, bx); S.A = (const char*)HB; S.a_tstep = 0; S.Bt = (const char*)W_MOE13; S.b_tstep = (size_t)256 * D * (MOE_UP8 ? 1 : 2); S.b_estride = (size_t)2 * EXPD * D * (MOE_UP8 ? 1 : 2);
            S.tokslot = TOKSLOT + p * MAXSLOT; S.rowbytes = D * (MOE_UP8 ? 1 : 2);
            pg8::EpiSwiGLU<MOE_DN8> E{ACTB, EXPD, MOE_UP8 ? 1.0f / (H8_SCALE * W8_SCALE) : 1.0f};
            pg8::gemm_phase<pg8::EpiSwiGLU<MOE_DN8>, pg8::MoeSched, true, true, MOE_UP8>(lds, D * (MOE_UP8 ? 1 : 2), S, E);
        }
        SEAM(15 + 2 * p);
        if (IN(16 + 2 * p)) {
            pg8::MoeSched S; MOE_SCHED(S, p); const int nP = META[p * 16 + 8] >> 8;
            constexpr int RBD = EXPD * (MOE_DN8 ? 1 : 2), NTD = RBD / 128;
            int nPm = nP, jpart = -1; const int qpart = bx & 7;
            { const int nwg = nP * 4, nfull = nwg / G, nrem = nwg - nfull * G; if (nrem > 0 && 8 * nrem <= G && (nfull * G) % 4 == 0 && NTD >= 16) { nPm = nfull * G / 4; if (bx < 8 * nrem) jpart = bx >> 3; } }
            S.init(nPm, 4, G, bx); S.A = (const char*)ACTB; S.a_tstep = (size_t)256 * RBD; S.Bt = (const char*)W_MOE2; S.b_tstep = (size_t)256 * RBD; S.b_estride = (size_t)D * RBD;
            S.tokslot = TOKSLOT + p * MAXSLOT; S.rowbytes = 0;
#define MOE_DOWN(FINAL_) do { pg8::EpiMoeDown<FINAL_> E{TOKSLOT + p * MAXSLOT, GSLOT + p * MAXSLOT, XB, out, MOD1 + 5 * 1024, MOE_DN8 ? 1.0f / (A8_SCALE * W8_SCALE) : 1.0f}; \
                if (nPm > 0) pg8::gemm_phase<pg8::EpiMoeDown<FINAL_>, pg8::MoeSched, true, false, MOE_DN8>(lds, RBD, S, E); \
                if (jpart >= 0) {       \
                    const int gsz = nP - nPm; pg8::Unit u; u.pm = nPm + jpart % gsz; u.pn = jpart / gsz; \
                    { pg8::MoeSchedTail T; MOE_SCHED(T, p); T.init(nP, 4, G, bx); T.A = S.A; T.a_tstep = S.a_tstep; T.Bt = S.Bt; T.b_tstep = S.b_tstep; T.b_estride = S.b_estride; T.tokslot = S.tokslot; T.rowbytes = 0; \
                      constexpr int P = NTD / 2, base = P / 8, extra = P % 8; T.pmT = u.pm; T.pnT = u.pn; T.k0T = 2 * (qpart * base + (qpart < extra ? qpart : extra)); T.nkT = 2 * (base + (qpart < extra ? 1 : 0)); \
                      pg8::EpiPartStore EP{KPART + (size_t)bx * (32 * 512 * 4)}; \
                      pg8::gemm_phase<pg8::EpiPartStore, pg8::MoeSchedTail, true, false, MOE_DN8, true>(lds, RBD, T, EP); } \
                    unsigned* kc = ctl + CW_KCNT + p * 64 + jpart; \
                    asm volatile("s_waitcnt vmcnt(0)" ::: "memory"); __syncthreads(); \
                    if (tid == 0) { __builtin_amdgcn_fence(__ATOMIC_RELEASE, "agent"); asm volatile("s_waitcnt vmcnt(0)" ::: "memory"); (void)xb_add(kc, 1u); \
                        XB_SPIN(xb_ld(kc) < 8u, ctl + CW_BAR); __builtin_amdgcn_fence(__ATOMIC_ACQUIRE, "agent"); asm volatile("s_waitcnt vmcnt(0)" ::: "memory"); } \
                    __syncthreads(); \
                    const int ai = qpart >> 2, m = qpart & 3; \
                    f32x4 v[2][2]; \
                    _Pragma("unroll") for (int bj = 0; bj < 2; ++bj) _Pragma("unroll") for (int n = 0; n < 2; ++n) { f32x4 a = (f32x4){0.f, 0.f, 0.f, 0.f}; \
                        const f32x4* pp = (const f32x4*)(KPART + (size_t)(jpart * 8) * (32 * 512 * 4)) + (size_t)((((ai * 2 + bj) * 4 + m) * 2 + n) * 512 + tid); \
                        _Pragma("unroll") for (int qq = 0; qq < 8; ++qq) a += pp[(size_t)qq * (32 * 512)]; \
                        v[bj][n] = a; } \
                    E.slice(v, u, ai, m, wave >> 2, wave & 3, lane & 15, lane >> 4); } } while (0)
            if (p == 0) MOE_DOWN(false); else MOE_DOWN(true);
#undef MOE_DOWN
        }
        if (p == 0) SEAM(16);
    }
#undef IN
#undef SEAM
}


constexpr int N_PHASES = 19;
extern "C" void kernel_launch(void* const* d_in, const int* in_sizes, int n_in, void* d_out, int out_size, void* d_ws, size_t ws_size, hipStream_t stream) {
    static int grid = 0;
    if (grid == 0) {
        if (n_in != 28 || in_sizes[0] != M * D || out_size != M * D || ws_size < WS_TOTAL) { fprintf(stderr, "kernel_launch: unexpected problem shape (n_in %d, out %d, ws %zu)\n", n_in, out_size, ws_size); grid = -1; return; }
        int dev = 0, cus = 0, per_cu = 0;
        if (hipGetDevice(&dev) != hipSuccess || hipDeviceGetAttribute(&cus, hipDeviceAttributeMultiprocessorCount, dev) != hipSuccess) { grid = -1; return; }
        if (hipFuncSetAttribute((const void*)mk_fwd, hipFuncAttributeMaxDynamicSharedMemorySize, LDS_BYTES) != hipSuccess) { fprintf(stderr, "kernel_launch: hipFuncSetAttribute failed\n"); grid = -1; return; }
        if (hipOccupancyMaxActiveBlocksPerMultiprocessor(&per_cu, (const void*)mk_fwd, NWAVES * 64, LDS_BYTES) != hipSuccess || per_cu < 1) { fprintf(stderr, "kernel_launch: occupancy query reports %d\n", per_cu); }
        (void)hipGetLastError();
        grid = cus;
        if (grid < 128) { fprintf(stderr, "kernel_launch: built for a >= 128-CU device (64 GLA scan workgroups + weight-copy workgroups); got %d\n", grid); grid = -1; return; }
    }
    if (grid < 0) return;
    if (hipMemsetAsync((char*)d_ws + WS_CTL, 0, CTL_ZERO_BYTES, stream) != hipSuccess) return;
    Args a{};
    const float** ap = (const float**)&a;
    for (int i = 0; i < 28; ++i) ap[i] = (const float*)d_in[i];
    a.out = (float*)d_out; a.ws = (unsigned char*)d_ws;
    if (MK_N_LAUNCHES == 1) { a.ph_lo = 0; a.ph_hi = N_PHASES; hipLaunchKernelGGL(mk_fwd, dim3(grid), dim3(NWAVES * 64), LDS_BYTES, stream, a); }
    else { for (int p = 0; p < N_PHASES; ++p) { a.ph_lo = p; a.ph_hi = p + 1; hipLaunchKernelGGL(mk_fwd, dim3(grid), dim3(NWAVES * 64), LDS_BYTES, stream, a); } }
}
```

```cpp
#include <hip/hip_runtime.h>
#include <cstdio>
#include <cstdint>

#ifndef PROBE_DUP
#define PROBE_DUP -1
#endif
#ifndef MK_N_LAUNCHES
#define MK_N_LAUNCHES 1
#endif

#define LAS __attribute__((address_space(3)))
#define GAS __attribute__((address_space(1)))
typedef unsigned short bf16;
typedef short bf16x8 __attribute__((ext_vector_type(8)));
typedef short s16x4 __attribute__((ext_vector_type(4)));
typedef float f32x4 __attribute__((ext_vector_type(4)));
typedef float f32x2 __attribute__((ext_vector_type(2)));
typedef float f32x16 __attribute__((ext_vector_type(16)));
typedef unsigned u32x4 __attribute__((ext_vector_type(4)));
typedef unsigned u32x2 __attribute__((ext_vector_type(2)));

constexpr int D = 1024, BATCH = 16, SEQ = 4096, M = BATCH * SEQ;
constexpr int FFN = 2816, NEXP = 8, EXPD = 3584;
constexpr int GLA_N = 3584;
constexpr float EPS = 1e-6f;
constexpr float LOG2E = 1.4426950408889634f;
constexpr int NWAVES = 8;
constexpr int MAXSLOT = M + NEXP * 256;

constexpr size_t MiB = 1u << 20;
constexpr size_t WS_CTL = 0, CTL_ZERO_BYTES = 64 * 1024;
constexpr size_t WS_MOD = 256 * 1024;
constexpr size_t WS_LCNT = 1 * MiB + 256 * 1024;
constexpr size_t WS_META = 1 * MiB + 512 * 1024;
constexpr size_t WS_ROUTE = 2 * MiB;
constexpr size_t WS_TOKSLOT = 4 * MiB;
constexpr size_t WS_GSLOT = 5 * MiB;
constexpr size_t WS_W_DAIN = 8 * MiB, WS_W_DAOUT = 14 * MiB, WS_W_FFN13 = 16 * MiB, WS_W_FFN2 = 27 * MiB;
constexpr size_t WS_W_GLAIN = 33 * MiB, WS_W_GLAOUT = 40 * MiB, WS_W_MOE13 = 42 * MiB, WS_W_MOE2 = 154 * MiB;
constexpr size_t WS_H = 210 * MiB;
constexpr size_t WS_Q = 338 * MiB;
constexpr size_t WS_END = WS_Q + 464 * MiB;
constexpr size_t WS_XB = WS_END;
constexpr size_t WS_TOTAL = WS_XB + (size_t)M * D * 2;
constexpr size_t GA_UNIT = 43008;
static_assert(4096 * GA_UNIT <= (size_t)M * D * 4, "the GLA per-chunk operands are parked in d_out (free until the last phase writes the result)");
static_assert(WS_TOKSLOT + 2 * MAXSLOT * 4 <= WS_GSLOT && WS_GSLOT + 2 * MAXSLOT * 4 <= WS_W_DAIN, "ws map");
static_assert(WS_W_FFN2 + (size_t)D * FFN * 2 <= WS_W_GLAIN && WS_W_GLAIN + (size_t)GLA_N * D * 2 <= WS_W_GLAOUT, "ws map");
static_assert(WS_W_MOE13 + (size_t)NEXP * 2 * EXPD * D * 2 <= WS_W_MOE2 && WS_W_MOE2 + (size_t)NEXP * D * EXPD * 2 <= WS_H, "ws map");
static_assert((size_t)MAXSLOT * EXPD * 2 <= 464 * MiB && (size_t)M * 3072 * 2 + (size_t)M * 512 * 2 <= 464 * MiB, "ws map");
constexpr int CW_BAR = 4096, CW_KCNT = 8192;

constexpr int RING_BYTES = 131072;
constexpr int TAB_OFF = RING_BYTES;
constexpr int MISC_OFF = 155648;
constexpr int LDS_BYTES = MISC_OFF + 1024;

__device__ __forceinline__ unsigned f2bf(float f) { unsigned u = __builtin_bit_cast(unsigned, f); return (u + 0x7fffu + ((u >> 16) & 1u)) >> 16; }
__device__ __forceinline__ unsigned pk2(float lo, float hi) { return f2bf(lo) | (f2bf(hi) << 16); }
__device__ __forceinline__ float bf2f(unsigned short b) { return __builtin_bit_cast(float, ((unsigned)b) << 16); }
__device__ __forceinline__ unsigned cvt_pk_bf16(float lo, float hi) { unsigned r; asm volatile("v_cvt_pk_bf16_f32 %0, %1, %2" : "=v"(r) : "v"(lo), "v"(hi)); return r; }
__device__ __forceinline__ float wave_sum(float v) {
#pragma unroll
    for (int o = 1; o < 64; o <<= 1) v += __shfl_xor(v, o);
    return v;
}
__device__ __forceinline__ float wave_max(float v) {
#pragma unroll
    for (int o = 1; o < 64; o <<= 1) v = fmaxf(v, __shfl_xor(v, o));
    return v;
}
typedef int v8i __attribute__((ext_vector_type(8)));
typedef int v4i __attribute__((ext_vector_type(4)));
constexpr bool FFN_UP8 = false, FFN_DN8 = true, MOE_UP8 = true, MOE_DN8 = true;
constexpr float W8_SCALE = 64.0f, H8_SCALE = 8.0f, A8_SCALE = 4.0f;
__device__ __forceinline__ float clamp448(float x) { return fminf(fmaxf(x, -448.0f), 448.0f); }
__device__ __forceinline__ unsigned pk_fp8x4(float a, float b, float c, float d) {
    unsigned w = 0u; w = __builtin_amdgcn_cvt_pk_fp8_f32(clamp448(a), clamp448(b), w, false); w = __builtin_amdgcn_cvt_pk_fp8_f32(clamp448(c), clamp448(d), w, true); return w; }
__device__ __forceinline__ f32x4 ld_bf16x4(const bf16* p) { const u32x2 w = *(const u32x2*)p; return (f32x4){__builtin_bit_cast(float, w[0] << 16), __builtin_bit_cast(float, w[0] & 0xffff0000u), __builtin_bit_cast(float, w[1] << 16), __builtin_bit_cast(float, w[1] & 0xffff0000u)}; }
__device__ __forceinline__ void st_bf16x4(bf16* p, f32x4 v) { *(u32x2*)p = (u32x2){cvt_pk_bf16(v[0], v[1]), cvt_pk_bf16(v[2], v[3])}; }
__device__ __forceinline__ float fast_silu(float a) { return a * __builtin_amdgcn_rcpf(1.0f + __builtin_amdgcn_exp2f(-a * LOG2E)); }

namespace pg8 {
constexpr int BM = 256, BK = 64, HALF = 128, HTB = HALF * BK * 2, STAGE_BYTES = 8 * HTB, NXCD = 8, WGM = 8;
__host__ __device__ __forceinline__ int lds_byte(int r, int c) { const int rr = r & 7, ch = (c >> 3) ^ rr; return (r >> 3) * 1024 + (rr * 8 + ch) * 16 + (c & 7) * 2; }
__host__ __device__ __forceinline__ void stage_rc(int b, int& R, int& C) { const int piece = b / 1024, slot = (b % 1024) / 16, rr = slot >> 3, ch = (slot & 7) ^ rr; R = piece * 8 + rr; C = ch * 8; }
__host__ __device__ __forceinline__ int perm32(int rho) { const int n = rho >> 4, i = rho & 15; return 8 * (i >> 2) + 4 * n + (i & 3); }

struct Unit { int pm, pn, k0, nk, part; };
struct TileOrder {
    int nM, nN, nwg, G, c;
    __device__ void init(int nM_, int nN_, int G_, int c_) { nM = nM_; nN = nN_; nwg = nM * nN; G = G_; c = c_; }
    __device__ bool next(int i, Unit& u) const { return at((long)i * G + c, u); }
    __device__ bool at(const long L, Unit& u) const {
        if (L >= nwg) return false;
        int wgid = (int)L; { const int q = nwg / NXCD, r = nwg % NXCD, xcd = wgid % NXCD, off = wgid / NXCD; wgid = (xcd < r ? xcd * (q + 1) : r * (q + 1) + (xcd - r) * q) + off; }
        const int nig = WGM * nN, gid = wgid / nig, fm = gid * WGM, gsz = (nM - fm) < WGM ? (nM - fm) : WGM;
        u.pm = fm + ((wgid % nig) % gsz); u.pn = (wgid % nig) / gsz; return true;
    }
};
struct DenseSched : TileOrder {
    const char* A; const char* Bt; size_t tstep;
    __device__ __forceinline__ const char* a_base(const Unit& u) const { return A + (size_t)u.pm * tstep; }
    __device__ __forceinline__ const char* b_base(const Unit& u) const { return Bt + (size_t)u.pn * tstep; }
    __device__ __forceinline__ unsigned row_off(const Unit&, int) const { return 0u; }
};
struct MoeSched : TileOrder {
    const char* A; const char* Bt; size_t a_tstep, b_tstep, b_estride; const int* tokslot; unsigned rowbytes; int g1, g2, g3, g4, g5, g6, g7;
    __device__ __forceinline__ int expert(int pm) const { const int r = pm * 256; return (r >= g1) + (r >= g2) + (r >= g3) + (r >= g4) + (r >= g5) + (r >= g6) + (r >= g7); }
    __device__ __forceinline__ const char* a_base(const Unit& u) const { return A + (size_t)u.pm * a_tstep; }
    __device__ __forceinline__ const char* b_base(const Unit& u) const { return Bt + (size_t)expert(u.pm) * b_estride + (size_t)u.pn * b_tstep; }
    __device__ __forceinline__ unsigned row_off(const Unit& u, int r) const { int t = tokslot[u.pm * 256 + r]; t = t < 0 ? 0 : t; return (unsigned)t * rowbytes; }
};
struct MoeSchedTail : MoeSched {
    int pmT, pnT, k0T, nkT;
    __device__ bool next(int i, Unit& u) const { if (i != 0) return false; u.pm = pmT; u.pn = pnT; u.k0 = k0T; u.nk = nkT; u.part = 1; return true; }
};

struct EpiQKV {
    static constexpr bool PERM = true;
    bf16* Q; size_t tstride; const float* qg; const float* kg; float qscale;
    __device__ __forceinline__ void operator()(const f32x4 (&acc)[2][2][4][2], const Unit& u, int wr, int wc, int fr, int fq) const {
        const int t = u.pn >> 2;
        bf16* base = Q + (size_t)t * tstride;
        const int lc0 = 256 * (u.pn & 3) + 64 * wc + 8 * fq;
        const int row0 = u.pm * BM + wr * 64 + fr;
        if (t < 2) {
            const float* g = qg; if (t == 1) g = kg;
            g += 64 * (wc & 1) + 8 * fq;
            f32x4 gv[2][2];
#pragma unroll
            for (int bj = 0; bj < 2; ++bj)
#pragma unroll
                for (int n = 0; n < 2; ++n) gv[bj][n] = *(const f32x4*)(g + 32 * bj + 4 * n);
            float sc = 1.0f; if (t == 0) sc = qscale;
#pragma unroll
            for (int ai = 0; ai < 2; ++ai)
#pragma unroll
                for (int m = 0; m < 4; ++m) {
                    float ss = 0.f;
#pragma unroll
                    for (int bj = 0; bj < 2; ++bj)
#pragma unroll
                        for (int n = 0; n < 2; ++n) { const f32x4 x = acc[ai][bj][m][n]; ss += (x[0] * x[0] + x[1] * x[1]) + (x[2] * x[2] + x[3] * x[3]); }
                    ss += __shfl_xor(ss, 16); ss += __shfl_xor(ss, 32);
                    const float rs = __builtin_amdgcn_rsqf(ss * (1.0f / 64.0f) + EPS) * sc;
                    const int R = row0 + ai * HALF + m * 16;
                    bf16* rowp = base + (size_t)R * D + lc0;
#pragma unroll
                    for (int bj = 0; bj < 2; ++bj) { const f32x4 v0 = acc[ai][bj][m][0] * rs * gv[bj][0], v1 = acc[ai][bj][m][1] * rs * gv[bj][1];
                        u32x4 w; w.x = cvt_pk_bf16(v0[0], v0[1]); w.y = cvt_pk_bf16(v0[2], v0[3]); w.z = cvt_pk_bf16(v1[0], v1[1]); w.w = cvt_pk_bf16(v1[2], v1[3]);
                        if (t == 1) {
                            const int col = lc0 + 32 * bj, hh_ = col >> 7, cg = (col & 127) >> 3, b_ = R >> 12, s_ = R & 4095;
                            *(u32x4*)(base + ((((size_t)(b_ * 8 + hh_) * 64 + (s_ >> 6)) * 16 + cg) * 64 + (s_ & 63)) * 8) = w; }
                        else *(u32x4*)(rowp + 32 * bj) = w; }
                }
        } else {
#pragma unroll
            for (int ai = 0; ai < 2; ++ai)
#pragma unroll
                for (int m = 0; m < 4; ++m) { const int R = row0 + ai * HALF + m * 16, b_ = R >> 12, s_ = R & 4095;
#pragma unroll
                    for (int bj = 0; bj < 2; ++bj) { const f32x4 v0 = acc[ai][bj][m][0], v1 = acc[ai][bj][m][1];
                        u32x4 w; w.x = cvt_pk_bf16(v0[0], v0[1]); w.y = cvt_pk_bf16(v0[2], v0[3]); w.z = cvt_pk_bf16(v1[0], v1[1]); w.w = cvt_pk_bf16(v1[2], v1[3]);
                        const int col = lc0 + 32 * bj, hh_ = col >> 7, c_ = col & 127, p_ = (c_ >> 5) * 4 + ((s_ & 63) >> 4), li = ((s_ & 15) << 2) + ((c_ & 31) >> 3);
                        *(u32x4*)(base + ((((size_t)(b_ * 8 + hh_) * 64 + (s_ >> 6)) * 16 + p_) * 64 + li) * 8) = w; } }
        }
    }
};
template <bool BASE16, bool OUT16> struct EpiResid {
    static constexpr bool PERM = true;
    const void* base; void* out; const float* gate; float descale;
    __device__ __forceinline__ void operator()(const f32x4 (&acc)[2][2][4][2], const Unit& u, int wr, int wc, int fr, int fq) const {
        const int row0 = u.pm * BM + wr * 64 + fr, col0 = u.pn * BM + wc * 32 + 8 * fq, b = u.pm >> 4;
        f32x4 gv[2][2];
#pragma unroll
        for (int bj = 0; bj < 2; ++bj)
#pragma unroll
            for (int n = 0; n < 2; ++n) gv[bj][n] = *(const f32x4*)(gate + (size_t)b * 6144 + col0 + bj * HALF + 4 * n) * descale;
#pragma unroll
        for (int ai = 0; ai < 2; ++ai) {
            f32x4 bs[4][2][2];
#pragma unroll
            for (int m = 0; m < 4; ++m) { const size_t off = (size_t)(row0 + ai * HALF + m * 16) * D + col0;
#pragma unroll
                for (int bj = 0; bj < 2; ++bj) { const size_t o = off + bj * HALF;
                    if constexpr (BASE16) { const u32x4 w = *(const u32x4*)((const bf16*)base + o);
                        bs[m][bj][0] = (f32x4){__builtin_bit_cast(float, w[0] << 16), __builtin_bit_cast(float, w[0] & 0xffff0000u), __builtin_bit_cast(float, w[1] << 16), __builtin_bit_cast(float, w[1] & 0xffff0000u)};
                        bs[m][bj][1] = (f32x4){__builtin_bit_cast(float, w[2] << 16), __builtin_bit_cast(float, w[2] & 0xffff0000u), __builtin_bit_cast(float, w[3] << 16), __builtin_bit_cast(float, w[3] & 0xffff0000u)}; }
                    else { bs[m][bj][0] = *(const f32x4*)((const float*)base + o); bs[m][bj][1] = *(const f32x4*)((const float*)base + o + 4); } } }
#pragma unroll
            for (int m = 0; m < 4; ++m) { const size_t off = (size_t)(row0 + ai * HALF + m * 16) * D + col0;
#pragma unroll
                for (int bj = 0; bj < 2; ++bj) { const size_t o = off + bj * HALF;
                    const f32x4 r0 = bs[m][bj][0] + gv[bj][0] * acc[ai][bj][m][0], r1 = bs[m][bj][1] + gv[bj][1] * acc[ai][bj][m][1];
                    if constexpr (OUT16) *(u32x4*)((bf16*)out + o) = (u32x4){cvt_pk_bf16(r0[0], r0[1]), cvt_pk_bf16(r0[2], r0[3]), cvt_pk_bf16(r1[0], r1[1]), cvt_pk_bf16(r1[2], r1[3])};
                    else { *(f32x4*)((float*)out + o) = r0; *(f32x4*)((float*)out + o + 4) = r1; } } }
            asm volatile("" ::: "memory"); }
    }
};
template <bool OUT8> struct EpiSwiGLU {
    static constexpr bool PERM = true;
    void* O; int ldo; float descale;
    __device__ __forceinline__ void operator()(const f32x4 (&acc)[2][2][4][2], const Unit& u, int wr, int wc, int fr, int fq) const {
        const int row0 = u.pm * BM + wr * 64 + fr, col0 = u.pn * HALF + wc * 32 + 8 * fq;
#pragma unroll
        for (int ai = 0; ai < 2; ++ai)
#pragma unroll
            for (int m = 0; m < 4; ++m) { const unsigned eo = (unsigned)(row0 + ai * HALF + m * 16) * (unsigned)ldo + (unsigned)col0;
                f32x4 v0, v1;
#pragma unroll
                for (int i = 0; i < 4; ++i) { v0[i] = fast_silu(acc[ai][0][m][0][i] * descale) * (acc[ai][1][m][0][i] * descale); v1[i] = fast_silu(acc[ai][0][m][1][i] * descale) * (acc[ai][1][m][1][i] * descale); }
                if constexpr (OUT8) { v0 = v0 * A8_SCALE; v1 = v1 * A8_SCALE; *(u32x2*)((unsigned char*)O + eo) = (u32x2){pk_fp8x4(v0[0], v0[1], v0[2], v0[3]), pk_fp8x4(v1[0], v1[1], v1[2], v1[3])}; }
                else { u32x4 w; w.x = cvt_pk_bf16(v0[0], v0[1]); w.y = cvt_pk_bf16(v0[2], v0[3]); w.z = cvt_pk_bf16(v1[0], v1[1]); w.w = cvt_pk_bf16(v1[2], v1[3]); *(u32x4*)((bf16*)O + eo) = w; } }
    }
};
struct EpiGLA {
    static constexpr bool PERM = true;
    bf16* P; bf16* LA; const float* ba; const float* og;
    __device__ __forceinline__ void operator()(const f32x4 (&acc)[2][2][4][2], const Unit& u, int wr, int wc, int fr, int fq) const {
        const int row0 = u.pm * BM + wr * 64 + fr;
        if (u.pn < 12) {
            const int col0 = u.pn * BM + wc * 32 + 8 * fq; const bool isr = u.pn >= 8;
            f32x4 gv[2][2];
#pragma unroll
            for (int bj = 0; bj < 2; ++bj)
#pragma unroll
                for (int n = 0; n < 2; ++n) gv[bj][n] = isr ? *(const f32x4*)(og + wc * 32 + 8 * fq + bj * HALF + 4 * n) : (f32x4){1.f, 1.f, 1.f, 1.f};
#pragma unroll
            for (int ai = 0; ai < 2; ++ai)
#pragma unroll
                for (int m = 0; m < 4; ++m) { bf16* rowp = P + (size_t)(row0 + ai * HALF + m * 16) * 3072 + col0;
#pragma unroll
                    for (int bj = 0; bj < 2; ++bj) { f32x4 v0 = acc[ai][bj][m][0], v1 = acc[ai][bj][m][1];
                        if (isr) {
#pragma unroll
                            for (int i = 0; i < 4; ++i) { v0[i] = gv[bj][0][i] * fast_silu(v0[i]); v1[i] = gv[bj][1][i] * fast_silu(v1[i]); } }
                        u32x4 w; w.x = cvt_pk_bf16(v0[0], v0[1]); w.y = cvt_pk_bf16(v0[2], v0[3]); w.z = cvt_pk_bf16(v1[0], v1[1]); w.w = cvt_pk_bf16(v1[2], v1[3]);
                        *(u32x4*)(rowp + bj * HALF) = w; } }
        } else {
            const int col0 = (u.pn - 12) * BM + wc * 32 + 8 * fq;
            f32x4 bv[2][2];
#pragma unroll
            for (int bj = 0; bj < 2; ++bj)
#pragma unroll
                for (int n = 0; n < 2; ++n) bv[bj][n] = *(const f32x4*)(ba + col0 + bj * HALF + 4 * n);
#pragma unroll
            for (int ai = 0; ai < 2; ++ai)
#pragma unroll
                for (int m = 0; m < 4; ++m) { bf16* rowp = LA + (size_t)(row0 + ai * HALF + m * 16) * 512 + col0;
#pragma unroll
                    for (int bj = 0; bj < 2; ++bj) { f32x4 v[2];
#pragma unroll
                        for (int n = 0; n < 2; ++n)
#pragma unroll
                            for (int i = 0; i < 4; ++i) { const float z = acc[ai][bj][m][n][i] + bv[bj][n][i];
                                v[n][i] = (fminf(z, 0.f) - __logf(1.0f + __expf(-fabsf(z)))) * (1.0f / 16.0f); }
                        u32x4 w; w.x = cvt_pk_bf16(v[0][0], v[0][1]); w.y = cvt_pk_bf16(v[0][2], v[0][3]); w.z = cvt_pk_bf16(v[1][0], v[1][1]); w.w = cvt_pk_bf16(v[1][2], v[1][3]);
                        *(u32x4*)(rowp + bj * HALF) = w; } }
        }
    }
};
template <bool FINAL> struct EpiMoeDown {
    static constexpr bool PERM = true;
    const int* tokslot; const float* gslot; bf16* xb; float* outf; const float* gate; float descale;
    __device__ __forceinline__ void row(const f32x4 (&v)[2][2], int srow, int col0) const {
        const int tok = tokslot[srow];
        if (tok >= 0) { const float g = gslot[srow] * descale; const float* gp = gate + (size_t)(tok >> 12) * 6144 + col0; const size_t ro = (size_t)tok * D + col0;
#pragma unroll
            for (int bj = 0; bj < 2; ++bj) { const f32x4 g0 = *(const f32x4*)(gp + bj * HALF), g1 = *(const f32x4*)(gp + bj * HALF + 4); const u32x4 w = *(const u32x4*)(xb + ro + bj * HALF);
                const f32x4 b0 = (f32x4){__builtin_bit_cast(float, w[0] << 16), __builtin_bit_cast(float, w[0] & 0xffff0000u), __builtin_bit_cast(float, w[1] << 16), __builtin_bit_cast(float, w[1] & 0xffff0000u)};
                const f32x4 b1 = (f32x4){__builtin_bit_cast(float, w[2] << 16), __builtin_bit_cast(float, w[2] & 0xffff0000u), __builtin_bit_cast(float, w[3] << 16), __builtin_bit_cast(float, w[3] & 0xffff0000u)};
                const f32x4 r0 = b0 + g0 * g * v[bj][0], r1 = b1 + g1 * g * v[bj][1];
                if constexpr (FINAL) { *(f32x4*)(outf + ro + bj * HALF) = r0; *(f32x4*)(outf + ro + bj * HALF + 4) = r1; }
                else *(u32x4*)(xb + ro + bj * HALF) = (u32x4){cvt_pk_bf16(r0[0], r0[1]), cvt_pk_bf16(r0[2], r0[3]), cvt_pk_bf16(r1[0], r1[1]), cvt_pk_bf16(r1[2], r1[3])}; } }
    }
    __device__ __forceinline__ void operator()(const f32x4 (&acc)[2][2][4][2], const Unit& u, int wr, int wc, int fr, int fq) const {
        const int srow0 = u.pm * BM + wr * 64 + fr, col0 = u.pn * BM + wc * 32 + 8 * fq;
        int tok[8]; float gsl[8];
#pragma unroll
        for (int i = 0; i < 8; ++i) { const int srow = srow0 + (i >> 2) * HALF + (i & 3) * 16; tok[i] = tokslot[srow]; gsl[i] = gslot[srow] * descale; }
#pragma unroll
        for (int i0 = 0; i0 < 8; i0 += 2) {
            u32x4 w[2][2]; f32x4 gt[2][2][2];
#pragma unroll
            for (int q = 0; q < 2; ++q) { const int t = tok[i0 + q] < 0 ? 0 : tok[i0 + q]; const float* gp = gate + (size_t)(t >> 12) * 6144 + col0; const size_t ro = (size_t)t * D + col0;
#pragma unroll
                for (int bj = 0; bj < 2; ++bj) { w[q][bj] = *(const u32x4*)(xb + ro + bj * HALF); gt[q][bj][0] = *(const f32x4*)(gp + bj * HALF); gt[q][bj][1] = *(const f32x4*)(gp + bj * HALF + 4); } }
#pragma unroll
            for (int q = 0; q < 2; ++q) { const int i = i0 + q, ai = i >> 2, m = i & 3;
                if (tok[i] >= 0) { const float g = gsl[i]; const size_t ro = (size_t)tok[i] * D + col0;
#pragma unroll
                    for (int bj = 0; bj < 2; ++bj) { const u32x4 ww = w[q][bj];
                        const f32x4 b0 = (f32x4){__builtin_bit_cast(float, ww[0] << 16), __builtin_bit_cast(float, ww[0] & 0xffff0000u), __builtin_bit_cast(float, ww[1] << 16), __builtin_bit_cast(float, ww[1] & 0xffff0000u)};
                        const f32x4 b1 = (f32x4){__builtin_bit_cast(float, ww[2] << 16), __builtin_bit_cast(float, ww[2] & 0xffff0000u), __builtin_bit_cast(float, ww[3] << 16), __builtin_bit_cast(float, ww[3] & 0xffff0000u)};
                        const f32x4 r0 = b0 + gt[q][bj][0] * g * acc[ai][bj][m][0], r1 = b1 + gt[q][bj][1] * g * acc[ai][bj][m][1];
                        if constexpr (FINAL) { *(f32x4*)(outf + ro + bj * HALF) = r0; *(f32x4*)(outf + ro + bj * HALF + 4) = r1; }
                        else *(u32x4*)(xb + ro + bj * HALF) = (u32x4){cvt_pk_bf16(r0[0], r0[1]), cvt_pk_bf16(r0[2], r0[3]), cvt_pk_bf16(r1[0], r1[1]), cvt_pk_bf16(r1[2], r1[3])}; } } }
            asm volatile("" ::: "memory"); }
    }
    __device__ __forceinline__ void slice(const f32x4 (&v)[2][2], const Unit& u, int ai, int m, int wr, int wc, int fr, int fq) const {
        row(v, u.pm * BM + wr * 64 + fr + ai * HALF + m * 16, u.pn * BM + wc * 32 + 8 * fq);
    }
};
struct EpiPartStore {
    static constexpr bool PERM = true;
    float* part;
    __device__ __forceinline__ void operator()(const f32x4 (&acc)[2][2][4][2], const Unit&, int wr, int wc, int fr, int fq) const {
        f32x4* p = (f32x4*)part + ((wr * 4 + wc) * 64 + fq * 16 + fr);
#pragma unroll
        for (int ai = 0; ai < 2; ++ai)
#pragma unroll
            for (int bj = 0; bj < 2; ++bj)
#pragma unroll
                for (int m = 0; m < 4; ++m)
#pragma unroll
                    for (int n = 0; n < 2; ++n) { *p = acc[ai][bj][m][n]; p += 512; asm volatile("" : "+v"(p)); }
    }
};

template <class Epi, class Sched, bool ALIGN_EPI, bool GATHER, bool FP8 = false, bool KSPLIT = false>
__device__ __forceinline__ void gemm_phase(LAS unsigned char* lds, const int RB, const Sched& S, const Epi& E) {
    const int tid = threadIdx.x, wid = __builtin_amdgcn_readfirstlane(tid >> 6), lane = tid & 63, wr = wid >> 2, wc = wid & 3, fr = lane & 15, fq = lane >> 4;
    const int nt = RB / 128;
    unsigned voffB0, voffA0;
    const size_t kstep = (size_t)(BK * 2);
    const size_t hstep = (size_t)HALF * RB;
    const size_t qstep = (size_t)64 * RB;
    { int R, C; stage_rc(tid * 16, R, C); const int Rb = Epi::PERM ? ((R & ~31) + perm32(R & 31)) : R;
        voffB0 = (unsigned)(Rb * RB + C * 2); voffA0 = (unsigned)(R * RB + C * 2); }
    LAS unsigned* mytab = (LAS unsigned*)(lds + STAGE_BYTES) + tid;
#define PG8_TABFILL(par, U) do { _Pragma("unroll") for (int _h = 0; _h < 2; ++_h) _Pragma("unroll") for (int _i = 0; _i < 2; ++_i) { int _R, _C; stage_rc(tid * 16 + _i * 8192, _R, _C); \
        mytab[((par) * 4 + _h * 2 + _i) * 512] = S.row_off(U, _h * HALF + _R) + (unsigned)_C * 2u; } } while (0)
    const unsigned ldsw = (unsigned)wid * 1024u;
    const int aoff = lds_byte(wr * 64 + fr, fq * 8), boff = lds_byte(wc * 32 + fr, fq * 8), aoff1 = aoff ^ 64, boff1 = boff ^ 64;
#define PG8_SA(b, h) (((b) * 2 + (h)) * HTB)
#define PG8_SB(b, h) ((4 + (b) * 2 + (h)) * HTB)
#define PG8_STAGE_B(bufoff, gbase) do { _Pragma("unroll") for (int _i = 0; _i < 2; ++_i) \
        __builtin_amdgcn_global_load_lds((const unsigned*)((const char*)(gbase) + _i * qstep + voffB0), (LAS unsigned*)(lds + (bufoff) + ldsw + _i * 8192), 16, 0, 0); } while (0)
#define PG8_STAGE_A(bufoff, gbase, va, h) do { _Pragma("unroll") for (int _i = 0; _i < 2; ++_i) \
        __builtin_amdgcn_global_load_lds((const unsigned*)((const char*)(gbase) + (GATHER ? (size_t)0 : (size_t)(h) * hstep + _i * qstep) + (GATHER ? (va)[h][_i] : voffA0)), (LAS unsigned*)(lds + (bufoff) + ldsw + _i * 8192), 16, 0, 0); } while (0)
#define PG8_LDA(dst, b, h) do { _Pragma("unroll") for (int m = 0; m < 4; ++m) { if constexpr (FP8) dst##8[m] = __builtin_shufflevector(*(const LAS v4i*)(lds + PG8_SA(b, h) + aoff + m * 2048), *(const LAS v4i*)(lds + PG8_SA(b, h) + aoff1 + m * 2048), 0, 1, 2, 3, 4, 5, 6, 7); \
        else { dst[m][0] = *(const LAS bf16x8*)(lds + PG8_SA(b, h) + aoff + m * 2048); dst[m][1] = *(const LAS bf16x8*)(lds + PG8_SA(b, h) + aoff1 + m * 2048); } } } while (0)
#define PG8_LDB(dst, b, h) do { _Pragma("unroll") for (int n = 0; n < 2; ++n) { if constexpr (FP8) dst##8[n] = __builtin_shufflevector(*(const LAS v4i*)(lds + PG8_SB(b, h) + boff + n * 2048), *(const LAS v4i*)(lds + PG8_SB(b, h) + boff1 + n * 2048), 0, 1, 2, 3, 4, 5, 6, 7); \
        else { dst[n][0] = *(const LAS bf16x8*)(lds + PG8_SB(b, h) + boff + n * 2048); dst[n][1] = *(const LAS bf16x8*)(lds + PG8_SB(b, h) + boff1 + n * 2048); } } } while (0)
#define PG8_CAT(x0, x1) __builtin_shufflevector(__builtin_bit_cast(v4i, x0), __builtin_bit_cast(v4i, x1), 0, 1, 2, 3, 4, 5, 6, 7)
#define PG8_MMA(ai, bj, At, Bt) do { __builtin_amdgcn_s_setprio(1); _Pragma("unroll") for (int m = 0; m < 4; ++m) _Pragma("unroll") for (int n = 0; n < 2; ++n) { \
        if constexpr (FP8) asm volatile("v_mfma_scale_f32_16x16x128_f8f6f4 %0, %1, %2, %0, %3, %3 op_sel_hi:[0,0,0]" : "+v"(acc[ai][bj][m][n]) : "v"(Bt##8[n]), "v"(At##8[m]), "v"(sc8));   \
        else { _Pragma("unroll") for (int k = 0; k < 2; ++k) acc[ai][bj][m][n] = __builtin_amdgcn_mfma_f32_16x16x32_bf16(Bt[n][k], At[m][k], acc[ai][bj][m][n], 0, 0, 0); } } \
        __builtin_amdgcn_s_setprio(0); } while (0)
#define PG8_WAIT_V(n) asm volatile("s_waitcnt vmcnt(" #n ")" ::: "memory")
#define PG8_WAIT_L(n) asm volatile("s_waitcnt lgkmcnt(" #n ")" ::: "memory")
#define PG8_BAR __builtin_amdgcn_s_barrier()
#define PG8_SCHED __builtin_amdgcn_sched_barrier(0)
    Unit cur, nxt; int ui = 0;
    if (!S.next(0, cur)) return;
    f32x4 acc[2][2][4][2];
#pragma unroll
    for (int a = 0; a < 2; ++a)
#pragma unroll
        for (int b = 0; b < 2; ++b)
#pragma unroll
            for (int m = 0; m < 4; ++m)
#pragma unroll
                for (int n = 0; n < 2; ++n) acc[a][b][m][n] = (f32x4){0.f, 0.f, 0.f, 0.f};
    const int sc8 = 0x7f7f7f7f;
    bf16x8 At[4][2], B0[2][2], B1[2][2]; v8i At8[4], B08[2], B18[2];
    const char* cA = S.a_base(cur); const char* cB = S.b_base(cur);
    if constexpr (KSPLIT) { cA += (size_t)cur.k0 * kstep; cB += (size_t)cur.k0 * kstep; }
    unsigned cvA[2][2] = {{0u, 0u}, {0u, 0u}};
    if constexpr (GATHER) {
        PG8_TABFILL(0, cur);
#pragma unroll
        for (int h = 0; h < 2; ++h)
#pragma unroll
            for (int i = 0; i < 2; ++i) cvA[h][i] = mytab[(h * 2 + i) * 512];
    }
    PG8_STAGE_B(PG8_SB(0, 0), cB); PG8_STAGE_B(PG8_SB(0, 1), cB + hstep); PG8_STAGE_A(PG8_SA(0, 0), cA, cvA, 0); PG8_STAGE_A(PG8_SA(0, 1), cA, cvA, 1);
    if (wr == 1) PG8_BAR;
    PG8_WAIT_V(2); PG8_BAR;
    PG8_STAGE_B(PG8_SB(1, 0), cB + kstep); PG8_STAGE_A(PG8_SA(1, 0), cA + kstep, cvA, 0); PG8_STAGE_B(PG8_SB(1, 1), cB + hstep + kstep);
    PG8_WAIT_V(6); PG8_BAR;
    for (;;) {
        const bool has_next = S.next(ui + 1, nxt);
        const char* nA = has_next ? S.a_base(nxt) : cA; const char* nB = has_next ? S.b_base(nxt) : cB;
        if constexpr (KSPLIT) { if (has_next) { nA += (size_t)nxt.k0 * kstep; nB += (size_t)nxt.k0 * kstep; } }
        if constexpr (GATHER) { if (has_next) PG8_TABFILL((ui + 1) & 1, nxt); }
        const int ntc = KSPLIT ? cur.nk : nt;
#pragma unroll 1
        for (int t = 0; t < ntc; t += 2) {
            const bool last = (t == ntc - 2);
            const char* a1 = cA + (size_t)(t + 1) * kstep;
            const char* a2 = last ? nA : cA + (size_t)(t + 2) * kstep; const char* b2 = last ? nB : cB + (size_t)(t + 2) * kstep;
            const char* a3 = a2 + kstep; const char* b3 = b2 + kstep;
            unsigned wA[2][2] = {{0u, 0u}, {0u, 0u}};
            if constexpr (GATHER) {
                const int pc = ui & 1, pw = (last && has_next) ? (pc ^ 1) : pc;
#pragma unroll
                for (int i = 0; i < 2; ++i) { cvA[1][i] = mytab[(pc * 4 + 2 + i) * 512]; wA[0][i] = mytab[(pw * 4 + i) * 512]; wA[1][i] = mytab[(pw * 4 + 2 + i) * 512]; }
            }
            PG8_LDB(B0, 0, 0); PG8_LDB(B1, 0, 1); PG8_SCHED; PG8_LDA(At, 0, 0); PG8_STAGE_A(PG8_SA(1, 1), a1, cvA, 1);
            PG8_WAIT_V(8); PG8_WAIT_L(0); PG8_BAR; PG8_MMA(0, 0, At, B0); PG8_MMA(0, 1, At, B1); PG8_BAR; PG8_SCHED;
            PG8_LDA(At, 0, 1); PG8_STAGE_B(PG8_SB(0, 0), b2); PG8_STAGE_B(PG8_SB(0, 1), b2 + hstep); PG8_STAGE_A(PG8_SA(0, 0), a2, wA, 0);
            PG8_WAIT_V(8); PG8_WAIT_L(0); PG8_BAR; PG8_MMA(1, 0, At, B0); PG8_MMA(1, 1, At, B1); PG8_BAR; PG8_SCHED;
            PG8_LDB(B0, 1, 0); PG8_LDB(B1, 1, 1); PG8_SCHED; PG8_LDA(At, 1, 0); PG8_STAGE_A(PG8_SA(0, 1), a2, wA, 1);
            PG8_WAIT_V(8); PG8_WAIT_L(0); PG8_BAR; PG8_MMA(0, 0, At, B0); PG8_MMA(0, 1, At, B1); PG8_BAR; PG8_SCHED;
            PG8_LDA(At, 1, 1); PG8_STAGE_B(PG8_SB(1, 0), b3); PG8_STAGE_B(PG8_SB(1, 1), b3 + hstep); PG8_STAGE_A(PG8_SA(1, 0), a3, wA, 0);
            PG8_WAIT_V(8); PG8_WAIT_L(0); PG8_BAR; PG8_MMA(1, 0, At, B0); PG8_MMA(1, 1, At, B1); PG8_BAR; PG8_SCHED;
        }
        if constexpr (ALIGN_EPI) { if (wr == 0) PG8_BAR; }
        if constexpr (FP8) asm volatile("s_nop 15\n\ts_nop 15" ::: "memory");
        { int el; asm volatile("v_mbcnt_lo_u32_b32 %0, -1, 0\n\tv_mbcnt_hi_u32_b32 %0, -1, %0" : "=v"(el));
          E(acc, cur, wr, wc, el & 15, el >> 4); }
        if (!has_next) break;
#pragma unroll
        for (int a = 0; a < 2; ++a)
#pragma unroll
            for (int b = 0; b < 2; ++b)
#pragma unroll
                for (int m = 0; m < 4; ++m)
#pragma unroll
                    for (int n = 0; n < 2; ++n) acc[a][b][m][n] = (f32x4){0.f, 0.f, 0.f, 0.f};
        cur = nxt; cA = nA; cB = nB; ++ui;
        if constexpr (ALIGN_EPI) { if (wr == 1) PG8_BAR; }
    }
    PG8_WAIT_V(0);
    if constexpr (!ALIGN_EPI) { if (wr == 0) PG8_BAR; }
    PG8_BAR;
#undef PG8_SA
#undef PG8_SB
#undef PG8_STAGE_A
#undef PG8_TABFILL
#undef PG8_STAGE_B
#undef PG8_LDA
#undef PG8_LDB
#undef PG8_MMA
#undef PG8_CAT
#undef PG8_WAIT_V
#undef PG8_WAIT_L
#undef PG8_BAR
#undef PG8_SCHED
}
}

#define XB_TMO      128
#define XB_XCNT(j)  (256  + 64 * (j))
#define XB_XSUB(j)  (1280 + 64 * (j))
#define XB_XGEN(j)  (2304 + 64 * (j))
#define XB_TOP      3328
#define XB_TOPGEN   3392
#define XCD_BAR_WORDS 3456
#define XB_SPIN_CAP (1u << 18)
__device__ __forceinline__ unsigned xb_ld(unsigned* p)              { return __hip_atomic_load(p, __ATOMIC_RELAXED, __HIP_MEMORY_SCOPE_AGENT); }
__device__ __forceinline__ unsigned xb_add(unsigned* p, unsigned v) { return __hip_atomic_fetch_add(p, v, __ATOMIC_RELAXED, __HIP_MEMORY_SCOPE_AGENT); }
__device__ __forceinline__ unsigned xb_xcc_id() { return (unsigned)__builtin_amdgcn_s_getreg((3 << 11) | 20) & 0xFu; }
#define XB_SPIN(cond, bar) do { unsigned _sp = 0; while (cond) { __builtin_amdgcn_s_sleep(1); \
    if ((++_sp & 255u) == 0u) { if (xb_ld(&(bar)[XB_TMO])) break; if (_sp > XB_SPIN_CAP) { atomicAdd(&(bar)[XB_TMO], 1u); break; } } } } while (0)
struct XcdBarrier { unsigned* bar; unsigned x; volatile LAS unsigned* st; };
__device__ __forceinline__ XcdBarrier xcd_barrier_post(unsigned* bar, volatile LAS unsigned* st) {
    XcdBarrier b; b.bar = bar; b.x = xb_xcc_id(); b.st = st;
    if (threadIdx.x == 0) (void)xb_add(&bar[XB_XCNT(b.x)], 1u);
    return b;
}
__device__ __forceinline__ void xcd_barrier_complete(unsigned* bar, unsigned x, unsigned& nloc, unsigned& nx) {
    const unsigned G = gridDim.x * gridDim.y * gridDim.z;
    unsigned sum, cnt, mine, sp = 0u;
    for (;;) {
        sum = 0u; cnt = 0u; mine = 0u;
#pragma unroll
        for (unsigned j = 0; j < 16; ++j) { const unsigned c = xb_ld(&bar[XB_XCNT(j)]); sum += c; cnt += (c > 0u) ? 1u : 0u; mine = (j == x) ? c : mine; }
        if (sum == G) break;
        __builtin_amdgcn_s_sleep(1);
        if ((++sp & 255u) == 0u) { if (xb_ld(&bar[XB_TMO])) break; if (sp > XB_SPIN_CAP) { atomicAdd(&bar[XB_TMO], 1u); break; } }
    }
    nloc = mine > 0u ? mine : 1u; nx = cnt > 0u ? cnt : 1u;
}
__device__ __forceinline__ void xcd_barrier(const XcdBarrier& b) {
    asm volatile("s_waitcnt vmcnt(0)" ::: "memory");
    __syncthreads();
    if (threadIdx.x == 0) {
        unsigned* bar = b.bar;
        __builtin_amdgcn_s_waitcnt(0);
        unsigned nloc = b.st[0], nx = b.st[1];
        if (nloc == 0u) { xcd_barrier_complete(bar, b.x, nloc, nx); b.st[0] = nloc; b.st[1] = nx; }
        const unsigned old = xb_add(&bar[XB_XSUB(b.x)], 1u);
        const unsigned gen = old / nloc;
        if (old + 1u == (gen + 1u) * nloc) {
            __builtin_amdgcn_fence(__ATOMIC_RELEASE, "agent");
            asm volatile("s_waitcnt vmcnt(0)" ::: "memory");
            const unsigned og = xb_add(&bar[XB_TOP], 1u);
            const unsigned tg = og / nx;
            if (og + 1u == (tg + 1u) * nx) xb_add(&bar[XB_TOPGEN], 1u);
            else XB_SPIN(xb_ld(&bar[XB_TOPGEN]) == tg, bar);
            __builtin_amdgcn_fence(__ATOMIC_ACQUIRE, "agent");
            xb_add(&bar[XB_XGEN(b.x)], 1u);
            asm volatile("s_waitcnt vmcnt(0)" ::: "memory");
        } else {
            XB_SPIN(xb_ld(&bar[XB_XGEN(b.x)]) == gen, bar);
            __builtin_amdgcn_fence(__ATOMIC_ACQUIRE, "agent");
            asm volatile("s_waitcnt vmcnt(0)" ::: "memory");
        }
    }
    __syncthreads();
}

struct Args {
    const float* x; const float* c; const float* ada_w; const float* ada_b; const float* norm1_g; const float* norm2_g;
    const float* da_w_in; const float* da_q_gain; const float* da_k_gain; const float* da_lam_q1; const float* da_lam_k1; const float* da_lam_q2; const float* da_lam_k2;
    const float* da_subln_g; const float* da_w_out;
    const float* gla_w_in; const float* gla_w_a1; const float* gla_w_a2; const float* gla_b_a; const float* gla_out_g; const float* gla_w_out;
    const float* ffn_w1; const float* ffn_w3; const float* ffn_w2;
    const float* moe_router; const float* moe_w1; const float* moe_w3; const float* moe_w2;
    float* out; unsigned char* ws; int ph_lo, ph_hi;
};

__device__ __forceinline__ void p0_transpose_item(const float* W, int ldw, int k0, int n0, bf16* WT, int dst_row0, int Kp, LAS float* scr, int lane) {
#pragma unroll 8
    for (int i = 0; i < 32; ++i) { const int kk = 2 * i + (lane >> 5); scr[kk * 33 + (lane & 31)] = W[(size_t)(k0 + kk) * ldw + n0 + (lane & 31)]; }
    asm volatile("s_waitcnt lgkmcnt(0)" ::: "memory");
    const int c = lane & 7;
#pragma unroll
    for (int j = 0; j < 4; ++j) { const int n = (lane >> 3) + 8 * j; const LAS float* s = scr + (8 * c) * 33 + n;
        u32x4 o; o.x = pk2(s[0 * 33], s[1 * 33]); o.y = pk2(s[2 * 33], s[3 * 33]); o.z = pk2(s[4 * 33], s[5 * 33]); o.w = pk2(s[6 * 33], s[7 * 33]);
        *(u32x4*)(WT + (size_t)(dst_row0 + n) * Kp + k0 + 8 * c) = o; }
    asm volatile("s_waitcnt lgkmcnt(0)" ::: "memory");
}

__device__ __forceinline__ void p0_transpose_item8(const float* W, int ldw, int k0, int n0, unsigned char* WT8, int dst_row0, int Kp, LAS float* scr, int lane) {
#pragma unroll 8
    for (int i = 0; i < 32; ++i) { const int kk = 2 * i + (lane >> 5); scr[kk * 33 + (lane & 31)] = W[(size_t)(k0 + kk) * ldw + n0 + (lane & 31)]; }
    asm volatile("s_waitcnt lgkmcnt(0)" ::: "memory");
    const int c = lane & 7;
#pragma unroll
    for (int j = 0; j < 4; ++j) { const int n = (lane >> 3) + 8 * j; const LAS float* sp = scr + (8 * c) * 33 + n;
        const u32x2 o = (u32x2){pk_fp8x4(sp[0 * 33] * W8_SCALE, sp[1 * 33] * W8_SCALE, sp[2 * 33] * W8_SCALE, sp[3 * 33] * W8_SCALE), pk_fp8x4(sp[4 * 33] * W8_SCALE, sp[5 * 33] * W8_SCALE, sp[6 * 33] * W8_SCALE, sp[7 * 33] * W8_SCALE)};
        *(u32x2*)(WT8 + (size_t)(dst_row0 + n) * Kp + k0 + 8 * c) = o; }
    asm volatile("s_waitcnt lgkmcnt(0)" ::: "memory");
}

namespace att {
__device__ __forceinline__ int crow(int r, int hi) { return (r & 3) + 8 * (r >> 2) + 4 * hi; }
__host__ __device__ constexpr int dwin(int h) { return (int)(150.0 / (1.4426950408889634 / (double)(1 << (h + 1)))); }
__host__ __device__ constexpr int tstart(int h, int jq) { const int q0 = 128 * jq, d = dwin(h); return q0 > d ? (q0 - d) / 64 : 0; }
struct Plan { unsigned char n[16]; unsigned char u[16][48]; };
constexpr Plan make_plan() {
    Plan p{}; int load[16] = {};
    for (int w = 0; w < 16; ++w) p.n[w] = 0;
    for (int h = 7; h >= 0; --h) {
        int cost[32] = {}, ord[32] = {};
        for (int j = 0; j < 32; ++j) { cost[j] = 2 * j + 2 - tstart(h, j); ord[j] = j; }
        for (int a = 1; a < 32; ++a) { const int x = ord[a]; int b = a - 1; while (b >= 0 && cost[ord[b]] < cost[x]) { ord[b + 1] = ord[b]; --b; } ord[b + 1] = x; }
        for (int a = 0; a < 32; ++a) { int best = 0; for (int w = 1; w < 16; ++w) if (load[w] < load[best]) best = w;
            p.u[best][p.n[best]++] = (unsigned char)(h * 32 + ord[a]); load[best] += cost[ord[a]]; }
    }
    return p;
}
__device__ const Plan PLAN = make_plan();
constexpr int BUFB = 32768, NBUF = 3, KOFF = 0, VOFF = 16384, WSF_OFF = NBUF * BUFB;
__device__ __forceinline__ s16x4 vtr(const LAS unsigned char* p) { return __builtin_bit_cast(s16x4, __builtin_amdgcn_ds_read_tr16_b64_v4i16((LAS s16x4*)p)); }

__device__ __forceinline__ void attn_unit(LAS unsigned char* lds, const bf16* Q, const bf16* K, const bf16* V, bf16* O, int b, int h, int jq,
                                          float sl2, float mref0, float mref1, float lam, const float* subg) {
    const int tid = threadIdx.x, lane = tid & 63, r32 = lane & 31, hi = lane >> 5; const int wid = __builtin_amdgcn_readfirstlane(tid >> 6);
    const int mp = wid >> 2, w4 = wid & 3;
    const size_t rowbase = (size_t)b * SEQ; const int q0 = jq * 128;
    const int nT = (q0 >> 6) + 2, myc = (q0 + 32 * w4) >> 6, t0 = tstart(h, jq);
    const bf16* Qw = Q + (rowbase + q0 + 32 * w4 + r32) * D + h * 128 + mp * 64 + hi * 8;
    bf16x8 qr[4];
#pragma unroll
    for (int d0 = 0; d0 < 4; ++d0) qr[d0] = *(const bf16x8*)(Qw + d0 * 16);
    const bf16* ksrc = K + ((size_t)(b * 8 + h) * 64 * 16 + wid) * 512 + lane * 8;
    const int p0 = wid, p1 = wid + 8;
    const bf16* vsrc0 = V + ((size_t)(b * 8 + h) * 64 * 16 + p0) * 512 + lane * 8;
    const bf16* vsrc1 = V + ((size_t)(b * 8 + h) * 64 * 16 + p1) * 512 + lane * 8;
#define ATT_DMA1(gp_, la_) asm volatile("s_mov_b32 m0, %0\n\ts_nop 0\n\tglobal_load_lds_dwordx4 %1, off" :: "s"(la_), "v"(gp_) : "memory", "m0")
#define ATT_DMA(t, bs) do { const unsigned bb_ = (unsigned)__builtin_amdgcn_readfirstlane((int)(ldsu + (unsigned)((bs) * BUFB))); \
        ATT_DMA1(ksrc + (size_t)(t) * 8192, bb_ + (unsigned)(KOFF + wid * 1024)); \
        ATT_DMA1(ksrc + (size_t)(t) * 8192 + 4096, bb_ + (unsigned)(KOFF + 8192 + wid * 1024)); \
        ATT_DMA1(vsrc0 + (size_t)(t) * 8192, bb_ + (unsigned)(VOFF + p0 * 1024)); \
        ATT_DMA1(vsrc1 + (size_t)(t) * 8192, bb_ + (unsigned)(VOFF + p1 * 1024)); } while (0)
    const unsigned ldsu = (unsigned)(unsigned long long)lds;
    const float qpos = (float)(q0 + 32 * w4 + r32);
    const float mref = mp ? mref1 : mref0;
    const float baseL = -sl2 * qpos - mref, sl8 = 8.0f * sl2, sl32 = 32.0f * sl2;
    float lsum = 0.f; f32x16 o[4];
#pragma unroll
    for (int d0 = 0; d0 < 4; ++d0)
#pragma unroll
        for (int r = 0; r < 16; ++r) o[d0][r] = 0.f;
    ATT_DMA(t0, 0);
    if (t0 + 1 < nT) ATT_DMA(t0 + 1, 1);
    asm volatile("" :: "v"(qr[0]), "v"(qr[1]), "v"(qr[2]), "v"(qr[3]) : "memory");
    int slot = 0;
    for (int t = t0; t < nT; ++t) {
        if (t + 1 < nT) asm volatile("s_waitcnt vmcnt(4)" ::: "memory"); else asm volatile("s_waitcnt vmcnt(0)" ::: "memory");
        asm volatile("s_waitcnt lgkmcnt(0)" ::: "memory"); __builtin_amdgcn_s_barrier(); asm volatile("" ::: "memory");
        if (t + 2 < nT) { const int s2 = slot >= 1 ? slot - 1 : 2; ATT_DMA(t + 2, s2); }
        if (t <= myc) {
            const LAS unsigned char* bb = lds + slot * BUFB;
            f32x16 c0, c1;
            if (t < myc) {
                const float kb = baseL + sl2 * (float)(64 * t + 4 * hi);
#pragma unroll
                for (int r = 0; r < 16; ++r) { c0[r] = (r == 0) ? kb : ((r & 3) ? c0[r - 1] + sl2 : c0[r - 4] + sl8); c1[r] = c0[r] + sl32; }
            } else {
                const float qk = qpos - (float)(64 * t + 4 * hi);
                float x[16];
#pragma unroll
                for (int r = 0; r < 16; ++r) { x[r] = (r == 0) ? qk : ((r & 3) ? x[r - 1] - 1.0f : x[r - 4] - 8.0f); c0[r] = -sl2 * fabsf(x[r]) - mref; c1[r] = -sl2 * fabsf(x[r] - 32.0f) - mref; }
            }
            const LAS unsigned char* kb_ = bb + KOFF + mp * 8192 + hi * 1024 + r32 * 16;
#define ATT_SB() __builtin_amdgcn_sched_barrier(0)
            bf16x8 kf[8];
#pragma unroll
            for (int d0 = 0; d0 < 4; ++d0) { kf[2 * d0] = *(const LAS bf16x8*)(kb_ + d0 * 2048); kf[2 * d0 + 1] = *(const LAS bf16x8*)(kb_ + d0 * 2048 + 512); }
            const LAS unsigned char* vp = bb + VOFF + ((lane >> 4) & 1) * 32 + (lane & 3) * 8 + (4 * hi + ((lane & 15) >> 2)) * 64;
            s16x4 vlo[16], vhi[16];
#pragma unroll
            for (int ks = 0; ks < 2; ++ks)
#pragma unroll
                for (int d0 = 0; d0 < 4; ++d0) { vlo[d0 * 4 + ks] = vtr(vp + d0 * 4096 + ks * 1024); vhi[d0 * 4 + ks] = vtr(vp + d0 * 4096 + ks * 1024 + 512); }
            ATT_SB();
#pragma unroll
            for (int d0 = 0; d0 < 4; ++d0) c0 = __builtin_amdgcn_mfma_f32_32x32x16_bf16(kf[2 * d0], qr[d0], c0, 0, 0, 0);
            ATT_SB();
            float sacc = 0.f;
#pragma unroll
            for (int d0 = 0; d0 < 4; ++d0) {
                c1 = __builtin_amdgcn_mfma_f32_32x32x16_bf16(kf[2 * d0 + 1], qr[d0], c1, 0, 0, 0);
                ATT_SB();
#pragma unroll
                for (int e = 0; e < 4; ++e) { c0[4 * d0 + e] = __builtin_amdgcn_exp2f(c0[4 * d0 + e]); sacc += c0[4 * d0 + e]; }
                ATT_SB();
            }
            u32x4 pw[4];
#pragma unroll
            for (int g = 0; g < 4; ++g) { pw[0][g] = cvt_pk_bf16(c0[2 * g], c0[2 * g + 1]); pw[1][g] = cvt_pk_bf16(c0[8 + 2 * g], c0[8 + 2 * g + 1]); }
#pragma unroll
            for (int ks = 2; ks < 4; ++ks)
#pragma unroll
                for (int d0 = 0; d0 < 4; ++d0) { vlo[d0 * 4 + ks] = vtr(vp + d0 * 4096 + ks * 1024); vhi[d0 * 4 + ks] = vtr(vp + d0 * 4096 + ks * 1024 + 512); }
            ATT_SB();
#pragma unroll
            for (int j = 0; j < 8; ++j) { const int ks = j >> 2, d0 = j & 3;
                { const s16x4 lo = vlo[d0 * 4 + ks], hh = vhi[d0 * 4 + ks];
                  const bf16x8 vf = (bf16x8){lo[0], lo[1], lo[2], lo[3], hh[0], hh[1], hh[2], hh[3]};
                  o[d0] = __builtin_amdgcn_mfma_f32_32x32x16_bf16(__builtin_bit_cast(bf16x8, pw[ks]), vf, o[d0], 0, 0, 0); }
                ATT_SB();
                c1[2 * j] = __builtin_amdgcn_exp2f(c1[2 * j]); c1[2 * j + 1] = __builtin_amdgcn_exp2f(c1[2 * j + 1]); sacc += c1[2 * j] + c1[2 * j + 1];
                ATT_SB();
            }
            lsum += sacc;
#pragma unroll
            for (int g = 0; g < 4; ++g) { pw[2][g] = cvt_pk_bf16(c1[2 * g], c1[2 * g + 1]); pw[3][g] = cvt_pk_bf16(c1[8 + 2 * g], c1[8 + 2 * g + 1]); }
            ATT_SB();
#pragma unroll
            for (int j = 8; j < 16; ++j) { const int ks = j >> 2, d0 = j & 3;
                const s16x4 lo = vlo[d0 * 4 + ks], hh = vhi[d0 * 4 + ks];
                const bf16x8 vf = (bf16x8){lo[0], lo[1], lo[2], lo[3], hh[0], hh[1], hh[2], hh[3]};
                o[d0] = __builtin_amdgcn_mfma_f32_32x32x16_bf16(__builtin_bit_cast(bf16x8, pw[ks]), vf, o[d0], 0, 0, 0); }
#undef ATT_SB
        }
        slot = slot == 2 ? 0 : slot + 1;
    }
#undef ATT_DMA
#undef ATT_DMA1
    int el; asm volatile("v_mbcnt_lo_u32_b32 %0, -1, 0\n\tv_mbcnt_hi_u32_b32 %0, -1, %0" : "=v"(el));
    const int r32e = el & 31, hie = el >> 5;
    lsum += __shfl_xor(lsum, 32);
    LAS float* wsf = (LAS float*)(lds + WSF_OFF) + wid * 32;
    if (hie == 0) wsf[r32e] = lsum;
    asm volatile("s_waitcnt lgkmcnt(0)" ::: "memory");
    float rl[16];
#pragma unroll
    for (int r = 0; r < 16; ++r) rl[r] = __builtin_amdgcn_rcpf(wsf[crow(r, hie)]);
#pragma unroll
    for (int d0 = 0; d0 < 4; ++d0)
#pragma unroll
        for (int r = 0; r < 16; ++r) o[d0][r] *= rl[r];
    __syncthreads();
    LAS float* X = (LAS float*)lds + w4 * 4096;
    if (mp == 1) {
#pragma unroll
        for (int d0 = 0; d0 < 4; ++d0)
#pragma unroll
            for (int r = 0; r < 16; ++r) X[(d0 * 16 + r) * 64 + el] = o[d0][r];
    }
    __syncthreads();
    if (mp == 0) {
        float ss[16];
#pragma unroll
        for (int r = 0; r < 16; ++r) ss[r] = 0.f;
#pragma unroll
        for (int d0 = 0; d0 < 4; ++d0)
#pragma unroll
            for (int r = 0; r < 16; ++r) { const float dd = o[d0][r] - lam * X[(d0 * 16 + r) * 64 + el]; o[d0][r] = dd; ss[r] += dd * dd; }
#pragma unroll
        for (int r = 0; r < 16; ++r) {
            float s = ss[r];
#pragma unroll
            for (int of = 1; of < 32; of <<= 1) s += __shfl_xor(s, of);
            ss[r] = __builtin_amdgcn_rsqf(s * (1.0f / 128.0f) + EPS) * 0.8f;
        }
        bf16* Ow = O + (rowbase + q0 + 32 * w4) * D + h * 128 + r32e;
#pragma unroll
        for (int d0 = 0; d0 < 4; ++d0) { const float gcol = subg[32 * d0 + r32e];
#pragma unroll
            for (int r = 0; r < 16; ++r) Ow[(size_t)crow(r, hie) * D + 32 * d0] = (bf16)f2bf(o[d0][r] * ss[r] * gcol); }
    }
    __syncthreads();
}
}

__global__ void __launch_bounds__(NWAVES * 64, 2) mk_fwd(Args args) {
    extern __shared__ __attribute__((aligned(16))) unsigned char lds_raw[];
    LAS unsigned char* lds = (LAS unsigned char*)lds_raw;
    volatile LAS unsigned* MISC = (volatile LAS unsigned*)(lds + MISC_OFF);
    const int tid = threadIdx.x, lane = tid & 63, wave = __builtin_amdgcn_readfirstlane(tid >> 6);
    const int G = gridDim.x; const int bx = blockIdx.x;
    const int vcu = (G % 8 == 0) ? (bx % 8) * (G / 8) + bx / 8 : bx;
    unsigned char* ws = args.ws;
    unsigned* ctl = (unsigned*)(ws + WS_CTL);
    float* MOD = (float*)(ws + WS_MOD);
    unsigned* LCNT = (unsigned*)(ws + WS_LCNT);
    int* META = (int*)(ws + WS_META);
    u32x4* ROUTE = (u32x4*)(ws + WS_ROUTE);
    int* TOKSLOT = (int*)(ws + WS_TOKSLOT);
    float* GSLOT = (float*)(ws + WS_GSLOT);
    bf16* W_DAIN = (bf16*)(ws + WS_W_DAIN); bf16* W_DAOUT = (bf16*)(ws + WS_W_DAOUT); bf16* W_FFN13 = (bf16*)(ws + WS_W_FFN13); bf16* W_FFN2 = (bf16*)(ws + WS_W_FFN2);
    bf16* W_GLAIN = (bf16*)(ws + WS_W_GLAIN); bf16* W_GLAOUT = (bf16*)(ws + WS_W_GLAOUT); bf16* W_MOE13 = (bf16*)(ws + WS_W_MOE13); bf16* W_MOE2 = (bf16*)(ws + WS_W_MOE2);
    bf16* HB = (bf16*)(ws + WS_H);
    bf16* QB = (bf16*)(ws + WS_Q);
    bf16* KB = QB + (size_t)M * D; bf16* VB = KB + (size_t)M * D;
    bf16* ACTB = QB;
    bf16* GP = QB;
    bf16* GLAB = QB + (size_t)M * 3072;
    float* out = args.out;
    bf16* XB = (bf16*)(ws + WS_XB);
    float* KPART = (float*)(ws + WS_Q + 320 * MiB);
    static_assert(MOE_DN8 && (size_t)MAXSLOT * EXPD <= 320 * MiB && 320 * MiB + 256 * (size_t)(32 * 512 * 16) <= 464 * MiB, "K-split partials do not fit behind the MoE activations");

    for (int u = tid; u < 256; u += NWAVES * 64) ((LAS unsigned*)(lds + MISC_OFF))[u] = 0u;
    __syncthreads();
    XcdBarrier bar; bar.bar = ctl + CW_BAR; bar.x = 0; bar.st = nullptr;
    if (MK_N_LAUNCHES == 1) bar = xcd_barrier_post(ctl + CW_BAR, MISC + 8);
    const int lo = args.ph_lo, hi = args.ph_hi;
#define IN(k) (lo <= (k) && (k) < hi)
#define SEAM(k) do { if (IN(k) && IN((k) + 1)) xcd_barrier(bar); } while (0)
    const int gw = vcu * NWAVES + wave, NGW = G * NWAVES;

    if (IN(0)) {
        if (bx < 192) {
            LAS float* cact = (LAS float*)lds;
            for (int e = tid; e < 16 * 1024; e += 512) { const int b = e >> 10, k = e & 1023; const float v = args.c[e]; cact[k * 16 + b] = v / (1.0f + __expf(-v)); }
            __syncthreads();
            const int col = tid & 63, ks = tid >> 6, n = bx * 64 + col, layer = n / 6144, nn = n % 6144;
            const float* wp = args.ada_w + (size_t)layer * 1024 * 6144 + nn;
            float a[16];
#pragma unroll
            for (int b = 0; b < 16; ++b) a[b] = 0.f;
            for (int k = ks * 128; k < ks * 128 + 128; ++k) { const float w = wp[(size_t)k * 6144];
#pragma unroll
                for (int q = 0; q < 4; ++q) { const f32x4 cv = *(const LAS f32x4*)(cact + k * 16 + 4 * q); a[4 * q] += cv[0] * w; a[4 * q + 1] += cv[1] * w; a[4 * q + 2] += cv[2] * w; a[4 * q + 3] += cv[3] * w; } }
            LAS float* red = (LAS float*)(lds + 65536);
#pragma unroll
            for (int b = 0; b < 16; ++b) red[(ks * 16 + b) * 64 + col] = a[b];
            __syncthreads();
            for (int e = tid; e < 1024; e += 512) { const int b = e >> 6, cc = e & 63; float s = 0.f;
#pragma unroll
                for (int k8 = 0; k8 < 8; ++k8) s += red[(k8 * 16 + b) * 64 + cc];
                const int n2 = bx * 64 + cc, l2 = n2 / 6144, nn2 = n2 % 6144;
                MOD[((size_t)l2 * 16 + b) * 6144 + nn2] = s + args.ada_b[l2 * 6144 + nn2]; }
            __syncthreads();
        }
        for (int i = bx * 512 + tid; i < 2 * MAXSLOT; i += G * 512) TOKSLOT[i] = -1;
        LAS float* scr = (LAS float*)(lds + wave * 16384);
        constexpr int I_DAIN = 16 * 96, I_SQ = 16 * 32, I_F13 = 16 * 88, I_F2 = 44 * 32, I_GLAIN = 16 * 96, I_GA = 512;
        constexpr int NITEMS = I_DAIN + I_SQ + 2 * I_F13 + I_F2 + I_GLAIN + I_SQ + I_GA;
        for (int it = gw; it < NITEMS; it += NGW) {
            int r = it;
            if (r < I_DAIN) { const int kb = r / 96, nb = r % 96, n0 = 32 * nb, l = n0 & 255;
                p0_transpose_item(args.da_w_in, 3072, 64 * kb, n0, W_DAIN, (n0 & ~255) + 128 * ((l >> 5) & 1) + 32 * (l >> 6), D, scr, lane); continue; } r -= I_DAIN;
            if (r < I_SQ) { const int kb = r / 32, nb = r % 32; p0_transpose_item(args.da_w_out, D, 64 * kb, 32 * nb, W_DAOUT, 32 * nb, D, scr, lane); continue; } r -= I_SQ;
            if (r < 2 * I_F13) { const int w = r / I_F13, q = r % I_F13, kb = q / 88, nb = q % 88, n0 = 32 * nb;
                if (FFN_UP8) p0_transpose_item8(w ? args.ffn_w3 : args.ffn_w1, FFN, 64 * kb, n0, (unsigned char*)W_FFN13, (n0 >> 7) * 256 + w * 128 + (n0 & 127), D, scr, lane);
                else p0_transpose_item(w ? args.ffn_w3 : args.ffn_w1, FFN, 64 * kb, n0, W_FFN13, (n0 >> 7) * 256 + w * 128 + (n0 & 127), D, scr, lane); continue; } r -= 2 * I_F13;
            if (r < I_F2) { const int kb = r / 32, nb = r % 32; if (FFN_DN8) p0_transpose_item8(args.ffn_w2, D, 64 * kb, 32 * nb, (unsigned char*)W_FFN2, 32 * nb, FFN, scr, lane); else p0_transpose_item(args.ffn_w2, D, 64 * kb, 32 * nb, W_FFN2, 32 * nb, FFN, scr, lane); continue; } r -= I_F2;
            if (r < I_GLAIN) { const int kb = r / 96, nb = r % 96; p0_transpose_item(args.gla_w_in, 3072, 64 * kb, 32 * nb, W_GLAIN, 32 * nb, D, scr, lane); continue; } r -= I_GLAIN;
            if (r < I_SQ) { const int kb = r / 32, nb = r % 32; p0_transpose_item(args.gla_w_out, D, 64 * kb, 32 * nb, W_GLAOUT, 32 * nb, D, scr, lane); continue; } r -= I_SQ;
            if (r < I_GA) {
                const int j = r; float a2[16];
#pragma unroll
                for (int q = 0; q < 16; ++q) a2[q] = args.gla_w_a2[q * 512 + j];
                bf16* dst = W_GLAIN + (size_t)(3072 + j) * D + lane * 16;
                unsigned pk[8];
#pragma unroll
                for (int kk = 0; kk < 16; kk += 2) { float s0 = 0.f, s1 = 0.f; const float* w1p = args.gla_w_a1 + (size_t)(lane * 16 + kk) * 16;
#pragma unroll
                    for (int q = 0; q < 16; ++q) { s0 += w1p[q] * a2[q]; s1 += w1p[16 + q] * a2[q]; }
                    pk[kk >> 1] = pk2(s0, s1); }
                *(u32x4*)dst = (u32x4){pk[0], pk[1], pk[2], pk[3]}; *(u32x4*)(dst + 8) = (u32x4){pk[4], pk[5], pk[6], pk[7]};
                continue; }
        }
    }
    SEAM(0);

#define NORM_LOAD(XSRC, SRC16, m_, v_, s_) do { s_ = 0.f; \
            _Pragma("unroll") for (int j = 0; j < 4; ++j) { v_[j] = (SRC16) ? ld_bf16x4((const bf16*)(XSRC) + (size_t)(m_) * D + 4 * lane + 256 * j) : *((const f32x4*)((const float*)(XSRC) + (size_t)(m_) * D) + lane + 64 * j); s_ += (v_[j][0] * v_[j][0] + v_[j][1] * v_[j][1]) + (v_[j][2] * v_[j][2] + v_[j][3] * v_[j][3]); } } while (0)
#define NORM_ROW(GVEC, MODROW, ROUTER, OUT8, m_, v_, s_) do { const int m = (m_); const int b = m >> 12; f32x4 (&v)[4] = v_; \
            const float* mrow = (MODROW) + (size_t)b * 6144; \
            const float rstd = __builtin_amdgcn_rsqf(wave_sum(s_) * (1.0f / D) + EPS); \
            _Pragma("unroll") for (int j = 0; j < 4; ++j) { const f32x4 gg = *((const f32x4*)(GVEC) + lane + 64 * j), sh = *((const f32x4*)mrow + lane + 64 * j), sc = *((const f32x4*)(mrow + 1024) + lane + 64 * j); \
                v[j] = v[j] * rstd * gg * (sc + 1.0f) + sh; } \
            if (OUT8) { unsigned* o4 = (unsigned*)((unsigned char*)HB + (size_t)m * D) + lane; \
                _Pragma("unroll") for (int j = 0; j < 4; ++j) o4[64 * j] = pk_fp8x4(v[j][0] * H8_SCALE, v[j][1] * H8_SCALE, v[j][2] * H8_SCALE, v[j][3] * H8_SCALE); } \
            else { u32x2* o8 = (u32x2*)(HB + (size_t)m * D) + lane; \
                _Pragma("unroll") for (int j = 0; j < 4; ++j) o8[64 * j] = (u32x2){pk2(v[j][0], v[j][1]), pk2(v[j][2], v[j][3])}; } \
            if (ROUTER) { ROUTER_BODY } } while (0)
#define NORM_PHASE(XSRC, SRC16, GVEC, MODROW, ROUTER, OUT8) do { \
        const int rpw = (M + NGW - 1) / NGW; const int r_lo = (ROUTER ? (bx * NWAVES + wave) : gw) * rpw; \
        for (int rr = 0; rr < rpw; rr += 2) { const int m0 = r_lo + rr; if (m0 >= M) break; const bool two = (rr + 1 < rpw) && (m0 + 1 < M); \
            f32x4 va[4], vb[4]; float sa, sb = 0.f; \
            NORM_LOAD(XSRC, SRC16, m0, va, sa); if (two) NORM_LOAD(XSRC, SRC16, m0 + 1, vb, sb); \
            NORM_ROW(GVEC, MODROW, ROUTER, OUT8, m0, va, sa); if (two) NORM_ROW(GVEC, MODROW, ROUTER, OUT8, m0 + 1, vb, sb); } } while (0)
#define ROUTER_BODY
    if (IN(1)) { NORM_PHASE(args.x, false, args.norm1_g, MOD, 0, false); }
    SEAM(1);

    if (IN(2)) {
        pg8::DenseSched S; S.init(M / 256, 12, G, bx); S.A = (const char*)HB; S.Bt = (const char*)W_DAIN; S.tstep = (size_t)256 * D * 2;
        pg8::EpiQKV E{QB, (size_t)M * D, args.da_q_gain, args.da_k_gain, 0.125f * LOG2E};
        pg8::gemm_phase<pg8::EpiQKV, pg8::DenseSched, true, false>(lds, 2 * D, S, E);
    }
    SEAM(2);

    if (IN(3)) {
        float a1 = args.da_lam_q1[lane] * args.da_lam_k1[lane], a2 = args.da_lam_q2[lane] * args.da_lam_k2[lane];
        const float lam = __expf(wave_sum(a1)) - __expf(wave_sum(a2)) + 0.2f;
        const float gq0 = wave_max(fabsf(args.da_q_gain[lane])), gq1 = wave_max(fabsf(args.da_q_gain[64 + lane]));
        const float gk0 = wave_max(fabsf(args.da_k_gain[lane])), gk1 = wave_max(fabsf(args.da_k_gain[64 + lane]));
        const float mref0 = 8.0f * LOG2E * gq0 * gk0 * 1.01f, mref1 = 8.0f * LOG2E * gq1 * gk1 * 1.01f;
        for (int rep = 0; rep < (PROBE_DUP == 3 ? 2 : 1); ++rep)
        for (int bb = vcu >> 4; bb < BATCH; bb += (G >= 16 ? (G >> 4) : 1)) {
            const int w16 = vcu & 15, nu = att::PLAN.n[w16];
            for (int i = 0; i < nu; ++i) { const int hj = att::PLAN.u[w16][i], h = hj >> 5, jq = hj & 31;
                const float sl2 = LOG2E * exp2f(-(float)(h + 1));
                att::attn_unit(lds, QB, KB, VB, HB, bb, h, jq, sl2, mref0, mref1, lam, args.da_subln_g); }
        }
    }
    SEAM(3);

    if (IN(4)) {
        pg8::DenseSched S; S.init(M / 256, 4, G, bx); S.A = (const char*)HB; S.Bt = (const char*)W_DAOUT; S.tstep = (size_t)256 * D * 2;
        pg8::EpiResid<false, true> E{args.x, XB, MOD + 2048, 1.0f};
        pg8::gemm_phase<pg8::EpiResid<false, true>, pg8::DenseSched, true, false>(lds, 2 * D, S, E);
    }
    SEAM(4);
    if (IN(5)) { NORM_PHASE(XB, true, args.norm2_g, MOD + 3072, 0, FFN_UP8); }
    SEAM(5);

    if (IN(6)) {
        pg8::DenseSched S; S.init(M / 256, 2 * FFN / 256, G, bx); S.A = (const char*)HB; S.Bt = (const char*)W_FFN13; S.tstep = (size_t)256 * D * (FFN_UP8 ? 1 : 2);
        pg8::EpiSwiGLU<FFN_DN8> E{ACTB, FFN, FFN_UP8 ? 1.0f / (H8_SCALE * W8_SCALE) : 1.0f};
        pg8::gemm_phase<pg8::EpiSwiGLU<FFN_DN8>, pg8::DenseSched, true, false, FFN_UP8>(lds, D * (FFN_UP8 ? 1 : 2), S, E);
    }
    SEAM(6);
    if (IN(7)) {
        pg8::DenseSched S; S.init(M / 256, 4, G, bx); S.A = (const char*)ACTB; S.Bt = (const char*)W_FFN2; S.tstep = (size_t)256 * FFN * (FFN_DN8 ? 1 : 2);
        pg8::EpiResid<true, true> E{XB, XB, MOD + 5 * 1024, FFN_DN8 ? 1.0f / (A8_SCALE * W8_SCALE) : 1.0f};
        pg8::gemm_phase<pg8::EpiResid<true, true>, pg8::DenseSched, true, false, FFN_DN8>(lds, FFN * (FFN_DN8 ? 1 : 2), S, E);
    }
    SEAM(7);

    float* MOD1 = MOD + 16 * 6144;
    if (IN(8)) { NORM_PHASE(XB, true, args.norm1_g + D, MOD1, 0, false); }
    SEAM(8);
    if (IN(9)) {
        pg8::DenseSched S; S.init(M / 256, GLA_N / 256, G, bx); S.A = (const char*)HB; S.Bt = (const char*)W_GLAIN; S.tstep = (size_t)256 * D * 2;
        pg8::EpiGLA E{GP, GLAB, args.gla_b_a, args.gla_out_g};
        pg8::gemm_phase<pg8::EpiGLA, pg8::DenseSched, true, false>(lds, 2 * D, S, E);
    }
    SEAM(9);

    unsigned char* GA = (unsigned char*)out;
    static_assert(4096 * GA_UNIT <= 192 * MiB && 256 * MiB <= (size_t)M * D * 4 && (size_t)M * 512 * 2 >= 64 * MiB, "o-fragment parking");
#define OFRAG(b_, n_, h_) (((b_) < 8 ? (unsigned char*)GLAB : (unsigned char*)out + 192 * MiB) + (size_t)(((((b_) & 7) * 64 + (n_)) * 4) + (h_)) * 32768)
    if (IN(10)) {
        LAS unsigned char* QDp = lds; LAS unsigned char* KDTc = lds + 16384; LAS unsigned char* ATc = lds + 32768; LAS float* DV = (LAS float*)(lds + 40960);
        LAS bf16* KI = (LAS bf16*)(lds + 43008); LAS float* QT = (LAS float*)(lds + 60416);
        const int fr = lane & 15, fq = lane >> 4;
        const int j = tid & 127, tq = tid >> 7;
        const int cq = j >> 4, wq = j & 15, hq = (wq >> 2) & 1, jq2 = ((wq >> 3) << 2) | (wq & 3);
        for (int rep = 0; rep < (PROBE_DUP == 10 ? 2 : 1); ++rep)
        for (int u = bx; u < 4096; u += G) {
            const int h = u & 3, n = (u >> 2) & 63, b = u >> 8;
            const size_t R0 = (size_t)b * SEQ + 64 * n;
            float la[16], qv[16], kv[16];
#pragma unroll
            for (int i = 0; i < 16; ++i) { const size_t row = R0 + 16 * tq + i; la[i] = bf2f(GLAB[row * 512 + h * 128 + j]); qv[i] = bf2f(GP[row * 3072 + h * 128 + j]); kv[i] = bf2f(GP[row * 3072 + 512 + h * 128 + j]); }
#pragma unroll
            for (int i = 1; i < 16; ++i) la[i] += la[i - 1];
            QT[tq * 128 + j] = la[15];
            __syncthreads();
            float pre = 0.f, tot = 0.f;
#pragma unroll
            for (int q = 0; q < 4; ++q) { const float v = QT[q * 128 + j]; tot += v; pre += (q < tq) ? v : 0.f; }
            unsigned kdp[8];
#pragma unroll
            for (int i = 0; i < 16; ++i) { const float bb = pre + la[i]; const int t = 16 * tq + i;
                *(LAS bf16*)(QDp + (((cq * 2 + hq) * 64 + t) * 16) + jq2 * 2) = (bf16)f2bf(qv[i] * 0.08838834764831845f * __expf(bb));
                KI[t * 136 + j] = (bf16)f2bf(kv[i] * __expf(-bb));
                const float kd = kv[i] * __expf(tot - bb);
                if (i & 1) kdp[i >> 1] |= f2bf(kd) << 16; else kdp[i >> 1] = f2bf(kd); }
            *(LAS u32x4*)(KDTc + ((2 * tq) * 128 + j) * 16) = (u32x4){kdp[0], kdp[1], kdp[2], kdp[3]};
            *(LAS u32x4*)(KDTc + ((2 * tq + 1) * 128 + j) * 16) = (u32x4){kdp[4], kdp[5], kdp[6], kdp[7]};
            if (tq == 0) DV[j] = __expf(tot);
            __syncthreads();
#pragma unroll
            for (int q = 0; q < 2; ++q) { const int idx = 2 * wave + q, ti = idx >> 2, si = idx & 3;
                f32x4 c = (f32x4){0.f, 0.f, 0.f, 0.f};
                if (si <= ti) {
#pragma unroll
                    for (int ks = 0; ks < 4; ++ks) { const int cc = 2 * ks + (fq >> 1), jb = 4 * (fq & 1), t = 16 * ti + fr;
                        const u32x2 alo = *(const LAS u32x2*)(QDp + (((cc * 2 + 0) * 64 + t) * 16) + jb * 2), ahi = *(const LAS u32x2*)(QDp + (((cc * 2 + 1) * 64 + t) * 16) + jb * 2);
                        const u32x4 af = (u32x4){alo[0], alo[1], ahi[0], ahi[1]};
                        const bf16x8 bfr = *(const LAS bf16x8*)(KI + (16 * si + fr) * 136 + 32 * ks + 8 * fq);
                        c = __builtin_amdgcn_mfma_f32_16x16x32_bf16(__builtin_bit_cast(bf16x8, af), bfr, c, 0, 0, 0); }
                }
#pragma unroll
                for (int r = 0; r < 4; ++r) { const int t = 16 * ti + 4 * fq + r, sx = 16 * si + fr; *(LAS bf16*)(ATc + (((sx >> 3) * 64 + t) * 16) + (sx & 7) * 2) = (bf16)f2bf(sx <= t ? c[r] : 0.f); } }
            __syncthreads();
            { u32x4* dst = (u32x4*)(GA + (size_t)u * GA_UNIT);
              for (int v = tid; v < 41472 / 16; v += 512) dst[v] = *(const LAS u32x4*)(lds + v * 16); }
            __syncthreads();
        }
    }
    SEAM(10);

    const int sstride = G >= 256 ? 4 : (G >= 128 ? 2 : 1);
    const bool is_scan = (vcu % sstride == 0) && (vcu / sstride < 64);
    const int scan_id = vcu / sstride;
    const int copy_id = vcu < 64 * sstride ? (vcu / sstride) * (sstride - 1) + (vcu % sstride) - 1 : 64 * (sstride - 1) + (vcu - 64 * sstride);
    if (IN(11) && !is_scan) {
        LAS float* scr = (LAS float*)(lds + wave * 16384);
        constexpr int I_M13 = 16 * 112, I_M2 = 56 * 32, NIT = NEXP * 2 * I_M13 + NEXP * I_M2;
        const int nwv = (G - 64) * NWAVES;
        for (int rep = 0; rep < (PROBE_DUP == 20 ? 2 : 1); ++rep)
        for (int it = copy_id * NWAVES + wave; it < NIT; it += nwv) {
            int r = it;
            if (r < NEXP * 2 * I_M13) { const int e = r / (2 * I_M13), q2 = r % (2 * I_M13), w = q2 / I_M13, q = q2 % I_M13, kb = q / 112, nb = q % 112, n0 = 32 * nb;
                if (MOE_UP8) p0_transpose_item8((w ? args.moe_w3 : args.moe_w1) + (size_t)e * D * EXPD, EXPD, 64 * kb, n0, (unsigned char*)W_MOE13 + (size_t)e * 2 * EXPD * D, (n0 >> 7) * 256 + w * 128 + (n0 & 127), D, scr, lane);
                else p0_transpose_item((w ? args.moe_w3 : args.moe_w1) + (size_t)e * D * EXPD, EXPD, 64 * kb, n0, W_MOE13 + (size_t)e * 2 * EXPD * D, (n0 >> 7) * 256 + w * 128 + (n0 & 127), D, scr, lane); continue; }
            r -= NEXP * 2 * I_M13;
            { const int e = r / I_M2, q = r % I_M2, kb = q / 32, nb = q % 32;
                if (MOE_DN8) p0_transpose_item8(args.moe_w2 + (size_t)e * EXPD * D, D, 64 * kb, 32 * nb, (unsigned char*)W_MOE2 + (size_t)e * D * EXPD, 32 * nb, EXPD, scr, lane);
                else p0_transpose_item(args.moe_w2 + (size_t)e * EXPD * D, D, 64 * kb, 32 * nb, W_MOE2 + (size_t)e * D * EXPD, 32 * nb, EXPD, scr, lane); }
        }
    }
    if (IN(11) && is_scan) {
        const int b = scan_id >> 2, h = scan_id & 3;
        constexpr int BUFB = 74752, VOFF = 41984, GO_OFF = 2 * BUFB;
        LAS float* GO = (LAS float*)(lds + GO_OFF);
        if (tid < 256) GO[tid] = args.gla_out_g[tid];
        const int r32 = lane & 31, hh = lane >> 5;
        const int c0 = 32 * wave;
        const unsigned char* gabase = GA + ((size_t)b * 256 + h) * GA_UNIT;
        const bf16* vsrc = GP + ((size_t)b * SEQ + (lane >> 2)) * 3072 + 1024 + h * 256 + 32 * wave + (lane & 3) * 8;
#define GLA_DMA(n_, bs_) do { LAS unsigned char* bb_ = lds + (bs_) * BUFB; const unsigned char* ga_ = gabase + (size_t)(n_) * 4 * GA_UNIT; \
        _Pragma("unroll") for (int k_ = 0; k_ < 6; ++k_) { int p_ = wave + 8 * k_; p_ = p_ > 40 ? 40 : p_; \
            __builtin_amdgcn_global_load_lds((const unsigned*)(ga_ + p_ * 1024 + lane * 16), (LAS unsigned*)(bb_ + p_ * 1024), 16, 0, 0); } \
        _Pragma("unroll") for (int ks_ = 0; ks_ < 4; ++ks_) \
            __builtin_amdgcn_global_load_lds((const unsigned*)(vsrc + ((size_t)(n_) * 64 + 16 * ks_) * 3072), (LAS unsigned*)(bb_ + VOFF + (ks_ * 8 + wave) * 1024), 16, 0, 0); } while (0)
#define GLA_BAR() do { asm volatile("s_waitcnt lgkmcnt(0)" ::: "memory"); __builtin_amdgcn_s_barrier(); asm volatile("" ::: "memory"); } while (0)
        for (int rep = 0; rep < (PROBE_DUP == 11 ? 2 : 1); ++rep) {
        f32x16 Sacc[4];
#pragma unroll
        for (int kt = 0; kt < 4; ++kt)
#pragma unroll
            for (int r = 0; r < 16; ++r) Sacc[kt][r] = 0.f;
        GLA_DMA(0, 0);
        asm volatile("s_waitcnt vmcnt(0)" ::: "memory");
        for (int n = 0; n < 64; ++n) {
            const size_t R0 = (size_t)b * SEQ + 64 * n;
            asm volatile("s_waitcnt vmcnt(4)" ::: "memory");
            GLA_BAR();
            if (n + 1 < 64) GLA_DMA(n + 1, (n + 1) & 1);
            LAS unsigned char* bb = lds + (n & 1) * BUFB;
            const LAS unsigned char* QDp = bb; const LAS unsigned char* KDTc = bb + 16384; const LAS unsigned char* ATc = bb + 32768; const LAS float* DV = (const LAS float*)(bb + 40960);
            bf16x8 vf[4];
#pragma unroll
            for (int ks = 0; ks < 4; ++ks) { const LAS unsigned char* vp = bb + VOFF + (ks * 8 + wave) * 1024 + ((lane >> 4) & 1) * 32 + (lane & 3) * 8 + (8 * hh + ((lane & 15) >> 2)) * 64;
                const s16x4 lo = att::vtr(vp), hi4 = att::vtr(vp + 256); vf[ks] = (bf16x8){lo[0], lo[1], lo[2], lo[3], hi4[0], hi4[1], hi4[2], hi4[3]}; }
            f32x16 o[2];
#pragma unroll
            for (int tt = 0; tt < 2; ++tt)
#pragma unroll
                for (int r = 0; r < 16; ++r) o[tt][r] = 0.f;
            bf16x8 qa[16], aa[6];
#pragma unroll
            for (int kt = 0; kt < 4; ++kt)
#pragma unroll
                for (int sx = 0; sx < 2; ++sx)
#pragma unroll
                    for (int tt = 0; tt < 2; ++tt) qa[(kt * 2 + sx) * 2 + tt] = *(const LAS bf16x8*)(QDp + ((((kt * 2 + sx) * 2 + hh) * 64 + 32 * tt + r32) * 16));
#pragma unroll
            for (int i = 0; i < 6; ++i) { const int tt = i < 2 ? 0 : 1, ks = i < 2 ? i : i - 2;
                aa[i] = *(const LAS bf16x8*)(ATc + (((2 * ks + hh) * 64 + 32 * tt + r32) * 16)); }
            __builtin_amdgcn_sched_barrier(0);
#pragma unroll
            for (int kt = 0; kt < 4; ++kt)
#pragma unroll
                for (int sx = 0; sx < 2; ++sx) {
                    u32x4 sb;
#pragma unroll
                    for (int g = 0; g < 4; ++g) sb[g] = cvt_pk_bf16(Sacc[kt][8 * sx + 2 * g], Sacc[kt][8 * sx + 2 * g + 1]);
#pragma unroll
                    for (int tt = 0; tt < 2; ++tt) o[tt] = __builtin_amdgcn_mfma_f32_32x32x16_bf16(qa[(kt * 2 + sx) * 2 + tt], __builtin_bit_cast(bf16x8, sb), o[tt], 0, 0, 0);
                }
#pragma unroll
            for (int i = 0; i < 6; ++i) { const int tt = i < 2 ? 0 : 1, ks = i < 2 ? i : i - 2;
                o[tt] = __builtin_amdgcn_mfma_f32_32x32x16_bf16(aa[i], vf[ks], o[tt], 0, 0, 0); }
            __builtin_amdgcn_sched_barrier(0);
            { u32x4* dst = (u32x4*)(OFRAG(b, n, h)) + (wave * 4) * 64 + lane;
#pragma unroll
              for (int tt = 0; tt < 2; ++tt)
#pragma unroll
                  for (int q = 0; q < 2; ++q) { u32x4 w;
#pragma unroll
                      for (int g = 0; g < 4; ++g) w[g] = cvt_pk_bf16(o[tt][8 * q + 2 * g], o[tt][8 * q + 2 * g + 1]);
                      dst[(tt * 2 + q) * 64] = w; } }
            __builtin_amdgcn_sched_barrier(0);
            f32x4 dvv[16]; bf16x8 ka[16];
#pragma unroll
            for (int kt = 0; kt < 4; ++kt)
#pragma unroll
                for (int g = 0; g < 4; ++g) dvv[kt * 4 + g] = *(const LAS f32x4*)(DV + 32 * kt + 8 * g + 4 * hh);
#pragma unroll
            for (int ks = 0; ks < 4; ++ks)
#pragma unroll
                for (int kt = 0; kt < 4; ++kt) ka[ks * 4 + kt] = *(const LAS bf16x8*)(KDTc + (((2 * ks + hh) * 128 + 32 * kt + r32) * 16));
            __builtin_amdgcn_sched_barrier(0);
#pragma unroll
            for (int kt = 0; kt < 4; ++kt)
#pragma unroll
                for (int g = 0; g < 4; ++g)
#pragma unroll
                    for (int e = 0; e < 4; ++e) Sacc[kt][4 * g + e] *= dvv[kt * 4 + g][e];
#pragma unroll
            for (int ks = 0; ks < 4; ++ks)
#pragma unroll
                for (int kt = 0; kt < 4; ++kt) Sacc[kt] = __builtin_amdgcn_mfma_f32_32x32x16_bf16(ka[ks * 4 + kt], vf[ks], Sacc[kt], 0, 0, 0);
        }
        asm volatile("s_waitcnt vmcnt(0)" ::: "memory");
        GLA_BAR();
        }
#undef GLA_DMA
#undef GLA_BAR
    }
    if (IN(11)) {
        static_assert(MK_N_LAUNCHES == 1, "the scan follow-up sits behind an in-phase grid barrier");
        xcd_barrier(bar);
        LAS float* OS = (LAS float*)lds;
        const int r32 = lane & 31, hh = lane >> 5, c0 = 32 * wave;
        u32x4 fr[4], rwv[4];
#define P10C_LOAD(u_) do { const int b_ = (u_) >> 8, n_ = ((u_) >> 2) & 63, h_ = (u_) & 3; const u32x4* src_ = (const u32x4*)(OFRAG(b_, n_, h_)) + (wave * 4) * 64 + lane; \
            _Pragma("unroll") for (int k_ = 0; k_ < 4; ++k_) fr[k_] = src_[k_ * 64]; \
            const bf16* rp0_ = GP + ((size_t)b_ * SEQ + 64 * n_ + (tid >> 3)) * 3072 + 2048 + h_ * 256 + 32 * (tid & 7); \
            _Pragma("unroll") for (int i_ = 0; i_ < 4; ++i_) rwv[i_] = *(const u32x4*)(rp0_ + 8 * i_); } while (0)
        int u = bx;
        if (u < 4096) P10C_LOAD(u);
        for (; u < 4096; u += G) {
            const int b = u >> 8, n = (u >> 2) & 63, h = u & 3; const size_t R0 = (size_t)b * SEQ + 64 * n;
            u32x4 rw_c[4];
#pragma unroll
            for (int i = 0; i < 4; ++i) rw_c[i] = rwv[i];
            __syncthreads();
#pragma unroll
            for (int tt = 0; tt < 2; ++tt)
#pragma unroll
                for (int q = 0; q < 2; ++q)
#pragma unroll
                    for (int g = 0; g < 4; ++g) { const unsigned w = fr[tt * 2 + q][g]; const int r = 8 * q + 2 * g;
                        OS[(32 * tt + att::crow(r, hh)) * 260 + c0 + r32] = __builtin_bit_cast(float, w << 16);
                        OS[(32 * tt + att::crow(r + 1, hh)) * 260 + c0 + r32] = __builtin_bit_cast(float, w & 0xffff0000u); }
            __syncthreads();
            if (u + G < 4096) P10C_LOAD(u + G);
            { const int t = tid >> 3, seg = tid & 7; f32x4 ov[8]; float ss = 0.f;
#pragma unroll
              for (int i = 0; i < 8; ++i) { ov[i] = *(const LAS f32x4*)(OS + t * 260 + 32 * seg + 4 * i); ss += (ov[i][0] * ov[i][0] + ov[i][1] * ov[i][1]) + (ov[i][2] * ov[i][2] + ov[i][3] * ov[i][3]); }
              ss += __shfl_xor(ss, 1); ss += __shfl_xor(ss, 2); ss += __shfl_xor(ss, 4);
              const float rs = __builtin_amdgcn_rsqf(ss * (1.0f / 256.0f) + EPS);
              bf16* op = HB + (R0 + t) * D + h * 256 + 32 * seg;
#pragma unroll
              for (int i = 0; i < 4; ++i) { const u32x4 rw = rw_c[i]; u32x4 w;
#pragma unroll
                  for (int e = 0; e < 4; ++e) { const float r0 = __builtin_bit_cast(float, rw[e] << 16), r1 = __builtin_bit_cast(float, rw[e] & 0xffff0000u);
                      const int cidx = 8 * i + 2 * e;
                      const float v0 = ov[(cidx) >> 2][(cidx) & 3] * rs * r0, v1 = ov[(cidx + 1) >> 2][(cidx + 1) & 3] * rs * r1;
                      w[e] = pk2(v0, v1); }
                  *(u32x4*)(op + 8 * i) = w; } }
        }
#undef P10C_LOAD
    }
    SEAM(11);


    if (IN(12)) {
        pg8::DenseSched S; S.init(M / 256, 4, G, bx); S.A = (const char*)HB; S.Bt = (const char*)W_GLAOUT; S.tstep = (size_t)256 * D * 2;
        pg8::EpiResid<true, true> E{XB, XB, MOD1 + 2048, 1.0f};
        pg8::gemm_phase<pg8::EpiResid<true, true>, pg8::DenseSched, true, false>(lds, 2 * D, S, E);
    }
    SEAM(12);

    if (IN(13)) {
        LAS float* RW = (LAS float*)lds;
        LAS unsigned* EL = (LAS unsigned*)(lds + 32768);
        LAS float* GL = (LAS float*)(lds + 32768 + 4096);
        for (int e = tid; e < 8192; e += 512) { const int k = e >> 3, ex = e & 7;
            RW[((((k >> 8) * 4 + (k & 3)) * 2 + (ex >> 2)) * 64 + ((k & 255) >> 2)) * 4 + (ex & 3)] = args.moe_router[e]; }
        __syncthreads();
#undef ROUTER_BODY
#define ROUTER_BODY { float lg[8]; \
            _Pragma("unroll") for (int e = 0; e < 8; ++e) lg[e] = 0.f; \
            _Pragma("unroll") for (int j = 0; j < 4; ++j) _Pragma("unroll") for (int i = 0; i < 4; ++i) { const f32x4 w0 = *((const LAS f32x4*)RW + ((j * 4 + i) * 2) * 64 + lane), w1 = *((const LAS f32x4*)RW + ((j * 4 + i) * 2 + 1) * 64 + lane); const float hv = v[j][i]; \
                lg[0] += hv * w0[0]; lg[1] += hv * w0[1]; lg[2] += hv * w0[2]; lg[3] += hv * w0[3]; lg[4] += hv * w1[0]; lg[5] += hv * w1[1]; lg[6] += hv * w1[2]; lg[7] += hv * w1[3]; } \
            _Pragma("unroll") for (int e = 0; e < 8; ++e) lg[e] = wave_sum(lg[e]); \
            float v1 = lg[0]; \
            _Pragma("unroll") for (int e = 1; e < 8; ++e) v1 = fmaxf(v1, lg[e]); \
            int e1 = 7; \
            _Pragma("unroll") for (int e = 6; e >= 0; --e) e1 = (lg[e] == v1) ? e : e1; \
            float v2 = -3.0e38f; \
            _Pragma("unroll") for (int e = 0; e < 8; ++e) v2 = fmaxf(v2, (e == e1) ? -3.0e38f : lg[e]); \
            int e2 = -1; \
            _Pragma("unroll") for (int e = 7; e >= 0; --e) e2 = (e != e1 && lg[e] == v2) ? e : e2; \
            if (lane == 0) { EL[m - wg_row0] = (unsigned)e1 | ((unsigned)e2 << 8); GL[m - wg_row0] = v1 - v2; } }
        const int rpw12 = (M + NGW - 1) / NGW, rows_wg12 = rpw12 * NWAVES, wg_row0 = bx * rows_wg12;
        NORM_PHASE(XB, true, args.norm2_g + D, MOD1 + 3072, 1, MOE_UP8);
        __syncthreads();
        {
            int nrows = M - wg_row0; nrows = nrows > rows_wg12 ? rows_wg12 : nrows;
            for (int r = tid; r < nrows; r += 512) { const unsigned ew = EL[r]; const unsigned e1 = ew & 255u, e2 = ew >> 8; unsigned l1 = 0, l2 = 0;
                for (int q = 0; q < r; ++q) { const unsigned w = EL[q]; l1 += ((w & 255u) == e1) ? 1u : 0u; l2 += ((w >> 8) == e2) ? 1u : 0u; }
                ROUTE[wg_row0 + r] = (u32x4){ew, __builtin_bit_cast(unsigned, GL[r]), l1, l2}; }
            if (tid < 16) { const unsigned e = tid & 7; unsigned cnt = 0; for (int q = 0; q < nrows; ++q) { const unsigned w = EL[q]; cnt += ((tid < 8 ? (w & 255u) : (w >> 8)) == e) ? 1u : 0u; } LCNT[bx * 16 + tid] = cnt; }
        }
    }
    SEAM(13);

    if (IN(14)) {
        LAS int* PRE = (LAS int*)lds;
        LAS int* GOFF = (LAS int*)(lds + 256);
        if (tid < 16) { int pre = 0, tot = 0; for (int w = 0; w < G; ++w) { const int v = (int)LCNT[w * 16 + tid]; tot += v; pre += (w < bx) ? v : 0; } PRE[tid] = pre; ((LAS int*)(lds + 512))[tid] = (tot + 255) & ~255; }
        __syncthreads();
        if (tid < 2) { int acc = 0; for (int e = 0; e < 8; ++e) { GOFF[tid * 9 + e] = acc; acc += ((LAS int*)(lds + 512))[tid * 8 + e]; } GOFF[tid * 9 + 8] = acc;
            if (bx == 0) { for (int e = 0; e < 9; ++e) META[tid * 16 + e] = GOFF[tid * 9 + e]; } }
        __syncthreads();
        const int rpw = (M + NGW - 1) / NGW, rows_wg = rpw * NWAVES;
        for (int r = tid; r < rows_wg; r += 512) { const int m = bx * rows_wg + r; if (m >= M) break;
            const u32x4 rt = ROUTE[m]; const int e1 = rt[0] & 255, e2 = (rt[0] >> 8) & 255; const unsigned gbits = rt[1]; const float gap = __builtin_bit_cast(float, gbits); const float g1 = 1.0f / (1.0f + expf(-gap));
            const int s1 = GOFF[e1] + PRE[e1] + (int)rt[2], s2 = GOFF[9 + e2] + PRE[8 + e2] + (int)rt[3];
            TOKSLOT[s1] = m; GSLOT[s1] = g1; TOKSLOT[MAXSLOT + s2] = m; GSLOT[MAXSLOT + s2] = 1.0f - g1; }
    }
    SEAM(14);

#define MOE_SCHED(S, p) do { const int* mt = META + (p) * 16; S.g1 = mt[1]; S.g2 = mt[2]; S.g3 = mt[3]; S.g4 = mt[4]; S.g5 = mt[5]; S.g6 = mt[6]; S.g7 = mt[7]; } while (0)
#pragma unroll
    for (int p = 0; p < 2; ++p) {
        if (IN(15 + 2 * p)) {
            pg8::MoeSched S; MOE_SCHED(S, p); const int nP = META[p * 16 + 8] >> 8;
            S.init(nP, 2 * EXPD / 256, G, bx); S.A = (const char*)HB; S.a_tstep = 0; S.Bt = (const char*)W_MOE13; S.b_tstep = (size_t)256 * D * (MOE_UP8 ? 1 : 2); S.b_estride = (size_t)2 * EXPD * D * (MOE_UP8 ? 1 : 2);
            S.tokslot = TOKSLOT + p * MAXSLOT; S.rowbytes = D * (MOE_UP8 ? 1 : 2);
            pg8::EpiSwiGLU<MOE_DN8> E{ACTB, EXPD, MOE_UP8 ? 1.0f / (H8_SCALE * W8_SCALE) : 1.0f};
            pg8::gemm_phase<pg8::EpiSwiGLU<MOE_DN8>, pg8::MoeSched, true, true, MOE_UP8>(lds, D * (MOE_UP8 ? 1 : 2), S, E);
        }
        SEAM(15 + 2 * p);
        if (IN(16 + 2 * p)) {
            pg8::MoeSched S; MOE_SCHED(S, p); const int nP = META[p * 16 + 8] >> 8;
            constexpr int RBD = EXPD * (MOE_DN8 ? 1 : 2), NTD = RBD / 128;
            int nPm = nP, jpart = -1; const int qpart = bx & 7;
            { const int nwg = nP * 4, nfull = nwg / G, nrem = nwg - nfull * G; if (nrem > 0 && 8 * nrem <= G && (nfull * G) % 4 == 0 && NTD >= 16) { nPm = nfull * G / 4; if (bx < 8 * nrem) jpart = bx >> 3; } }
            S.init(nPm, 4, G, bx); S.A = (const char*)ACTB; S.a_tstep = (size_t)256 * RBD; S.Bt = (const char*)W_MOE2; S.b_tstep = (size_t)256 * RBD; S.b_estride = (size_t)D * RBD;
            S.tokslot = TOKSLOT + p * MAXSLOT; S.rowbytes = 0;
#define MOE_DOWN(FINAL_) do { pg8::EpiMoeDown<FINAL_> E{TOKSLOT + p * MAXSLOT, GSLOT + p * MAXSLOT, XB, out, MOD1 + 5 * 1024, MOE_DN8 ? 1.0f / (A8_SCALE * W8_SCALE) : 1.0f}; \
                if (nPm > 0) pg8::gemm_phase<pg8::EpiMoeDown<FINAL_>, pg8::MoeSched, true, false, MOE_DN8>(lds, RBD, S, E); \
                if (jpart >= 0) {       \
                    const int gsz = nP - nPm; pg8::Unit u; u.pm = nPm + jpart % gsz; u.pn = jpart / gsz; \
                    { pg8::MoeSchedTail T; MOE_SCHED(T, p); T.init(nP, 4, G, bx); T.A = S.A; T.a_tstep = S.a_tstep; T.Bt = S.Bt; T.b_tstep = S.b_tstep; T.b_estride = S.b_estride; T.tokslot = S.tokslot; T.rowbytes = 0; \
                      constexpr int P = NTD / 2, base = P / 8, extra = P % 8; T.pmT = u.pm; T.pnT = u.pn; T.k0T = 2 * (qpart * base + (qpart < extra ? qpart : extra)); T.nkT = 2 * (base + (qpart < extra ? 1 : 0)); \
                      pg8::EpiPartStore EP{KPART + (size_t)bx * (32 * 512 * 4)}; \
                      pg8::gemm_phase<pg8::EpiPartStore, pg8::MoeSchedTail, true, false, MOE_DN8, true>(lds, RBD, T, EP); } \
                    unsigned* kc = ctl + CW_KCNT + p * 64 + jpart; \
                    asm volatile("s_waitcnt vmcnt(0)" ::: "memory"); __syncthreads(); \
                    if (tid == 0) { __builtin_amdgcn_fence(__ATOMIC_RELEASE, "agent"); asm volatile("s_waitcnt vmcnt(0)" ::: "memory"); (void)xb_add(kc, 1u); \
                        XB_SPIN(xb_ld(kc) < 8u, ctl + CW_BAR); __builtin_amdgcn_fence(__ATOMIC_ACQUIRE, "agent"); asm volatile("s_waitcnt vmcnt(0)" ::: "memory"); } \
                    __syncthreads(); \
                    const int ai = qpart >> 2, m = qpart & 3; \
                    f32x4 v[2][2]; \
                    _Pragma("unroll") for (int bj = 0; bj < 2; ++bj) _Pragma("unroll") for (int n = 0; n < 2; ++n) { f32x4 a = (f32x4){0.f, 0.f, 0.f, 0.f}; \
                        const f32x4* pp = (const f32x4*)(KPART + (size_t)(jpart * 8) * (32 * 512 * 4)) + (size_t)((((ai * 2 + bj) * 4 + m) * 2 + n) * 512 + tid); \
                        _Pragma("unroll") for (int qq = 0; qq < 8; ++qq) a += pp[(size_t)qq * (32 * 512)]; \
                        v[bj][n] = a; } \
                    E.slice(v, u, ai, m, wave >> 2, wave & 3, lane & 15, lane >> 4); } } while (0)
            if (p == 0) MOE_DOWN(false); else MOE_DOWN(true);
#undef MOE_DOWN
        }
        if (p == 0) SEAM(16);
    }
#undef IN
#undef SEAM
}


constexpr int N_PHASES = 19;
extern "C" void kernel_launch(void* const* d_in, const int* in_sizes, int n_in, void* d_out, int out_size, void* d_ws, size_t ws_size, hipStream_t stream) {
    static int grid = 0;
    if (grid == 0) {
        if (n_in != 28 || in_sizes[0] != M * D || out_size != M * D || ws_size < WS_TOTAL) { fprintf(stderr, "kernel_launch: unexpected problem shape (n_in %d, out %d, ws %zu)\n", n_in, out_size, ws_size); grid = -1; return; }
        int dev = 0, cus = 0, per_cu = 0;
        if (hipGetDevice(&dev) != hipSuccess || hipDeviceGetAttribute(&cus, hipDeviceAttributeMultiprocessorCount, dev) != hipSuccess) { grid = -1; return; }
        if (hipFuncSetAttribute((const void*)mk_fwd, hipFuncAttributeMaxDynamicSharedMemorySize, LDS_BYTES) != hipSuccess) { fprintf(stderr, "kernel_launch: hipFuncSetAttribute failed\n"); grid = -1; return; }
        if (hipOccupancyMaxActiveBlocksPerMultiprocessor(&per_cu, (const void*)mk_fwd, NWAVES * 64, LDS_BYTES) != hipSuccess || per_cu < 1) { fprintf(stderr, "kernel_launch: occupancy query reports %d\n", per_cu); }
        (void)hipGetLastError();
        grid = cus;
        if (grid < 128) { fprintf(stderr, "kernel_launch: built for a >= 128-CU device (64 GLA scan workgroups + weight-copy workgroups); got %d\n", grid); grid = -1; return; }
    }
    if (grid < 0) return;
    if (hipMemsetAsync((char*)d_ws + WS_CTL, 0, CTL_ZERO_BYTES, stream) != hipSuccess) return;
    Args a{};
    const float** ap = (const float**)&a;
    for (int i = 0; i < 28; ++i) ap[i] = (const float*)d_in[i];
    a.out = (float*)d_out; a.ws = (unsigned char*)d_ws;
    if (MK_N_LAUNCHES == 1) { a.ph_lo = 0; a.ph_hi = N_PHASES; hipLaunchKernelGGL(mk_fwd, dim3(grid), dim3(NWAVES * 64), LDS_BYTES, stream, a); }
    else { for (int p = 0; p < N_PHASES; ++p) { a.ph_lo = p; a.ph_hi = p + 1; hipLaunchKernelGGL(mk_fwd, dim3(grid), dim3(NWAVES * 64), LDS_BYTES, stream, a); } }
}
```

```cpp
#include <hip/hip_runtime.h>
#include <cstdio>
#include <cstdint>

#ifndef PROBE_DUP
#define PROBE_DUP -1
#endif
#ifndef MK_N_LAUNCHES
#define MK_N_LAUNCHES 1
#endif

#define LAS __attribute__((address_space(3)))
#define GAS __attribute__((address_space(1)))
typedef unsigned short bf16;
typedef short bf16x8 __attribute__((ext_vector_type(8)));
typedef short s16x4 __attribute__((ext_vector_type(4)));
typedef float f32x4 __attribute__((ext_vector_type(4)));
typedef float f32x2 __attribute__((ext_vector_type(2)));
typedef float f32x16 __attribute__((ext_vector_type(16)));
typedef unsigned u32x4 __attribute__((ext_vector_type(4)));
typedef unsigned u32x2 __attribute__((ext_vector_type(2)));

constexpr int D = 1024, BATCH = 16, SEQ = 4096, M = BATCH * SEQ;
constexpr int FFN = 2816, NEXP = 8, EXPD = 3584;
constexpr int GLA_N = 3584;
constexpr float EPS = 1e-6f;
constexpr float LOG2E = 1.4426950408889634f;
constexpr int NWAVES = 8;
constexpr int MAXSLOT = M + NEXP * 256;

constexpr size_t MiB = 1u << 20;
constexpr size_t WS_CTL = 0, CTL_ZERO_BYTES = 64 * 1024;
constexpr size_t WS_MOD = 256 * 1024;
constexpr size_t WS_LCNT = 1 * MiB + 256 * 1024;
constexpr size_t WS_META = 1 * MiB + 512 * 1024;
constexpr size_t WS_ROUTE = 2 * MiB;
constexpr size_t WS_TOKSLOT = 4 * MiB;
constexpr size_t WS_GSLOT = 5 * MiB;
constexpr size_t WS_W_DAIN = 8 * MiB, WS_W_DAOUT = 14 * MiB, WS_W_FFN13 = 16 * MiB, WS_W_FFN2 = 27 * MiB;
constexpr size_t WS_W_GLAIN = 33 * MiB, WS_W_GLAOUT = 40 * MiB, WS_W_MOE13 = 42 * MiB, WS_W_MOE2 = 154 * MiB;
constexpr size_t WS_H = 210 * MiB;
constexpr size_t WS_Q = 338 * MiB;
constexpr size_t WS_END = WS_Q + 464 * MiB;
constexpr size_t WS_XB = WS_END;
constexpr size_t WS_TOTAL = WS_XB + (size_t)M * D * 2;
constexpr size_t GA_UNIT = 43008;
static_assert(4096 * GA_UNIT <= (size_t)M * D * 4, "the GLA per-chunk operands are parked in d_out (free until the last phase writes the result)");
static_assert(WS_TOKSLOT + 2 * MAXSLOT * 4 <= WS_GSLOT && WS_GSLOT + 2 * MAXSLOT * 4 <= WS_W_DAIN, "ws map");
static_assert(WS_W_FFN2 + (size_t)D * FFN * 2 <= WS_W_GLAIN && WS_W_GLAIN + (size_t)GLA_N * D * 2 <= WS_W_GLAOUT, "ws map");
static_assert(WS_W_MOE13 + (size_t)NEXP * 2 * EXPD * D * 2 <= WS_W_MOE2 && WS_W_MOE2 + (size_t)NEXP * D * EXPD * 2 <= WS_H, "ws map");
static_assert((size_t)MAXSLOT * EXPD * 2 <= 464 * MiB && (size_t)M * 3072 * 2 + (size_t)M * 512 * 2 <= 464 * MiB, "ws map");
constexpr int CW_BAR = 4096, CW_KCNT = 8192;

constexpr int RING_BYTES = 131072;
constexpr int TAB_OFF = RING_BYTES;
constexpr int MISC_OFF = 155648;
constexpr int LDS_BYTES = MISC_OFF + 1024;

__device__ __forceinline__ unsigned f2bf(float f) { unsigned u = __builtin_bit_cast(unsigned, f); return (u + 0x7fffu + ((u >> 16) & 1u)) >> 16; }
__device__ __forceinline__ unsigned pk2(float lo, float hi) { return f2bf(lo) | (f2bf(hi) << 16); }
__device__ __forceinline__ float bf2f(unsigned short b) { return __builtin_bit_cast(float, ((unsigned)b) << 16); }
__device__ __forceinline__ unsigned cvt_pk_bf16(float lo, float hi) { unsigned r; asm volatile("v_cvt_pk_bf16_f32 %0, %1, %2" : "=v"(r) : "v"(lo), "v"(hi)); return r; }
__device__ __forceinline__ float wave_sum(float v) {
#pragma unroll
    for (int o = 1; o < 64; o <<= 1) v += __shfl_xor(v, o);
    return v;
}
__device__ __forceinline__ float wave_max(float v) {
#pragma unroll
    for (int o = 1; o < 64; o <<= 1) v = fmaxf(v, __shfl_xor(v, o));
    return v;
}
typedef int v8i __attribute__((ext_vector_type(8)));
typedef int v4i __attribute__((ext_vector_type(4)));
constexpr bool FFN_UP8 = false, FFN_DN8 = true, MOE_UP8 = true, MOE_DN8 = true;
constexpr float W8_SCALE = 64.0f, H8_SCALE = 8.0f, A8_SCALE = 4.0f;
__device__ __forceinline__ float clamp448(float x) { return fminf(fmaxf(x, -448.0f), 448.0f); }
__device__ __forceinline__ unsigned pk_fp8x4(float a, float b, float c, float d) {
    unsigned w = 0u; w = __builtin_amdgcn_cvt_pk_fp8_f32(clamp448(a), clamp448(b), w, false); w = __builtin_amdgcn_cvt_pk_fp8_f32(clamp448(c), clamp448(d), w, true); return w; }
__device__ __forceinline__ f32x4 ld_bf16x4(const bf16* p) { const u32x2 w = *(const u32x2*)p; return (f32x4){__builtin_bit_cast(float, w[0] << 16), __builtin_bit_cast(float, w[0] & 0xffff0000u), __builtin_bit_cast(float, w[1] << 16), __builtin_bit_cast(float, w[1] & 0xffff0000u)}; }
__device__ __forceinline__ void st_bf16x4(bf16* p, f32x4 v) { *(u32x2*)p = (u32x2){cvt_pk_bf16(v[0], v[1]), cvt_pk_bf16(v[2], v[3])}; }
__device__ __forceinline__ float fast_silu(float a) { return a * __builtin_amdgcn_rcpf(1.0f + __builtin_amdgcn_exp2f(-a * LOG2E)); }

namespace pg8 {
constexpr int BM = 256, BK = 64, HALF = 128, HTB = HALF * BK * 2, STAGE_BYTES = 8 * HTB, NXCD = 8, WGM = 8;
__host__ __device__ __forceinline__ int lds_byte(int r, int c) { const int rr = r & 7, ch = (c >> 3) ^ rr; return (r >> 3) * 1024 + (rr * 8 + ch) * 16 + (c & 7) * 2; }
__host__ __device__ __forceinline__ void stage_rc(int b, int& R, int& C) { const int piece = b / 1024, slot = (b % 1024) / 16, rr = slot >> 3, ch = (slot & 7) ^ rr; R = piece * 8 + rr; C = ch * 8; }
__host__ __device__ __forceinline__ int perm32(int rho) { const int n = rho >> 4, i = rho & 15; return 8 * (i >> 2) + 4 * n + (i & 3); }

struct Unit { int pm, pn, k0, nk, part; };
struct TileOrder {
    int nM, nN, nwg, G, c;
    __device__ void init(int nM_, int nN_, int G_, int c_) { nM = nM_; nN = nN_; nwg = nM * nN; G = G_; c = c_; }
    __device__ bool next(int i, Unit& u) const { return at((long)i * G + c, u); }
    __device__ bool at(const long L, Unit& u) const {
        if (L >= nwg) return false;
        int wgid = (int)L; { const int q = nwg / NXCD, r = nwg % NXCD, xcd = wgid % NXCD, off = wgid / NXCD; wgid = (xcd < r ? xcd * (q + 1) : r * (q + 1) + (xcd - r) * q) + off; }
        const int nig = WGM * nN, gid = wgid / nig, fm = gid * WGM, gsz = (nM - fm) < WGM ? (nM - fm) : WGM;
        u.pm = fm + ((wgid % nig) % gsz); u.pn = (wgid % nig) / gsz; return true;
    }
};
struct DenseSched : TileOrder {
    const char* A; const char* Bt; size_t tstep;
    __device__ __forceinline__ const char* a_base(const Unit& u) const { return A + (size_t)u.pm * tstep; }
    __device__ __forceinline__ const char* b_base(const Unit& u) const { return Bt + (size_t)u.pn * tstep; }
    __device__ __forceinline__ unsigned row_off(const Unit&, int) const { return 0u; }
};
struct MoeSched : TileOrder {
    const char* A; const char* Bt; size_t a_tstep, b_tstep, b_estride; const int* tokslot; unsigned rowbytes; int g1, g2, g3, g4, g5, g6, g7;
    __device__ __forceinline__ int expert(int pm) const { const int r = pm * 256; return (r >= g1) + (r >= g2) + (r >= g3) + (r >= g4) + (r >= g5) + (r >= g6) + (r >= g7); }
    __device__ __forceinline__ const char* a_base(const Unit& u) const { return A + (size_t)u.pm * a_tstep; }
    __device__ __forceinline__ const char* b_base(const Unit& u) const { return Bt + (size_t)expert(u.pm) * b_estride + (size_t)u.pn * b_tstep; }
    __device__ __forceinline__ unsigned row_off(const Unit& u, int r) const { int t = tokslot[u.pm * 256 + r]; t = t < 0 ? 0 : t; return (unsigned)t * rowbytes; }
};
struct MoeSchedTail : MoeSched {
    int pmT, pnT, k0T, nkT;
    __device__ bool next(int i, Unit& u) const { if (i != 0) return false; u.pm = pmT; u.pn = pnT; u.k0 = k0T; u.nk = nkT; u.part = 1; return true; }
};

struct EpiQKV {
    static constexpr bool PERM = true;
    bf16* Q; size_t tstride; const float* qg; const float* kg; float qscale;
    __device__ __forceinline__ void operator()(const f32x4 (&acc)[2][2][4][2], const Unit& u, int wr, int wc, int fr, int fq) const {
        const int t = u.pn >> 2;
        bf16* base = Q + (size_t)t * tstride;
        const int lc0 = 256 * (u.pn & 3) + 64 * wc + 8 * fq;
        const int row0 = u.pm * BM + wr * 64 + fr;
        if (t < 2) {
            const float* g = qg; if (t == 1) g = kg;
            g += 64 * (wc & 1) + 8 * fq;
            f32x4 gv[2][2];
#pragma unroll
            for (int bj = 0; bj < 2; ++bj)
#pragma unroll
                for (int n = 0; n < 2; ++n) gv[bj][n] = *(const f32x4*)(g + 32 * bj + 4 * n);
            float sc = 1.0f; if (t == 0) sc = qscale;
#pragma unroll
            for (int ai = 0; ai < 2; ++ai)
#pragma unroll
                for (int m = 0; m < 4; ++m) {
                    float ss = 0.f;
#pragma unroll
                    for (int bj = 0; bj < 2; ++bj)
#pragma unroll
                        for (int n = 0; n < 2; ++n) { const f32x4 x = acc[ai][bj][m][n]; ss += (x[0] * x[0] + x[1] * x[1]) + (x[2] * x[2] + x[3] * x[3]); }
                    ss += __shfl_xor(ss, 16); ss += __shfl_xor(ss, 32);
                    const float rs = __builtin_amdgcn_rsqf(ss * (1.0f / 64.0f) + EPS) * sc;
                    const int R = row0 + ai * HALF + m * 16;
                    bf16* rowp = base + (size_t)R * D + lc0;
#pragma unroll
                    for (int bj = 0; bj < 2; ++bj) { const f32x4 v0 = acc[ai][bj][m][0] * rs * gv[bj][0], v1 = acc[ai][bj][m][1] * rs * gv[bj][1];
                        u32x4 w; w.x = cvt_pk_bf16(v0[0], v0[1]); w.y = cvt_pk_bf16(v0[2], v0[3]); w.z = cvt_pk_bf16(v1[0], v1[1]); w.w = cvt_pk_bf16(v1[2], v1[3]);
                        if (t == 1) {
                            const int col = lc0 + 32 * bj, hh_ = col >> 7, cg = (col & 127) >> 3, b_ = R >> 12, s_ = R & 4095;
                            *(u32x4*)(base + ((((size_t)(b_ * 8 + hh_) * 64 + (s_ >> 6)) * 16 + cg) * 64 + (s_ & 63)) * 8) = w; }
                        else *(u32x4*)(rowp + 32 * bj) = w; }
                }
        } else {
#pragma unroll
            for (int ai = 0; ai < 2; ++ai)
#pragma unroll
                for (int m = 0; m < 4; ++m) { const int R = row0 + ai * HALF + m * 16, b_ = R >> 12, s_ = R & 4095;
#pragma unroll
                    for (int bj = 0; bj < 2; ++bj) { const f32x4 v0 = acc[ai][bj][m][0], v1 = acc[ai][bj][m][1];
                        u32x4 w; w.x = cvt_pk_bf16(v0[0], v0[1]); w.y = cvt_pk_bf16(v0[2], v0[3]); w.z = cvt_pk_bf16(v1[0], v1[1]); w.w = cvt_pk_bf16(v1[2], v1[3]);
                        const int col = lc0 + 32 * bj, hh_ = col >> 7, c_ = col & 127, p_ = (c_ >> 5) * 4 + ((s_ & 63) >> 4), li = ((s_ & 15) << 2) + ((c_ & 31) >> 3);
                        *(u32x4*)(base + ((((size_t)(b_ * 8 + hh_) * 64 + (s_ >> 6)) * 16 + p_) * 64 + li) * 8) = w; } }
        }
    }
};
template <bool BASE16, bool OUT16> struct EpiResid {
    static constexpr bool PERM = true;
    const void* base; void* out; const float* gate; float descale;
    __device__ __forceinline__ void operator()(const f32x4 (&acc)[2][2][4][2], const Unit& u, int wr, int wc, int fr, int fq) const {
        const int row0 = u.pm * BM + wr * 64 + fr, col0 = u.pn * BM + wc * 32 + 8 * fq, b = u.pm >> 4;
        f32x4 gv[2][2];
#pragma unroll
        for (int bj = 0; bj < 2; ++bj)
#pragma unroll
            for (int n = 0; n < 2; ++n) gv[bj][n] = *(const f32x4*)(gate + (size_t)b * 6144 + col0 + bj * HALF + 4 * n) * descale;
#pragma unroll
        for (int ai = 0; ai < 2; ++ai) {
            f32x4 bs[4][2][2];
#pragma unroll
            for (int m = 0; m < 4; ++m) { const size_t off = (size_t)(row0 + ai * HALF + m * 16) * D + col0;
#pragma unroll
                for (int bj = 0; bj < 2; ++bj) { const size_t o = off + bj * HALF;
                    if constexpr (BASE16) { const u32x4 w = *(const u32x4*)((const bf16*)base + o);
                        bs[m][bj][0] = (f32x4){__builtin_bit_cast(float, w[0] << 16), __builtin_bit_cast(float, w[0] & 0xffff0000u), __builtin_bit_cast(float, w[1] << 16), __builtin_bit_cast(float, w[1] & 0xffff0000u)};
                        bs[m][bj][1] = (f32x4){__builtin_bit_cast(float, w[2] << 16), __builtin_bit_cast(float, w[2] & 0xffff0000u), __builtin_bit_cast(float, w[3] << 16), __builtin_bit_cast(float, w[3] & 0xffff0000u)}; }
                    else { bs[m][bj][0] = *(const f32x4*)((const float*)base + o); bs[m][bj][1] = *(const f32x4*)((const float*)base + o + 4); } } }
#pragma unroll
            for (int m = 0; m < 4; ++m) { const size_t off = (size_t)(row0 + ai * HALF + m * 16) * D + col0;
#pragma unroll
                for (int bj = 0; bj < 2; ++bj) { const size_t o = off + bj * HALF;
                    const f32x4 r0 = bs[m][bj][0] + gv[bj][0] * acc[ai][bj][m][0], r1 = bs[m][bj][1] + gv[bj][1] * acc[ai][bj][m][1];
                    if constexpr (OUT16) *(u32x4*)((bf16*)out + o) = (u32x4){cvt_pk_bf16(r0[0], r0[1]), cvt_pk_bf16(r0[2], r0[3]), cvt_pk_bf16(r1[0], r1[1]), cvt_pk_bf16(r1[2], r1[3])};
                    else { *(f32x4*)((float*)out + o) = r0; *(f32x4*)((float*)out + o + 4) = r1; } } }
            asm volatile("" ::: "memory"); }
    }
};
template <bool OUT8> struct EpiSwiGLU {
    static constexpr bool PERM = true;
    void* O; int ldo; float descale;
    __device__ __forceinline__ void operator()(const f32x4 (&acc)[2][2][4][2], const Unit& u, int wr, int wc, int fr, int fq) const {
        const int row0 = u.pm * BM + wr * 64 + fr, col0 = u.pn * HALF + wc * 32 + 8 * fq;
#pragma unroll
        for (int ai = 0; ai < 2; ++ai)
#pragma unroll
            for (int m = 0; m < 4; ++m) { const unsigned eo = (unsigned)(row0 + ai * HALF + m * 16) * (unsigned)ldo + (unsigned)col0;
                f32x4 v0, v1;
#pragma unroll
                for (int i = 0; i < 4; ++i) { v0[i] = fast_silu(acc[ai][0][m][0][i] * descale) * (acc[ai][1][m][0][i] * descale); v1[i] = fast_silu(acc[ai][0][m][1][i] * descale) * (acc[ai][1][m][1][i] * descale); }
                if constexpr (OUT8) { v0 = v0 * A8_SCALE; v1 = v1 * A8_SCALE; *(u32x2*)((unsigned char*)O + eo) = (u32x2){pk_fp8x4(v0[0], v0[1], v0[2], v0[3]), pk_fp8x4(v1[0], v1[1], v1[2], v1[3])}; }
                else { u32x4 w; w.x = cvt_pk_bf16(v0[0], v0[1]); w.y = cvt_pk_bf16(v0[2], v0[3]); w.z = cvt_pk_bf16(v1[0], v1[1]); w.w = cvt_pk_bf16(v1[2], v1[3]); *(u32x4*)((bf16*)O + eo) = w; } }
    }
};
struct EpiGLA {
    static constexpr bool PERM = true;
    bf16* P; bf16* LA; const float* ba; const float* og;
    __device__ __forceinline__ void operator()(const f32x4 (&acc)[2][2][4][2], const Unit& u, int wr, int wc, int fr, int fq) const {
        const int row0 = u.pm * BM + wr * 64 + fr;
        if (u.pn < 12) {
            const int col0 = u.pn * BM + wc * 32 + 8 * fq; const bool isr = u.pn >= 8;
            f32x4 gv[2][2];
#pragma unroll
            for (int bj = 0; bj < 2; ++bj)
#pragma unroll
                for (int n = 0; n < 2; ++n) gv[bj][n] = isr ? *(const f32x4*)(og + wc * 32 + 8 * fq + bj * HALF + 4 * n) : (f32x4){1.f, 1.f, 1.f, 1.f};
#pragma unroll
            for (int ai = 0; ai < 2; ++ai)
#pragma unroll
                for (int m = 0; m < 4; ++m) { bf16* rowp = P + (size_t)(row0 + ai * HALF + m * 16) * 3072 + col0;
#pragma unroll
                    for (int bj = 0; bj < 2; ++bj) { f32x4 v0 = acc[ai][bj][m][0], v1 = acc[ai][bj][m][1];
                        if (isr) {
#pragma unroll
                            for (int i = 0; i < 4; ++i) { v0[i] = gv[bj][0][i] * fast_silu(v0[i]); v1[i] = gv[bj][1][i] * fast_silu(v1[i]); } }
                        u32x4 w; w.x = cvt_pk_bf16(v0[0], v0[1]); w.y = cvt_pk_bf16(v0[2], v0[3]); w.z = cvt_pk_bf16(v1[0], v1[1]); w.w = cvt_pk_bf16(v1[2], v1[3]);
                        *(u32x4*)(rowp + bj * HALF) = w; } }
        } else {
            const int col0 = (u.pn - 12) * BM + wc * 32 + 8 * fq;
            f32x4 bv[2][2];
#pragma unroll
            for (int bj = 0; bj < 2; ++bj)
#pragma unroll
                for (int n = 0; n < 2; ++n) bv[bj][n] = *(const f32x4*)(ba + col0 + bj * HALF + 4 * n);
#pragma unroll
            for (int ai = 0; ai < 2; ++ai)
#pragma unroll
                for (int m = 0; m < 4; ++m) { bf16* rowp = LA + (size_t)(row0 + ai * HALF + m * 16) * 512 + col0;
#pragma unroll
                    for (int bj = 0; bj < 2; ++bj) { f32x4 v[2];
#pragma unroll
                        for (int n = 0; n < 2; ++n)
#pragma unroll
                            for (int i = 0; i < 4; ++i) { const float z = acc[ai][bj][m][n][i] + bv[bj][n][i];
                                v[n][i] = (fminf(z, 0.f) - __logf(1.0f + __expf(-fabsf(z)))) * (1.0f / 16.0f); }
                        u32x4 w; w.x = cvt_pk_bf16(v[0][0], v[0][1]); w.y = cvt_pk_bf16(v[0][2], v[0][3]); w.z = cvt_pk_bf16(v[1][0], v[1][1]); w.w = cvt_pk_bf16(v[1][2], v[1][3]);
                        *(u32x4*)(rowp + bj * HALF) = w; } }
        }
    }
};
template <bool FINAL> struct EpiMoeDown {
    static constexpr bool PERM = true;
    const int* tokslot; const float* gslot; bf16* xb; float* outf; const float* gate; float descale;
    __device__ __forceinline__ void row(const f32x4 (&v)[2][2], int srow, int col0) const {
        const int tok = tokslot[srow];
        if (tok >= 0) { const float g = gslot[srow] * descale; const float* gp = gate + (size_t)(tok >> 12) * 6144 + col0; const size_t ro = (size_t)tok * D + col0;
#pragma unroll
            for (int bj = 0; bj < 2; ++bj) { const f32x4 g0 = *(const f32x4*)(gp + bj * HALF), g1 = *(const f32x4*)(gp + bj * HALF + 4); const u32x4 w = *(const u32x4*)(xb + ro + bj * HALF);
                const f32x4 b0 = (f32x4){__builtin_bit_cast(float, w[0] << 16), __builtin_bit_cast(float, w[0] & 0xffff0000u), __builtin_bit_cast(float, w[1] << 16), __builtin_bit_cast(float, w[1] & 0xffff0000u)};
                const f32x4 b1 = (f32x4){__builtin_bit_cast(float, w[2] << 16), __builtin_bit_cast(float, w[2] & 0xffff0000u), __builtin_bit_cast(float, w[3] << 16), __builtin_bit_cast(float, w[3] & 0xffff0000u)};
                const f32x4 r0 = b0 + g0 * g * v[bj][0], r1 = b1 + g1 * g * v[bj][1];
                if constexpr (FINAL) { *(f32x4*)(outf + ro + bj * HALF) = r0; *(f32x4*)(outf + ro + bj * HALF + 4) = r1; }
                else *(u32x4*)(xb + ro + bj * HALF) = (u32x4){cvt_pk_bf16(r0[0], r0[1]), cvt_pk_bf16(r0[2], r0[3]), cvt_pk_bf16(r1[0], r1[1]), cvt_pk_bf16(r1[2], r1[3])}; } }
    }
    __device__ __forceinline__ void operator()(const f32x4 (&acc)[2][2][4][2], const Unit& u, int wr, int wc, int fr, int fq) const {
        const int srow0 = u.pm * BM + wr * 64 + fr, col0 = u.pn * BM + wc * 32 + 8 * fq;
        int tok[8]; float gsl[8];
#pragma unroll
        for (int i = 0; i < 8; ++i) { const int srow = srow0 + (i >> 2) * HALF + (i & 3) * 16; tok[i] = tokslot[srow]; gsl[i] = gslot[srow] * descale; }
#pragma unroll
        for (int i0 = 0; i0 < 8; i0 += 2) {
            u32x4 w[2][2]; f32x4 gt[2][2][2];
#pragma unroll
            for (int q = 0; q < 2; ++q) { const int t = tok[i0 + q] < 0 ? 0 : tok[i0 + q]; const float* gp = gate + (size_t)(t >> 12) * 6144 + col0; const size_t ro = (size_t)t * D + col0;
#pragma unroll
                for (int bj = 0; bj < 2; ++bj) { w[q][bj] = *(const u32x4*)(xb + ro + bj * HALF); gt[q][bj][0] = *(const f32x4*)(gp + bj * HALF); gt[q][bj][1] = *(const f32x4*)(gp + bj * HALF + 4); } }
#pragma unroll
            for (int q = 0; q < 2; ++q) { const int i = i0 + q, ai = i >> 2, m = i & 3;
                if (tok[i] >= 0) { const float g = gsl[i]; const size_t ro = (size_t)tok[i] * D + col0;
#pragma unroll
                    for (int bj = 0; bj < 2; ++bj) { const u32x4 ww = w[q][bj];
                        const f32x4 b0 = (f32x4){__builtin_bit_cast(float, ww[0] << 16), __builtin_bit_cast(float, ww[0] & 0xffff0000u), __builtin_bit_cast(float, ww[1] << 16), __builtin_bit_cast(float, ww[1] & 0xffff0000u)};
                        const f32x4 b1 = (f32x4){__builtin_bit_cast(float, ww[2] << 16), __builtin_bit_cast(float, ww[2] & 0xffff0000u), __builtin_bit_cast(float, ww[3] << 16), __builtin_bit_cast(float, ww[3] & 0xffff0000u)};
                        const f32x4 r0 = b0 + gt[q][bj][0] * g * acc[ai][bj][m][0], r1 = b1 + gt[q][bj][1] * g * acc[ai][bj][m][1];
                        if constexpr (FINAL) { *(f32x4*)(outf + ro + bj * HALF) = r0; *(f32x4*)(outf + ro + bj * HALF + 4) = r1; }
                        else *(u32x4*)(xb + ro + bj * HALF) = (u32x4){cvt_pk_bf16(r0[0], r0[1]), cvt_pk_bf16(r0[2], r0[3]), cvt_pk_bf16(r1[0], r1[1]), cvt_pk_bf16(r1[2], r1[3])}; } } }
            asm volatile("" ::: "memory"); }
    }
    __device__ __forceinline__ void slice(const f32x4 (&v)[2][2], const Unit& u, int ai, int m, int wr, int wc, int fr, int fq) const {
        row(v, u.pm * BM + wr * 64 + fr + ai * HALF + m * 16, u.pn * BM + wc * 32 + 8 * fq);
    }
};
struct EpiPartStore {
    static constexpr bool PERM = true;
    float* part;
    __device__ __forceinline__ void operator()(const f32x4 (&acc)[2][2][4][2], const Unit&, int wr, int wc, int fr, int fq) const {
        f32x4* p = (f32x4*)part + ((wr * 4 + wc) * 64 + fq * 16 + fr);
#pragma unroll
        for (int ai = 0; ai < 2; ++ai)
#pragma unroll
            for (int bj = 0; bj < 2; ++bj)
#pragma unroll
                for (int m = 0; m < 4; ++m)
#pragma unroll
                    for (int n = 0; n < 2; ++n) { *p = acc[ai][bj][m][n]; p += 512; asm volatile("" : "+v"(p)); }
    }
};

template <class Epi, class Sched, bool ALIGN_EPI, bool GATHER, bool FP8 = false, bool KSPLIT = false>
__device__ __forceinline__ void gemm_phase(LAS unsigned char* lds, const int RB, const Sched& S, const Epi& E) {
    const int tid = threadIdx.x, wid = __builtin_amdgcn_readfirstlane(tid >> 6), lane = tid & 63, wr = wid >> 2, wc = wid & 3, fr = lane & 15, fq = lane >> 4;
    const int nt = RB / 128;
    unsigned voffB0, voffA0;
    const size_t kstep = (size_t)(BK * 2);
    const size_t hstep = (size_t)HALF * RB;
    const size_t qstep = (size_t)64 * RB;
    { int R, C; stage_rc(tid * 16, R, C); const int Rb = Epi::PERM ? ((R & ~31) + perm32(R & 31)) : R;
        voffB0 = (unsigned)(Rb * RB + C * 2); voffA0 = (unsigned)(R * RB + C * 2); }
    LAS unsigned* mytab = (LAS unsigned*)(lds + STAGE_BYTES) + tid;
#define PG8_TABFILL(par, U) do { _Pragma("unroll") for (int _h = 0; _h < 2; ++_h) _Pragma("unroll") for (int _i = 0; _i < 2; ++_i) { int _R, _C; stage_rc(tid * 16 + _i * 8192, _R, _C); \
        mytab[((par) * 4 + _h * 2 + _i) * 512] = S.row_off(U, _h * HALF + _R) + (unsigned)_C * 2u; } } while (0)
    const unsigned ldsw = (unsigned)wid * 1024u;
    const int aoff = lds_byte(wr * 64 + fr, fq * 8), boff = lds_byte(wc * 32 + fr, fq * 8), aoff1 = aoff ^ 64, boff1 = boff ^ 64;
#define PG8_SA(b, h) (((b) * 2 + (h)) * HTB)
#define PG8_SB(b, h) ((4 + (b) * 2 + (h)) * HTB)
#define PG8_STAGE_B(bufoff, gbase) do { _Pragma("unroll") for (int _i = 0; _i < 2; ++_i) \
        __builtin_amdgcn_global_load_lds((const unsigned*)((const char*)(gbase) + _i * qstep + voffB0), (LAS unsigned*)(lds + (bufoff) + ldsw + _i * 8192), 16, 0, 0); } while (0)
#define PG8_STAGE_A(bufoff, gbase, va, h) do { _Pragma("unroll") for (int _i = 0; _i < 2; ++_i) \
        __builtin_amdgcn_global_load_lds((const unsigned*)((const char*)(gbase) + (GATHER ? (size_t)0 : (size_t)(h) * hstep + _i * qstep) + (GATHER ? (va)[h][_i] : voffA0)), (LAS unsigned*)(lds + (bufoff) + ldsw + _i * 8192), 16, 0, 0); } while (0)
#define PG8_LDA(dst, b, h) do { _Pragma("unroll") for (int m = 0; m < 4; ++m) { if constexpr (FP8) dst##8[m] = __builtin_shufflevector(*(const LAS v4i*)(lds + PG8_SA(b, h) + aoff + m * 2048), *(const LAS v4i*)(lds + PG8_SA(b, h) + aoff1 + m * 2048), 0, 1, 2, 3, 4, 5, 6, 7); \
        else { dst[m][0] = *(const LAS bf16x8*)(lds + PG8_SA(b, h) + aoff + m * 2048); dst[m][1] = *(const LAS bf16x8*)(lds + PG8_SA(b, h) + aoff1 + m * 2048); } } } while (0)
#define PG8_LDB(dst, b, h) do { _Pragma("unroll") for (int n = 0; n < 2; ++n) { if constexpr (FP8) dst##8[n] = __builtin_shufflevector(*(const LAS v4i*)(lds + PG8_SB(b, h) + boff + n * 2048), *(const LAS v4i*)(lds + PG8_SB(b, h) + boff1 + n * 2048), 0, 1, 2, 3, 4, 5, 6, 7); \
        else { dst[n][0] = *(const LAS bf16x8*)(lds + PG8_SB(b, h) + boff + n * 2048); dst[n][1] = *(const LAS bf16x8*)(lds + PG8_SB(b, h) + boff1 + n * 2048); } } } while (0)
#define PG8_CAT(x0, x1) __builtin_shufflevector(__builtin_bit_cast(v4i, x0), __builtin_bit_cast(v4i, x1), 0, 1, 2, 3, 4, 5, 6, 7)
#define PG8_MMA(ai, bj, At, Bt) do { __builtin_amdgcn_s_setprio(1); _Pragma("unroll") for (int m = 0; m < 4; ++m) _Pragma("unroll") for (int n = 0; n < 2; ++n) { \
        if constexpr (FP8) asm volatile("v_mfma_scale_f32_16x16x128_f8f6f4 %0, %1, %2, %0, %3, %3 op_sel_hi:[0,0,0]" : "+v"(acc[ai][bj][m][n]) : "v"(Bt##8[n]), "v"(At##8[m]), "v"(sc8));   \
        else { _Pragma("unroll") for (int k = 0; k < 2; ++k) acc[ai][bj][m][n] = __builtin_amdgcn_mfma_f32_16x16x32_bf16(Bt[n][k], At[m][k], acc[ai][bj][m][n], 0, 0, 0); } } \
        __builtin_amdgcn_s_setprio(0); } while (0)
#define PG8_WAIT_V(n) asm volatile("s_waitcnt vmcnt(" #n ")" ::: "memory")
#define PG8_WAIT_L(n) asm volatile("s_waitcnt lgkmcnt(" #n ")" ::: "memory")
#define PG8_BAR __builtin_amdgcn_s_barrier()
#define PG8_SCHED __builtin_amdgcn_sched_barrier(0)
    Unit cur, nxt; int ui = 0;
    if (!S.next(0, cur)) return;
    f32x4 acc[2][2][4][2];
#pragma unroll
    for (int a = 0; a < 2; ++a)
#pragma unroll
        for (int b = 0; b < 2; ++b)
#pragma unroll
            for (int m = 0; m < 4; ++m)
#pragma unroll
                for (int n = 0; n < 2; ++n) acc[a][b][m][n] = (f32x4){0.f, 0.f, 0.f, 0.f};
    const int sc8 = 0x7f7f7f7f;
    bf16x8 At[4][2], B0[2][2], B1[2][2]; v8i At8[4], B08[2], B18[2];
    const char* cA = S.a_base(cur); const char* cB = S.b_base(cur);
    if constexpr (KSPLIT) { cA += (size_t)cur.k0 * kstep; cB += (size_t)cur.k0 * kstep; }
    unsigned cvA[2][2] = {{0u, 0u}, {0u, 0u}};
    if constexpr (GATHER) {
        PG8_TABFILL(0, cur);
#pragma unroll
        for (int h = 0; h < 2; ++h)
#pragma unroll
            for (int i = 0; i < 2; ++i) cvA[h][i] = mytab[(h * 2 + i) * 512];
    }
    PG8_STAGE_B(PG8_SB(0, 0), cB); PG8_STAGE_B(PG8_SB(0, 1), cB + hstep); PG8_STAGE_A(PG8_SA(0, 0), cA, cvA, 0); PG8_STAGE_A(PG8_SA(0, 1), cA, cvA, 1);
    if (wr == 1) PG8_BAR;
    PG8_WAIT_V(2); PG8_BAR;
    PG8_STAGE_B(PG8_SB(1, 0), cB + kstep); PG8_STAGE_A(PG8_SA(1, 0), cA + kstep, cvA, 0); PG8_STAGE_B(PG8_SB(1, 1), cB + hstep + kstep);
    PG8_WAIT_V(6); PG8_BAR;
    for (;;) {
        const bool has_next = S.next(ui + 1, nxt);
        const char* nA = has_next ? S.a_base(nxt) : cA; const char* nB = has_next ? S.b_base(nxt) : cB;
        if constexpr (KSPLIT) { if (has_next) { nA += (size_t)nxt.k0 * kstep; nB += (size_t)nxt.k0 * kstep; } }
        if constexpr (GATHER) { if (has_next) PG8_TABFILL((ui + 1) & 1, nxt); }
        const int ntc = KSPLIT ? cur.nk : nt;
#pragma unroll 1
        for (int t = 0; t < ntc; t += 2) {
            const bool last = (t == ntc - 2);
            const char* a1 = cA + (size_t)(t + 1) * kstep;
            const char* a2 = last ? nA : cA + (size_t)(t + 2) * kstep; const char* b2 = last ? nB : cB + (size_t)(t + 2) * kstep;
            const char* a3 = a2 + kstep; const char* b3 = b2 + kstep;
            unsigned wA[2][2] = {{0u, 0u}, {0u, 0u}};
            if constexpr (GATHER) {
                const int pc = ui & 1, pw = (last && has_next) ? (pc ^ 1) : pc;
#pragma unroll
                for (int i = 0; i < 2; ++i) { cvA[1][i] = mytab[(pc * 4 + 2 + i) * 512]; wA[0][i] = mytab[(pw * 4 + i) * 512]; wA[1][i] = mytab[(pw * 4 + 2 + i) * 512]; }
            }
            PG8_LDB(B0, 0, 0); PG8_LDB(B1, 0, 1); PG8_SCHED; PG8_LDA(At, 0, 0); PG8_STAGE_A(PG8_SA(1, 1), a1, cvA, 1);
            PG8_WAIT_V(8); PG8_WAIT_L(0); PG8_BAR; PG8_MMA(0, 0, At, B0); PG8_MMA(0, 1, At, B1); PG8_BAR; PG8_SCHED;
            PG8_LDA(At, 0, 1); PG8_STAGE_B(PG8_SB(0, 0), b2); PG8_STAGE_B(PG8_SB(0, 1), b2 + hstep); PG8_STAGE_A(PG8_SA(0, 0), a2, wA, 0);
            PG8_WAIT_V(8); PG8_WAIT_L(0); PG8_BAR; PG8_MMA(1, 0, At, B0); PG8_MMA(1, 1, At, B1); PG8_BAR; PG8_SCHED;
            PG8_LDB(B0, 1, 0); PG8_LDB(B1, 1, 1); PG8_SCHED; PG8_LDA(At, 1, 0); PG8_STAGE_A(PG8_SA(0, 1), a2, wA, 1);
            PG8_WAIT_V(8); PG8_WAIT_L(0); PG8_BAR; PG8_MMA(0, 0, At, B0); PG8_MMA(0, 1, At, B1); PG8_BAR; PG8_SCHED;
            PG8_LDA(At, 1, 1); PG8_STAGE_B(PG8_SB(1, 0), b3); PG8_STAGE_B(PG8_SB(1, 1), b3 + hstep); PG8_STAGE_A(PG8_SA(1, 0), a3, wA, 0);
            PG8_WAIT_V(8); PG8_WAIT_L(0); PG8_BAR; PG8_MMA(1, 0, At, B0); PG8_MMA(1, 1, At, B1); PG8_BAR; PG8_SCHED;
        }
        if constexpr (ALIGN_EPI) { if (wr == 0) PG8_BAR; }
        if constexpr (FP8) asm volatile("s_nop 15\n\ts_nop 15" ::: "memory");
        { int el; asm volatile("v_mbcnt_lo_u32_b32 %0, -1, 0\n\tv_mbcnt_hi_u32_b32 %0, -1, %0" : "=v"(el));
          E(acc, cur, wr, wc, el & 15, el >> 4); }
        if (!has_next) break;
#pragma unroll
        for (int a = 0; a < 2; ++a)
#pragma unroll
            for (int b = 0; b < 2; ++b)
#pragma unroll
                for (int m = 0; m < 4; ++m)
#pragma unroll
                    for (int n = 0; n < 2; ++n) acc[a][b][m][n] = (f32x4){0.f, 0.f, 0.f, 0.f};
        cur = nxt; cA = nA; cB = nB; ++ui;
        if constexpr (ALIGN_EPI) { if (wr == 1) PG8_BAR; }
    }
    PG8_WAIT_V(0);
    if constexpr (!ALIGN_EPI) { if (wr == 0) PG8_BAR; }
    PG8_BAR;
#undef PG8_SA
#undef PG8_SB
#undef PG8_STAGE_A
#undef PG8_TABFILL
#undef PG8_STAGE_B
#undef PG8_LDA
#undef PG8_LDB
#undef PG8_MMA
#undef PG8_CAT
#undef PG8_WAIT_V
#undef PG8_WAIT_L
#undef PG8_BAR
#undef PG8_SCHED
}
}

#define XB_TMO      128
#define XB_XCNT(j)  (256  + 64 * (j))
#define XB_XSUB(j)  (1280 + 64 * (j))
#define XB_XGEN(j)  (2304 + 64 * (j))
#define XB_TOP      3328
#define XB_TOPGEN   3392
#define XCD_BAR_WORDS 3456
#define XB_SPIN_CAP (1u << 18)
__device__ __forceinline__ unsigned xb_ld(unsigned* p)              { return __hip_atomic_load(p, __ATOMIC_RELAXED, __HIP_MEMORY_SCOPE_AGENT); }
__device__ __forceinline__ unsigned xb_add(unsigned* p, unsigned v) { return __hip_atomic_fetch_add(p, v, __ATOMIC_RELAXED, __HIP_MEMORY_SCOPE_AGENT); }
__device__ __forceinline__ unsigned xb_xcc_id() { return (unsigned)__builtin_amdgcn_s_getreg((3 << 11) | 20) & 0xFu; }
#define XB_SPIN(cond, bar) do { unsigned _sp = 0; while (cond) { __builtin_amdgcn_s_sleep(1); \
    if ((++_sp & 255u) == 0u) { if (xb_ld(&(bar)[XB_TMO])) break; if (_sp > XB_SPIN_CAP) { atomicAdd(&(bar)[XB_TMO], 1u); break; } } } } while (0)
struct XcdBarrier { unsigned* bar; unsigned x; volatile LAS unsigned* st; };
__device__ __forceinline__ XcdBarrier xcd_barrier_post(unsigned* bar, volatile LAS unsigned* st) {
    XcdBarrier b; b.bar = bar; b.x = xb_xcc_id(); b.st = st;
    if (threadIdx.x == 0) (void)xb_add(&bar[XB_XCNT(b.x)], 1u);
    return b;
}
__device__ __forceinline__ void xcd_barrier_complete(unsigned* bar, unsigned x, unsigned& nloc, unsigned& nx) {
    const unsigned G = gridDim.x * gridDim.y * gridDim.z;
    unsigned sum, cnt, mine, sp = 0u;
    for (;;) {
        sum = 0u; cnt = 0u; mine = 0u;
#pragma unroll
        for (unsigned j = 0; j < 16; ++j) { const unsigned c = xb_ld(&bar[XB_XCNT(j)]); sum += c; cnt += (c > 0u) ? 1u : 0u; mine = (j == x) ? c : mine; }
        if (sum == G) break;
        __builtin_amdgcn_s_sleep(1);
        if ((++sp & 255u) == 0u) { if (xb_ld(&bar[XB_TMO])) break; if (sp > XB_SPIN_CAP) { atomicAdd(&bar[XB_TMO], 1u); break; } }
    }
    nloc = mine > 0u ? mine : 1u; nx = cnt > 0u ? cnt : 1u;
}
__device__ __forceinline__ void xcd_barrier(const XcdBarrier& b) {
    asm volatile("s_waitcnt vmcnt(0)" ::: "memory");
    __syncthreads();
    if (threadIdx.x == 0) {
        unsigned* bar = b.bar;
        __builtin_amdgcn_s_waitcnt(0);
        unsigned nloc = b.st[0], nx = b.st[1];
        if (nloc == 0u) { xcd_barrier_complete(bar, b.x, nloc, nx); b.st[0] = nloc; b.st[1] = nx; }
        const unsigned old = xb_add(&bar[XB_XSUB(b.x)], 1u);
        const unsigned gen = old / nloc;
        if (old + 1u == (gen + 1u) * nloc) {
            __builtin_amdgcn_fence(__ATOMIC_RELEASE, "agent");
            asm volatile("s_waitcnt vmcnt(0)" ::: "memory");
            const unsigned og = xb_add(&bar[XB_TOP], 1u);
            const unsigned tg = og / nx;
            if (og + 1u == (tg + 1u) * nx) xb_add(&bar[XB_TOPGEN], 1u);
            else XB_SPIN(xb_ld(&bar[XB_TOPGEN]) == tg, bar);
            __builtin_amdgcn_fence(__ATOMIC_ACQUIRE, "agent");
            xb_add(&bar[XB_XGEN(b.x)], 1u);
            asm volatile("s_waitcnt vmcnt(0)" ::: "memory");
        } else {
            XB_SPIN(xb_ld(&bar[XB_XGEN(b.x)]) == gen, bar);
            __builtin_amdgcn_fence(__ATOMIC_ACQUIRE, "agent");
            asm volatile("s_waitcnt vmcnt(0)" ::: "memory");
        }
    }
    __syncthreads();
}

struct Args {
    const float* x; const float* c; const float* ada_w; const float* ada_b; const float* norm1_g; const float* norm2_g;
    const float* da_w_in; const float* da_q_gain; const float* da_k_gain; const float* da_lam_q1; const float* da_lam_k1; const float* da_lam_q2; const float* da_lam_k2;
    const float* da_subln_g; const float* da_w_out;
    const float* gla_w_in; const float* gla_w_a1; const float* gla_w_a2; const float* gla_b_a; const float* gla_out_g; const float* gla_w_out;
    const float* ffn_w1; const float* ffn_w3; const float* ffn_w2;
    const float* moe_router; const float* moe_w1; const float* moe_w3; const float* moe_w2;
    float* out; unsigned char* ws; int ph_lo, ph_hi;
};

__device__ __forceinline__ void p0_transpose_item(const float* W, int ldw, int k0, int n0, bf16* WT, int dst_row0, int Kp, LAS float* scr, int lane) {
#pragma unroll 8
    for (int i = 0; i < 32; ++i) { const int kk = 2 * i + (lane >> 5); scr[kk * 33 + (lane & 31)] = W[(size_t)(k0 + kk) * ldw + n0 + (lane & 31)]; }
    asm volatile("s_waitcnt lgkmcnt(0)" ::: "memory");
    const int c = lane & 7;
#pragma unroll
    for (int j = 0; j < 4; ++j) { const int n = (lane >> 3) + 8 * j; const LAS float* s = scr + (8 * c) * 33 + n;
        u32x4 o; o.x = pk2(s[0 * 33], s[1 * 33]); o.y = pk2(s[2 * 33], s[3 * 33]); o.z = pk2(s[4 * 33], s[5 * 33]); o.w = pk2(s[6 * 33], s[7 * 33]);
        *(u32x4*)(WT + (size_t)(dst_row0 + n) * Kp + k0 + 8 * c) = o; }
    asm volatile("s_waitcnt lgkmcnt(0)" ::: "memory");
}

__device__ __forceinline__ void p0_transpose_item8(const float* W, int ldw, int k0, int n0, unsigned char* WT8, int dst_row0, int Kp, LAS float* scr, int lane) {
#pragma unroll 8
    for (int i = 0; i < 32; ++i) { const int kk = 2 * i + (lane >> 5); scr[kk * 33 + (lane & 31)] = W[(size_t)(k0 + kk) * ldw + n0 + (lane & 31)]; }
    asm volatile("s_waitcnt lgkmcnt(0)" ::: "memory");
    const int c = lane & 7;
#pragma unroll
    for (int j = 0; j < 4; ++j) { const int n = (lane >> 3) + 8 * j; const LAS float* sp = scr + (8 * c) * 33 + n;
        const u32x2 o = (u32x2){pk_fp8x4(sp[0 * 33] * W8_SCALE, sp[1 * 33] * W8_SCALE, sp[2 * 33] * W8_SCALE, sp[3 * 33] * W8_SCALE), pk_fp8x4(sp[4 * 33] * W8_SCALE, sp[5 * 33] * W8_SCALE, sp[6 * 33] * W8_SCALE, sp[7 * 33] * W8_SCALE)};
        *(u32x2*)(WT8 + (size_t)(dst_row0 + n) * Kp + k0 + 8 * c) = o; }
    asm volatile("s_waitcnt lgkmcnt(0)" ::: "memory");
}

namespace att {
__device__ __forceinline__ int crow(int r, int hi) { return (r & 3) + 8 * (r >> 2) + 4 * hi; }
__host__ __device__ constexpr int dwin(int h) { return (int)(150.0 / (1.4426950408889634 / (double)(1 << (h + 1)))); }
__host__ __device__ constexpr int tstart(int h, int jq) { const int q0 = 128 * jq, d = dwin(h); return q0 > d ? (q0 - d) / 64 : 0; }
struct Plan { unsigned char n[16]; unsigned char u[16][48]; };
constexpr Plan make_plan() {
    Plan p{}; int load[16] = {};
    for (int w = 0; w < 16; ++w) p.n[w] = 0;
    for (int h = 7; h >= 0; --h) {
        int cost[32] = {}, ord[32] = {};
        for (int j = 0; j < 32; ++j) { cost[j] = 2 * j + 2 - tstart(h, j); ord[j] = j; }
        for (int a = 1; a < 32; ++a) { const int x = ord[a]; int b = a - 1; while (b >= 0 && cost[ord[b]] < cost[x]) { ord[b + 1] = ord[b]; --b; } ord[b + 1] = x; }
        for (int a = 0; a < 32; ++a) { int best = 0; for (int w = 1; w < 16; ++w) if (load[w] < load[best]) best = w;
            p.u[best][p.n[best]++] = (unsigned char)(h * 32 + ord[a]); load[best] += cost[ord[a]]; }
    }
    return p;
}
__device__ const Plan PLAN = make_plan();
constexpr int BUFB = 32768, NBUF = 3, KOFF = 0, VOFF = 16384, WSF_OFF = NBUF * BUFB;
__device__ __forceinline__ s16x4 vtr(const LAS unsigned char* p) { return __builtin_bit_cast(s16x4, __builtin_amdgcn_ds_read_tr16_b64_v4i16((LAS s16x4*)p)); }

__device__ __forceinline__ void attn_unit(LAS unsigned char* lds, const bf16* Q, const bf16* K, const bf16* V, bf16* O, int b, int h, int jq,
                                          float sl2, float mref0, float mref1, float lam, const float* subg) {
    const int tid = threadIdx.x, lane = tid & 63, r32 = lane & 31, hi = lane >> 5; const int wid = __builtin_amdgcn_readfirstlane(tid >> 6);
    const int mp = wid >> 2, w4 = wid & 3;
    const size_t rowbase = (size_t)b * SEQ; const int q0 = jq * 128;
    const int nT = (q0 >> 6) + 2, myc = (q0 + 32 * w4) >> 6, t0 = tstart(h, jq);
    const bf16* Qw = Q + (rowbase + q0 + 32 * w4 + r32) * D + h * 128 + mp * 64 + hi * 8;
    bf16x8 qr[4];
#pragma unroll
    for (int d0 = 0; d0 < 4; ++d0) qr[d0] = *(const bf16x8*)(Qw + d0 * 16);
    const bf16* ksrc = K + ((size_t)(b * 8 + h) * 64 * 16 + wid) * 512 + lane * 8;
    const int p0 = wid, p1 = wid + 8;
    const bf16* vsrc0 = V + ((size_t)(b * 8 + h) * 64 * 16 + p0) * 512 + lane * 8;
    const bf16* vsrc1 = V + ((size_t)(b * 8 + h) * 64 * 16 + p1) * 512 + lane * 8;
#define ATT_DMA1(gp_, la_) asm volatile("s_mov_b32 m0, %0\n\ts_nop 0\n\tglobal_load_lds_dwordx4 %1, off" :: "s"(la_), "v"(gp_) : "memory", "m0")
#define ATT_DMA(t, bs) do { const unsigned bb_ = (unsigned)__builtin_amdgcn_readfirstlane((int)(ldsu + (unsigned)((bs) * BUFB))); \
        ATT_DMA1(ksrc + (size_t)(t) * 8192, bb_ + (unsigned)(KOFF + wid * 1024)); \
        ATT_DMA1(ksrc + (size_t)(t) * 8192 + 4096, bb_ + (unsigned)(KOFF + 8192 + wid * 1024)); \
        ATT_DMA1(vsrc0 + (size_t)(t) * 8192, bb_ + (unsigned)(VOFF + p0 * 1024)); \
        ATT_DMA1(vsrc1 + (size_t)(t) * 8192, bb_ + (unsigned)(VOFF + p1 * 1024)); } while (0)
    const unsigned ldsu = (unsigned)(unsigned long long)lds;
    const float qpos = (float)(q0 + 32 * w4 + r32);
    const float mref = mp ? mref1 : mref0;
    const float baseL = -sl2 * qpos - mref, sl8 = 8.0f * sl2, sl32 = 32.0f * sl2;
    float lsum = 0.f; f32x16 o[4];
#pragma unroll
    for (int d0 = 0; d0 < 4; ++d0)
#pragma unroll
        for (int r = 0; r < 16; ++r) o[d0][r] = 0.f;
    ATT_DMA(t0, 0);
    if (t0 + 1 < nT) ATT_DMA(t0 + 1, 1);
    asm volatile("" :: "v"(qr[0]), "v"(qr[1]), "v"(qr[2]), "v"(qr[3]) : "memory");
    int slot = 0;
    for (int t = t0; t < nT; ++t) {
        if (t + 1 < nT) asm volatile("s_waitcnt vmcnt(4)" ::: "memory"); else asm volatile("s_waitcnt vmcnt(0)" ::: "memory");
        asm volatile("s_waitcnt lgkmcnt(0)" ::: "memory"); __builtin_amdgcn_s_barrier(); asm volatile("" ::: "memory");
        if (t + 2 < nT) { const int s2 = slot >= 1 ? slot - 1 : 2; ATT_DMA(t + 2, s2); }
        if (t <= myc) {
            const LAS unsigned char* bb = lds + slot * BUFB;
            f32x16 c0, c1;
            if (t < myc) {
                const float kb = baseL + sl2 * (float)(64 * t + 4 * hi);
#pragma unroll
                for (int r = 0; r < 16; ++r) { c0[r] = (r == 0) ? kb : ((r & 3) ? c0[r - 1] + sl2 : c0[r - 4] + sl8); c1[r] = c0[r] + sl32; }
            } else {
                const float qk = qpos - (float)(64 * t + 4 * hi);
                float x[16];
#pragma unroll
                for (int r = 0; r < 16; ++r) { x[r] = (r == 0) ? qk : ((r & 3) ? x[r - 1] - 1.0f : x[r - 4] - 8.0f); c0[r] = -sl2 * fabsf(x[r]) - mref; c1[r] = -sl2 * fabsf(x[r] - 32.0f) - mref; }
            }
            const LAS unsigned char* kb_ = bb + KOFF + mp * 8192 + hi * 1024 + r32 * 16;
#define ATT_SB() __builtin_amdgcn_sched_barrier(0)
            bf16x8 kf[8];
#pragma unroll
            for (int d0 = 0; d0 < 4; ++d0) { kf[2 * d0] = *(const LAS bf16x8*)(kb_ + d0 * 2048); kf[2 * d0 + 1] = *(const LAS bf16x8*)(kb_ + d0 * 2048 + 512); }
            const LAS unsigned char* vp = bb + VOFF + ((lane >> 4) & 1) * 32 + (lane & 3) * 8 + (4 * hi + ((lane & 15) >> 2)) * 64;
            s16x4 vlo[16], vhi[16];
#pragma unroll
            for (int ks = 0; ks < 2; ++ks)
#pragma unroll
                for (int d0 = 0; d0 < 4; ++d0) { vlo[d0 * 4 + ks] = vtr(vp + d0 * 4096 + ks * 1024); vhi[d0 * 4 + ks] = vtr(vp + d0 * 4096 + ks * 1024 + 512); }
            ATT_SB();
#pragma unroll
            for (int d0 = 0; d0 < 4; ++d0) c0 = __builtin_amdgcn_mfma_f32_32x32x16_bf16(kf[2 * d0], qr[d0], c0, 0, 0, 0);
            ATT_SB();
            float sacc = 0.f;
#pragma unroll
            for (int d0 = 0; d0 < 4; ++d0) {
                c1 = __builtin_amdgcn_mfma_f32_32x32x16_bf16(kf[2 * d0 + 1], qr[d0], c1, 0, 0, 0);
                ATT_SB();
#pragma unroll
                for (int e = 0; e < 4; ++e) { c0[4 * d0 + e] = __builtin_amdgcn_exp2f(c0[4 * d0 + e]); sacc += c0[4 * d0 + e]; }
                ATT_SB();
            }
            u32x4 pw[4];
#pragma unroll
            for (int g = 0; g < 4; ++g) { pw[0][g] = cvt_pk_bf16(c0[2 * g], c0[2 * g + 1]); pw[1][g] = cvt_pk_bf16(c0[8 + 2 * g], c0[8 + 2 * g + 1]); }
#pragma unroll
            for (int ks = 2; ks < 4; ++ks)
#pragma unroll
                for (int d0 = 0; d0 < 4; ++d0) { vlo[d0 * 4 + ks] = vtr(vp + d0 * 4096 + ks * 1024); vhi[d0 * 4 + ks] = vtr(vp + d0 * 4096 + ks * 1024 + 512); }
            ATT_SB();
#pragma unroll
            for (int j = 0; j < 8; ++j) { const int ks = j >> 2, d0 = j & 3;
                { const s16x4 lo = vlo[d0 * 4 + ks], hh = vhi[d0 * 4 + ks];
                  const bf16x8 vf = (bf16x8){lo[0], lo[1], lo[2], lo[3], hh[0], hh[1], hh[2], hh[3]};
                  o[d0] = __builtin_amdgcn_mfma_f32_32x32x16_bf16(__builtin_bit_cast(bf16x8, pw[ks]), vf, o[d0], 0, 0, 0); }
                ATT_SB();
                c1[2 * j] = __builtin_amdgcn_exp2f(c1[2 * j]); c1[2 * j + 1] = __builtin_amdgcn_exp2f(c1[2 * j + 1]); sacc += c1[2 * j] + c1[2 * j + 1];
                ATT_SB();
            }
            lsum += sacc;
#pragma unroll
            for (int g = 0; g < 4; ++g) { pw[2][g] = cvt_pk_bf16(c1[2 * g], c1[2 * g + 1]); pw[3][g] = cvt_pk_bf16(c1[8 + 2 * g], c1[8 + 2 * g + 1]); }
            ATT_SB();
#pragma unroll
            for (int j = 8; j < 16; ++j) { const int ks = j >> 2, d0 = j & 3;
                const s16x4 lo = vlo[d0 * 4 + ks], hh = vhi[d0 * 4 + ks];
                const bf16x8 vf = (bf16x8){lo[0], lo[1], lo[2], lo[3], hh[0], hh[1], hh[2], hh[3]};
                o[d0] = __builtin_amdgcn_mfma_f32_32x32x16_bf16(__builtin_bit_cast(bf16x8, pw[ks]), vf, o[d0], 0, 0, 0); }
#undef ATT_SB
        }
        slot = slot == 2 ? 0 : slot + 1;
    }
#undef ATT_DMA
#undef ATT_DMA1
    int el; asm volatile("v_mbcnt_lo_u32_b32 %0, -1, 0\n\tv_mbcnt_hi_u32_b32 %0, -1, %0" : "=v"(el));
    const int r32e = el & 31, hie = el >> 5;
    lsum += __shfl_xor(lsum, 32);
    LAS float* wsf = (LAS float*)(lds + WSF_OFF) + wid * 32;
    if (hie == 0) wsf[r32e] = lsum;
    asm volatile("s_waitcnt lgkmcnt(0)" ::: "memory");
    float rl[16];
#pragma unroll
    for (int r = 0; r < 16; ++r) rl[r] = __builtin_amdgcn_rcpf(wsf[crow(r, hie)]);
#pragma unroll
    for (int d0 = 0; d0 < 4; ++d0)
#pragma unroll
        for (int r = 0; r < 16; ++r) o[d0][r] *= rl[r];
    __syncthreads();
    LAS float* X = (LAS float*)lds + w4 * 4096;
    if (mp == 1) {
#pragma unroll
        for (int d0 = 0; d0 < 4; ++d0)
#pragma unroll
            for (int r = 0; r < 16; ++r) X[(d0 * 16 + r) * 64 + el] = o[d0][r];
    }
    __syncthreads();
    if (mp == 0) {
        float ss[16];
#pragma unroll
        for (int r = 0; r < 16; ++r) ss[r] = 0.f;
#pragma unroll
        for (int d0 = 0; d0 < 4; ++d0)
#pragma unroll
            for (int r = 0; r < 16; ++r) { const float dd = o[d0][r] - lam * X[(d0 * 16 + r) * 64 + el]; o[d0][r] = dd; ss[r] += dd * dd; }
#pragma unroll
        for (int r = 0; r < 16; ++r) {
            float s = ss[r];
#pragma unroll
            for (int of = 1; of < 32; of <<= 1) s += __shfl_xor(s, of);
            ss[r] = __builtin_amdgcn_rsqf(s * (1.0f / 128.0f) + EPS) * 0.8f;
        }
        bf16* Ow = O + (rowbase + q0 + 32 * w4) * D + h * 128 + r32e;
#pragma unroll
        for (int d0 = 0; d0 < 4; ++d0) { const float gcol = subg[32 * d0 + r32e];
#pragma unroll
            for (int r = 0; r < 16; ++r) Ow[(size_t)crow(r, hie) * D + 32 * d0] = (bf16)f2bf(o[d0][r] * ss[r] * gcol); }
    }
    __syncthreads();
}
}

__global__ void __launch_bounds__(NWAVES * 64, 2) mk_fwd(Args args) {
    extern __shared__ __attribute__((aligned(16))) unsigned char lds_raw[];
    LAS unsigned char* lds = (LAS unsigned char*)lds_raw;
    volatile LAS unsigned* MISC = (volatile LAS unsigned*)(lds + MISC_OFF);
    const int tid = threadIdx.x, lane = tid & 63, wave = __builtin_amdgcn_readfirstlane(tid >> 6);
    const int G = gridDim.x; const int bx = blockIdx.x;
    const int vcu = (G % 8 == 0) ? (bx % 8) * (G / 8) + bx / 8 : bx;
    unsigned char* ws = args.ws;
    unsigned* ctl = (unsigned*)(ws + WS_CTL);
    float* MOD = (float*)(ws + WS_MOD);
    unsigned* LCNT = (unsigned*)(ws + WS_LCNT);
    int* META = (int*)(ws + WS_META);
    u32x4* ROUTE = (u32x4*)(ws + WS_ROUTE);
    int* TOKSLOT = (int*)(ws + WS_TOKSLOT);
    float* GSLOT = (float*)(ws + WS_GSLOT);
    bf16* W_DAIN = (bf16*)(ws + WS_W_DAIN); bf16* W_DAOUT = (bf16*)(ws + WS_W_DAOUT); bf16* W_FFN13 = (bf16*)(ws + WS_W_FFN13); bf16* W_FFN2 = (bf16*)(ws + WS_W_FFN2);
    bf16* W_GLAIN = (bf16*)(ws + WS_W_GLAIN); bf16* W_GLAOUT = (bf16*)(ws + WS_W_GLAOUT); bf16* W_MOE13 = (bf16*)(ws + WS_W_MOE13); bf16* W_MOE2 = (bf16*)(ws + WS_W_MOE2);
    bf16* HB = (bf16*)(ws + WS_H);
    bf16* QB = (bf16*)(ws + WS_Q);
    bf16* KB = QB + (size_t)M * D; bf16* VB = KB + (size_t)M * D;
    bf16* ACTB = QB;
    bf16* GP = QB;
    bf16* GLAB = QB + (size_t)M * 3072;
    float* out = args.out;
    bf16* XB = (bf16*)(ws + WS_XB);
    float* KPART = (float*)(ws + WS_Q + 320 * MiB);
    static_assert(MOE_DN8 && (size_t)MAXSLOT * EXPD <= 320 * MiB && 320 * MiB + 256 * (size_t)(32 * 512 * 16) <= 464 * MiB, "K-split partials do not fit behind the MoE activations");

    for (int u = tid; u < 256; u += NWAVES * 64) ((LAS unsigned*)(lds + MISC_OFF))[u] = 0u;
    __syncthreads();
    XcdBarrier bar; bar.bar = ctl + CW_BAR; bar.x = 0; bar.st = nullptr;
    if (MK_N_LAUNCHES == 1) bar = xcd_barrier_post(ctl + CW_BAR, MISC + 8);
    const int lo = args.ph_lo, hi = args.ph_hi;
#define IN(k) (lo <= (k) && (k) < hi)
#define SEAM(k) do { if (IN(k) && IN((k) + 1)) xcd_barrier(bar); } while (0)
    const int gw = vcu * NWAVES + wave, NGW = G * NWAVES;

    if (IN(0)) {
        if (bx < 192) {
            LAS float* cact = (LAS float*)lds;
            for (int e = tid; e < 16 * 1024; e += 512) { const int b = e >> 10, k = e & 1023; const float v = args.c[e]; cact[k * 16 + b] = v / (1.0f + __expf(-v)); }
            __syncthreads();
            const int col = tid & 63, ks = tid >> 6, n = bx * 64 + col, layer = n / 6144, nn = n % 6144;
            const float* wp = args.ada_w + (size_t)layer * 1024 * 6144 + nn;
            float a[16];
#pragma unroll
            for (int b = 0; b < 16; ++b) a[b] = 0.f;
            for (int k = ks * 128; k < ks * 128 + 128; ++k) { const float w = wp[(size_t)k * 6144];
#pragma unroll
                for (int q = 0; q < 4; ++q) { const f32x4 cv = *(const LAS f32x4*)(cact + k * 16 + 4 * q); a[4 * q] += cv[0] * w; a[4 * q + 1] += cv[1] * w; a[4 * q + 2] += cv[2] * w; a[4 * q + 3] += cv[3] * w; } }
            LAS float* red = (LAS float*)(lds + 65536);
#pragma unroll
            for (int b = 0; b < 16; ++b) red[(ks * 16 + b) * 64 + col] = a[b];
            __syncthreads();
            for (int e = tid; e < 1024; e += 512) { const int b = e >> 6, cc = e & 63; float s = 0.f;
#pragma unroll
                for (int k8 = 0; k8 < 8; ++k8) s += red[(k8 * 16 + b) * 64 + cc];
                const int n2 = bx * 64 + cc, l2 = n2 / 6144, nn2 = n2 % 6144;
                MOD[((size_t)l2 * 16 + b) * 6144 + nn2] = s + args.ada_b[l2 * 6144 + nn2]; }
            __syncthreads();
        }
        for (int i = bx * 512 + tid; i < 2 * MAXSLOT; i += G * 512) TOKSLOT[i] = -1;
        LAS float* scr = (LAS float*)(lds + wave * 16384);
        constexpr int I_DAIN = 16 * 96, I_SQ = 16 * 32, I_F13 = 16 * 88, I_F2 = 44 * 32, I_GLAIN = 16 * 96, I_GA = 512;
        constexpr int NITEMS = I_DAIN + I_SQ + 2 * I_F13 + I_F2 + I_GLAIN + I_SQ + I_GA;
        for (int it = gw; it < NITEMS; it += NGW) {
            int r = it;
            if (r < I_DAIN) { const int kb = r / 96, nb = r % 96, n0 = 32 * nb, l = n0 & 255;
                p0_transpose_item(args.da_w_in, 3072, 64 * kb, n0, W_DAIN, (n0 & ~255) + 128 * ((l >> 5) & 1) + 32 * (l >> 6), D, scr, lane); continue; } r -= I_DAIN;
            if (r < I_SQ) { const int kb = r / 32, nb = r % 32; p0_transpose_item(args.da_w_out, D, 64 * kb, 32 * nb, W_DAOUT, 32 * nb, D, scr, lane); continue; } r -= I_SQ;
            if (r < 2 * I_F13) { const int w = r / I_F13, q = r % I_F13, kb = q / 88, nb = q % 88, n0 = 32 * nb;
                if (FFN_UP8) p0_transpose_item8(w ? args.ffn_w3 : args.ffn_w1, FFN, 64 * kb, n0, (unsigned char*)W_FFN13, (n0 >> 7) * 256 + w * 128 + (n0 & 127), D, scr, lane);
                else p0_transpose_item(w ? args.ffn_w3 : args.ffn_w1, FFN, 64 * kb, n0, W_FFN13, (n0 >> 7) * 256 + w * 128 + (n0 & 127), D, scr, lane); continue; } r -= 2 * I_F13;
            if (r < I_F2) { const int kb = r / 32, nb = r % 32; if (FFN_DN8) p0_transpose_item8(args.ffn_w2, D, 64 * kb, 32 * nb, (unsigned char*)W_FFN2, 32 * nb, FFN, scr, lane); else p0_transpose_item(args.ffn_w2, D, 64 * kb, 32 * nb, W_FFN2, 32 * nb, FFN, scr, lane); continue; } r -= I_F2;
            if (r < I_GLAIN) { const int kb = r / 96, nb = r % 96; p0_transpose_item(args.gla_w_in, 3072, 64 * kb, 32 * nb, W_GLAIN, 32 * nb, D, scr, lane); continue; } r -= I_GLAIN;
            if (r < I_SQ) { const int kb = r / 32, nb = r % 32; p0_transpose_item(args.gla_w_out, D, 64 * kb, 32 * nb, W_GLAOUT, 32 * nb, D, scr, lane); continue; } r -= I_SQ;
            if (r < I_GA) {
                const int j = r; float a2[16];
#pragma unroll
                for (int q = 0; q < 16; ++q) a2[q] = args.gla_w_a2[q * 512 + j];
                bf16* dst = W_GLAIN + (size_t)(3072 + j) * D + lane * 16;
                unsigned pk[8];
#pragma unroll
                for (int kk = 0; kk < 16; kk += 2) { float s0 = 0.f, s1 = 0.f; const float* w1p = args.gla_w_a1 + (size_t)(lane * 16 + kk) * 16;
#pragma unroll
                    for (int q = 0; q < 16; ++q) { s0 += w1p[q] * a2[q]; s1 += w1p[16 + q] * a2[q]; }
                    pk[kk >> 1] = pk2(s0, s1); }
                *(u32x4*)dst = (u32x4){pk[0], pk[1], pk[2], pk[3]}; *(u32x4*)(dst + 8) = (u32x4){pk[4], pk[5], pk[6], pk[7]};
                continue; }
        }
    }
    SEAM(0);

#define NORM_LOAD(XSRC, SRC16, m_, v_, s_) do { s_ = 0.f; \
            _Pragma("unroll") for (int j = 0; j < 4; ++j) { v_[j] = (SRC16) ? ld_bf16x4((const bf16*)(XSRC) + (size_t)(m_) * D + 4 * lane + 256 * j) : *((const f32x4*)((const float*)(XSRC) + (size_t)(m_) * D) + lane + 64 * j); s_ += (v_[j][0] * v_[j][0] + v_[j][1] * v_[j][1]) + (v_[j][2] * v_[j][2] + v_[j][3] * v_[j][3]); } } while (0)
#define NORM_ROW(GVEC, MODROW, ROUTER, OUT8, m_, v_, s_) do { const int m = (m_); f32x4 (&v)[4] = v_; \
            { const int b = m >> 12; if (b != ncb) { ncb = b; const float* mrow = (MODROW) + (size_t)b * 6144;        \
                _Pragma("unroll") for (int j = 0; j < 4; ++j) { const f32x4 gg = *((const f32x4*)(GVEC) + lane + 64 * j), sc = *((const f32x4*)(mrow + 1024) + lane + 64 * j); ngs[j] = gg * (sc + 1.0f); nsh[j] = *((const f32x4*)mrow + lane + 64 * j); } } } \
            const float rstd = __builtin_amdgcn_rsqf(wave_sum(s_) * (1.0f / D) + EPS); \
            _Pragma("unroll") for (int j = 0; j < 4; ++j) v[j] = v[j] * rstd * ngs[j] + nsh[j]; \
            if (OUT8) { unsigned* o4 = (unsigned*)((unsigned char*)HB + (size_t)m * D) + lane; \
                _Pragma("unroll") for (int j = 0; j < 4; ++j) o4[64 * j] = pk_fp8x4(v[j][0] * H8_SCALE, v[j][1] * H8_SCALE, v[j][2] * H8_SCALE, v[j][3] * H8_SCALE); } \
            else { u32x2* o8 = (u32x2*)(HB + (size_t)m * D) + lane; \
                _Pragma("unroll") for (int j = 0; j < 4; ++j) o8[64 * j] = (u32x2){pk2(v[j][0], v[j][1]), pk2(v[j][2], v[j][3])}; } \
            if (ROUTER) { ROUTER_BODY } } while (0)
#define NORM_PHASE(XSRC, SRC16, GVEC, MODROW, ROUTER, OUT8) do { \
        const int rpw = (M + NGW - 1) / NGW; const int r_lo = (ROUTER ? (bx * NWAVES + wave) : gw) * rpw; int ncb = -1; f32x4 ngs[4], nsh[4]; \
        for (int rr = 0; rr < rpw; rr += 4) { const int m0 = r_lo + rr; if (m0 >= M) break; \
            f32x4 va[4], vb[4], vc[4], vd[4]; float sa, sb = 0.f, sc_ = 0.f, sd = 0.f; \
            const bool hb = (rr + 1 < rpw) && (m0 + 1 < M), hc = (rr + 2 < rpw) && (m0 + 2 < M), hd = (rr + 3 < rpw) && (m0 + 3 < M); \
            NORM_LOAD(XSRC, SRC16, m0, va, sa); if (hb) NORM_LOAD(XSRC, SRC16, m0 + 1, vb, sb); if (hc) NORM_LOAD(XSRC, SRC16, m0 + 2, vc, sc_); if (hd) NORM_LOAD(XSRC, SRC16, m0 + 3, vd, sd); \
            NORM_ROW(GVEC, MODROW, ROUTER, OUT8, m0, va, sa); if (hb) NORM_ROW(GVEC, MODROW, ROUTER, OUT8, m0 + 1, vb, sb); \
            if (hc) NORM_ROW(GVEC, MODROW, ROUTER, OUT8, m0 + 2, vc, sc_); if (hd) NORM_ROW(GVEC, MODROW, ROUTER, OUT8, m0 + 3, vd, sd); } } while (0)
#define ROUTER_BODY
    if (IN(1)) { NORM_PHASE(args.x, false, args.norm1_g, MOD, 0, false); }
    SEAM(1);

    if (IN(2)) {
        pg8::DenseSched S; S.init(M / 256, 12, G, bx); S.A = (const char*)HB; S.Bt = (const char*)W_DAIN; S.tstep = (size_t)256 * D * 2;
        pg8::EpiQKV E{QB, (size_t)M * D, args.da_q_gain, args.da_k_gain, 0.125f * LOG2E};
        pg8::gemm_phase<pg8::EpiQKV, pg8::DenseSched, true, false>(lds, 2 * D, S, E);
    }
    SEAM(2);

    if (IN(3)) {
        float a1 = args.da_lam_q1[lane] * args.da_lam_k1[lane], a2 = args.da_lam_q2[lane] * args.da_lam_k2[lane];
        const float lam = __expf(wave_sum(a1)) - __expf(wave_sum(a2)) + 0.2f;
        const float gq0 = wave_max(fabsf(args.da_q_gain[lane])), gq1 = wave_max(fabsf(args.da_q_gain[64 + lane]));
        const float gk0 = wave_max(fabsf(args.da_k_gain[lane])), gk1 = wave_max(fabsf(args.da_k_gain[64 + lane]));
        const float mref0 = 8.0f * LOG2E * gq0 * gk0 * 1.01f, mref1 = 8.0f * LOG2E * gq1 * gk1 * 1.01f;
        for (int rep = 0; rep < (PROBE_DUP == 3 ? 2 : 1); ++rep)
        for (int bb = vcu >> 4; bb < BATCH; bb += (G >= 16 ? (G >> 4) : 1)) {
            const int w16 = vcu & 15, nu = att::PLAN.n[w16];
            for (int i = 0; i < nu; ++i) { const int hj = att::PLAN.u[w16][i], h = hj >> 5, jq = hj & 31;
                const float sl2 = LOG2E * exp2f(-(float)(h + 1));
                att::attn_unit(lds, QB, KB, VB, HB, bb, h, jq, sl2, mref0, mref1, lam, args.da_subln_g); }
        }
    }
    SEAM(3);

    if (IN(4)) {
        pg8::DenseSched S; S.init(M / 256, 4, G, bx); S.A = (const char*)HB; S.Bt = (const char*)W_DAOUT; S.tstep = (size_t)256 * D * 2;
        pg8::EpiResid<false, true> E{args.x, XB, MOD + 2048, 1.0f};
        pg8::gemm_phase<pg8::EpiResid<false, true>, pg8::DenseSched, true, false>(lds, 2 * D, S, E);
    }
    SEAM(4);
    if (IN(5)) { NORM_PHASE(XB, true, args.norm2_g, MOD + 3072, 0, FFN_UP8); }
    SEAM(5);

    if (IN(6)) {
        pg8::DenseSched S; S.init(M / 256, 2 * FFN / 256, G, bx); S.A = (const char*)HB; S.Bt = (const char*)W_FFN13; S.tstep = (size_t)256 * D * (FFN_UP8 ? 1 : 2);
        pg8::EpiSwiGLU<FFN_DN8> E{ACTB, FFN, FFN_UP8 ? 1.0f / (H8_SCALE * W8_SCALE) : 1.0f};
        pg8::gemm_phase<pg8::EpiSwiGLU<FFN_DN8>, pg8::DenseSched, true, false, FFN_UP8>(lds, D * (FFN_UP8 ? 1 : 2), S, E);
    }
    SEAM(6);
    if (IN(7)) {
        pg8::DenseSched S; S.init(M / 256, 4, G, bx); S.A = (const char*)ACTB; S.Bt = (const char*)W_FFN2; S.tstep = (size_t)256 * FFN * (FFN_DN8 ? 1 : 2);
        pg8::EpiResid<true, true> E{XB, XB, MOD + 5 * 1024, FFN_DN8 ? 1.0f / (A8_SCALE * W8_SCALE) : 1.0f};
        pg8::gemm_phase<pg8::EpiResid<true, true>, pg8::DenseSched, true, false, FFN_DN8>(lds, FFN * (FFN_DN8 ? 1 : 2), S, E);
    }
    SEAM(7);

    float* MOD1 = MOD + 16 * 6144;
    if (IN(8)) { NORM_PHASE(XB, true, args.norm1_g + D, MOD1, 0, false); }
    SEAM(8);
    if (IN(9)) {
        pg8::DenseSched S; S.init(M / 256, GLA_N / 256, G, bx); S.A = (const char*)HB; S.Bt = (const char*)W_GLAIN; S.tstep = (size_t)256 * D * 2;
        pg8::EpiGLA E{GP, GLAB, args.gla_b_a, args.gla_out_g};
        pg8::gemm_phase<pg8::EpiGLA, pg8::DenseSched, true, false>(lds, 2 * D, S, E);
    }
    SEAM(9);

    unsigned char* GA = (unsigned char*)out;
    static_assert(4096 * GA_UNIT <= 192 * MiB && 256 * MiB <= (size_t)M * D * 4 && (size_t)M * 512 * 2 >= 64 * MiB, "o-fragment parking");
#define OFRAG(b_, n_, h_) (((b_) < 8 ? (unsigned char*)GLAB : (unsigned char*)out + 192 * MiB) + (size_t)(((((b_) & 7) * 64 + (n_)) * 4) + (h_)) * 32768)
    if (IN(10)) {
        LAS unsigned char* QDp = lds; LAS unsigned char* KDTc = lds + 16384; LAS unsigned char* ATc = lds + 32768; LAS float* DV = (LAS float*)(lds + 40960);
        LAS bf16* KI = (LAS bf16*)(lds + 43008); LAS float* QT = (LAS float*)(lds + 60416);
        const int fr = lane & 15, fq = lane >> 4;
        const int j = tid & 127, tq = tid >> 7;
        const int cq = j >> 4, wq = j & 15, hq = (wq >> 2) & 1, jq2 = ((wq >> 3) << 2) | (wq & 3);
        for (int rep = 0; rep < (PROBE_DUP == 10 ? 2 : 1); ++rep)
        for (int u = bx; u < 4096; u += G) {
            const int h = u & 3, n = (u >> 2) & 63, b = u >> 8;
            const size_t R0 = (size_t)b * SEQ + 64 * n;
            float la[16], qv[16], kv[16];
#pragma unroll
            for (int i = 0; i < 16; ++i) { const size_t row = R0 + 16 * tq + i; la[i] = bf2f(GLAB[row * 512 + h * 128 + j]); qv[i] = bf2f(GP[row * 3072 + h * 128 + j]); kv[i] = bf2f(GP[row * 3072 + 512 + h * 128 + j]); }
#pragma unroll
            for (int i = 1; i < 16; ++i) la[i] += la[i - 1];
            QT[tq * 128 + j] = la[15];
            __syncthreads();
            float pre = 0.f, tot = 0.f;
#pragma unroll
            for (int q = 0; q < 4; ++q) { const float v = QT[q * 128 + j]; tot += v; pre += (q < tq) ? v : 0.f; }
            unsigned kdp[8];
#pragma unroll
            for (int i = 0; i < 16; ++i) { const float bb = pre + la[i]; const int t = 16 * tq + i;
                *(LAS bf16*)(QDp + (((cq * 2 + hq) * 64 + t) * 16) + jq2 * 2) = (bf16)f2bf(qv[i] * 0.08838834764831845f * __expf(bb));
                KI[t * 136 + j] = (bf16)f2bf(kv[i] * __expf(-bb));
                const float kd = kv[i] * __expf(tot - bb);
                if (i & 1) kdp[i >> 1] |= f2bf(kd) << 16; else kdp[i >> 1] = f2bf(kd); }
            *(LAS u32x4*)(KDTc + ((2 * tq) * 128 + j) * 16) = (u32x4){kdp[0], kdp[1], kdp[2], kdp[3]};
            *(LAS u32x4*)(KDTc + ((2 * tq + 1) * 128 + j) * 16) = (u32x4){kdp[4], kdp[5], kdp[6], kdp[7]};
            if (tq == 0) DV[j] = __expf(tot);
            __syncthreads();
#pragma unroll
            for (int q = 0; q < 2; ++q) { const int idx = 2 * wave + q, ti = idx >> 2, si = idx & 3;
                f32x4 c = (f32x4){0.f, 0.f, 0.f, 0.f};
                if (si <= ti) {
#pragma unroll
                    for (int ks = 0; ks < 4; ++ks) { const int cc = 2 * ks + (fq >> 1), jb = 4 * (fq & 1), t = 16 * ti + fr;
                        const u32x2 alo = *(const LAS u32x2*)(QDp + (((cc * 2 + 0) * 64 + t) * 16) + jb * 2), ahi = *(const LAS u32x2*)(QDp + (((cc * 2 + 1) * 64 + t) * 16) + jb * 2);
                        const u32x4 af = (u32x4){alo[0], alo[1], ahi[0], ahi[1]};
                        const bf16x8 bfr = *(const LAS bf16x8*)(KI + (16 * si + fr) * 136 + 32 * ks + 8 * fq);
                        c = __builtin_amdgcn_mfma_f32_16x16x32_bf16(__builtin_bit_cast(bf16x8, af), bfr, c, 0, 0, 0); }
                }
#pragma unroll
                for (int r = 0; r < 4; ++r) { const int t = 16 * ti + 4 * fq + r, sx = 16 * si + fr; *(LAS bf16*)(ATc + (((sx >> 3) * 64 + t) * 16) + (sx & 7) * 2) = (bf16)f2bf(sx <= t ? c[r] : 0.f); } }
            __syncthreads();
            { u32x4* dst = (u32x4*)(GA + (size_t)u * GA_UNIT);
              for (int v = tid; v < 41472 / 16; v += 512) dst[v] = *(const LAS u32x4*)(lds + v * 16); }
            __syncthreads();
        }
    }
    SEAM(10);

    const int sstride = G >= 256 ? 4 : (G >= 128 ? 2 : 1);
    const bool is_scan = (vcu % sstride == 0) && (vcu / sstride < 64);
    const int scan_id = vcu / sstride;
    const int copy_id = vcu < 64 * sstride ? (vcu / sstride) * (sstride - 1) + (vcu % sstride) - 1 : 64 * (sstride - 1) + (vcu - 64 * sstride);
    if (IN(11) && !is_scan) {
        LAS float* scr = (LAS float*)(lds + wave * 16384);
        constexpr int I_M13 = 16 * 112, I_M2 = 56 * 32, NIT = NEXP * 2 * I_M13 + NEXP * I_M2;
        const int nwv = (G - 64) * NWAVES;
        for (int rep = 0; rep < (PROBE_DUP == 20 ? 2 : 1); ++rep)
        for (int it = copy_id * NWAVES + wave; it < NIT; it += nwv) {
            int r = it;
            if (r < NEXP * 2 * I_M13) { const int e = r / (2 * I_M13), q2 = r % (2 * I_M13), w = q2 / I_M13, q = q2 % I_M13, kb = q / 112, nb = q % 112, n0 = 32 * nb;
                if (MOE_UP8) p0_transpose_item8((w ? args.moe_w3 : args.moe_w1) + (size_t)e * D * EXPD, EXPD, 64 * kb, n0, (unsigned char*)W_MOE13 + (size_t)e * 2 * EXPD * D, (n0 >> 7) * 256 + w * 128 + (n0 & 127), D, scr, lane);
                else p0_transpose_item((w ? args.moe_w3 : args.moe_w1) + (size_t)e * D * EXPD, EXPD, 64 * kb, n0, W_MOE13 + (size_t)e * 2 * EXPD * D, (n0 >> 7) * 256 + w * 128 + (n0 & 127), D, scr, lane); continue; }
            r -= NEXP * 2 * I_M13;
            { const int e = r / I_M2, q = r % I_M2, kb = q / 32, nb = q % 32;
                if (MOE_DN8) p0_transpose_item8(args.moe_w2 + (size_t)e * EXPD * D, D, 64 * kb, 32 * nb, (unsigned char*)W_MOE2 + (size_t)e * D * EXPD, 32 * nb, EXPD, scr, lane);
                else p0_transpose_item(args.moe_w2 + (size_t)e * EXPD * D, D, 64 * kb, 32 * nb, W_MOE2 + (size_t)e * D * EXPD, 32 * nb, EXPD, scr, lane); }
        }
    }
    if (IN(11) && is_scan) {
        const int b = scan_id >> 2, h = scan_id & 3;
        constexpr int BUFB = 74752, VOFF = 41984, GO_OFF = 2 * BUFB;
        LAS float* GO = (LAS float*)(lds + GO_OFF);
        if (tid < 256) GO[tid] = args.gla_out_g[tid];
        const int r32 = lane & 31, hh = lane >> 5;
        const int c0 = 32 * wave;
        const unsigned char* gabase = GA + ((size_t)b * 256 + h) * GA_UNIT;
        const bf16* vsrc = GP + ((size_t)b * SEQ + (lane >> 2)) * 3072 + 1024 + h * 256 + 32 * wave + (lane & 3) * 8;
#define GLA_DMA(n_, bs_) do { LAS unsigned char* bb_ = lds + (bs_) * BUFB; const unsigned char* ga_ = gabase + (size_t)(n_) * 4 * GA_UNIT; \
        _Pragma("unroll") for (int k_ = 0; k_ < 6; ++k_) { int p_ = wave + 8 * k_; p_ = p_ > 40 ? 40 : p_; \
            __builtin_amdgcn_global_load_lds((const unsigned*)(ga_ + p_ * 1024 + lane * 16), (LAS unsigned*)(bb_ + p_ * 1024), 16, 0, 0); } \
        _Pragma("unroll") for (int ks_ = 0; ks_ < 4; ++ks_) \
            __builtin_amdgcn_global_load_lds((const unsigned*)(vsrc + ((size_t)(n_) * 64 + 16 * ks_) * 3072), (LAS unsigned*)(bb_ + VOFF + (ks_ * 8 + wave) * 1024), 16, 0, 0); } while (0)
#define GLA_BAR() do { asm volatile("s_waitcnt lgkmcnt(0)" ::: "memory"); __builtin_amdgcn_s_barrier(); asm volatile("" ::: "memory"); } while (0)
        for (int rep = 0; rep < (PROBE_DUP == 11 ? 2 : 1); ++rep) {
        f32x16 Sacc[4];
#pragma unroll
        for (int kt = 0; kt < 4; ++kt)
#pragma unroll
            for (int r = 0; r < 16; ++r) Sacc[kt][r] = 0.f;
        GLA_DMA(0, 0);
        asm volatile("s_waitcnt vmcnt(0)" ::: "memory");
        for (int n = 0; n < 64; ++n) {
            const size_t R0 = (size_t)b * SEQ + 64 * n;
            asm volatile("s_waitcnt vmcnt(4)" ::: "memory");
            GLA_BAR();
            if (n + 1 < 64) GLA_DMA(n + 1, (n + 1) & 1);
            LAS unsigned char* bb = lds + (n & 1) * BUFB;
            const LAS unsigned char* QDp = bb; const LAS unsigned char* KDTc = bb + 16384; const LAS unsigned char* ATc = bb + 32768; const LAS float* DV = (const LAS float*)(bb + 40960);
            bf16x8 vf[4];
#pragma unroll
            for (int ks = 0; ks < 4; ++ks) { const LAS unsigned char* vp = bb + VOFF + (ks * 8 + wave) * 1024 + ((lane >> 4) & 1) * 32 + (lane & 3) * 8 + (8 * hh + ((lane & 15) >> 2)) * 64;
                const s16x4 lo = att::vtr(vp), hi4 = att::vtr(vp + 256); vf[ks] = (bf16x8){lo[0], lo[1], lo[2], lo[3], hi4[0], hi4[1], hi4[2], hi4[3]}; }
            f32x16 o[2];
#pragma unroll
            for (int tt = 0; tt < 2; ++tt)
#pragma unroll
                for (int r = 0; r < 16; ++r) o[tt][r] = 0.f;
            bf16x8 qa[16], aa[6];
#pragma unroll
            for (int kt = 0; kt < 4; ++kt)
#pragma unroll
                for (int sx = 0; sx < 2; ++sx)
#pragma unroll
                    for (int tt = 0; tt < 2; ++tt) qa[(kt * 2 + sx) * 2 + tt] = *(const LAS bf16x8*)(QDp + ((((kt * 2 + sx) * 2 + hh) * 64 + 32 * tt + r32) * 16));
#pragma unroll
            for (int i = 0; i < 6; ++i) { const int tt = i < 2 ? 0 : 1, ks = i < 2 ? i : i - 2;
                aa[i] = *(const LAS bf16x8*)(ATc + (((2 * ks + hh) * 64 + 32 * tt + r32) * 16)); }
            __builtin_amdgcn_sched_barrier(0);
#pragma unroll
            for (int kt = 0; kt < 4; ++kt)
#pragma unroll
                for (int sx = 0; sx < 2; ++sx) {
                    u32x4 sb;
#pragma unroll
                    for (int g = 0; g < 4; ++g) sb[g] = cvt_pk_bf16(Sacc[kt][8 * sx + 2 * g], Sacc[kt][8 * sx + 2 * g + 1]);
#pragma unroll
                    for (int tt = 0; tt < 2; ++tt) o[tt] = __builtin_amdgcn_mfma_f32_32x32x16_bf16(qa[(kt * 2 + sx) * 2 + tt], __builtin_bit_cast(bf16x8, sb), o[tt], 0, 0, 0);
                }
#pragma unroll
            for (int i = 0; i < 6; ++i) { const int tt = i < 2 ? 0 : 1, ks = i < 2 ? i : i - 2;
                o[tt] = __builtin_amdgcn_mfma_f32_32x32x16_bf16(aa[i], vf[ks], o[tt], 0, 0, 0); }
            __builtin_amdgcn_sched_barrier(0);
            { u32x4* dst = (u32x4*)(OFRAG(b, n, h)) + (wave * 4) * 64 + lane;
#pragma unroll
              for (int tt = 0; tt < 2; ++tt)
#pragma unroll
                  for (int q = 0; q < 2; ++q) { u32x4 w;
#pragma unroll
                      for (int g = 0; g < 4; ++g) w[g] = cvt_pk_bf16(o[tt][8 * q + 2 * g], o[tt][8 * q + 2 * g + 1]);
                      dst[(tt * 2 + q) * 64] = w; } }
            __builtin_amdgcn_sched_barrier(0);
            f32x4 dvv[16]; bf16x8 ka[16];
#pragma unroll
            for (int kt = 0; kt < 4; ++kt)
#pragma unroll
                for (int g = 0; g < 4; ++g) dvv[kt * 4 + g] = *(const LAS f32x4*)(DV + 32 * kt + 8 * g + 4 * hh);
#pragma unroll
            for (int ks = 0; ks < 4; ++ks)
#pragma unroll
                for (int kt = 0; kt < 4; ++kt) ka[ks * 4 + kt] = *(const LAS bf16x8*)(KDTc + (((2 * ks + hh) * 128 + 32 * kt + r32) * 16));
            __builtin_amdgcn_sched_barrier(0);
#pragma unroll
            for (int kt = 0; kt < 4; ++kt)
#pragma unroll
                for (int g = 0; g < 4; ++g)
#pragma unroll
                    for (int e = 0; e < 4; ++e) Sacc[kt][4 * g + e] *= dvv[kt * 4 + g][e];
#pragma unroll
            for (int ks = 0; ks < 4; ++ks)
#pragma unroll
                for (int kt = 0; kt < 4; ++kt) Sacc[kt] = __builtin_amdgcn_mfma_f32_32x32x16_bf16(ka[ks * 4 + kt], vf[ks], Sacc[kt], 0, 0, 0);
        }
        asm volatile("s_waitcnt vmcnt(0)" ::: "memory");
        GLA_BAR();
        }
#undef GLA_DMA
#undef GLA_BAR
    }
    if (IN(11)) {
        static_assert(MK_N_LAUNCHES == 1, "the scan follow-up sits behind an in-phase grid barrier");
        xcd_barrier(bar);
        LAS float* OS = (LAS float*)lds;
        const int r32 = lane & 31, hh = lane >> 5, c0 = 32 * wave;
        u32x4 fr[4], rwv[4];
#define P10C_LOAD(u_) do { const int b_ = (u_) >> 8, n_ = ((u_) >> 2) & 63, h_ = (u_) & 3; const u32x4* src_ = (const u32x4*)(OFRAG(b_, n_, h_)) + (wave * 4) * 64 + lane; \
            _Pragma("unroll") for (int k_ = 0; k_ < 4; ++k_) fr[k_] = src_[k_ * 64]; \
            const bf16* rp0_ = GP + ((size_t)b_ * SEQ + 64 * n_ + (tid >> 3)) * 3072 + 2048 + h_ * 256 + 32 * (tid & 7); \
            _Pragma("unroll") for (int i_ = 0; i_ < 4; ++i_) rwv[i_] = *(const u32x4*)(rp0_ + 8 * i_); } while (0)
        int u = bx;
        if (u < 4096) P10C_LOAD(u);
        for (; u < 4096; u += G) {
            const int b = u >> 8, n = (u >> 2) & 63, h = u & 3; const size_t R0 = (size_t)b * SEQ + 64 * n;
            u32x4 rw_c[4];
#pragma unroll
            for (int i = 0; i < 4; ++i) rw_c[i] = rwv[i];
            __syncthreads();
#pragma unroll
            for (int tt = 0; tt < 2; ++tt)
#pragma unroll
                for (int q = 0; q < 2; ++q)
#pragma unroll
                    for (int g = 0; g < 4; ++g) { const unsigned w = fr[tt * 2 + q][g]; const int r = 8 * q + 2 * g;
                        OS[(32 * tt + att::crow(r, hh)) * 260 + c0 + r32] = __builtin_bit_cast(float, w << 16);
                        OS[(32 * tt + att::crow(r + 1, hh)) * 260 + c0 + r32] = __builtin_bit_cast(float, w & 0xffff0000u); }
            __syncthreads();
            if (u + G < 4096) P10C_LOAD(u + G);
            { const int t = tid >> 3, seg = tid & 7; f32x4 ov[8]; float ss = 0.f;
#pragma unroll
              for (int i = 0; i < 8; ++i) { ov[i] = *(const LAS f32x4*)(OS + t * 260 + 32 * seg + 4 * i); ss += (ov[i][0] * ov[i][0] + ov[i][1] * ov[i][1]) + (ov[i][2] * ov[i][2] + ov[i][3] * ov[i][3]); }
              ss += __shfl_xor(ss, 1); ss += __shfl_xor(ss, 2); ss += __shfl_xor(ss, 4);
              const float rs = __builtin_amdgcn_rsqf(ss * (1.0f / 256.0f) + EPS);
              bf16* op = HB + (R0 + t) * D + h * 256 + 32 * seg;
#pragma unroll
              for (int i = 0; i < 4; ++i) { const u32x4 rw = rw_c[i]; u32x4 w;
#pragma unroll
                  for (int e = 0; e < 4; ++e) { const float r0 = __builtin_bit_cast(float, rw[e] << 16), r1 = __builtin_bit_cast(float, rw[e] & 0xffff0000u);
                      const int cidx = 8 * i + 2 * e;
                      const float v0 = ov[(cidx) >> 2][(cidx) & 3] * rs * r0, v1 = ov[(cidx + 1) >> 2][(cidx + 1) & 3] * rs * r1;
                      w[e] = pk2(v0, v1); }
                  *(u32x4*)(op + 8 * i) = w; } }
        }
#undef P10C_LOAD
    }
    SEAM(11);


    if (IN(12)) {
        pg8::DenseSched S; S.init(M / 256, 4, G, bx); S.A = (const char*)HB; S.Bt = (const char*)W_GLAOUT; S.tstep = (size_t)256 * D * 2;
        pg8::EpiResid<true, true> E{XB, XB, MOD1 + 2048, 1.0f};
        pg8::gemm_phase<pg8::EpiResid<true, true>, pg8::DenseSched, true, false>(lds, 2 * D, S, E);
    }
    SEAM(12);

    if (IN(13)) {
        LAS float* RW = (LAS float*)lds;
        LAS unsigned* EL = (LAS unsigned*)(lds + 32768);
        LAS float* GL = (LAS float*)(lds + 32768 + 4096);
        for (int e = tid; e < 8192; e += 512) { const int k = e >> 3, ex = e & 7;
            RW[((((k >> 8) * 4 + (k & 3)) * 2 + (ex >> 2)) * 64 + ((k & 255) >> 2)) * 4 + (ex & 3)] = args.moe_router[e]; }
        __syncthreads();
#undef ROUTER_BODY
#define ROUTER_BODY { float lg[8]; \
            _Pragma("unroll") for (int e = 0; e < 8; ++e) lg[e] = 0.f; \
            _Pragma("unroll") for (int j = 0; j < 4; ++j) _Pragma("unroll") for (int i = 0; i < 4; ++i) { const f32x4 w0 = *((const LAS f32x4*)RW + ((j * 4 + i) * 2) * 64 + lane), w1 = *((const LAS f32x4*)RW + ((j * 4 + i) * 2 + 1) * 64 + lane); const float hv = v[j][i]; \
                lg[0] += hv * w0[0]; lg[1] += hv * w0[1]; lg[2] += hv * w0[2]; lg[3] += hv * w0[3]; lg[4] += hv * w1[0]; lg[5] += hv * w1[1]; lg[6] += hv * w1[2]; lg[7] += hv * w1[3]; } \
            _Pragma("unroll") for (int e = 0; e < 8; ++e) lg[e] = wave_sum(lg[e]); \
            float v1 = lg[0]; \
            _Pragma("unroll") for (int e = 1; e < 8; ++e) v1 = fmaxf(v1, lg[e]); \
            int e1 = 7; \
            _Pragma("unroll") for (int e = 6; e >= 0; --e) e1 = (lg[e] == v1) ? e : e1; \
            float v2 = -3.0e38f; \
            _Pragma("unroll") for (int e = 0; e < 8; ++e) v2 = fmaxf(v2, (e == e1) ? -3.0e38f : lg[e]); \
            int e2 = -1; \
            _Pragma("unroll") for (int e = 7; e >= 0; --e) e2 = (e != e1 && lg[e] == v2) ? e : e2; \
            if (lane == 0) { EL[m - wg_row0] = (unsigned)e1 | ((unsigned)e2 << 8); GL[m - wg_row0] = v1 - v2; } }
        const int rpw12 = (M + NGW - 1) / NGW, rows_wg12 = rpw12 * NWAVES, wg_row0 = bx * rows_wg12;
        NORM_PHASE(XB, true, args.norm2_g + D, MOD1 + 3072, 1, MOE_UP8);
        __syncthreads();
        {
            int nrows = M - wg_row0; nrows = nrows > rows_wg12 ? rows_wg12 : nrows;
            for (int r = tid; r < nrows; r += 512) { const unsigned ew = EL[r]; const unsigned e1 = ew & 255u, e2 = ew >> 8; unsigned l1 = 0, l2 = 0;
                for (int q = 0; q < r; ++q) { const unsigned w = EL[q]; l1 += ((w & 255u) == e1) ? 1u : 0u; l2 += ((w >> 8) == e2) ? 1u : 0u; }
                ROUTE[wg_row0 + r] = (u32x4){ew, __builtin_bit_cast(unsigned, GL[r]), l1, l2}; }
            if (tid < 16) { const unsigned e = tid & 7; unsigned cnt = 0; for (int q = 0; q < nrows; ++q) { const unsigned w = EL[q]; cnt += ((tid < 8 ? (w & 255u) : (w >> 8)) == e) ? 1u : 0u; } LCNT[bx * 16 + tid] = cnt; }
        }
    }
    SEAM(13);

    if (IN(14)) {
        LAS int* PRE = (LAS int*)lds;
        LAS int* GOFF = (LAS int*)(lds + 256);
        if (tid < 16) { int pre = 0, tot = 0; for (int w = 0; w < G; ++w) { const int v = (int)LCNT[w * 16 + tid]; tot += v; pre += (w < bx) ? v : 0; } PRE[tid] = pre; ((LAS int*)(lds + 512))[tid] = (tot + 255) & ~255; }
        __syncthreads();
        if (tid < 2) { int acc = 0; for (int e = 0; e < 8; ++e) { GOFF[tid * 9 + e] = acc; acc += ((LAS int*)(lds + 512))[tid * 8 + e]; } GOFF[tid * 9 + 8] = acc;
            if (bx == 0) { for (int e = 0; e < 9; ++e) META[tid * 16 + e] = GOFF[tid * 9 + e]; } }
        __syncthreads();
        const int rpw = (M + NGW - 1) / NGW, rows_wg = rpw * NWAVES;
        for (int r = tid; r < rows_wg; r += 512) { const int m = bx * rows_wg + r; if (m >= M) break;
            const u32x4 rt = ROUTE[m]; const int e1 = rt[0] & 255, e2 = (rt[0] >> 8) & 255; const unsigned gbits = rt[1]; const float gap = __builtin_bit_cast(float, gbits); const float g1 = 1.0f / (1.0f + expf(-gap));
            const int s1 = GOFF[e1] + PRE[e1] + (int)rt[2], s2 = GOFF[9 + e2] + PRE[8 + e2] + (int)rt[3];
            TOKSLOT[s1] = m; GSLOT[s1] = g1; TOKSLOT[MAXSLOT + s2] = m; GSLOT[MAXSLOT + s2] = 1.0f - g1; }
    }
    SEAM(14);

#define MOE_SCHED(S, p) do { const int* mt = META + (p) * 16; S.g1 = mt[1]; S.g2 = mt[2]; S.g3 = mt[3]; S.g4 = mt[4]; S.g5 = mt[5]; S.g6 = mt[6]; S.g7 = mt[7]; } while (0)
#pragma unroll
    for (int p = 0; p < 2; ++p) {
        if (IN(15 + 2 * p)) {
            pg8::MoeSched S; MOE_SCHED(S, p); const int nP = META[p * 16 + 8] >> 8;
            S.init(nP, 2 * EXPD / 256, G, bx); S.A = (const char*)HB; S.a_tstep = 0; S.Bt = (const char*)W_MOE13; S.b_tstep = (size_t)256 * D * (MOE_UP8 ? 1 : 2); S.b_estride = (size_t)2 * EXPD * D * (MOE_UP8 ? 1 : 2);
            S.tokslot = TOKSLOT + p * MAXSLOT; S.rowbytes = D * (MOE_UP8 ? 1 : 2);
            pg8::EpiSwiGLU<MOE_DN8> E{ACTB, EXPD, MOE_UP8 ? 1.0f / (H8_SCALE * W8_SCALE) : 1.0f};
            pg8::gemm_phase<pg8::EpiSwiGLU<MOE_DN8>, pg8::MoeSched, true, true, MOE_UP8>(lds, D * (MOE_UP8 ? 1 : 2), S, E);
        }
        SEAM(15 + 2 * p);
        if (IN(16 + 2 * p)) {
            pg8::MoeSched S; MOE_SCHED(S, p); const int nP = META[p * 16 + 8] >> 8;
            constexpr int RBD = EXPD * (MOE_DN8 ? 1 : 2), NTD = RBD / 128;
            int nPm = nP, jpart = -1; const int qpart = bx & 7;
            { const int nwg = nP * 4, nfull = nwg / G, nrem = nwg - nfull * G; if (nrem > 0 && 8 * nrem <= G && (nfull * G) % 4 == 0 && NTD >= 16) { nPm = nfull * G / 4; if (bx < 8 * nrem) jpart = bx >> 3; } }
            S.init(nPm, 4, G, bx); S.A = (const char*)ACTB; S.a_tstep = (size_t)256 * RBD; S.Bt = (const char*)W_MOE2; S.b_tstep = (size_t)256 * RBD; S.b_estride = (size_t)D * RBD;
            S.tokslot = TOKSLOT + p * MAXSLOT; S.rowbytes = 0;
#define MOE_DOWN(FINAL_) do { pg8::EpiMoeDown<FINAL_> E{TOKSLOT + p * MAXSLOT, GSLOT + p * MAXSLOT, XB, out, MOD1 + 5 * 1024, MOE_DN8 ? 1.0f / (A8_SCALE * W8_SCALE) : 1.0f}; \
                if (nPm > 0) pg8::gemm_phase<pg8::EpiMoeDown<FINAL_>, pg8::MoeSched, true, false, MOE_DN8>(lds, RBD, S, E); \
                if (jpart >= 0) {       \
                    const int gsz = nP - nPm; pg8::Unit u; u.pm = nPm + jpart % gsz; u.pn = jpart / gsz; \
                    { pg8::MoeSchedTail T; MOE_SCHED(T, p); T.init(nP, 4, G, bx); T.A = S.A; T.a_tstep = S.a_tstep; T.Bt = S.Bt; T.b_tstep = S.b_tstep; T.b_estride = S.b_estride; T.tokslot = S.tokslot; T.rowbytes = 0; \
                      constexpr int P = NTD / 2, base = P / 8, extra = P % 8; T.pmT = u.pm; T.pnT = u.pn; T.k0T = 2 * (qpart * base + (qpart < extra ? qpart : extra)); T.nkT = 2 * (base + (qpart < extra ? 1 : 0)); \
                      pg8::EpiPartStore EP{KPART + (size_t)bx * (32 * 512 * 4)}; \
                      pg8::gemm_phase<pg8::EpiPartStore, pg8::MoeSchedTail, true, false, MOE_DN8, true>(lds, RBD, T, EP); } \
                    unsigned* kc = ctl + CW_KCNT + p * 64 + jpart; \
                    asm volatile("s_waitcnt vmcnt(0)" ::: "memory"); __syncthreads(); \
                    if (tid == 0) { __builtin_amdgcn_fence(__ATOMIC_RELEASE, "agent"); asm volatile("s_waitcnt vmcnt(0)" ::: "memory"); (void)xb_add(kc, 1u); \
                        XB_SPIN(xb_ld(kc) < 8u, ctl + CW_BAR); __builtin_amdgcn_fence(__ATOMIC_ACQUIRE, "agent"); asm volatile("s_waitcnt vmcnt(0)" ::: "memory"); } \
                    __syncthreads(); \
                    const int ai = qpart >> 2, m = qpart & 3; \
                    f32x4 v[2][2]; \
                    _Pragma("unroll") for (int bj = 0; bj < 2; ++bj) _Pragma("unroll") for (int n = 0; n < 2; ++n) { f32x4 a = (f32x4){0.f, 0.f, 0.f, 0.f}; \
                        const f32x4* pp = (const f32x4*)(KPART + (size_t)(jpart * 8) * (32 * 512 * 4)) + (size_t)((((ai * 2 + bj) * 4 + m) * 2 + n) * 512 + tid); \
                        _Pragma("unroll") for (int qq = 0; qq < 8; ++qq) a += pp[(size_t)qq * (32 * 512)]; \
                        v[bj][n] = a; } \
                    E.slice(v, u, ai, m, wave >> 2, wave & 3, lane & 15, lane >> 4); } } while (0)
            if (p == 0) MOE_DOWN(false); else MOE_DOWN(true);
#undef MOE_DOWN
        }
        if (p == 0) SEAM(16);
    }
#undef IN
#undef SEAM
}


constexpr int N_PHASES = 19;
extern "C" void kernel_launch(void* const* d_in, const int* in_sizes, int n_in, void* d_out, int out_size, void* d_ws, size_t ws_size, hipStream_t stream) {
    static int grid = 0;
    if (grid == 0) {
        if (n_in != 28 || in_sizes[0] != M * D || out_size != M * D || ws_size < WS_TOTAL) { fprintf(stderr, "kernel_launch: unexpected problem shape (n_in %d, out %d, ws %zu)\n", n_in, out_size, ws_size); grid = -1; return; }
        int dev = 0, cus = 0, per_cu = 0;
        if (hipGetDevice(&dev) != hipSuccess || hipDeviceGetAttribute(&cus, hipDeviceAttributeMultiprocessorCount, dev) != hipSuccess) { grid = -1; return; }
        if (hipFuncSetAttribute((const void*)mk_fwd, hipFuncAttributeMaxDynamicSharedMemorySize, LDS_BYTES) != hipSuccess) { fprintf(stderr, "kernel_launch: hipFuncSetAttribute failed\n"); grid = -1; return; }
        if (hipOccupancyMaxActiveBlocksPerMultiprocessor(&per_cu, (const void*)mk_fwd, NWAVES * 64, LDS_BYTES) != hipSuccess || per_cu < 1) { fprintf(stderr, "kernel_launch: occupancy query reports %d\n", per_cu); }
        (void)hipGetLastError();
        grid = cus;
        if (grid < 128) { fprintf(stderr, "kernel_launch: built for a >= 128-CU device (64 GLA scan workgroups + weight-copy workgroups); got %d\n", grid); grid = -1; return; }
    }
    if (grid < 0) return;
    if (hipMemsetAsync((char*)d_ws + WS_CTL, 0, CTL_ZERO_BYTES, stream) != hipSuccess) return;
    Args a{};
    const float** ap = (const float**)&a;
    for (int i = 0; i < 28; ++i) ap[i] = (const float*)d_in[i];
    a.out = (float*)d_out; a.ws = (unsigned char*)d_ws;
    if (MK_N_LAUNCHES == 1) { a.ph_lo = 0; a.ph_hi = N_PHASES; hipLaunchKernelGGL(mk_fwd, dim3(grid), dim3(NWAVES * 64), LDS_BYTES, stream, a); }
    else { for (int p = 0; p < N_PHASES; ++p) { a.ph_lo = p; a.ph_hi = p + 1; hipLaunchKernelGGL(mk_fwd, dim3(grid), dim3(NWAVES * 64), LDS_BYTES, stream, a); } }
}
```

```cpp
#include <hip/hip_runtime.h>
#include <cstdio>
#include <cstdint>

#ifndef PROBE_DUP
#define PROBE_DUP -1
#endif
#ifndef MK_N_LAUNCHES
#define MK_N_LAUNCHES 1
#endif

#define LAS __attribute__((address_space(3)))
#define GAS __attribute__((address_space(1)))
typedef unsigned short bf16;
typedef short bf16x8 __attribute__((ext_vector_type(8)));
typedef short s16x4 __attribute__((ext_vector_type(4)));
typedef float f32x4 __attribute__((ext_vector_type(4)));
typedef float f32x2 __attribute__((ext_vector_type(2)));
typedef float f32x16 __attribute__((ext_vector_type(16)));
typedef unsigned u32x4 __attribute__((ext_vector_type(4)));
typedef unsigned u32x2 __attribute__((ext_vector_type(2)));

constexpr int D = 1024, BATCH = 16, SEQ = 4096, M = BATCH * SEQ;
constexpr int FFN = 2816, NEXP = 8, EXPD = 3584;
constexpr int GLA_N = 3584;
constexpr float EPS = 1e-6f;
constexpr float LOG2E = 1.4426950408889634f;
constexpr int NWAVES = 8;
constexpr int MAXSLOT = M + NEXP * 256;

constexpr size_t MiB = 1u << 20;
constexpr size_t WS_CTL = 0, CTL_ZERO_BYTES = 64 * 1024;
constexpr size_t WS_MOD = 256 * 1024;
constexpr size_t WS_LCNT = 1 * MiB + 256 * 1024;
constexpr size_t WS_META = 1 * MiB + 512 * 1024;
constexpr size_t WS_ROUTE = 2 * MiB;
constexpr size_t WS_TOKSLOT = 4 * MiB;
constexpr size_t WS_GSLOT = 5 * MiB;
constexpr size_t WS_W_DAIN = 8 * MiB, WS_W_DAOUT = 14 * MiB, WS_W_FFN13 = 16 * MiB, WS_W_FFN2 = 27 * MiB;
constexpr size_t WS_W_GLAIN = 33 * MiB, WS_W_GLAOUT = 40 * MiB, WS_W_MOE13 = 42 * MiB, WS_W_MOE2 = 154 * MiB;
constexpr size_t WS_H = 210 * MiB;
constexpr size_t WS_Q = 338 * MiB;
constexpr size_t WS_END = WS_Q + 464 * MiB;
constexpr size_t WS_XB = WS_END;
constexpr size_t WS_TOTAL = WS_XB + (size_t)M * D * 2;
constexpr size_t GA_UNIT = 43008;
static_assert(4096 * GA_UNIT <= (size_t)M * D * 4, "the GLA per-chunk operands are parked in d_out (free until the last phase writes the result)");
static_assert(WS_TOKSLOT + 2 * MAXSLOT * 4 <= WS_GSLOT && WS_GSLOT + 2 * MAXSLOT * 4 <= WS_W_DAIN, "ws map");
static_assert(WS_W_FFN2 + (size_t)D * FFN * 2 <= WS_W_GLAIN && WS_W_GLAIN + (size_t)GLA_N * D * 2 <= WS_W_GLAOUT, "ws map");
static_assert(WS_W_MOE13 + (size_t)NEXP * 2 * EXPD * D * 2 <= WS_W_MOE2 && WS_W_MOE2 + (size_t)NEXP * D * EXPD * 2 <= WS_H, "ws map");
static_assert((size_t)MAXSLOT * EXPD * 2 <= 464 * MiB && (size_t)M * 3072 * 2 + (size_t)M * 512 * 2 <= 464 * MiB, "ws map");
constexpr int CW_BAR = 4096, CW_KCNT = 8192;

constexpr int RING_BYTES = 131072;
constexpr int TAB_OFF = RING_BYTES;
constexpr int MISC_OFF = 155648;
constexpr int LDS_BYTES = MISC_OFF + 1024;

__device__ __forceinline__ unsigned f2bf(float f) { unsigned u = __builtin_bit_cast(unsigned, f); return (u + 0x7fffu + ((u >> 16) & 1u)) >> 16; }
__device__ __forceinline__ unsigned pk2(float lo, float hi) { return f2bf(lo) | (f2bf(hi) << 16); }
__device__ __forceinline__ float bf2f(unsigned short b) { return __builtin_bit_cast(float, ((unsigned)b) << 16); }
__device__ __forceinline__ unsigned cvt_pk_bf16(float lo, float hi) { unsigned r; asm volatile("v_cvt_pk_bf16_f32 %0, %1, %2" : "=v"(r) : "v"(lo), "v"(hi)); return r; }
__device__ __forceinline__ float wave_sum(float v) {
#pragma unroll
    for (int o = 1; o < 64; o <<= 1) v += __shfl_xor(v, o);
    return v;
}
__device__ __forceinline__ float wave_max(float v) {
#pragma unroll
    for (int o = 1; o < 64; o <<= 1) v = fmaxf(v, __shfl_xor(v, o));
    return v;
}
typedef int v8i __attribute__((ext_vector_type(8)));
typedef int v4i __attribute__((ext_vector_type(4)));
constexpr bool FFN_UP8 = false, FFN_DN8 = true, MOE_UP8 = true, MOE_DN8 = true;
constexpr float W8_SCALE = 64.0f, H8_SCALE = 8.0f, A8_SCALE = 4.0f;
__device__ __forceinline__ float clamp448(float x) { return fminf(fmaxf(x, -448.0f), 448.0f); }
__device__ __forceinline__ unsigned pk_fp8x4(float a, float b, float c, float d) {
    unsigned w = 0u; w = __builtin_amdgcn_cvt_pk_fp8_f32(clamp448(a), clamp448(b), w, false); w = __builtin_amdgcn_cvt_pk_fp8_f32(clamp448(c), clamp448(d), w, true); return w; }
__device__ __forceinline__ f32x4 ld_bf16x4(const bf16* p) { const u32x2 w = *(const u32x2*)p; return (f32x4){__builtin_bit_cast(float, w[0] << 16), __builtin_bit_cast(float, w[0] & 0xffff0000u), __builtin_bit_cast(float, w[1] << 16), __builtin_bit_cast(float, w[1] & 0xffff0000u)}; }
__device__ __forceinline__ void st_bf16x4(bf16* p, f32x4 v) { *(u32x2*)p = (u32x2){cvt_pk_bf16(v[0], v[1]), cvt_pk_bf16(v[2], v[3])}; }
__device__ __forceinline__ float fast_silu(float a) { return a * __builtin_amdgcn_rcpf(1.0f + __builtin_amdgcn_exp2f(-a * LOG2E)); }

namespace pg8 {
constexpr int BM = 256, BK = 64, HALF = 128, HTB = HALF * BK * 2, STAGE_BYTES = 8 * HTB, NXCD = 8, WGM = 8;
__host__ __device__ __forceinline__ int lds_byte(int r, int c) { const int rr = r & 7, ch = (c >> 3) ^ rr; return (r >> 3) * 1024 + (rr * 8 + ch) * 16 + (c & 7) * 2; }
__host__ __device__ __forceinline__ void stage_rc(int b, int& R, int& C) { const int piece = b / 1024, slot = (b % 1024) / 16, rr = slot >> 3, ch = (slot & 7) ^ rr; R = piece * 8 + rr; C = ch * 8; }
__host__ __device__ __forceinline__ int perm32(int rho) { const int n = rho >> 4, i = rho & 15; return 8 * (i >> 2) + 4 * n + (i & 3); }

struct Unit { int pm, pn, k0, nk, part; };
struct TileOrder {
    int nM, nN, nwg, G, c;
    __device__ void init(int nM_, int nN_, int G_, int c_) { nM = nM_; nN = nN_; nwg = nM * nN; G = G_; c = c_; }
    __device__ bool next(int i, Unit& u) const { return at((long)i * G + c, u); }
    __device__ bool at(const long L, Unit& u) const {
        if (L >= nwg) return false;
        int wgid = (int)L; { const int q = nwg / NXCD, r = nwg % NXCD, xcd = wgid % NXCD, off = wgid / NXCD; wgid = (xcd < r ? xcd * (q + 1) : r * (q + 1) + (xcd - r) * q) + off; }
        const int nig = WGM * nN, gid = wgid / nig, fm = gid * WGM, gsz = (nM - fm) < WGM ? (nM - fm) : WGM;
        u.pm = fm + ((wgid % nig) % gsz); u.pn = (wgid % nig) / gsz; return true;
    }
};
struct DenseSched : TileOrder {
    const char* A; const char* Bt; size_t tstep;
    __device__ __forceinline__ const char* a_base(const Unit& u) const { return A + (size_t)u.pm * tstep; }
    __device__ __forceinline__ const char* b_base(const Unit& u) const { return Bt + (size_t)u.pn * tstep; }
    __device__ __forceinline__ unsigned row_off(const Unit&, int) const { return 0u; }
};
struct MoeSched : TileOrder {
    const char* A; const char* Bt; size_t a_tstep, b_tstep, b_estride; const int* tokslot; unsigned rowbytes; int g1, g2, g3, g4, g5, g6, g7;
    __device__ __forceinline__ int expert(int pm) const { const int r = pm * 256; return (r >= g1) + (r >= g2) + (r >= g3) + (r >= g4) + (r >= g5) + (r >= g6) + (r >= g7); }
    __device__ __forceinline__ const char* a_base(const Unit& u) const { return A + (size_t)u.pm * a_tstep; }
    __device__ __forceinline__ const char* b_base(const Unit& u) const { return Bt + (size_t)expert(u.pm) * b_estride + (size_t)u.pn * b_tstep; }
    __device__ __forceinline__ unsigned row_off(const Unit& u, int r) const { int t = tokslot[u.pm * 256 + r]; t = t < 0 ? 0 : t; return (unsigned)t * rowbytes; }
};
struct MoeSchedTail : MoeSched {
    int pmT, pnT, k0T, nkT;
    __device__ bool next(int i, Unit& u) const { if (i != 0) return false; u.pm = pmT; u.pn = pnT; u.k0 = k0T; u.nk = nkT; u.part = 1; return true; }
};

struct EpiQKV {
    static constexpr bool PERM = true;
    bf16* Q; size_t tstride; const float* qg; const float* kg; float qscale;
    __device__ __forceinline__ void operator()(const f32x4 (&acc)[2][2][4][2], const Unit& u, int wr, int wc, int fr, int fq) const {
        const int t = u.pn >> 2;
        bf16* base = Q + (size_t)t * tstride;
        const int lc0 = 256 * (u.pn & 3) + 64 * wc + 8 * fq;
        const int row0 = u.pm * BM + wr * 64 + fr;
        if (t < 2) {
            const float* g = qg; if (t == 1) g = kg;
            g += 64 * (wc & 1) + 8 * fq;
            f32x4 gv[2][2];
#pragma unroll
            for (int bj = 0; bj < 2; ++bj)
#pragma unroll
                for (int n = 0; n < 2; ++n) gv[bj][n] = *(const f32x4*)(g + 32 * bj + 4 * n);
            float sc = 1.0f; if (t == 0) sc = qscale;
#pragma unroll
            for (int ai = 0; ai < 2; ++ai)
#pragma unroll
                for (int m = 0; m < 4; ++m) {
                    float ss = 0.f;
#pragma unroll
                    for (int bj = 0; bj < 2; ++bj)
#pragma unroll
                        for (int n = 0; n < 2; ++n) { const f32x4 x = acc[ai][bj][m][n]; ss += (x[0] * x[0] + x[1] * x[1]) + (x[2] * x[2] + x[3] * x[3]); }
                    ss += __shfl_xor(ss, 16); ss += __shfl_xor(ss, 32);
                    const float rs = __builtin_amdgcn_rsqf(ss * (1.0f / 64.0f) + EPS) * sc;
                    const int R = row0 + ai * HALF + m * 16;
                    bf16* rowp = base + (size_t)R * D + lc0;
#pragma unroll
                    for (int bj = 0; bj < 2; ++bj) { const f32x4 v0 = acc[ai][bj][m][0] * rs * gv[bj][0], v1 = acc[ai][bj][m][1] * rs * gv[bj][1];
                        u32x4 w; w.x = cvt_pk_bf16(v0[0], v0[1]); w.y = cvt_pk_bf16(v0[2], v0[3]); w.z = cvt_pk_bf16(v1[0], v1[1]); w.w = cvt_pk_bf16(v1[2], v1[3]);
                        if (t == 1) {
                            const int col = lc0 + 32 * bj, hh_ = col >> 7, cg = (col & 127) >> 3, b_ = R >> 12, s_ = R & 4095;
                            *(u32x4*)(base + ((((size_t)(b_ * 8 + hh_) * 64 + (s_ >> 6)) * 16 + cg) * 64 + (s_ & 63)) * 8) = w; }
                        else *(u32x4*)(rowp + 32 * bj) = w; }
                }
        } else {
#pragma unroll
            for (int ai = 0; ai < 2; ++ai)
#pragma unroll
                for (int m = 0; m < 4; ++m) { const int R = row0 + ai * HALF + m * 16, b_ = R >> 12, s_ = R & 4095;
#pragma unroll
                    for (int bj = 0; bj < 2; ++bj) { const f32x4 v0 = acc[ai][bj][m][0], v1 = acc[ai][bj][m][1];
                        u32x4 w; w.x = cvt_pk_bf16(v0[0], v0[1]); w.y = cvt_pk_bf16(v0[2], v0[3]); w.z = cvt_pk_bf16(v1[0], v1[1]); w.w = cvt_pk_bf16(v1[2], v1[3]);
                        const int col = lc0 + 32 * bj, hh_ = col >> 7, c_ = col & 127, p_ = (c_ >> 5) * 4 + ((s_ & 63) >> 4), li = ((s_ & 15) << 2) + ((c_ & 31) >> 3);
                        *(u32x4*)(base + ((((size_t)(b_ * 8 + hh_) * 64 + (s_ >> 6)) * 16 + p_) * 64 + li) * 8) = w; } }
        }
    }
};
template <bool BASE16, bool OUT16> struct EpiResid {
    static constexpr bool PERM = true;
    const void* base; void* out; const float* gate; float descale;
    __device__ __forceinline__ void operator()(const f32x4 (&acc)[2][2][4][2], const Unit& u, int wr, int wc, int fr, int fq) const {
        const int row0 = u.pm * BM + wr * 64 + fr, col0 = u.pn * BM + wc * 32 + 8 * fq, b = u.pm >> 4;
        f32x4 gv[2][2];
#pragma unroll
        for (int bj = 0; bj < 2; ++bj)
#pragma unroll
            for (int n = 0; n < 2; ++n) gv[bj][n] = *(const f32x4*)(gate + (size_t)b * 6144 + col0 + bj * HALF + 4 * n) * descale;
#pragma unroll
        for (int ai = 0; ai < 2; ++ai) {
            f32x4 bs[4][2][2];
#pragma unroll
            for (int m = 0; m < 4; ++m) { const size_t off = (size_t)(row0 + ai * HALF + m * 16) * D + col0;
#pragma unroll
                for (int bj = 0; bj < 2; ++bj) { const size_t o = off + bj * HALF;
                    if constexpr (BASE16) { const u32x4 w = *(const u32x4*)((const bf16*)base + o);
                        bs[m][bj][0] = (f32x4){__builtin_bit_cast(float, w[0] << 16), __builtin_bit_cast(float, w[0] & 0xffff0000u), __builtin_bit_cast(float, w[1] << 16), __builtin_bit_cast(float, w[1] & 0xffff0000u)};
                        bs[m][bj][1] = (f32x4){__builtin_bit_cast(float, w[2] << 16), __builtin_bit_cast(float, w[2] & 0xffff0000u), __builtin_bit_cast(float, w[3] << 16), __builtin_bit_cast(float, w[3] & 0xffff0000u)}; }
                    else { bs[m][bj][0] = *(const f32x4*)((const float*)base + o); bs[m][bj][1] = *(const f32x4*)((const float*)base + o + 4); } } }
#pragma unroll
            for (int m = 0; m < 4; ++m) { const size_t off = (size_t)(row0 + ai * HALF + m * 16) * D + col0;
#pragma unroll
                for (int bj = 0; bj < 2; ++bj) { const size_t o = off + bj * HALF;
                    const f32x4 r0 = bs[m][bj][0] + gv[bj][0] * acc[ai][bj][m][0], r1 = bs[m][bj][1] + gv[bj][1] * acc[ai][bj][m][1];
                    if constexpr (OUT16) *(u32x4*)((bf16*)out + o) = (u32x4){cvt_pk_bf16(r0[0], r0[1]), cvt_pk_bf16(r0[2], r0[3]), cvt_pk_bf16(r1[0], r1[1]), cvt_pk_bf16(r1[2], r1[3])};
                    else { *(f32x4*)((float*)out + o) = r0; *(f32x4*)((float*)out + o + 4) = r1; } } }
            asm volatile("" ::: "memory"); }
    }
};
template <bool OUT8> struct EpiSwiGLU {
    static constexpr bool PERM = true;
    void* O; int ldo; float descale;
    __device__ __forceinline__ void operator()(const f32x4 (&acc)[2][2][4][2], const Unit& u, int wr, int wc, int fr, int fq) const {
        const int row0 = u.pm * BM + wr * 64 + fr, col0 = u.pn * HALF + wc * 32 + 8 * fq;
#pragma unroll
        for (int ai = 0; ai < 2; ++ai)
#pragma unroll
            for (int m = 0; m < 4; ++m) { const unsigned eo = (unsigned)(row0 + ai * HALF + m * 16) * (unsigned)ldo + (unsigned)col0;
                f32x4 v0, v1;
#pragma unroll
                for (int i = 0; i < 4; ++i) { v0[i] = fast_silu(acc[ai][0][m][0][i] * descale) * (acc[ai][1][m][0][i] * descale); v1[i] = fast_silu(acc[ai][0][m][1][i] * descale) * (acc[ai][1][m][1][i] * descale); }
                if constexpr (OUT8) { v0 = v0 * A8_SCALE; v1 = v1 * A8_SCALE; *(u32x2*)((unsigned char*)O + eo) = (u32x2){pk_fp8x4(v0[0], v0[1], v0[2], v0[3]), pk_fp8x4(v1[0], v1[1], v1[2], v1[3])}; }
                else { u32x4 w; w.x = cvt_pk_bf16(v0[0], v0[1]); w.y = cvt_pk_bf16(v0[2], v0[3]); w.z = cvt_pk_bf16(v1[0], v1[1]); w.w = cvt_pk_bf16(v1[2], v1[3]); *(u32x4*)((bf16*)O + eo) = w; } }
    }
};
struct EpiGLA {
    static constexpr bool PERM = true;
    bf16* P; bf16* LA; const float* ba; const float* og;
    __device__ __forceinline__ void operator()(const f32x4 (&acc)[2][2][4][2], const Unit& u, int wr, int wc, int fr, int fq) const {
        const int row0 = u.pm * BM + wr * 64 + fr;
        if (u.pn < 12) {
            const int col0 = u.pn * BM + wc * 32 + 8 * fq; const bool isr = u.pn >= 8;
            f32x4 gv[2][2];
#pragma unroll
            for (int bj = 0; bj < 2; ++bj)
#pragma unroll
                for (int n = 0; n < 2; ++n) gv[bj][n] = isr ? *(const f32x4*)(og + wc * 32 + 8 * fq + bj * HALF + 4 * n) : (f32x4){1.f, 1.f, 1.f, 1.f};
#pragma unroll
            for (int ai = 0; ai < 2; ++ai)
#pragma unroll
                for (int m = 0; m < 4; ++m) { bf16* rowp = P + (size_t)(row0 + ai * HALF + m * 16) * 3072 + col0;
#pragma unroll
                    for (int bj = 0; bj < 2; ++bj) { f32x4 v0 = acc[ai][bj][m][0], v1 = acc[ai][bj][m][1];
                        if (isr) {
#pragma unroll
                            for (int i = 0; i < 4; ++i) { v0[i] = gv[bj][0][i] * fast_silu(v0[i]); v1[i] = gv[bj][1][i] * fast_silu(v1[i]); } }
                        u32x4 w; w.x = cvt_pk_bf16(v0[0], v0[1]); w.y = cvt_pk_bf16(v0[2], v0[3]); w.z = cvt_pk_bf16(v1[0], v1[1]); w.w = cvt_pk_bf16(v1[2], v1[3]);
                        *(u32x4*)(rowp + bj * HALF) = w; } }
        } else {
            const int col0 = (u.pn - 12) * BM + wc * 32 + 8 * fq;
            f32x4 bv[2][2];
#pragma unroll
            for (int bj = 0; bj < 2; ++bj)
#pragma unroll
                for (int n = 0; n < 2; ++n) bv[bj][n] = *(const f32x4*)(ba + col0 + bj * HALF + 4 * n);
#pragma unroll
            for (int ai = 0; ai < 2; ++ai)
#pragma unroll
                for (int m = 0; m < 4; ++m) { bf16* rowp = LA + (size_t)(row0 + ai * HALF + m * 16) * 512 + col0;
#pragma unroll
                    for (int bj = 0; bj < 2; ++bj) { f32x4 v[2];
#pragma unroll
                        for (int n = 0; n < 2; ++n)
#pragma unroll
                            for (int i = 0; i < 4; ++i) { const float z = acc[ai][bj][m][n][i] + bv[bj][n][i];
                                v[n][i] = (fminf(z, 0.f) - __logf(1.0f + __expf(-fabsf(z)))) * (1.0f / 16.0f); }
                        u32x4 w; w.x = cvt_pk_bf16(v[0][0], v[0][1]); w.y = cvt_pk_bf16(v[0][2], v[0][3]); w.z = cvt_pk_bf16(v[1][0], v[1][1]); w.w = cvt_pk_bf16(v[1][2], v[1][3]);
                        *(u32x4*)(rowp + bj * HALF) = w; } }
        }
    }
};
template <bool FINAL> struct EpiMoeDown {
    static constexpr bool PERM = true;
    const int* tokslot; const float* gslot; bf16* xb; float* outf; const float* gate; float descale;
    __device__ __forceinline__ void row(const f32x4 (&v)[2][2], int srow, int col0) const {
        const int tok = tokslot[srow];
        if (tok >= 0) { const float g = gslot[srow] * descale; const float* gp = gate + (size_t)(tok >> 12) * 6144 + col0; const size_t ro = (size_t)tok * D + col0;
#pragma unroll
            for (int bj = 0; bj < 2; ++bj) { const f32x4 g0 = *(const f32x4*)(gp + bj * HALF), g1 = *(const f32x4*)(gp + bj * HALF + 4); const u32x4 w = *(const u32x4*)(xb + ro + bj * HALF);
                const f32x4 b0 = (f32x4){__builtin_bit_cast(float, w[0] << 16), __builtin_bit_cast(float, w[0] & 0xffff0000u), __builtin_bit_cast(float, w[1] << 16), __builtin_bit_cast(float, w[1] & 0xffff0000u)};
                const f32x4 b1 = (f32x4){__builtin_bit_cast(float, w[2] << 16), __builtin_bit_cast(float, w[2] & 0xffff0000u), __builtin_bit_cast(float, w[3] << 16), __builtin_bit_cast(float, w[3] & 0xffff0000u)};
                const f32x4 r0 = b0 + g0 * g * v[bj][0], r1 = b1 + g1 * g * v[bj][1];
                if constexpr (FINAL) { *(f32x4*)(outf + ro + bj * HALF) = r0; *(f32x4*)(outf + ro + bj * HALF + 4) = r1; }
                else *(u32x4*)(xb + ro + bj * HALF) = (u32x4){cvt_pk_bf16(r0[0], r0[1]), cvt_pk_bf16(r0[2], r0[3]), cvt_pk_bf16(r1[0], r1[1]), cvt_pk_bf16(r1[2], r1[3])}; } }
    }
    __device__ __forceinline__ void operator()(const f32x4 (&acc)[2][2][4][2], const Unit& u, int wr, int wc, int fr, int fq) const {
        const int srow0 = u.pm * BM + wr * 64 + fr, col0 = u.pn * BM + wc * 32 + 8 * fq;
        int tok[8]; float gsl[8];
#pragma unroll
        for (int i = 0; i < 8; ++i) { const int srow = srow0 + (i >> 2) * HALF + (i & 3) * 16; tok[i] = tokslot[srow]; gsl[i] = gslot[srow] * descale; }
#pragma unroll
        for (int i0 = 0; i0 < 8; i0 += 2) {
            u32x4 w[2][2]; f32x4 gt[2][2][2];
#pragma unroll
            for (int q = 0; q < 2; ++q) { const int t = tok[i0 + q] < 0 ? 0 : tok[i0 + q]; const float* gp = gate + (size_t)(t >> 12) * 6144 + col0; const size_t ro = (size_t)t * D + col0;
#pragma unroll
                for (int bj = 0; bj < 2; ++bj) { w[q][bj] = *(const u32x4*)(xb + ro + bj * HALF); gt[q][bj][0] = *(const f32x4*)(gp + bj * HALF); gt[q][bj][1] = *(const f32x4*)(gp + bj * HALF + 4); } }
#pragma unroll
            for (int q = 0; q < 2; ++q) { const int i = i0 + q, ai = i >> 2, m = i & 3;
                if (tok[i] >= 0) { const float g = gsl[i]; const size_t ro = (size_t)tok[i] * D + col0;
#pragma unroll
                    for (int bj = 0; bj < 2; ++bj) { const u32x4 ww = w[q][bj];
                        const f32x4 b0 = (f32x4){__builtin_bit_cast(float, ww[0] << 16), __builtin_bit_cast(float, ww[0] & 0xffff0000u), __builtin_bit_cast(float, ww[1] << 16), __builtin_bit_cast(float, ww[1] & 0xffff0000u)};
                        const f32x4 b1 = (f32x4){__builtin_bit_cast(float, ww[2] << 16), __builtin_bit_cast(float, ww[2] & 0xffff0000u), __builtin_bit_cast(float, ww[3] << 16), __builtin_bit_cast(float, ww[3] & 0xffff0000u)};
                        const f32x4 r0 = b0 + gt[q][bj][0] * g * acc[ai][bj][m][0], r1 = b1 + gt[q][bj][1] * g * acc[ai][bj][m][1];
                        if constexpr (FINAL) { *(f32x4*)(outf + ro + bj * HALF) = r0; *(f32x4*)(outf + ro + bj * HALF + 4) = r1; }
                        else *(u32x4*)(xb + ro + bj * HALF) = (u32x4){cvt_pk_bf16(r0[0], r0[1]), cvt_pk_bf16(r0[2], r0[3]), cvt_pk_bf16(r1[0], r1[1]), cvt_pk_bf16(r1[2], r1[3])}; } } }
            asm volatile("" ::: "memory"); }
    }
    __device__ __forceinline__ void slice(const f32x4 (&v)[2][2], const Unit& u, int ai, int m, int wr, int wc, int fr, int fq) const {
        row(v, u.pm * BM + wr * 64 + fr + ai * HALF + m * 16, u.pn * BM + wc * 32 + 8 * fq);
    }
};
struct EpiPartStore {
    static constexpr bool PERM = true;
    float* part;
    __device__ __forceinline__ void operator()(const f32x4 (&acc)[2][2][4][2], const Unit&, int wr, int wc, int fr, int fq) const {
        f32x4* p = (f32x4*)part + ((wr * 4 + wc) * 64 + fq * 16 + fr);
#pragma unroll
        for (int ai = 0; ai < 2; ++ai)
#pragma unroll
            for (int bj = 0; bj < 2; ++bj)
#pragma unroll
                for (int m = 0; m < 4; ++m)
#pragma unroll
                    for (int n = 0; n < 2; ++n) { *p = acc[ai][bj][m][n]; p += 512; asm volatile("" : "+v"(p)); }
    }
};

template <class Epi, class Sched, bool ALIGN_EPI, bool GATHER, bool FP8 = false, bool KSPLIT = false>
__device__ __forceinline__ void gemm_phase(LAS unsigned char* lds, const int RB, const Sched& S, const Epi& E) {
    const int tid = threadIdx.x, wid = __builtin_amdgcn_readfirstlane(tid >> 6), lane = tid & 63, wr = wid >> 2, wc = wid & 3, fr = lane & 15, fq = lane >> 4;
    const int nt = RB / 128;
    unsigned voffB0, voffA0;
    const size_t kstep = (size_t)(BK * 2);
    const size_t hstep = (size_t)HALF * RB;
    const size_t qstep = (size_t)64 * RB;
    { int R, C; stage_rc(tid * 16, R, C); const int Rb = Epi::PERM ? ((R & ~31) + perm32(R & 31)) : R;
        voffB0 = (unsigned)(Rb * RB + C * 2); voffA0 = (unsigned)(R * RB + C * 2); }
    LAS unsigned* mytab = (LAS unsigned*)(lds + STAGE_BYTES) + tid;
#define PG8_TABFILL(par, U) do { _Pragma("unroll") for (int _h = 0; _h < 2; ++_h) _Pragma("unroll") for (int _i = 0; _i < 2; ++_i) { int _R, _C; stage_rc(tid * 16 + _i * 8192, _R, _C); \
        mytab[((par) * 4 + _h * 2 + _i) * 512] = S.row_off(U, _h * HALF + _R) + (unsigned)_C * 2u; } } while (0)
    const unsigned ldsw = (unsigned)wid * 1024u;
    const int aoff = lds_byte(wr * 64 + fr, fq * 8), boff = lds_byte(wc * 32 + fr, fq * 8), aoff1 = aoff ^ 64, boff1 = boff ^ 64;
#define PG8_SA(b, h) (((b) * 2 + (h)) * HTB)
#define PG8_SB(b, h) ((4 + (b) * 2 + (h)) * HTB)
#define PG8_STAGE_B(bufoff, gbase) do { _Pragma("unroll") for (int _i = 0; _i < 2; ++_i) \
        __builtin_amdgcn_global_load_lds((const unsigned*)((const char*)(gbase) + _i * qstep + voffB0), (LAS unsigned*)(lds + (bufoff) + ldsw + _i * 8192), 16, 0, 0); } while (0)
#define PG8_STAGE_A(bufoff, gbase, va, h) do { _Pragma("unroll") for (int _i = 0; _i < 2; ++_i) \
        __builtin_amdgcn_global_load_lds((const unsigned*)((const char*)(gbase) + (GATHER ? (size_t)0 : (size_t)(h) * hstep + _i * qstep) + (GATHER ? (va)[h][_i] : voffA0)), (LAS unsigned*)(lds + (bufoff) + ldsw + _i * 8192), 16, 0, 0); } while (0)
#define PG8_LDA(dst, b, h) do { _Pragma("unroll") for (int m = 0; m < 4; ++m) { if constexpr (FP8) dst##8[m] = __builtin_shufflevector(*(const LAS v4i*)(lds + PG8_SA(b, h) + aoff + m * 2048), *(const LAS v4i*)(lds + PG8_SA(b, h) + aoff1 + m * 2048), 0, 1, 2, 3, 4, 5, 6, 7); \
        else { dst[m][0] = *(const LAS bf16x8*)(lds + PG8_SA(b, h) + aoff + m * 2048); dst[m][1] = *(const LAS bf16x8*)(lds + PG8_SA(b, h) + aoff1 + m * 2048); } } } while (0)
#define PG8_LDB(dst, b, h) do { _Pragma("unroll") for (int n = 0; n < 2; ++n) { if constexpr (FP8) dst##8[n] = __builtin_shufflevector(*(const LAS v4i*)(lds + PG8_SB(b, h) + boff + n * 2048), *(const LAS v4i*)(lds + PG8_SB(b, h) + boff1 + n * 2048), 0, 1, 2, 3, 4, 5, 6, 7); \
        else { dst[n][0] = *(const LAS bf16x8*)(lds + PG8_SB(b, h) + boff + n * 2048); dst[n][1] = *(const LAS bf16x8*)(lds + PG8_SB(b, h) + boff1 + n * 2048); } } } while (0)
#define PG8_CAT(x0, x1) __builtin_shufflevector(__builtin_bit_cast(v4i, x0), __builtin_bit_cast(v4i, x1), 0, 1, 2, 3, 4, 5, 6, 7)
#define PG8_MMA(ai, bj, At, Bt) do { __builtin_amdgcn_s_setprio(1); _Pragma("unroll") for (int m = 0; m < 4; ++m) _Pragma("unroll") for (int n = 0; n < 2; ++n) { \
        if constexpr (FP8) asm volatile("v_mfma_scale_f32_16x16x128_f8f6f4 %0, %1, %2, %0, %3, %3 op_sel_hi:[0,0,0]" : "+v"(acc[ai][bj][m][n]) : "v"(Bt##8[n]), "v"(At##8[m]), "v"(sc8));   \
        else { _Pragma("unroll") for (int k = 0; k < 2; ++k) acc[ai][bj][m][n] = __builtin_amdgcn_mfma_f32_16x16x32_bf16(Bt[n][k], At[m][k], acc[ai][bj][m][n], 0, 0, 0); } } \
        __builtin_amdgcn_s_setprio(0); } while (0)
#define PG8_WAIT_V(n) asm volatile("s_waitcnt vmcnt(" #n ")" ::: "memory")
#define PG8_WAIT_L(n) asm volatile("s_waitcnt lgkmcnt(" #n ")" ::: "memory")
#define PG8_BAR __builtin_amdgcn_s_barrier()
#define PG8_SCHED __builtin_amdgcn_sched_barrier(0)
    Unit cur, nxt; int ui = 0;
    if (!S.next(0, cur)) return;
    f32x4 acc[2][2][4][2];
#pragma unroll
    for (int a = 0; a < 2; ++a)
#pragma unroll
        for (int b = 0; b < 2; ++b)
#pragma unroll
            for (int m = 0; m < 4; ++m)
#pragma unroll
                for (int n = 0; n < 2; ++n) acc[a][b][m][n] = (f32x4){0.f, 0.f, 0.f, 0.f};
    const int sc8 = 0x7f7f7f7f;
    bf16x8 At[4][2], B0[2][2], B1[2][2]; v8i At8[4], B08[2], B18[2];
    const char* cA = S.a_base(cur); const char* cB = S.b_base(cur);
    if constexpr (KSPLIT) { cA += (size_t)cur.k0 * kstep; cB += (size_t)cur.k0 * kstep; }
    unsigned cvA[2][2] = {{0u, 0u}, {0u, 0u}};
    if constexpr (GATHER) {
        PG8_TABFILL(0, cur);
#pragma unroll
        for (int h = 0; h < 2; ++h)
#pragma unroll
            for (int i = 0; i < 2; ++i) cvA[h][i] = mytab[(h * 2 + i) * 512];
    }
    PG8_STAGE_B(PG8_SB(0, 0), cB); PG8_STAGE_B(PG8_SB(0, 1), cB + hstep); PG8_STAGE_A(PG8_SA(0, 0), cA, cvA, 0); PG8_STAGE_A(PG8_SA(0, 1), cA, cvA, 1);
    if (wr == 1) PG8_BAR;
    PG8_WAIT_V(2); PG8_BAR;
    PG8_STAGE_B(PG8_SB(1, 0), cB + kstep); PG8_STAGE_A(PG8_SA(1, 0), cA + kstep, cvA, 0); PG8_STAGE_B(PG8_SB(1, 1), cB + hstep + kstep);
    PG8_WAIT_V(6); PG8_BAR;
    for (;;) {
        const bool has_next = S.next(ui + 1, nxt);
        const char* nA = has_next ? S.a_base(nxt) : cA; const char* nB = has_next ? S.b_base(nxt) : cB;
        if constexpr (KSPLIT) { if (has_next) { nA += (size_t)nxt.k0 * kstep; nB += (size_t)nxt.k0 * kstep; } }
        if constexpr (GATHER) { if (has_next) PG8_TABFILL((ui + 1) & 1, nxt); }
        const int ntc = KSPLIT ? cur.nk : nt;
#pragma unroll 1
        for (int t = 0; t < ntc; t += 2) {
            const bool last = (t == ntc - 2);
            const char* a1 = cA + (size_t)(t + 1) * kstep;
            const char* a2 = last ? nA : cA + (size_t)(t + 2) * kstep; const char* b2 = last ? nB : cB + (size_t)(t + 2) * kstep;
            const char* a3 = a2 + kstep; const char* b3 = b2 + kstep;
            unsigned wA[2][2] = {{0u, 0u}, {0u, 0u}};
            if constexpr (GATHER) {
                const int pc = ui & 1, pw = (last && has_next) ? (pc ^ 1) : pc;
#pragma unroll
                for (int i = 0; i < 2; ++i) { cvA[1][i] = mytab[(pc * 4 + 2 + i) * 512]; wA[0][i] = mytab[(pw * 4 + i) * 512]; wA[1][i] = mytab[(pw * 4 + 2 + i) * 512]; }
            }
            PG8_LDB(B0, 0, 0); PG8_LDB(B1, 0, 1); PG8_SCHED; PG8_LDA(At, 0, 0); PG8_STAGE_A(PG8_SA(1, 1), a1, cvA, 1);
            PG8_WAIT_V(8); PG8_WAIT_L(0); PG8_BAR; PG8_MMA(0, 0, At, B0); PG8_MMA(0, 1, At, B1); PG8_BAR; PG8_SCHED;
            PG8_LDA(At, 0, 1); PG8_STAGE_B(PG8_SB(0, 0), b2); PG8_STAGE_B(PG8_SB(0, 1), b2 + hstep); PG8_STAGE_A(PG8_SA(0, 0), a2, wA, 0);
            PG8_WAIT_V(8); PG8_WAIT_L(0); PG8_BAR; PG8_MMA(1, 0, At, B0); PG8_MMA(1, 1, At, B1); PG8_BAR; PG8_SCHED;
            PG8_LDB(B0, 1, 0); PG8_LDB(B1, 1, 1); PG8_SCHED; PG8_LDA(At, 1, 0); PG8_STAGE_A(PG8_SA(0, 1), a2, wA, 1);
            PG8_WAIT_V(8); PG8_WAIT_L(0); PG8_BAR; PG8_MMA(0, 0, At, B0); PG8_MMA(0, 1, At, B1); PG8_BAR; PG8_SCHED;
            PG8_LDA(At, 1, 1); PG8_STAGE_B(PG8_SB(1, 0), b3); PG8_STAGE_B(PG8_SB(1, 1), b3 + hstep); PG8_STAGE_A(PG8_SA(1, 0), a3, wA, 0);
            PG8_WAIT_V(8); PG8_WAIT_L(0); PG8_BAR; PG8_MMA(1, 0, At, B0); PG8_MMA(1, 1, At, B1); PG8_BAR; PG8_SCHED;
        }
        if constexpr (ALIGN_EPI) { if (wr == 0) PG8_BAR; }
        if constexpr (FP8) asm volatile("s_nop 15\n\ts_nop 15" ::: "memory");
        { int el; asm volatile("v_mbcnt_lo_u32_b32 %0, -1, 0\n\tv_mbcnt_hi_u32_b32 %0, -1, %0" : "=v"(el));
          E(acc, cur, wr, wc, el & 15, el >> 4); }
        if (!has_next) break;
#pragma unroll
        for (int a = 0; a < 2; ++a)
#pragma unroll
            for (int b = 0; b < 2; ++b)
#pragma unroll
                for (int m = 0; m < 4; ++m)
#pragma unroll
                    for (int n = 0; n < 2; ++n) acc[a][b][m][n] = (f32x4){0.f, 0.f, 0.f, 0.f};
        cur = nxt; cA = nA; cB = nB; ++ui;
        if constexpr (ALIGN_EPI) { if (wr == 1) PG8_BAR; }
    }
    PG8_WAIT_V(0);
    if constexpr (!ALIGN_EPI) { if (wr == 0) PG8_BAR; }
    PG8_BAR;
#undef PG8_SA
#undef PG8_SB
#undef PG8_STAGE_A
#undef PG8_TABFILL
#undef PG8_STAGE_B
#undef PG8_LDA
#undef PG8_LDB
#undef PG8_MMA
#undef PG8_CAT
#undef PG8_WAIT_V
#undef PG8_WAIT_L
#undef PG8_BAR
#undef PG8_SCHED
}
}

#define XB_TMO      128
#define XB_XCNT(j)  (256  + 64 * (j))
#define XB_XSUB(j)  (1280 + 64 * (j))
#define XB_XGEN(j)  (2304 + 64 * (j))
#define XB_TOP      3328
#define XB_TOPGEN   3392
#define XCD_BAR_WORDS 3456
#define XB_SPIN_CAP (1u << 18)
__device__ __forceinline__ unsigned xb_ld(unsigned* p)              { return __hip_atomic_load(p, __ATOMIC_RELAXED, __HIP_MEMORY_SCOPE_AGENT); }
__device__ __forceinline__ unsigned xb_add(unsigned* p, unsigned v) { return __hip_atomic_fetch_add(p, v, __ATOMIC_RELAXED, __HIP_MEMORY_SCOPE_AGENT); }
__device__ __forceinline__ unsigned xb_xcc_id() { return (unsigned)__builtin_amdgcn_s_getreg((3 << 11) | 20) & 0xFu; }
#define XB_SPIN(cond, bar) do { unsigned _sp = 0; while (cond) { __builtin_amdgcn_s_sleep(1); \
    if ((++_sp & 255u) == 0u) { if (xb_ld(&(bar)[XB_TMO])) break; if (_sp > XB_SPIN_CAP) { atomicAdd(&(bar)[XB_TMO], 1u); break; } } } } while (0)
struct XcdBarrier { unsigned* bar; unsigned x; volatile LAS unsigned* st; };
__device__ __forceinline__ XcdBarrier xcd_barrier_post(unsigned* bar, volatile LAS unsigned* st) {
    XcdBarrier b; b.bar = bar; b.x = xb_xcc_id(); b.st = st;
    if (threadIdx.x == 0) (void)xb_add(&bar[XB_XCNT(b.x)], 1u);
    return b;
}
__device__ __forceinline__ void xcd_barrier_complete(unsigned* bar, unsigned x, unsigned& nloc, unsigned& nx) {
    const unsigned G = gridDim.x * gridDim.y * gridDim.z;
    unsigned sum, cnt, mine, sp = 0u;
    for (;;) {
        sum = 0u; cnt = 0u; mine = 0u;
#pragma unroll
        for (unsigned j = 0; j < 16; ++j) { const unsigned c = xb_ld(&bar[XB_XCNT(j)]); sum += c; cnt += (c > 0u) ? 1u : 0u; mine = (j == x) ? c : mine; }
        if (sum == G) break;
        __builtin_amdgcn_s_sleep(1);
        if ((++sp & 255u) == 0u) { if (xb_ld(&bar[XB_TMO])) break; if (sp > XB_SPIN_CAP) { atomicAdd(&bar[XB_TMO], 1u); break; } }
    }
    nloc = mine > 0u ? mine : 1u; nx = cnt > 0u ? cnt : 1u;
}
__device__ __forceinline__ void xcd_barrier(const XcdBarrier& b) {
    asm volatile("s_waitcnt vmcnt(0)" ::: "memory");
    __syncthreads();
    if (threadIdx.x == 0) {
        unsigned* bar = b.bar;
        __builtin_amdgcn_s_waitcnt(0);
        unsigned nloc = b.st[0], nx = b.st[1];
        if (nloc == 0u) { xcd_barrier_complete(bar, b.x, nloc, nx); b.st[0] = nloc; b.st[1] = nx; }
        const unsigned old = xb_add(&bar[XB_XSUB(b.x)], 1u);
        const unsigned gen = old / nloc;
        if (old + 1u == (gen + 1u) * nloc) {
            __builtin_amdgcn_fence(__ATOMIC_RELEASE, "agent");
            asm volatile("s_waitcnt vmcnt(0)" ::: "memory");
            const unsigned og = xb_add(&bar[XB_TOP], 1u);
            const unsigned tg = og / nx;
            if (og + 1u == (tg + 1u) * nx) xb_add(&bar[XB_TOPGEN], 1u);
            else XB_SPIN(xb_ld(&bar[XB_TOPGEN]) == tg, bar);
            __builtin_amdgcn_fence(__ATOMIC_ACQUIRE, "agent");
            xb_add(&bar[XB_XGEN(b.x)], 1u);
            asm volatile("s_waitcnt vmcnt(0)" ::: "memory");
        } else {
            XB_SPIN(xb_ld(&bar[XB_XGEN(b.x)]) == gen, bar);
            __builtin_amdgcn_fence(__ATOMIC_ACQUIRE, "agent");
            asm volatile("s_waitcnt vmcnt(0)" ::: "memory");
        }
    }
    __syncthreads();
}

struct Args {
    const float* x; const float* c; const float* ada_w; const float* ada_b; const float* norm1_g; const float* norm2_g;
    const float* da_w_in; const float* da_q_gain; const float* da_k_gain; const float* da_lam_q1; const float* da_lam_k1; const float* da_lam_q2; const float* da_lam_k2;
    const float* da_subln_g; const float* da_w_out;
    const float* gla_w_in; const float* gla_w_a1; const float* gla_w_a2; const float* gla_b_a; const float* gla_out_g; const float* gla_w_out;
    const float* ffn_w1; const float* ffn_w3; const float* ffn_w2;
    const float* moe_router; const float* moe_w1; const float* moe_w3; const float* moe_w2;
    float* out; unsigned char* ws; int ph_lo, ph_hi;
};

__device__ __forceinline__ void p0_transpose_item(const float* W, int ldw, int k0, int n0, bf16* WT, int dst_row0, int Kp, LAS float* scr, int lane) {
#pragma unroll 8
    for (int i = 0; i < 32; ++i) { const int kk = 2 * i + (lane >> 5); scr[kk * 33 + (lane & 31)] = W[(size_t)(k0 + kk) * ldw + n0 + (lane & 31)]; }
    asm volatile("s_waitcnt lgkmcnt(0)" ::: "memory");
    const int c = lane & 7;
#pragma unroll
    for (int j = 0; j < 4; ++j) { const int n = (lane >> 3) + 8 * j; const LAS float* s = scr + (8 * c) * 33 + n;
        u32x4 o; o.x = pk2(s[0 * 33], s[1 * 33]); o.y = pk2(s[2 * 33], s[3 * 33]); o.z = pk2(s[4 * 33], s[5 * 33]); o.w = pk2(s[6 * 33], s[7 * 33]);
        *(u32x4*)(WT + (size_t)(dst_row0 + n) * Kp + k0 + 8 * c) = o; }
    asm volatile("s_waitcnt lgkmcnt(0)" ::: "memory");
}

__device__ __forceinline__ void p0_transpose_item8(const float* W, int ldw, int k0, int n0, unsigned char* WT8, int dst_row0, int Kp, LAS float* scr, int lane) {
#pragma unroll 8
    for (int i = 0; i < 32; ++i) { const int kk = 2 * i + (lane >> 5); scr[kk * 33 + (lane & 31)] = W[(size_t)(k0 + kk) * ldw + n0 + (lane & 31)]; }
    asm volatile("s_waitcnt lgkmcnt(0)" ::: "memory");
    const int c = lane & 7;
#pragma unroll
    for (int j = 0; j < 4; ++j) { const int n = (lane >> 3) + 8 * j; const LAS float* sp = scr + (8 * c) * 33 + n;
        const u32x2 o = (u32x2){pk_fp8x4(sp[0 * 33] * W8_SCALE, sp[1 * 33] * W8_SCALE, sp[2 * 33] * W8_SCALE, sp[3 * 33] * W8_SCALE), pk_fp8x4(sp[4 * 33] * W8_SCALE, sp[5 * 33] * W8_SCALE, sp[6 * 33] * W8_SCALE, sp[7 * 33] * W8_SCALE)};
        *(u32x2*)(WT8 + (size_t)(dst_row0 + n) * Kp + k0 + 8 * c) = o; }
    asm volatile("s_waitcnt lgkmcnt(0)" ::: "memory");
}

namespace att {
__device__ __forceinline__ int crow(int r, int hi) { return (r & 3) + 8 * (r >> 2) + 4 * hi; }
__host__ __device__ constexpr int dwin(int h) { return (int)(150.0 / (1.4426950408889634 / (double)(1 << (h + 1)))); }
__host__ __device__ constexpr int tstart(int h, int jq) { const int q0 = 128 * jq, d = dwin(h); return q0 > d ? (q0 - d) / 64 : 0; }
struct Plan { unsigned char n[16]; unsigned char u[16][48]; };
constexpr Plan make_plan() {
    Plan p{}; int load[16] = {};
    for (int w = 0; w < 16; ++w) p.n[w] = 0;
    for (int h = 7; h >= 0; --h) {
        int cost[32] = {}, ord[32] = {};
        for (int j = 0; j < 32; ++j) { cost[j] = 2 * j + 2 - tstart(h, j); ord[j] = j; }
        for (int a = 1; a < 32; ++a) { const int x = ord[a]; int b = a - 1; while (b >= 0 && cost[ord[b]] < cost[x]) { ord[b + 1] = ord[b]; --b; } ord[b + 1] = x; }
        for (int a = 0; a < 32; ++a) { int best = 0; for (int w = 1; w < 16; ++w) if (load[w] < load[best]) best = w;
            p.u[best][p.n[best]++] = (unsigned char)(h * 32 + ord[a]); load[best] += cost[ord[a]]; }
    }
    return p;
}
__device__ const Plan PLAN = make_plan();
constexpr int BUFB = 32768, NBUF = 3, KOFF = 0, VOFF = 16384, WSF_OFF = NBUF * BUFB;
__device__ __forceinline__ s16x4 vtr(const LAS unsigned char* p) { return __builtin_bit_cast(s16x4, __builtin_amdgcn_ds_read_tr16_b64_v4i16((LAS s16x4*)p)); }

__device__ __forceinline__ void attn_unit(LAS unsigned char* lds, const bf16* Q, const bf16* K, const bf16* V, bf16* O, int b, int h, int jq,
                                          float sl2, float mref0, float mref1, float lam, const float* subg) {
    const int tid = threadIdx.x, lane = tid & 63, r32 = lane & 31, hi = lane >> 5; const int wid = __builtin_amdgcn_readfirstlane(tid >> 6);
    const int mp = wid >> 2, w4 = wid & 3;
    const size_t rowbase = (size_t)b * SEQ; const int q0 = jq * 128;
    const int nT = (q0 >> 6) + 2, myc = (q0 + 32 * w4) >> 6, t0 = tstart(h, jq);
    const bf16* Qw = Q + (rowbase + q0 + 32 * w4 + r32) * D + h * 128 + mp * 64 + hi * 8;
    bf16x8 qr[4];
#pragma unroll
    for (int d0 = 0; d0 < 4; ++d0) qr[d0] = *(const bf16x8*)(Qw + d0 * 16);
    const bf16* ksrc = K + ((size_t)(b * 8 + h) * 64 * 16 + wid) * 512 + lane * 8;
    const int p0 = wid, p1 = wid + 8;
    const bf16* vsrc0 = V + ((size_t)(b * 8 + h) * 64 * 16 + p0) * 512 + lane * 8;
    const bf16* vsrc1 = V + ((size_t)(b * 8 + h) * 64 * 16 + p1) * 512 + lane * 8;
#define ATT_DMA1(gp_, la_) asm volatile("s_mov_b32 m0, %0\n\ts_nop 0\n\tglobal_load_lds_dwordx4 %1, off" :: "s"(la_), "v"(gp_) : "memory", "m0")
#define ATT_DMA(t, bs) do { const unsigned bb_ = (unsigned)__builtin_amdgcn_readfirstlane((int)(ldsu + (unsigned)((bs) * BUFB))); \
        ATT_DMA1(ksrc + (size_t)(t) * 8192, bb_ + (unsigned)(KOFF + wid * 1024)); \
        ATT_DMA1(ksrc + (size_t)(t) * 8192 + 4096, bb_ + (unsigned)(KOFF + 8192 + wid * 1024)); \
        ATT_DMA1(vsrc0 + (size_t)(t) * 8192, bb_ + (unsigned)(VOFF + p0 * 1024)); \
        ATT_DMA1(vsrc1 + (size_t)(t) * 8192, bb_ + (unsigned)(VOFF + p1 * 1024)); } while (0)
    const unsigned ldsu = (unsigned)(unsigned long long)lds;
    const float qpos = (float)(q0 + 32 * w4 + r32);
    const float mref = mp ? mref1 : mref0;
    const float baseL = -sl2 * qpos - mref, sl8 = 8.0f * sl2, sl32 = 32.0f * sl2;
    float lsum = 0.f; f32x16 o[4];
#pragma unroll
    for (int d0 = 0; d0 < 4; ++d0)
#pragma unroll
        for (int r = 0; r < 16; ++r) o[d0][r] = 0.f;
    ATT_DMA(t0, 0);
    if (t0 + 1 < nT) ATT_DMA(t0 + 1, 1);
    asm volatile("" :: "v"(qr[0]), "v"(qr[1]), "v"(qr[2]), "v"(qr[3]) : "memory");
    int slot = 0;
    for (int t = t0; t < nT; ++t) {
        if (t + 1 < nT) asm volatile("s_waitcnt vmcnt(4)" ::: "memory"); else asm volatile("s_waitcnt vmcnt(0)" ::: "memory");
        asm volatile("s_waitcnt lgkmcnt(0)" ::: "memory"); __builtin_amdgcn_s_barrier(); asm volatile("" ::: "memory");
        if (t + 2 < nT) { const int s2 = slot >= 1 ? slot - 1 : 2; ATT_DMA(t + 2, s2); }
        if (t <= myc) {
            const LAS unsigned char* bb = lds + slot * BUFB;
            f32x16 c0, c1;
            if (t < myc) {
                const float kb = baseL + sl2 * (float)(64 * t + 4 * hi);
#pragma unroll
                for (int r = 0; r < 16; ++r) { c0[r] = (r == 0) ? kb : ((r & 3) ? c0[r - 1] + sl2 : c0[r - 4] + sl8); c1[r] = c0[r] + sl32; }
            } else {
                const float qk = qpos - (float)(64 * t + 4 * hi);
                float x[16];
#pragma unroll
                for (int r = 0; r < 16; ++r) { x[r] = (r == 0) ? qk : ((r & 3) ? x[r - 1] - 1.0f : x[r - 4] - 8.0f); c0[r] = -sl2 * fabsf(x[r]) - mref; c1[r] = -sl2 * fabsf(x[r] - 32.0f) - mref; }
            }
            const LAS unsigned char* kb_ = bb + KOFF + mp * 8192 + hi * 1024 + r32 * 16;
#define ATT_SB() __builtin_amdgcn_sched_barrier(0)
            bf16x8 kf[8];
#pragma unroll
            for (int d0 = 0; d0 < 4; ++d0) { kf[2 * d0] = *(const LAS bf16x8*)(kb_ + d0 * 2048); kf[2 * d0 + 1] = *(const LAS bf16x8*)(kb_ + d0 * 2048 + 512); }
            const LAS unsigned char* vp = bb + VOFF + ((lane >> 4) & 1) * 32 + (lane & 3) * 8 + (4 * hi + ((lane & 15) >> 2)) * 64;
            s16x4 vlo[16], vhi[16];
#pragma unroll
            for (int ks = 0; ks < 2; ++ks)
#pragma unroll
                for (int d0 = 0; d0 < 4; ++d0) { vlo[d0 * 4 + ks] = vtr(vp + d0 * 4096 + ks * 1024); vhi[d0 * 4 + ks] = vtr(vp + d0 * 4096 + ks * 1024 + 512); }
            ATT_SB();
#pragma unroll
            for (int d0 = 0; d0 < 4; ++d0) c0 = __builtin_amdgcn_mfma_f32_32x32x16_bf16(kf[2 * d0], qr[d0], c0, 0, 0, 0);
            ATT_SB();
            float sacc = 0.f;
#pragma unroll
            for (int d0 = 0; d0 < 4; ++d0) {
                c1 = __builtin_amdgcn_mfma_f32_32x32x16_bf16(kf[2 * d0 + 1], qr[d0], c1, 0, 0, 0);
                ATT_SB();
#pragma unroll
                for (int e = 0; e < 4; ++e) { c0[4 * d0 + e] = __builtin_amdgcn_exp2f(c0[4 * d0 + e]); sacc += c0[4 * d0 + e]; }
                ATT_SB();
            }
            u32x4 pw[4];
#pragma unroll
            for (int g = 0; g < 4; ++g) { pw[0][g] = cvt_pk_bf16(c0[2 * g], c0[2 * g + 1]); pw[1][g] = cvt_pk_bf16(c0[8 + 2 * g], c0[8 + 2 * g + 1]); }
#pragma unroll
            for (int ks = 2; ks < 4; ++ks)
#pragma unroll
                for (int d0 = 0; d0 < 4; ++d0) { vlo[d0 * 4 + ks] = vtr(vp + d0 * 4096 + ks * 1024); vhi[d0 * 4 + ks] = vtr(vp + d0 * 4096 + ks * 1024 + 512); }
            ATT_SB();
#pragma unroll
            for (int j = 0; j < 8; ++j) { const int ks = j >> 2, d0 = j & 3;
                { const s16x4 lo = vlo[d0 * 4 + ks], hh = vhi[d0 * 4 + ks];
                  const bf16x8 vf = (bf16x8){lo[0], lo[1], lo[2], lo[3], hh[0], hh[1], hh[2], hh[3]};
                  o[d0] = __builtin_amdgcn_mfma_f32_32x32x16_bf16(__builtin_bit_cast(bf16x8, pw[ks]), vf, o[d0], 0, 0, 0); }
                ATT_SB();
                c1[2 * j] = __builtin_amdgcn_exp2f(c1[2 * j]); c1[2 * j + 1] = __builtin_amdgcn_exp2f(c1[2 * j + 1]); sacc += c1[2 * j] + c1[2 * j + 1];
                ATT_SB();
            }
            lsum += sacc;
#pragma unroll
            for (int g = 0; g < 4; ++g) { pw[2][g] = cvt_pk_bf16(c1[2 * g], c1[2 * g + 1]); pw[3][g] = cvt_pk_bf16(c1[8 + 2 * g], c1[8 + 2 * g + 1]); }
            ATT_SB();
#pragma unroll
            for (int j = 8; j < 16; ++j) { const int ks = j >> 2, d0 = j & 3;
                const s16x4 lo = vlo[d0 * 4 + ks], hh = vhi[d0 * 4 + ks];
                const bf16x8 vf = (bf16x8){lo[0], lo[1], lo[2], lo[3], hh[0], hh[1], hh[2], hh[3]};
                o[d0] = __builtin_amdgcn_mfma_f32_32x32x16_bf16(__builtin_bit_cast(bf16x8, pw[ks]), vf, o[d0], 0, 0, 0); }
#undef ATT_SB
        }
        slot = slot == 2 ? 0 : slot + 1;
    }
#undef ATT_DMA
#undef ATT_DMA1
    int el; asm volatile("v_mbcnt_lo_u32_b32 %0, -1, 0\n\tv_mbcnt_hi_u32_b32 %0, -1, %0" : "=v"(el));
    const int r32e = el & 31, hie = el >> 5;
    lsum += __shfl_xor(lsum, 32);
    LAS float* wsf = (LAS float*)(lds + WSF_OFF) + wid * 32;
    if (hie == 0) wsf[r32e] = lsum;
    asm volatile("s_waitcnt lgkmcnt(0)" ::: "memory");
    float rl[16];
#pragma unroll
    for (int r = 0; r < 16; ++r) rl[r] = __builtin_amdgcn_rcpf(wsf[crow(r, hie)]);
#pragma unroll
    for (int d0 = 0; d0 < 4; ++d0)
#pragma unroll
        for (int r = 0; r < 16; ++r) o[d0][r] *= rl[r];
    __syncthreads();
    LAS float* X = (LAS float*)lds + w4 * 4096;
    if (mp == 1) {
#pragma unroll
        for (int d0 = 0; d0 < 4; ++d0)
#pragma unroll
            for (int r = 0; r < 16; ++r) X[(d0 * 16 + r) * 64 + el] = o[d0][r];
    }
    __syncthreads();
    if (mp == 0) {
        float ss[16];
#pragma unroll
        for (int r = 0; r < 16; ++r) ss[r] = 0.f;
#pragma unroll
        for (int d0 = 0; d0 < 4; ++d0)
#pragma unroll
            for (int r = 0; r < 16; ++r) { const float dd = o[d0][r] - lam * X[(d0 * 16 + r) * 64 + el]; o[d0][r] = dd; ss[r] += dd * dd; }
#pragma unroll
        for (int r = 0; r < 16; ++r) {
            float s = ss[r];
#pragma unroll
            for (int of = 1; of < 32; of <<= 1) s += __shfl_xor(s, of);
            ss[r] = __builtin_amdgcn_rsqf(s * (1.0f / 128.0f) + EPS) * 0.8f;
        }
        bf16* Ow = O + (rowbase + q0 + 32 * w4) * D + h * 128 + r32e;
#pragma unroll
        for (int d0 = 0; d0 < 4; ++d0) { const float gcol = subg[32 * d0 + r32e];
#pragma unroll
            for (int r = 0; r < 16; ++r) Ow[(size_t)crow(r, hie) * D + 32 * d0] = (bf16)f2bf(o[d0][r] * ss[r] * gcol); }
    }
    __syncthreads();
}
}

__global__ void __launch_bounds__(NWAVES * 64, 2) mk_fwd(Args args) {
    extern __shared__ __attribute__((aligned(16))) unsigned char lds_raw[];
    LAS unsigned char* lds = (LAS unsigned char*)lds_raw;
    volatile LAS unsigned* MISC = (volatile LAS unsigned*)(lds + MISC_OFF);
    const int tid = threadIdx.x, lane = tid & 63, wave = __builtin_amdgcn_readfirstlane(tid >> 6);
    const int G = gridDim.x; const int bx = blockIdx.x;
    const int vcu = (G % 8 == 0) ? (bx % 8) * (G / 8) + bx / 8 : bx;
    unsigned char* ws = args.ws;
    unsigned* ctl = (unsigned*)(ws + WS_CTL);
    float* MOD = (float*)(ws + WS_MOD);
    unsigned* LCNT = (unsigned*)(ws + WS_LCNT);
    int* META = (int*)(ws + WS_META);
    u32x4* ROUTE = (u32x4*)(ws + WS_ROUTE);
    int* TOKSLOT = (int*)(ws + WS_TOKSLOT);
    float* GSLOT = (float*)(ws + WS_GSLOT);
    bf16* W_DAIN = (bf16*)(ws + WS_W_DAIN); bf16* W_DAOUT = (bf16*)(ws + WS_W_DAOUT); bf16* W_FFN13 = (bf16*)(ws + WS_W_FFN13); bf16* W_FFN2 = (bf16*)(ws + WS_W_FFN2);
    bf16* W_GLAIN = (bf16*)(ws + WS_W_GLAIN); bf16* W_GLAOUT = (bf16*)(ws + WS_W_GLAOUT); bf16* W_MOE13 = (bf16*)(ws + WS_W_MOE13); bf16* W_MOE2 = (bf16*)(ws + WS_W_MOE2);
    bf16* HB = (bf16*)(ws + WS_H);
    bf16* QB = (bf16*)(ws + WS_Q);
    bf16* KB = QB + (size_t)M * D; bf16* VB = KB + (size_t)M * D;
    bf16* ACTB = QB;
    bf16* GP = QB;
    bf16* GLAB = QB + (size_t)M * 3072;
    float* out = args.out;
    bf16* XB = (bf16*)(ws + WS_XB);
    float* KPART = (float*)(ws + WS_Q + 320 * MiB);
    static_assert(MOE_DN8 && (size_t)MAXSLOT * EXPD <= 320 * MiB && 320 * MiB + 256 * (size_t)(32 * 512 * 16) <= 464 * MiB, "K-split partials do not fit behind the MoE activations");

    for (int u = tid; u < 256; u += NWAVES * 64) ((LAS unsigned*)(lds + MISC_OFF))[u] = 0u;
    __syncthreads();
    XcdBarrier bar; bar.bar = ctl + CW_BAR; bar.x = 0; bar.st = nullptr;
    if (MK_N_LAUNCHES == 1) bar = xcd_barrier_post(ctl + CW_BAR, MISC + 8);
    const int lo = args.ph_lo, hi = args.ph_hi;
#define IN(k) (lo <= (k) && (k) < hi)
#define SEAM(k) do { if (IN(k) && IN((k) + 1)) xcd_barrier(bar); } while (0)
    const int gw = vcu * NWAVES + wave, NGW = G * NWAVES;

    if (IN(0)) {
        if (bx < 192) {
            LAS float* cact = (LAS float*)lds;
            for (int e = tid; e < 16 * 1024; e += 512) { const int b = e >> 10, k = e & 1023; const float v = args.c[e]; cact[k * 16 + b] = v / (1.0f + __expf(-v)); }
            __syncthreads();
            const int col = tid & 63, ks = tid >> 6, n = bx * 64 + col, layer = n / 6144, nn = n % 6144;
            const float* wp = args.ada_w + (size_t)layer * 1024 * 6144 + nn;
            float a[16];
#pragma unroll
            for (int b = 0; b < 16; ++b) a[b] = 0.f;
            for (int k = ks * 128; k < ks * 128 + 128; ++k) { const float w = wp[(size_t)k * 6144];
#pragma unroll
                for (int q = 0; q < 4; ++q) { const f32x4 cv = *(const LAS f32x4*)(cact + k * 16 + 4 * q); a[4 * q] += cv[0] * w; a[4 * q + 1] += cv[1] * w; a[4 * q + 2] += cv[2] * w; a[4 * q + 3] += cv[3] * w; } }
            LAS float* red = (LAS float*)(lds + 65536);
#pragma unroll
            for (int b = 0; b < 16; ++b) red[(ks * 16 + b) * 64 + col] = a[b];
            __syncthreads();
            for (int e = tid; e < 1024; e += 512) { const int b = e >> 6, cc = e & 63; float s = 0.f;
#pragma unroll
                for (int k8 = 0; k8 < 8; ++k8) s += red[(k8 * 16 + b) * 64 + cc];
                const int n2 = bx * 64 + cc, l2 = n2 / 6144, nn2 = n2 % 6144;
                MOD[((size_t)l2 * 16 + b) * 6144 + nn2] = s + args.ada_b[l2 * 6144 + nn2]; }
            __syncthreads();
        }
        for (int i = bx * 512 + tid; i < 2 * MAXSLOT; i += G * 512) TOKSLOT[i] = -1;
        LAS float* scr = (LAS float*)(lds + wave * 16384);
        constexpr int I_DAIN = 16 * 96, I_SQ = 16 * 32, I_F13 = 16 * 88, I_F2 = 44 * 32, I_GLAIN = 16 * 96, I_GA = 512;
        constexpr int NITEMS = I_DAIN + I_SQ + 2 * I_F13 + I_F2 + I_GLAIN + I_SQ + I_GA;
        for (int it = gw; it < NITEMS; it += NGW) {
            int r = it;
            if (r < I_DAIN) { const int kb = r / 96, nb = r % 96, n0 = 32 * nb, l = n0 & 255;
                p0_transpose_item(args.da_w_in, 3072, 64 * kb, n0, W_DAIN, (n0 & ~255) + 128 * ((l >> 5) & 1) + 32 * (l >> 6), D, scr, lane); continue; } r -= I_DAIN;
            if (r < I_SQ) { const int kb = r / 32, nb = r % 32; p0_transpose_item(args.da_w_out, D, 64 * kb, 32 * nb, W_DAOUT, 32 * nb, D, scr, lane); continue; } r -= I_SQ;
            if (r < 2 * I_F13) { const int w = r / I_F13, q = r % I_F13, kb = q / 88, nb = q % 88, n0 = 32 * nb;
                if (FFN_UP8) p0_transpose_item8(w ? args.ffn_w3 : args.ffn_w1, FFN, 64 * kb, n0, (unsigned char*)W_FFN13, (n0 >> 7) * 256 + w * 128 + (n0 & 127), D, scr, lane);
                else p0_transpose_item(w ? args.ffn_w3 : args.ffn_w1, FFN, 64 * kb, n0, W_FFN13, (n0 >> 7) * 256 + w * 128 + (n0 & 127), D, scr, lane); continue; } r -= 2 * I_F13;
            if (r < I_F2) { const int kb = r / 32, nb = r % 32; if (FFN_DN8) p0_transpose_item8(args.ffn_w2, D, 64 * kb, 32 * nb, (unsigned char*)W_FFN2, 32 * nb, FFN, scr, lane); else p0_transpose_item(args.ffn_w2, D, 64 * kb, 32 * nb, W_FFN2, 32 * nb, FFN, scr, lane); continue; } r -= I_F2;
            if (r < I_GLAIN) { const int kb = r / 96, nb = r % 96; p0_transpose_item(args.gla_w_in, 3072, 64 * kb, 32 * nb, W_GLAIN, 32 * nb, D, scr, lane); continue; } r -= I_GLAIN;
            if (r < I_SQ) { const int kb = r / 32, nb = r % 32; p0_transpose_item(args.gla_w_out, D, 64 * kb, 32 * nb, W_GLAOUT, 32 * nb, D, scr, lane); continue; } r -= I_SQ;
            if (r < I_GA) {
                const int j = r; float a2[16];
#pragma unroll
                for (int q = 0; q < 16; ++q) a2[q] = args.gla_w_a2[q * 512 + j];
                bf16* dst = W_GLAIN + (size_t)(3072 + j) * D + lane * 16;
                unsigned pk[8];
#pragma unroll
                for (int kk = 0; kk < 16; kk += 2) { float s0 = 0.f, s1 = 0.f; const float* w1p = args.gla_w_a1 + (size_t)(lane * 16 + kk) * 16;
#pragma unroll
                    for (int q = 0; q < 16; ++q) { s0 += w1p[q] * a2[q]; s1 += w1p[16 + q] * a2[q]; }
                    pk[kk >> 1] = pk2(s0, s1); }
                *(u32x4*)dst = (u32x4){pk[0], pk[1], pk[2], pk[3]}; *(u32x4*)(dst + 8) = (u32x4){pk[4], pk[5], pk[6], pk[7]};
                continue; }
        }
    }
    SEAM(0);

#define NORM_LOAD(XSRC, SRC16, m_, v_, s_) do { s_ = 0.f; \
            _Pragma("unroll") for (int j = 0; j < 4; ++j) { v_[j] = (SRC16) ? ld_bf16x4((const bf16*)(XSRC) + (size_t)(m_) * D + 4 * lane + 256 * j) : *((const f32x4*)((const float*)(XSRC) + (size_t)(m_) * D) + lane + 64 * j); s_ += (v_[j][0] * v_[j][0] + v_[j][1] * v_[j][1]) + (v_[j][2] * v_[j][2] + v_[j][3] * v_[j][3]); } } while (0)
#define NORM_ROW(GVEC, MODROW, ROUTER, OUT8, m_, v_, s_) do { const int m = (m_); f32x4 (&v)[4] = v_; \
            { const int b = m >> 12; if (b != ncb) { ncb = b; const float* mrow = (MODROW) + (size_t)b * 6144;        \
                _Pragma("unroll") for (int j = 0; j < 4; ++j) { const f32x4 gg = *((const f32x4*)(GVEC) + lane + 64 * j), sc = *((const f32x4*)(mrow + 1024) + lane + 64 * j); ngs[j] = gg * (sc + 1.0f); nsh[j] = *((const f32x4*)mrow + lane + 64 * j); } } } \
            const float rstd = __builtin_amdgcn_rsqf(wave_sum(s_) * (1.0f / D) + EPS); \
            _Pragma("unroll") for (int j = 0; j < 4; ++j) v[j] = v[j] * rstd * ngs[j] + nsh[j]; \
            if (OUT8) { unsigned* o4 = (unsigned*)((unsigned char*)HB + (size_t)m * D) + lane; \
                _Pragma("unroll") for (int j = 0; j < 4; ++j) o4[64 * j] = pk_fp8x4(v[j][0] * H8_SCALE, v[j][1] * H8_SCALE, v[j][2] * H8_SCALE, v[j][3] * H8_SCALE); } \
            else { u32x2* o8 = (u32x2*)(HB + (size_t)m * D) + lane; \
                _Pragma("unroll") for (int j = 0; j < 4; ++j) o8[64 * j] = (u32x2){pk2(v[j][0], v[j][1]), pk2(v[j][2], v[j][3])}; } \
            if (ROUTER) { ROUTER_BODY } } while (0)
#define NORM_PHASE(XSRC, SRC16, GVEC, MODROW, ROUTER, OUT8) do { \
        const int rpw = (M + NGW - 1) / NGW; const int r_lo = (ROUTER ? (bx * NWAVES + wave) : gw) * rpw; int ncb = -1; f32x4 ngs[4], nsh[4]; \
        for (int rr = 0; rr < rpw; rr += 4) { const int m0 = r_lo + rr; if (m0 >= M) break; \
            f32x4 va[4], vb[4], vc[4], vd[4]; float sa, sb = 0.f, sc_ = 0.f, sd = 0.f; \
            const bool hb = (rr + 1 < rpw) && (m0 + 1 < M), hc = (rr + 2 < rpw) && (m0 + 2 < M), hd = (rr + 3 < rpw) && (m0 + 3 < M); \
            NORM_LOAD(XSRC, SRC16, m0, va, sa); if (hb) NORM_LOAD(XSRC, SRC16, m0 + 1, vb, sb); if (hc) NORM_LOAD(XSRC, SRC16, m0 + 2, vc, sc_); if (hd) NORM_LOAD(XSRC, SRC16, m0 + 3, vd, sd); \
            NORM_ROW(GVEC, MODROW, ROUTER, OUT8, m0, va, sa); if (hb) NORM_ROW(GVEC, MODROW, ROUTER, OUT8, m0 + 1, vb, sb); \
            if (hc) NORM_ROW(GVEC, MODROW, ROUTER, OUT8, m0 + 2, vc, sc_); if (hd) NORM_ROW(GVEC, MODROW, ROUTER, OUT8, m0 + 3, vd, sd); } } while (0)
#define ROUTER_BODY
    if (IN(1)) { NORM_PHASE(args.x, false, args.norm1_g, MOD, 0, false); }
    SEAM(1);

    if (IN(2)) {
        pg8::DenseSched S; S.init(M / 256, 12, G, bx); S.A = (const char*)HB; S.Bt = (const char*)W_DAIN; S.tstep = (size_t)256 * D * 2;
        pg8::EpiQKV E{QB, (size_t)M * D, args.da_q_gain, args.da_k_gain, 0.125f * LOG2E};
        pg8::gemm_phase<pg8::EpiQKV, pg8::DenseSched, true, false>(lds, 2 * D, S, E);
    }
    SEAM(2);

    if (IN(3)) {
        float a1 = args.da_lam_q1[lane] * args.da_lam_k1[lane], a2 = args.da_lam_q2[lane] * args.da_lam_k2[lane];
        const float lam = __expf(wave_sum(a1)) - __expf(wave_sum(a2)) + 0.2f;
        const float gq0 = wave_max(fabsf(args.da_q_gain[lane])), gq1 = wave_max(fabsf(args.da_q_gain[64 + lane]));
        const float gk0 = wave_max(fabsf(args.da_k_gain[lane])), gk1 = wave_max(fabsf(args.da_k_gain[64 + lane]));
        const float mref0 = 8.0f * LOG2E * gq0 * gk0 * 1.01f, mref1 = 8.0f * LOG2E * gq1 * gk1 * 1.01f;
        for (int rep = 0; rep < (PROBE_DUP == 3 ? 2 : 1); ++rep)
        for (int bb = vcu >> 4; bb < BATCH; bb += (G >= 16 ? (G >> 4) : 1)) {
            const int w16 = vcu & 15, nu = att::PLAN.n[w16];
            for (int i = 0; i < nu; ++i) { const int hj = att::PLAN.u[w16][i], h = hj >> 5, jq = hj & 31;
                const float sl2 = LOG2E * exp2f(-(float)(h + 1));
                att::attn_unit(lds, QB, KB, VB, HB, bb, h, jq, sl2, mref0, mref1, lam, args.da_subln_g); }
        }
    }
    SEAM(3);

    if (IN(4)) {
        pg8::DenseSched S; S.init(M / 256, 4, G, bx); S.A = (const char*)HB; S.Bt = (const char*)W_DAOUT; S.tstep = (size_t)256 * D * 2;
        pg8::EpiResid<false, true> E{args.x, XB, MOD + 2048, 1.0f};
        pg8::gemm_phase<pg8::EpiResid<false, true>, pg8::DenseSched, true, false>(lds, 2 * D, S, E);
    }
    SEAM(4);
    if (IN(5)) { NORM_PHASE(XB, true, args.norm2_g, MOD + 3072, 0, FFN_UP8); }
    SEAM(5);

    if (IN(6)) {
        pg8::DenseSched S; S.init(M / 256, 2 * FFN / 256, G, bx); S.A = (const char*)HB; S.Bt = (const char*)W_FFN13; S.tstep = (size_t)256 * D * (FFN_UP8 ? 1 : 2);
        pg8::EpiSwiGLU<FFN_DN8> E{ACTB, FFN, FFN_UP8 ? 1.0f / (H8_SCALE * W8_SCALE) : 1.0f};
        pg8::gemm_phase<pg8::EpiSwiGLU<FFN_DN8>, pg8::DenseSched, true, false, FFN_UP8>(lds, D * (FFN_UP8 ? 1 : 2), S, E);
    }
    SEAM(6);
    if (IN(7)) {
        pg8::DenseSched S; S.init(M / 256, 4, G, bx); S.A = (const char*)ACTB; S.Bt = (const char*)W_FFN2; S.tstep = (size_t)256 * FFN * (FFN_DN8 ? 1 : 2);
        pg8::EpiResid<true, true> E{XB, XB, MOD + 5 * 1024, FFN_DN8 ? 1.0f / (A8_SCALE * W8_SCALE) : 1.0f};
        pg8::gemm_phase<pg8::EpiResid<true, true>, pg8::DenseSched, true, false, FFN_DN8>(lds, FFN * (FFN_DN8 ? 1 : 2), S, E);
    }
    SEAM(7);

    float* MOD1 = MOD + 16 * 6144;
    if (IN(8)) { NORM_PHASE(XB, true, args.norm1_g + D, MOD1, 0, false); }
    SEAM(8);
    if (IN(9)) {
        pg8::DenseSched S; S.init(M / 256, GLA_N / 256, G, bx); S.A = (const char*)HB; S.Bt = (const char*)W_GLAIN; S.tstep = (size_t)256 * D * 2;
        pg8::EpiGLA E{GP, GLAB, args.gla_b_a, args.gla_out_g};
        pg8::gemm_phase<pg8::EpiGLA, pg8::DenseSched, true, false>(lds, 2 * D, S, E);
    }
    SEAM(9);

    unsigned char* GA = (unsigned char*)out;
    static_assert(4096 * GA_UNIT <= 192 * MiB && 256 * MiB <= (size_t)M * D * 4 && (size_t)M * 512 * 2 >= 64 * MiB, "o-fragment parking");
#define OFRAG(b_, n_, h_) (((b_) < 8 ? (unsigned char*)GLAB : (unsigned char*)out + 192 * MiB) + (size_t)(((((b_) & 7) * 64 + (n_)) * 4) + (h_)) * 32768)
    if (IN(10)) {
        LAS unsigned char* QDp = lds; LAS unsigned char* KDTc = lds + 16384; LAS unsigned char* ATc = lds + 32768; LAS float* DV = (LAS float*)(lds + 40960);
        LAS bf16* KI = (LAS bf16*)(lds + 43008); LAS float* QT = (LAS float*)(lds + 60416);
        const int fr = lane & 15, fq = lane >> 4;
        const int j = tid & 127, tq = tid >> 7;
        const int cq = j >> 4, wq = j & 15, hq = (wq >> 2) & 1, jq2 = ((wq >> 3) << 2) | (wq & 3);
        for (int rep = 0; rep < (PROBE_DUP == 10 ? 2 : 1); ++rep)
        for (int u = bx; u < 4096; u += G) {
            const int h = u & 3, n = (u >> 2) & 63, b = u >> 8;
            const size_t R0 = (size_t)b * SEQ + 64 * n;
            float la[16], qv[16], kv[16];
#pragma unroll
            for (int i = 0; i < 16; ++i) { const size_t row = R0 + 16 * tq + i; la[i] = bf2f(GLAB[row * 512 + h * 128 + j]); qv[i] = bf2f(GP[row * 3072 + h * 128 + j]); kv[i] = bf2f(GP[row * 3072 + 512 + h * 128 + j]); }
#pragma unroll
            for (int i = 1; i < 16; ++i) la[i] += la[i - 1];
            QT[tq * 128 + j] = la[15];
            __syncthreads();
            float pre = 0.f, tot = 0.f;
#pragma unroll
            for (int q = 0; q < 4; ++q) { const float v = QT[q * 128 + j]; tot += v; pre += (q < tq) ? v : 0.f; }
            unsigned kdp[8];
#pragma unroll
            for (int i = 0; i < 16; ++i) { const float bb = pre + la[i]; const int t = 16 * tq + i;
                *(LAS bf16*)(QDp + (((cq * 2 + hq) * 64 + t) * 16) + jq2 * 2) = (bf16)f2bf(qv[i] * 0.08838834764831845f * __expf(bb));
                KI[t * 136 + j] = (bf16)f2bf(kv[i] * __expf(-bb));
                const float kd = kv[i] * __expf(tot - bb);
                if (i & 1) kdp[i >> 1] |= f2bf(kd) << 16; else kdp[i >> 1] = f2bf(kd); }
            *(LAS u32x4*)(KDTc + ((2 * tq) * 128 + j) * 16) = (u32x4){kdp[0], kdp[1], kdp[2], kdp[3]};
            *(LAS u32x4*)(KDTc + ((2 * tq + 1) * 128 + j) * 16) = (u32x4){kdp[4], kdp[5], kdp[6], kdp[7]};
            if (tq == 0) DV[j] = __expf(tot);
            __syncthreads();
#pragma unroll
            for (int q = 0; q < 2; ++q) { const int idx = 2 * wave + q, ti = idx >> 2, si = idx & 3;
                f32x4 c = (f32x4){0.f, 0.f, 0.f, 0.f};
                if (si <= ti) {
#pragma unroll
                    for (int ks = 0; ks < 4; ++ks) { const int cc = 2 * ks + (fq >> 1), jb = 4 * (fq & 1), t = 16 * ti + fr;
                        const u32x2 alo = *(const LAS u32x2*)(QDp + (((cc * 2 + 0) * 64 + t) * 16) + jb * 2), ahi = *(const LAS u32x2*)(QDp + (((cc * 2 + 1) * 64 + t) * 16) + jb * 2);
                        const u32x4 af = (u32x4){alo[0], alo[1], ahi[0], ahi[1]};
                        const bf16x8 bfr = *(const LAS bf16x8*)(KI + (16 * si + fr) * 136 + 32 * ks + 8 * fq);
                        c = __builtin_amdgcn_mfma_f32_16x16x32_bf16(__builtin_bit_cast(bf16x8, af), bfr, c, 0, 0, 0); }
                }
#pragma unroll
                for (int r = 0; r < 4; ++r) { const int t = 16 * ti + 4 * fq + r, sx = 16 * si + fr; *(LAS bf16*)(ATc + (((sx >> 3) * 64 + t) * 16) + (sx & 7) * 2) = (bf16)f2bf(sx <= t ? c[r] : 0.f); } }
            __syncthreads();
            { u32x4* dst = (u32x4*)(GA + (size_t)u * GA_UNIT);
              for (int v = tid; v < 41472 / 16; v += 512) dst[v] = *(const LAS u32x4*)(lds + v * 16); }
            __syncthreads();
        }
    }
    SEAM(10);

    const int sstride = G >= 256 ? 4 : (G >= 128 ? 2 : 1);
    const bool is_scan = (vcu % sstride == 0) && (vcu / sstride < 64);
    const int scan_id = vcu / sstride;
    const int copy_id = vcu < 64 * sstride ? (vcu / sstride) * (sstride - 1) + (vcu % sstride) - 1 : 64 * (sstride - 1) + (vcu - 64 * sstride);
    if (IN(11) && !is_scan) {
        LAS float* scr = (LAS float*)(lds + wave * 16384);
        constexpr int I_M13 = 16 * 112, I_M2 = 56 * 32, NIT = NEXP * 2 * I_M13 + NEXP * I_M2;
        const int nwv = (G - 64) * NWAVES;
        for (int rep = 0; rep < (PROBE_DUP == 20 ? 2 : 1); ++rep)
        for (int it = copy_id * NWAVES + wave; it < NIT; it += nwv) {
            int r = it;
            if (r < NEXP * 2 * I_M13) { const int e = r / (2 * I_M13), q2 = r % (2 * I_M13), w = q2 / I_M13, q = q2 % I_M13, kb = q / 112, nb = q % 112, n0 = 32 * nb;
                if (MOE_UP8) p0_transpose_item8((w ? args.moe_w3 : args.moe_w1) + (size_t)e * D * EXPD, EXPD, 64 * kb, n0, (unsigned char*)W_MOE13 + (size_t)e * 2 * EXPD * D, (n0 >> 7) * 256 + w * 128 + (n0 & 127), D, scr, lane);
                else p0_transpose_item((w ? args.moe_w3 : args.moe_w1) + (size_t)e * D * EXPD, EXPD, 64 * kb, n0, W_MOE13 + (size_t)e * 2 * EXPD * D, (n0 >> 7) * 256 + w * 128 + (n0 & 127), D, scr, lane); continue; }
            r -= NEXP * 2 * I_M13;
            { const int e = r / I_M2, q = r % I_M2, kb = q / 32, nb = q % 32;
                if (MOE_DN8) p0_transpose_item8(args.moe_w2 + (size_t)e * EXPD * D, D, 64 * kb, 32 * nb, (unsigned char*)W_MOE2 + (size_t)e * D * EXPD, 32 * nb, EXPD, scr, lane);
                else p0_transpose_item(args.moe_w2 + (size_t)e * EXPD * D, D, 64 * kb, 32 * nb, W_MOE2 + (size_t)e * D * EXPD, 32 * nb, EXPD, scr, lane); }
        }
    }
    if (IN(11) && is_scan) {
        const int b = scan_id >> 2, h = scan_id & 3;
        constexpr int BUFB = 74752, VOFF = 41984, GO_OFF = 2 * BUFB;
        LAS float* GO = (LAS float*)(lds + GO_OFF);
        if (tid < 256) GO[tid] = args.gla_out_g[tid];
        const int r32 = lane & 31, hh = lane >> 5;
        const int c0 = 32 * wave;
        const unsigned char* gabase = GA + ((size_t)b * 256 + h) * GA_UNIT;
        const bf16* vsrc = GP + ((size_t)b * SEQ + (lane >> 2)) * 3072 + 1024 + h * 256 + 32 * wave + (lane & 3) * 8;
#define GLA_DMA(n_, bs_) do { LAS unsigned char* bb_ = lds + (bs_) * BUFB; const unsigned char* ga_ = gabase + (size_t)(n_) * 4 * GA_UNIT; \
        _Pragma("unroll") for (int k_ = 0; k_ < 6; ++k_) { int p_ = wave + 8 * k_; p_ = p_ > 40 ? 40 : p_; \
            __builtin_amdgcn_global_load_lds((const unsigned*)(ga_ + p_ * 1024 + lane * 16), (LAS unsigned*)(bb_ + p_ * 1024), 16, 0, 0); } \
        _Pragma("unroll") for (int ks_ = 0; ks_ < 4; ++ks_) \
            __builtin_amdgcn_global_load_lds((const unsigned*)(vsrc + ((size_t)(n_) * 64 + 16 * ks_) * 3072), (LAS unsigned*)(bb_ + VOFF + (ks_ * 8 + wave) * 1024), 16, 0, 0); } while (0)
#define GLA_BAR() do { asm volatile("s_waitcnt lgkmcnt(0)" ::: "memory"); __builtin_amdgcn_s_barrier(); asm volatile("" ::: "memory"); } while (0)
        for (int rep = 0; rep < (PROBE_DUP == 11 ? 2 : 1); ++rep) {
        f32x16 Sacc[4];
#pragma unroll
        for (int kt = 0; kt < 4; ++kt)
#pragma unroll
            for (int r = 0; r < 16; ++r) Sacc[kt][r] = 0.f;
        GLA_DMA(0, 0);
        asm volatile("s_waitcnt vmcnt(0)" ::: "memory");
        for (int n = 0; n < 64; ++n) {
            const size_t R0 = (size_t)b * SEQ + 64 * n;
            asm volatile("s_waitcnt vmcnt(4)" ::: "memory");
            GLA_BAR();
            if (n + 1 < 64) GLA_DMA(n + 1, (n + 1) & 1);
            LAS unsigned char* bb = lds + (n & 1) * BUFB;
            const LAS unsigned char* QDp = bb; const LAS unsigned char* KDTc = bb + 16384; const LAS unsigned char* ATc = bb + 32768; const LAS float* DV = (const LAS float*)(bb + 40960);
            bf16x8 vf[4];
#pragma unroll
            for (int ks = 0; ks < 4; ++ks) { const LAS unsigned char* vp = bb + VOFF + (ks * 8 + wave) * 1024 + ((lane >> 4) & 1) * 32 + (lane & 3) * 8 + (8 * hh + ((lane & 15) >> 2)) * 64;
                const s16x4 lo = att::vtr(vp), hi4 = att::vtr(vp + 256); vf[ks] = (bf16x8){lo[0], lo[1], lo[2], lo[3], hi4[0], hi4[1], hi4[2], hi4[3]}; }
            f32x16 o[2];
#pragma unroll
            for (int tt = 0; tt < 2; ++tt)
#pragma unroll
                for (int r = 0; r < 16; ++r) o[tt][r] = 0.f;
            bf16x8 qa[16], aa[6];
#pragma unroll
            for (int kt = 0; kt < 4; ++kt)
#pragma unroll
                for (int sx = 0; sx < 2; ++sx)
#pragma unroll
                    for (int tt = 0; tt < 2; ++tt) qa[(kt * 2 + sx) * 2 + tt] = *(const LAS bf16x8*)(QDp + ((((kt * 2 + sx) * 2 + hh) * 64 + 32 * tt + r32) * 16));
#pragma unroll
            for (int i = 0; i < 6; ++i) { const int tt = i < 2 ? 0 : 1, ks = i < 2 ? i : i - 2;
                aa[i] = *(const LAS bf16x8*)(ATc + (((2 * ks + hh) * 64 + 32 * tt + r32) * 16)); }
            __builtin_amdgcn_sched_barrier(0);
#pragma unroll
            for (int kt = 0; kt < 4; ++kt)
#pragma unroll
                for (int sx = 0; sx < 2; ++sx) {
                    u32x4 sb;
#pragma unroll
                    for (int g = 0; g < 4; ++g) sb[g] = cvt_pk_bf16(Sacc[kt][8 * sx + 2 * g], Sacc[kt][8 * sx + 2 * g + 1]);
#pragma unroll
                    for (int tt = 0; tt < 2; ++tt) o[tt] = __builtin_amdgcn_mfma_f32_32x32x16_bf16(qa[(kt * 2 + sx) * 2 + tt], __builtin_bit_cast(bf16x8, sb), o[tt], 0, 0, 0);
                }
#pragma unroll
            for (int i = 0; i < 6; ++i) { const int tt = i < 2 ? 0 : 1, ks = i < 2 ? i : i - 2;
                o[tt] = __builtin_amdgcn_mfma_f32_32x32x16_bf16(aa[i], vf[ks], o[tt], 0, 0, 0); }
            __builtin_amdgcn_sched_barrier(0);
            { u32x4* dst = (u32x4*)(OFRAG(b, n, h)) + (wave * 4) * 64 + lane;
#pragma unroll
              for (int tt = 0; tt < 2; ++tt)
#pragma unroll
                  for (int q = 0; q < 2; ++q) { u32x4 w;
#pragma unroll
                      for (int g = 0; g < 4; ++g) w[g] = cvt_pk_bf16(o[tt][8 * q + 2 * g], o[tt][8 * q + 2 * g + 1]);
                      dst[(tt * 2 + q) * 64] = w; } }
            __builtin_amdgcn_sched_barrier(0);
            f32x4 dvv[16]; bf16x8 ka[16];
#pragma unroll
            for (int kt = 0; kt < 4; ++kt)
#pragma unroll
                for (int g = 0; g < 4; ++g) dvv[kt * 4 + g] = *(const LAS f32x4*)(DV + 32 * kt + 8 * g + 4 * hh);
#pragma unroll
            for (int ks = 0; ks < 4; ++ks)
#pragma unroll
                for (int kt = 0; kt < 4; ++kt) ka[ks * 4 + kt] = *(const LAS bf16x8*)(KDTc + (((2 * ks + hh) * 128 + 32 * kt + r32) * 16));
            __builtin_amdgcn_sched_barrier(0);
#pragma unroll
            for (int kt = 0; kt < 4; ++kt)
#pragma unroll
                for (int g = 0; g < 4; ++g)
#pragma unroll
                    for (int e = 0; e < 4; ++e) Sacc[kt][4 * g + e] *= dvv[kt * 4 + g][e];
#pragma unroll
            for (int ks = 0; ks < 4; ++ks)
#pragma unroll
                for (int kt = 0; kt < 4; ++kt) Sacc[kt] = __builtin_amdgcn_mfma_f32_32x32x16_bf16(ka[ks * 4 + kt], vf[ks], Sacc[kt], 0, 0, 0);
        }
        asm volatile("s_waitcnt vmcnt(0)" ::: "memory");
        GLA_BAR();
        }
#undef GLA_DMA
#undef GLA_BAR
    }
    if (IN(11)) {
        static_assert(MK_N_LAUNCHES == 1, "the scan follow-up sits behind an in-phase grid barrier");
        xcd_barrier(bar);
        LAS float* OS = (LAS float*)lds;
        const int r32 = lane & 31, hh = lane >> 5, c0 = 32 * wave;
        u32x4 fr[4], rwv[4];
#define P10C_LOAD(u_) do { const int b_ = (u_) >> 8, n_ = ((u_) >> 2) & 63, h_ = (u_) & 3; const u32x4* src_ = (const u32x4*)(OFRAG(b_, n_, h_)) + (wave * 4) * 64 + lane; \
            _Pragma("unroll") for (int k_ = 0; k_ < 4; ++k_) fr[k_] = src_[k_ * 64]; \
            const bf16* rp0_ = GP + ((size_t)b_ * SEQ + 64 * n_ + (tid >> 3)) * 3072 + 2048 + h_ * 256 + 32 * (tid & 7); \
            _Pragma("unroll") for (int i_ = 0; i_ < 4; ++i_) rwv[i_] = *(const u32x4*)(rp0_ + 8 * i_); } while (0)
        int u = bx;
        if (u < 4096) P10C_LOAD(u);
        for (; u < 4096; u += G) {
            const int b = u >> 8, n = (u >> 2) & 63, h = u & 3; const size_t R0 = (size_t)b * SEQ + 64 * n;
            u32x4 rw_c[4];
#pragma unroll
            for (int i = 0; i < 4; ++i) rw_c[i] = rwv[i];
            __syncthreads();
#pragma unroll
            for (int tt = 0; tt < 2; ++tt)
#pragma unroll
                for (int q = 0; q < 2; ++q)
#pragma unroll
                    for (int g = 0; g < 4; ++g) { const unsigned w = fr[tt * 2 + q][g]; const int r = 8 * q + 2 * g;
                        OS[(32 * tt + att::crow(r, hh)) * 260 + c0 + r32] = __builtin_bit_cast(float, w << 16);
                        OS[(32 * tt + att::crow(r + 1, hh)) * 260 + c0 + r32] = __builtin_bit_cast(float, w & 0xffff0000u); }
            __syncthreads();
            if (u + G < 4096) P10C_LOAD(u + G);
            { const int t = tid >> 3, seg = tid & 7; f32x4 ov[8]; float ss = 0.f;
#pragma unroll
              for (int i = 0; i < 8; ++i) { ov[i] = *(const LAS f32x4*)(OS + t * 260 + 32 * seg + 4 * i); ss += (ov[i][0] * ov[i][0] + ov[i][1] * ov[i][1]) + (ov[i][2] * ov[i][2] + ov[i][3] * ov[i][3]); }
              ss += __shfl_xor(ss, 1); ss += __shfl_xor(ss, 2); ss += __shfl_xor(ss, 4);
              const float rs = __builtin_amdgcn_rsqf(ss * (1.0f / 256.0f) + EPS);
              bf16* op = HB + (R0 + t) * D + h * 256 + 32 * seg;
#pragma unroll
              for (int i = 0; i < 4; ++i) { const u32x4 rw = rw_c[i]; u32x4 w;
#pragma unroll
                  for (int e = 0; e < 4; ++e) { const float r0 = __builtin_bit_cast(float, rw[e] << 16), r1 = __builtin_bit_cast(float, rw[e] & 0xffff0000u);
                      const int cidx = 8 * i + 2 * e;
                      const float v0 = ov[(cidx) >> 2][(cidx) & 3] * rs * r0, v1 = ov[(cidx + 1) >> 2][(cidx + 1) & 3] * rs * r1;
                      w[e] = pk2(v0, v1); }
                  *(u32x4*)(op + 8 * i) = w; } }
        }
#undef P10C_LOAD
    }
    SEAM(11);


    if (IN(12)) {
        pg8::DenseSched S; S.init(M / 256, 4, G, bx); S.A = (const char*)HB; S.Bt = (const char*)W_GLAOUT; S.tstep = (size_t)256 * D * 2;
        pg8::EpiResid<true, true> E{XB, XB, MOD1 + 2048, 1.0f};
        pg8::gemm_phase<pg8::EpiResid<true, true>, pg8::DenseSched, true, false>(lds, 2 * D, S, E);
    }
    SEAM(12);

    if (IN(13)) {
        LAS float* RW = (LAS float*)lds;
        LAS unsigned* EL = (LAS unsigned*)(lds + 32768);
        LAS float* GL = (LAS float*)(lds + 32768 + 4096);
        for (int e = tid; e < 8192; e += 512) { const int k = e >> 3, ex = e & 7;
            RW[((((k >> 8) * 4 + (k & 3)) * 2 + (ex >> 2)) * 64 + ((k & 255) >> 2)) * 4 + (ex & 3)] = args.moe_router[e]; }
        __syncthreads();
#undef ROUTER_BODY
#define ROUTER_BODY { float lg[8]; \
            _Pragma("unroll") for (int e = 0; e < 8; ++e) lg[e] = 0.f; \
            _Pragma("unroll") for (int j = 0; j < 4; ++j) _Pragma("unroll") for (int i = 0; i < 4; ++i) { const f32x4 w0 = *((const LAS f32x4*)RW + ((j * 4 + i) * 2) * 64 + lane), w1 = *((const LAS f32x4*)RW + ((j * 4 + i) * 2 + 1) * 64 + lane); const float hv = v[j][i]; \
                lg[0] += hv * w0[0]; lg[1] += hv * w0[1]; lg[2] += hv * w0[2]; lg[3] += hv * w0[3]; lg[4] += hv * w1[0]; lg[5] += hv * w1[1]; lg[6] += hv * w1[2]; lg[7] += hv * w1[3]; } \
            _Pragma("unroll") for (int e = 0; e < 8; ++e) lg[e] = wave_sum(lg[e]); \
            float v1 = lg[0]; \
            _Pragma("unroll") for (int e = 1; e < 8; ++e) v1 = fmaxf(v1, lg[e]); \
            int e1 = 7; \
            _Pragma("unroll") for (int e = 6; e >= 0; --e) e1 = (lg[e] == v1) ? e : e1; \
            float v2 = -3.0e38f; \
            _Pragma("unroll") for (int e = 0; e < 8; ++e) v2 = fmaxf(v2, (e == e1) ? -3.0e38f : lg[e]); \
            int e2 = -1; \
            _Pragma("unroll") for (int e = 7; e >= 0; --e) e2 = (e != e1 && lg[e] == v2) ? e : e2; \
            if (lane == 0) { EL[m - wg_row0] = (unsigned)e1 | ((unsigned)e2 << 8); GL[m - wg_row0] = v1 - v2; } }
        const int rpw12 = (M + NGW - 1) / NGW, rows_wg12 = rpw12 * NWAVES, wg_row0 = bx * rows_wg12;
        NORM_PHASE(XB, true, args.norm2_g + D, MOD1 + 3072, 1, MOE_UP8);
        __syncthreads();
        {
            int nrows = M - wg_row0; nrows = nrows > rows_wg12 ? rows_wg12 : nrows;
            for (int r = tid; r < nrows; r += 512) { const unsigned ew = EL[r]; const unsigned e1 = ew & 255u, e2 = ew >> 8; unsigned l1 = 0, l2 = 0;
                for (int q = 0; q < r; ++q) { const unsigned w = EL[q]; l1 += ((w & 255u) == e1) ? 1u : 0u; l2 += ((w >> 8) == e2) ? 1u : 0u; }
                ROUTE[wg_row0 + r] = (u32x4){ew, __builtin_bit_cast(unsigned, GL[r]), l1, l2}; }
            if (tid < 16) { const unsigned e = tid & 7; unsigned cnt = 0; for (int q = 0; q < nrows; ++q) { const unsigned w = EL[q]; cnt += ((tid < 8 ? (w & 255u) : (w >> 8)) == e) ? 1u : 0u; } LCNT[bx * 16 + tid] = cnt; }
        }
    }
    SEAM(13);

    if (IN(14)) {
        LAS int* PRE = (LAS int*)lds;
        LAS int* GOFF = (LAS int*)(lds + 256);
        {
            LAS int* CNT = (LAS int*)(lds + 1024);
            LAS int* PART = (LAS int*)(lds + 1024 + 65536);
            for (int i = tid; i < G * 16; i += 512) CNT[i] = (int)LCNT[i];
            __syncthreads();
            { const int c = tid & 15, grp = tid >> 4; int pre = 0, tot = 0;
              for (int w = grp; w < G; w += 32) { const int v = CNT[w * 16 + c]; tot += v; pre += (w < bx) ? v : 0; }
              PART[(grp * 2) * 16 + c] = pre; PART[(grp * 2 + 1) * 16 + c] = tot; }
            __syncthreads();
            if (tid < 16) { int pre = 0, tot = 0; for (int g = 0; g < 32; ++g) { pre += PART[(g * 2) * 16 + tid]; tot += PART[(g * 2 + 1) * 16 + tid]; } PRE[tid] = pre; ((LAS int*)(lds + 512))[tid] = (tot + 255) & ~255; }
        }
        __syncthreads();
        if (tid < 2) { int acc = 0; for (int e = 0; e < 8; ++e) { GOFF[tid * 9 + e] = acc; acc += ((LAS int*)(lds + 512))[tid * 8 + e]; } GOFF[tid * 9 + 8] = acc;
            if (bx == 0) { for (int e = 0; e < 9; ++e) META[tid * 16 + e] = GOFF[tid * 9 + e]; } }
        __syncthreads();
        const int rpw = (M + NGW - 1) / NGW, rows_wg = rpw * NWAVES;
        for (int r = tid; r < rows_wg; r += 512) { const int m = bx * rows_wg + r; if (m >= M) break;
            const u32x4 rt = ROUTE[m]; const int e1 = rt[0] & 255, e2 = (rt[0] >> 8) & 255; const unsigned gbits = rt[1]; const float gap = __builtin_bit_cast(float, gbits); const float g1 = 1.0f / (1.0f + expf(-gap));
            const int s1 = GOFF[e1] + PRE[e1] + (int)rt[2], s2 = GOFF[9 + e2] + PRE[8 + e2] + (int)rt[3];
            TOKSLOT[s1] = m; GSLOT[s1] = g1; TOKSLOT[MAXSLOT + s2] = m; GSLOT[MAXSLOT + s2] = 1.0f - g1; }
    }
    SEAM(14);

#define MOE_SCHED(S, p) do { const int* mt = META + (p) * 16; S.g1 = mt[1]; S.g2 = mt[2]; S.g3 = mt[3]; S.g4 = mt[4]; S.g5 = mt[5]; S.g6 = mt[6]; S.g7 = mt[7]; } while (0)
#pragma unroll
    for (int p = 0; p < 2; ++p) {
        if (IN(15 + 2 * p)) {
            pg8::MoeSched S; MOE_SCHED(S, p); const int nP = META[p * 16 + 8] >> 8;
            S.init(nP, 2 * EXPD / 256, G, bx); S.A = (const char*)HB; S.a_tstep = 0; S.Bt = (const char*)W_MOE13; S.b_tstep = (size_t)256 * D * (MOE_UP8 ? 1 : 2); S.b_estride = (size_t)2 * EXPD * D * (MOE_UP8 ? 1 : 2);
            S.tokslot = TOKSLOT + p * MAXSLOT; S.rowbytes = D * (MOE_UP8 ? 1 : 2);
            pg8::EpiSwiGLU<MOE_DN8> E{ACTB, EXPD, MOE_UP8 ? 1.0f / (H8_SCALE * W8_SCALE) : 1.0f};
            pg8::gemm_phase<pg8::EpiSwiGLU<MOE_DN8>, pg8::MoeSched, true, true, MOE_UP8>(lds, D * (MOE_UP8 ? 1 : 2), S, E);
        }
        SEAM(15 + 2 * p);
        if (IN(16 + 2 * p)) {
            pg8::MoeSched S; MOE_SCHED(S, p); const int nP = META[p * 16 + 8] >> 8;
            constexpr int RBD = EXPD * (MOE_DN8 ? 1 : 2), NTD = RBD / 128;
            int nPm = nP, jpart = -1; const int qpart = bx & 7;
            { const int nwg = nP * 4, nfull = nwg / G, nrem = nwg - nfull * G; if (nrem > 0 && 8 * nrem <= G && (nfull * G) % 4 == 0 && NTD >= 16) { nPm = nfull * G / 4; if (bx < 8 * nrem) jpart = bx >> 3; } }
            S.init(nPm, 4, G, bx); S.A = (const char*)ACTB; S.a_tstep = (size_t)256 * RBD; S.Bt = (const char*)W_MOE2; S.b_tstep = (size_t)256 * RBD; S.b_estride = (size_t)D * RBD;
            S.tokslot = TOKSLOT + p * MAXSLOT; S.rowbytes = 0;
#define MOE_DOWN(FINAL_) do { pg8::EpiMoeDown<FINAL_> E{TOKSLOT + p * MAXSLOT, GSLOT + p * MAXSLOT, XB, out, MOD1 + 5 * 1024, MOE_DN8 ? 1.0f / (A8_SCALE * W8_SCALE) : 1.0f}; \
                if (nPm > 0) pg8::gemm_phase<pg8::EpiMoeDown<FINAL_>, pg8::MoeSched, true, false, MOE_DN8>(lds, RBD, S, E); \
                if (jpart >= 0) {       \
                    const int gsz = nP - nPm; pg8::Unit u; u.pm = nPm + jpart % gsz; u.pn = jpart / gsz; \
                    { pg8::MoeSchedTail T; MOE_SCHED(T, p); T.init(nP, 4, G, bx); T.A = S.A; T.a_tstep = S.a_tstep; T.Bt = S.Bt; T.b_tstep = S.b_tstep; T.b_estride = S.b_estride; T.tokslot = S.tokslot; T.rowbytes = 0; \
                      constexpr int P = NTD / 2, base = P / 8, extra = P % 8; T.pmT = u.pm; T.pnT = u.pn; T.k0T = 2 * (qpart * base + (qpart < extra ? qpart : extra)); T.nkT = 2 * (base + (qpart < extra ? 1 : 0)); \
                      pg8::EpiPartStore EP{KPART + (size_t)bx * (32 * 512 * 4)}; \
                      pg8::gemm_phase<pg8::EpiPartStore, pg8::MoeSchedTail, true, false, MOE_DN8, true>(lds, RBD, T, EP); } \
                    unsigned* kc = ctl + CW_KCNT + p * 64 + jpart; \
                    asm volatile("s_waitcnt vmcnt(0)" ::: "memory"); __syncthreads(); \
                    if (tid == 0) { __builtin_amdgcn_fence(__ATOMIC_RELEASE, "agent"); asm volatile("s_waitcnt vmcnt(0)" ::: "memory"); (void)xb_add(kc, 1u); \
                        XB_SPIN(xb_ld(kc) < 8u, ctl + CW_BAR); __builtin_amdgcn_fence(__ATOMIC_ACQUIRE, "agent"); asm volatile("s_waitcnt vmcnt(0)" ::: "memory"); } \
                    __syncthreads(); \
                    const int ai = qpart >> 2, m = qpart & 3; \
                    f32x4 v[2][2]; \
                    _Pragma("unroll") for (int bj = 0; bj < 2; ++bj) _Pragma("unroll") for (int n = 0; n < 2; ++n) { f32x4 a = (f32x4){0.f, 0.f, 0.f, 0.f}; \
                        const f32x4* pp = (const f32x4*)(KPART + (size_t)(jpart * 8) * (32 * 512 * 4)) + (size_t)((((ai * 2 + bj) * 4 + m) * 2 + n) * 512 + tid); \
                        _Pragma("unroll") for (int qq = 0; qq < 8; ++qq) a += pp[(size_t)qq * (32 * 512)]; \
                        v[bj][n] = a; } \
                    E.slice(v, u, ai, m, wave >> 2, wave & 3, lane & 15, lane >> 4); } } while (0)
            if (p == 0) MOE_DOWN(false); else MOE_DOWN(true);
#undef MOE_DOWN
        }
        if (p == 0) SEAM(16);
    }
#undef IN
#undef SEAM
}


constexpr int N_PHASES = 19;
extern "C" void kernel_launch(void* const* d_in, const int* in_sizes, int n_in, void* d_out, int out_size, void* d_ws, size_t ws_size, hipStream_t stream) {
    static int grid = 0;
    if (grid == 0) {
        if (n_in != 28 || in_sizes[0] != M * D || out_size != M * D || ws_size < WS_TOTAL) { fprintf(stderr, "kernel_launch: unexpected problem shape (n_in %d, out %d, ws %zu)\n", n_in, out_size, ws_size); grid = -1; return; }
        int dev = 0, cus = 0, per_cu = 0;
        if (hipGetDevice(&dev) != hipSuccess || hipDeviceGetAttribute(&cus, hipDeviceAttributeMultiprocessorCount, dev) != hipSuccess) { grid = -1; return; }
        if (hipFuncSetAttribute((const void*)mk_fwd, hipFuncAttributeMaxDynamicSharedMemorySize, LDS_BYTES) != hipSuccess) { fprintf(stderr, "kernel_launch: hipFuncSetAttribute failed\n"); grid = -1; return; }
        if (hipOccupancyMaxActiveBlocksPerMultiprocessor(&per_cu, (const void*)mk_fwd, NWAVES * 64, LDS_BYTES) != hipSuccess || per_cu < 1) { fprintf(stderr, "kernel_launch: occupancy query reports %d\n", per_cu); }
        (void)hipGetLastError();
        grid = cus;
        if (grid < 128) { fprintf(stderr, "kernel_launch: built for a >= 128-CU device (64 GLA scan workgroups + weight-copy workgroups); got %d\n", grid); grid = -1; return; }
    }
    if (grid < 0) return;
    if (hipMemsetAsync((char*)d_ws + WS_CTL, 0, CTL_ZERO_BYTES, stream) != hipSuccess) return;
    Args a{};
    const float** ap = (const float**)&a;
    for (int i = 0; i < 28; ++i) ap[i] = (const float*)d_in[i];
    a.out = (float*)d_out; a.ws = (unsigned char*)d_ws;
    if (MK_N_LAUNCHES == 1) { a.ph_lo = 0; a.ph_hi = N_PHASES; hipLaunchKernelGGL(mk_fwd, dim3(grid), dim3(NWAVES * 64), LDS_BYTES, stream, a); }
    else { for (int p = 0; p < N_PHASES; ++p) { a.ph_lo = p; a.ph_hi = p + 1; hipLaunchKernelGGL(mk_fwd, dim3(grid), dim3(NWAVES * 64), LDS_BYTES, stream, a); } }
}
```

```cpp
#include <hip/hip_runtime.h>
#include <cstdio>
#include <cstdint>

#ifndef PROBE_DUP
#define PROBE_DUP -1
#endif
#ifndef MK_N_LAUNCHES
#define MK_N_LAUNCHES 1
#endif

#define LAS __attribute__((address_space(3)))
#define GAS __attribute__((address_space(1)))
typedef unsigned short bf16;
typedef short bf16x8 __attribute__((ext_vector_type(8)));
typedef short s16x4 __attribute__((ext_vector_type(4)));
typedef float f32x4 __attribute__((ext_vector_type(4)));
typedef float f32x2 __attribute__((ext_vector_type(2)));
typedef float f32x16 __attribute__((ext_vector_type(16)));
typedef unsigned u32x4 __attribute__((ext_vector_type(4)));
typedef unsigned u32x2 __attribute__((ext_vector_type(2)));

constexpr int D = 1024, BATCH = 16, SEQ = 4096, M = BATCH * SEQ;
constexpr int FFN = 2816, NEXP = 8, EXPD = 3584;
constexpr int GLA_N = 3584;
constexpr float EPS = 1e-6f;
constexpr float LOG2E = 1.4426950408889634f;
constexpr int NWAVES = 8;
constexpr int MAXSLOT = M + NEXP * 256;

constexpr size_t MiB = 1u << 20;
constexpr size_t WS_CTL = 0, CTL_ZERO_BYTES = 64 * 1024;
constexpr size_t WS_MOD = 256 * 1024;
constexpr size_t WS_LCNT = 1 * MiB + 256 * 1024;
constexpr size_t WS_META = 1 * MiB + 512 * 1024;
constexpr size_t WS_ROUTE = 2 * MiB;
constexpr size_t WS_TOKSLOT = 4 * MiB;
constexpr size_t WS_GSLOT = 5 * MiB;
constexpr size_t WS_W_DAIN = 8 * MiB, WS_W_DAOUT = 14 * MiB, WS_W_FFN13 = 16 * MiB, WS_W_FFN2 = 27 * MiB;
constexpr size_t WS_W_GLAIN = 33 * MiB, WS_W_GLAOUT = 40 * MiB, WS_W_MOE13 = 42 * MiB, WS_W_MOE2 = 154 * MiB;
constexpr size_t WS_H = 210 * MiB;
constexpr size_t WS_Q = 338 * MiB;
constexpr size_t WS_END = WS_Q + 464 * MiB;
constexpr size_t WS_XB = WS_END;
constexpr size_t WS_TOTAL = WS_XB + (size_t)M * D * 2;
constexpr size_t GA_UNIT = 43008;
static_assert(4096 * GA_UNIT <= (size_t)M * D * 4, "the GLA per-chunk operands are parked in d_out (free until the last phase writes the result)");
static_assert(WS_TOKSLOT + 2 * MAXSLOT * 4 <= WS_GSLOT && WS_GSLOT + 2 * MAXSLOT * 4 <= WS_W_DAIN, "ws map");
static_assert(WS_W_FFN2 + (size_t)D * FFN * 2 <= WS_W_GLAIN && WS_W_GLAIN + (size_t)GLA_N * D * 2 <= WS_W_GLAOUT, "ws map");
static_assert(WS_W_MOE13 + (size_t)NEXP * 2 * EXPD * D * 2 <= WS_W_MOE2 && WS_W_MOE2 + (size_t)NEXP * D * EXPD * 2 <= WS_H, "ws map");
static_assert((size_t)MAXSLOT * EXPD * 2 <= 464 * MiB && (size_t)M * 3072 * 2 + (size_t)M * 512 * 2 <= 464 * MiB, "ws map");
constexpr int CW_BAR = 4096, CW_KCNT = 8192;

constexpr int RING_BYTES = 131072;
constexpr int TAB_OFF = RING_BYTES;
constexpr int MISC_OFF = 155648;
constexpr int LDS_BYTES = MISC_OFF + 1024;

__device__ __forceinline__ unsigned f2bf(float f) { unsigned u = __builtin_bit_cast(unsigned, f); return (u + 0x7fffu + ((u >> 16) & 1u)) >> 16; }
__device__ __forceinline__ unsigned pk2(float lo, float hi) { return f2bf(lo) | (f2bf(hi) << 16); }
__device__ __forceinline__ float bf2f(unsigned short b) { return __builtin_bit_cast(float, ((unsigned)b) << 16); }
__device__ __forceinline__ unsigned cvt_pk_bf16(float lo, float hi) { unsigned r; asm volatile("v_cvt_pk_bf16_f32 %0, %1, %2" : "=v"(r) : "v"(lo), "v"(hi)); return r; }
__device__ __forceinline__ float wave_sum(float v) {
#pragma unroll
    for (int o = 1; o < 64; o <<= 1) v += __shfl_xor(v, o);
    return v;
}
__device__ __forceinline__ float wave_max(float v) {
#pragma unroll
    for (int o = 1; o < 64; o <<= 1) v = fmaxf(v, __shfl_xor(v, o));
    return v;
}
typedef int v8i __attribute__((ext_vector_type(8)));
typedef int v4i __attribute__((ext_vector_type(4)));
constexpr bool FFN_UP8 = true, FFN_DN8 = true, MOE_UP8 = true, MOE_DN8 = true;
constexpr float W8_SCALE = 64.0f, H8_SCALE = 8.0f, A8_SCALE = 4.0f;
__device__ __forceinline__ float clamp448(float x) { return fminf(fmaxf(x, -448.0f), 448.0f); }
__device__ __forceinline__ unsigned pk_fp8x4(float a, float b, float c, float d) {
    unsigned w = 0u; w = __builtin_amdgcn_cvt_pk_fp8_f32(clamp448(a), clamp448(b), w, false); w = __builtin_amdgcn_cvt_pk_fp8_f32(clamp448(c), clamp448(d), w, true); return w; }
__device__ __forceinline__ f32x4 ld_bf16x4(const bf16* p) { const u32x2 w = *(const u32x2*)p; return (f32x4){__builtin_bit_cast(float, w[0] << 16), __builtin_bit_cast(float, w[0] & 0xffff0000u), __builtin_bit_cast(float, w[1] << 16), __builtin_bit_cast(float, w[1] & 0xffff0000u)}; }
__device__ __forceinline__ void st_bf16x4(bf16* p, f32x4 v) { *(u32x2*)p = (u32x2){cvt_pk_bf16(v[0], v[1]), cvt_pk_bf16(v[2], v[3])}; }
__device__ __forceinline__ float fast_silu(float a) { return a * __builtin_amdgcn_rcpf(1.0f + __builtin_amdgcn_exp2f(-a * LOG2E)); }

namespace pg8 {
constexpr int BM = 256, BK = 64, HALF = 128, HTB = HALF * BK * 2, STAGE_BYTES = 8 * HTB, NXCD = 8, WGM = 8;
__host__ __device__ __forceinline__ int lds_byte(int r, int c) { const int rr = r & 7, ch = (c >> 3) ^ rr; return (r >> 3) * 1024 + (rr * 8 + ch) * 16 + (c & 7) * 2; }
__host__ __device__ __forceinline__ void stage_rc(int b, int& R, int& C) { const int piece = b / 1024, slot = (b % 1024) / 16, rr = slot >> 3, ch = (slot & 7) ^ rr; R = piece * 8 + rr; C = ch * 8; }
__host__ __device__ __forceinline__ int perm32(int rho) { const int n = rho >> 4, i = rho & 15; return 8 * (i >> 2) + 4 * n + (i & 3); }

struct Unit { int pm, pn, k0, nk, part; };
struct TileOrder {
    int nM, nN, nwg, G, c;
    __device__ void init(int nM_, int nN_, int G_, int c_) { nM = nM_; nN = nN_; nwg = nM * nN; G = G_; c = c_; }
    __device__ bool next(int i, Unit& u) const { return at((long)i * G + c, u); }
    __device__ bool at(const long L, Unit& u) const {
        if (L >= nwg) return false;
        int wgid = (int)L; { const int q = nwg / NXCD, r = nwg % NXCD, xcd = wgid % NXCD, off = wgid / NXCD; wgid = (xcd < r ? xcd * (q + 1) : r * (q + 1) + (xcd - r) * q) + off; }
        const int nig = WGM * nN, gid = wgid / nig, fm = gid * WGM, gsz = (nM - fm) < WGM ? (nM - fm) : WGM;
        u.pm = fm + ((wgid % nig) % gsz); u.pn = (wgid % nig) / gsz; return true;
    }
};
struct DenseSched : TileOrder {
    const char* A; const char* Bt; size_t tstep;
    __device__ __forceinline__ const char* a_base(const Unit& u) const { return A + (size_t)u.pm * tstep; }
    __device__ __forceinline__ const char* b_base(const Unit& u) const { return Bt + (size_t)u.pn * tstep; }
    __device__ __forceinline__ unsigned row_off(const Unit&, int) const { return 0u; }
};
struct MoeSched : TileOrder {
    const char* A; const char* Bt; size_t a_tstep, b_tstep, b_estride; const int* tokslot; unsigned rowbytes; int g1, g2, g3, g4, g5, g6, g7;
    __device__ __forceinline__ int expert(int pm) const { const int r = pm * 256; return (r >= g1) + (r >= g2) + (r >= g3) + (r >= g4) + (r >= g5) + (r >= g6) + (r >= g7); }
    __device__ __forceinline__ const char* a_base(const Unit& u) const { return A + (size_t)u.pm * a_tstep; }
    __device__ __forceinline__ const char* b_base(const Unit& u) const { return Bt + (size_t)expert(u.pm) * b_estride + (size_t)u.pn * b_tstep; }
    __device__ __forceinline__ unsigned row_off(const Unit& u, int r) const { int t = tokslot[u.pm * 256 + r]; t = t < 0 ? 0 : t; return (unsigned)t * rowbytes; }
};
struct MoeSchedTail : MoeSched {
    int pmT, pnT, k0T, nkT;
    __device__ bool next(int i, Unit& u) const { if (i != 0) return false; u.pm = pmT; u.pn = pnT; u.k0 = k0T; u.nk = nkT; u.part = 1; return true; }
};

struct EpiQKV {
    static constexpr bool PERM = true;
    bf16* Q; size_t tstride; const float* qg; const float* kg; float qscale;
    __device__ __forceinline__ void operator()(const f32x4 (&acc)[2][2][4][2], const Unit& u, int wr, int wc, int fr, int fq) const {
        const int t = u.pn >> 2;
        bf16* base = Q + (size_t)t * tstride;
        const int lc0 = 256 * (u.pn & 3) + 64 * wc + 8 * fq;
        const int row0 = u.pm * BM + wr * 64 + fr;
        if (t < 2) {
            const float* g = qg; if (t == 1) g = kg;
            g += 64 * (wc & 1) + 8 * fq;
            f32x4 gv[2][2];
#pragma unroll
            for (int bj = 0; bj < 2; ++bj)
#pragma unroll
                for (int n = 0; n < 2; ++n) gv[bj][n] = *(const f32x4*)(g + 32 * bj + 4 * n);
            float sc = 1.0f; if (t == 0) sc = qscale;
#pragma unroll
            for (int ai = 0; ai < 2; ++ai)
#pragma unroll
                for (int m = 0; m < 4; ++m) {
                    float ss = 0.f;
#pragma unroll
                    for (int bj = 0; bj < 2; ++bj)
#pragma unroll
                        for (int n = 0; n < 2; ++n) { const f32x4 x = acc[ai][bj][m][n]; ss += (x[0] * x[0] + x[1] * x[1]) + (x[2] * x[2] + x[3] * x[3]); }
                    ss += __shfl_xor(ss, 16); ss += __shfl_xor(ss, 32);
                    const float rs = __builtin_amdgcn_rsqf(ss * (1.0f / 64.0f) + EPS) * sc;
                    const int R = row0 + ai * HALF + m * 16;
                    bf16* rowp = base + (size_t)R * D + lc0;
#pragma unroll
                    for (int bj = 0; bj < 2; ++bj) { const f32x4 v0 = acc[ai][bj][m][0] * rs * gv[bj][0], v1 = acc[ai][bj][m][1] * rs * gv[bj][1];
                        u32x4 w; w.x = cvt_pk_bf16(v0[0], v0[1]); w.y = cvt_pk_bf16(v0[2], v0[3]); w.z = cvt_pk_bf16(v1[0], v1[1]); w.w = cvt_pk_bf16(v1[2], v1[3]);
                        if (t == 1) {
                            const int col = lc0 + 32 * bj, hh_ = col >> 7, cg = (col & 127) >> 3, b_ = R >> 12, s_ = R & 4095;
                            *(u32x4*)(base + ((((size_t)(b_ * 8 + hh_) * 64 + (s_ >> 6)) * 16 + cg) * 64 + (s_ & 63)) * 8) = w; }
                        else *(u32x4*)(rowp + 32 * bj) = w; }
                }
        } else {
#pragma unroll
            for (int ai = 0; ai < 2; ++ai)
#pragma unroll
                for (int m = 0; m < 4; ++m) { const int R = row0 + ai * HALF + m * 16, b_ = R >> 12, s_ = R & 4095;
#pragma unroll
                    for (int bj = 0; bj < 2; ++bj) { const f32x4 v0 = acc[ai][bj][m][0], v1 = acc[ai][bj][m][1];
                        u32x4 w; w.x = cvt_pk_bf16(v0[0], v0[1]); w.y = cvt_pk_bf16(v0[2], v0[3]); w.z = cvt_pk_bf16(v1[0], v1[1]); w.w = cvt_pk_bf16(v1[2], v1[3]);
                        const int col = lc0 + 32 * bj, hh_ = col >> 7, c_ = col & 127, p_ = (c_ >> 5) * 4 + ((s_ & 63) >> 4), li = ((s_ & 15) << 2) + ((c_ & 31) >> 3);
                        *(u32x4*)(base + ((((size_t)(b_ * 8 + hh_) * 64 + (s_ >> 6)) * 16 + p_) * 64 + li) * 8) = w; } }
        }
    }
};
template <bool BASE16, bool OUT16> struct EpiResid {
    static constexpr bool PERM = true;
    const void* base; void* out; const float* gate; float descale;
    __device__ __forceinline__ void operator()(const f32x4 (&acc)[2][2][4][2], const Unit& u, int wr, int wc, int fr, int fq) const {
        const int row0 = u.pm * BM + wr * 64 + fr, col0 = u.pn * BM + wc * 32 + 8 * fq, b = u.pm >> 4;
        f32x4 gv[2][2];
#pragma unroll
        for (int bj = 0; bj < 2; ++bj)
#pragma unroll
            for (int n = 0; n < 2; ++n) gv[bj][n] = *(const f32x4*)(gate + (size_t)b * 6144 + col0 + bj * HALF + 4 * n) * descale;
#pragma unroll
        for (int ai = 0; ai < 2; ++ai) {
            f32x4 bs[4][2][2];
#pragma unroll
            for (int m = 0; m < 4; ++m) { const size_t off = (size_t)(row0 + ai * HALF + m * 16) * D + col0;
#pragma unroll
                for (int bj = 0; bj < 2; ++bj) { const size_t o = off + bj * HALF;
                    if constexpr (BASE16) { const u32x4 w = *(const u32x4*)((const bf16*)base + o);
                        bs[m][bj][0] = (f32x4){__builtin_bit_cast(float, w[0] << 16), __builtin_bit_cast(float, w[0] & 0xffff0000u), __builtin_bit_cast(float, w[1] << 16), __builtin_bit_cast(float, w[1] & 0xffff0000u)};
                        bs[m][bj][1] = (f32x4){__builtin_bit_cast(float, w[2] << 16), __builtin_bit_cast(float, w[2] & 0xffff0000u), __builtin_bit_cast(float, w[3] << 16), __builtin_bit_cast(float, w[3] & 0xffff0000u)}; }
                    else { bs[m][bj][0] = *(const f32x4*)((const float*)base + o); bs[m][bj][1] = *(const f32x4*)((const float*)base + o + 4); } } }
#pragma unroll
            for (int m = 0; m < 4; ++m) { const size_t off = (size_t)(row0 + ai * HALF + m * 16) * D + col0;
#pragma unroll
                for (int bj = 0; bj < 2; ++bj) { const size_t o = off + bj * HALF;
                    const f32x4 r0 = bs[m][bj][0] + gv[bj][0] * acc[ai][bj][m][0], r1 = bs[m][bj][1] + gv[bj][1] * acc[ai][bj][m][1];
                    if constexpr (OUT16) *(u32x4*)((bf16*)out + o) = (u32x4){cvt_pk_bf16(r0[0], r0[1]), cvt_pk_bf16(r0[2], r0[3]), cvt_pk_bf16(r1[0], r1[1]), cvt_pk_bf16(r1[2], r1[3])};
                    else { *(f32x4*)((float*)out + o) = r0; *(f32x4*)((float*)out + o + 4) = r1; } } }
            asm volatile("" ::: "memory"); }
    }
};
template <bool OUT8> struct EpiSwiGLU {
    static constexpr bool PERM = true;
    void* O; int ldo; float descale;
    __device__ __forceinline__ void operator()(const f32x4 (&acc)[2][2][4][2], const Unit& u, int wr, int wc, int fr, int fq) const {
        const int row0 = u.pm * BM + wr * 64 + fr, col0 = u.pn * HALF + wc * 32 + 8 * fq;
#pragma unroll
        for (int ai = 0; ai < 2; ++ai)
#pragma unroll
            for (int m = 0; m < 4; ++m) { const unsigned eo = (unsigned)(row0 + ai * HALF + m * 16) * (unsigned)ldo + (unsigned)col0;
                f32x4 v0, v1;
#pragma unroll
                for (int i = 0; i < 4; ++i) { v0[i] = fast_silu(acc[ai][0][m][0][i] * descale) * (acc[ai][1][m][0][i] * descale); v1[i] = fast_silu(acc[ai][0][m][1][i] * descale) * (acc[ai][1][m][1][i] * descale); }
                if constexpr (OUT8) { v0 = v0 * A8_SCALE; v1 = v1 * A8_SCALE; *(u32x2*)((unsigned char*)O + eo) = (u32x2){pk_fp8x4(v0[0], v0[1], v0[2], v0[3]), pk_fp8x4(v1[0], v1[1], v1[2], v1[3])}; }
                else { u32x4 w; w.x = cvt_pk_bf16(v0[0], v0[1]); w.y = cvt_pk_bf16(v0[2], v0[3]); w.z = cvt_pk_bf16(v1[0], v1[1]); w.w = cvt_pk_bf16(v1[2], v1[3]); *(u32x4*)((bf16*)O + eo) = w; } }
    }
};
struct EpiGLA {
    static constexpr bool PERM = true;
    bf16* P; bf16* LA; const float* ba; const float* og;
    __device__ __forceinline__ void operator()(const f32x4 (&acc)[2][2][4][2], const Unit& u, int wr, int wc, int fr, int fq) const {
        const int row0 = u.pm * BM + wr * 64 + fr;
        if (u.pn < 12) {
            const int col0 = u.pn * BM + wc * 32 + 8 * fq; const bool isr = u.pn >= 8;
            f32x4 gv[2][2];
#pragma unroll
            for (int bj = 0; bj < 2; ++bj)
#pragma unroll
                for (int n = 0; n < 2; ++n) gv[bj][n] = isr ? *(const f32x4*)(og + wc * 32 + 8 * fq + bj * HALF + 4 * n) : (f32x4){1.f, 1.f, 1.f, 1.f};
#pragma unroll
            for (int ai = 0; ai < 2; ++ai)
#pragma unroll
                for (int m = 0; m < 4; ++m) { bf16* rowp = P + (size_t)(row0 + ai * HALF + m * 16) * 3072 + col0;
#pragma unroll
                    for (int bj = 0; bj < 2; ++bj) { f32x4 v0 = acc[ai][bj][m][0], v1 = acc[ai][bj][m][1];
                        if (isr) {
#pragma unroll
                            for (int i = 0; i < 4; ++i) { v0[i] = gv[bj][0][i] * fast_silu(v0[i]); v1[i] = gv[bj][1][i] * fast_silu(v1[i]); } }
                        u32x4 w; w.x = cvt_pk_bf16(v0[0], v0[1]); w.y = cvt_pk_bf16(v0[2], v0[3]); w.z = cvt_pk_bf16(v1[0], v1[1]); w.w = cvt_pk_bf16(v1[2], v1[3]);
                        *(u32x4*)(rowp + bj * HALF) = w; } }
        } else {
            const int col0 = (u.pn - 12) * BM + wc * 32 + 8 * fq;
            f32x4 bv[2][2];
#pragma unroll
            for (int bj = 0; bj < 2; ++bj)
#pragma unroll
                for (int n = 0; n < 2; ++n) bv[bj][n] = *(const f32x4*)(ba + col0 + bj * HALF + 4 * n);
#pragma unroll
            for (int ai = 0; ai < 2; ++ai)
#pragma unroll
                for (int m = 0; m < 4; ++m) { bf16* rowp = LA + (size_t)(row0 + ai * HALF + m * 16) * 512 + col0;
#pragma unroll
                    for (int bj = 0; bj < 2; ++bj) { f32x4 v[2];
#pragma unroll
                        for (int n = 0; n < 2; ++n)
#pragma unroll
                            for (int i = 0; i < 4; ++i) { const float z = acc[ai][bj][m][n][i] + bv[bj][n][i];
                                v[n][i] = (fminf(z, 0.f) - __logf(1.0f + __expf(-fabsf(z)))) * (1.0f / 16.0f); }
                        u32x4 w; w.x = cvt_pk_bf16(v[0][0], v[0][1]); w.y = cvt_pk_bf16(v[0][2], v[0][3]); w.z = cvt_pk_bf16(v[1][0], v[1][1]); w.w = cvt_pk_bf16(v[1][2], v[1][3]);
                        *(u32x4*)(rowp + bj * HALF) = w; } }
        }
    }
};
template <bool FINAL> struct EpiMoeDown {
    static constexpr bool PERM = true;
    const int* tokslot; const float* gslot; bf16* xb; float* outf; const float* gate; float descale;
    __device__ __forceinline__ void row(const f32x4 (&v)[2][2], int srow, int col0) const {
        const int tok = tokslot[srow];
        if (tok >= 0) { const float g = gslot[srow] * descale; const float* gp = gate + (size_t)(tok >> 12) * 6144 + col0; const size_t ro = (size_t)tok * D + col0;
#pragma unroll
            for (int bj = 0; bj < 2; ++bj) { const f32x4 g0 = *(const f32x4*)(gp + bj * HALF), g1 = *(const f32x4*)(gp + bj * HALF + 4); const u32x4 w = *(const u32x4*)(xb + ro + bj * HALF);
                const f32x4 b0 = (f32x4){__builtin_bit_cast(float, w[0] << 16), __builtin_bit_cast(float, w[0] & 0xffff0000u), __builtin_bit_cast(float, w[1] << 16), __builtin_bit_cast(float, w[1] & 0xffff0000u)};
                const f32x4 b1 = (f32x4){__builtin_bit_cast(float, w[2] << 16), __builtin_bit_cast(float, w[2] & 0xffff0000u), __builtin_bit_cast(float, w[3] << 16), __builtin_bit_cast(float, w[3] & 0xffff0000u)};
                const f32x4 r0 = b0 + g0 * g * v[bj][0], r1 = b1 + g1 * g * v[bj][1];
                if constexpr (FINAL) { *(f32x4*)(outf + ro + bj * HALF) = r0; *(f32x4*)(outf + ro + bj * HALF + 4) = r1; }
                else *(u32x4*)(xb + ro + bj * HALF) = (u32x4){cvt_pk_bf16(r0[0], r0[1]), cvt_pk_bf16(r0[2], r0[3]), cvt_pk_bf16(r1[0], r1[1]), cvt_pk_bf16(r1[2], r1[3])}; } }
    }
    __device__ __forceinline__ void operator()(const f32x4 (&acc)[2][2][4][2], const Unit& u, int wr, int wc, int fr, int fq) const {
        const int srow0 = u.pm * BM + wr * 64 + fr, col0 = u.pn * BM + wc * 32 + 8 * fq;
        int tok[8]; float gsl[8];
#pragma unroll
        for (int i = 0; i < 8; ++i) { const int srow = srow0 + (i >> 2) * HALF + (i & 3) * 16; tok[i] = tokslot[srow]; gsl[i] = gslot[srow] * descale; }
#pragma unroll
        for (int i0 = 0; i0 < 8; i0 += 2) {
            u32x4 w[2][2]; f32x4 gt[2][2][2];
#pragma unroll
            for (int q = 0; q < 2; ++q) { const int t = tok[i0 + q] < 0 ? 0 : tok[i0 + q]; const float* gp = gate + (size_t)(t >> 12) * 6144 + col0; const size_t ro = (size_t)t * D + col0;
#pragma unroll
                for (int bj = 0; bj < 2; ++bj) { w[q][bj] = *(const u32x4*)(xb + ro + bj * HALF); gt[q][bj][0] = *(const f32x4*)(gp + bj * HALF); gt[q][bj][1] = *(const f32x4*)(gp + bj * HALF + 4); } }
#pragma unroll
            for (int q = 0; q < 2; ++q) { const int i = i0 + q, ai = i >> 2, m = i & 3;
                if (tok[i] >= 0) { const float g = gsl[i]; const size_t ro = (size_t)tok[i] * D + col0;
#pragma unroll
                    for (int bj = 0; bj < 2; ++bj) { const u32x4 ww = w[q][bj];
                        const f32x4 b0 = (f32x4){__builtin_bit_cast(float, ww[0] << 16), __builtin_bit_cast(float, ww[0] & 0xffff0000u), __builtin_bit_cast(float, ww[1] << 16), __builtin_bit_cast(float, ww[1] & 0xffff0000u)};
                        const f32x4 b1 = (f32x4){__builtin_bit_cast(float, ww[2] << 16), __builtin_bit_cast(float, ww[2] & 0xffff0000u), __builtin_bit_cast(float, ww[3] << 16), __builtin_bit_cast(float, ww[3] & 0xffff0000u)};
                        const f32x4 r0 = b0 + gt[q][bj][0] * g * acc[ai][bj][m][0], r1 = b1 + gt[q][bj][1] * g * acc[ai][bj][m][1];
                        if constexpr (FINAL) { *(f32x4*)(outf + ro + bj * HALF) = r0; *(f32x4*)(outf + ro + bj * HALF + 4) = r1; }
                        else *(u32x4*)(xb + ro + bj * HALF) = (u32x4){cvt_pk_bf16(r0[0], r0[1]), cvt_pk_bf16(r0[2], r0[3]), cvt_pk_bf16(r1[0], r1[1]), cvt_pk_bf16(r1[2], r1[3])}; } } }
            asm volatile("" ::: "memory"); }
    }
    __device__ __forceinline__ void slice(const f32x4 (&v)[2][2], const Unit& u, int ai, int m, int wr, int wc, int fr, int fq) const {
        row(v, u.pm * BM + wr * 64 + fr + ai * HALF + m * 16, u.pn * BM + wc * 32 + 8 * fq);
    }
};
struct EpiPartStore {
    static constexpr bool PERM = true;
    float* part;
    __device__ __forceinline__ void operator()(const f32x4 (&acc)[2][2][4][2], const Unit&, int wr, int wc, int fr, int fq) const {
        f32x4* p = (f32x4*)part + ((wr * 4 + wc) * 64 + fq * 16 + fr);
#pragma unroll
        for (int ai = 0; ai < 2; ++ai)
#pragma unroll
            for (int bj = 0; bj < 2; ++bj)
#pragma unroll
                for (int m = 0; m < 4; ++m)
#pragma unroll
                    for (int n = 0; n < 2; ++n) { *p = acc[ai][bj][m][n]; p += 512; asm volatile("" : "+v"(p)); }
    }
};

template <class Epi, class Sched, bool ALIGN_EPI, bool GATHER, bool FP8 = false, bool KSPLIT = false>
__device__ __forceinline__ void gemm_phase(LAS unsigned char* lds, const int RB, const Sched& S, const Epi& E) {
    const int tid = threadIdx.x, wid = __builtin_amdgcn_readfirstlane(tid >> 6), lane = tid & 63, wr = wid >> 2, wc = wid & 3, fr = lane & 15, fq = lane >> 4;
    const int nt = RB / 128;
    unsigned voffB0, voffA0;
    const size_t kstep = (size_t)(BK * 2);
    const size_t hstep = (size_t)HALF * RB;
    const size_t qstep = (size_t)64 * RB;
    { int R, C; stage_rc(tid * 16, R, C); const int Rb = Epi::PERM ? ((R & ~31) + perm32(R & 31)) : R;
        voffB0 = (unsigned)(Rb * RB + C * 2); voffA0 = (unsigned)(R * RB + C * 2); }
    LAS unsigned* mytab = (LAS unsigned*)(lds + STAGE_BYTES) + tid;
#define PG8_TABFILL(par, U) do { _Pragma("unroll") for (int _h = 0; _h < 2; ++_h) _Pragma("unroll") for (int _i = 0; _i < 2; ++_i) { int _R, _C; stage_rc(tid * 16 + _i * 8192, _R, _C); \
        mytab[((par) * 4 + _h * 2 + _i) * 512] = S.row_off(U, _h * HALF + _R) + (unsigned)_C * 2u; } } while (0)
    const unsigned ldsw = (unsigned)wid * 1024u;
    const int aoff = lds_byte(wr * 64 + fr, fq * 8), boff = lds_byte(wc * 32 + fr, fq * 8), aoff1 = aoff ^ 64, boff1 = boff ^ 64;
#define PG8_SA(b, h) (((b) * 2 + (h)) * HTB)
#define PG8_SB(b, h) ((4 + (b) * 2 + (h)) * HTB)
#define PG8_STAGE_B(bufoff, gbase) do { _Pragma("unroll") for (int _i = 0; _i < 2; ++_i) \
        __builtin_amdgcn_global_load_lds((const unsigned*)((const char*)(gbase) + _i * qstep + voffB0), (LAS unsigned*)(lds + (bufoff) + ldsw + _i * 8192), 16, 0, 0); } while (0)
#define PG8_STAGE_A(bufoff, gbase, va, h) do { _Pragma("unroll") for (int _i = 0; _i < 2; ++_i) \
        __builtin_amdgcn_global_load_lds((const unsigned*)((const char*)(gbase) + (GATHER ? (size_t)0 : (size_t)(h) * hstep + _i * qstep) + (GATHER ? (va)[h][_i] : voffA0)), (LAS unsigned*)(lds + (bufoff) + ldsw + _i * 8192), 16, 0, 0); } while (0)
#define PG8_LDA(dst, b, h) do { _Pragma("unroll") for (int m = 0; m < 4; ++m) { if constexpr (FP8) dst##8[m] = __builtin_shufflevector(*(const LAS v4i*)(lds + PG8_SA(b, h) + aoff + m * 2048), *(const LAS v4i*)(lds + PG8_SA(b, h) + aoff1 + m * 2048), 0, 1, 2, 3, 4, 5, 6, 7); \
        else { dst[m][0] = *(const LAS bf16x8*)(lds + PG8_SA(b, h) + aoff + m * 2048); dst[m][1] = *(const LAS bf16x8*)(lds + PG8_SA(b, h) + aoff1 + m * 2048); } } } while (0)
#define PG8_LDB(dst, b, h) do { _Pragma("unroll") for (int n = 0; n < 2; ++n) { if constexpr (FP8) dst##8[n] = __builtin_shufflevector(*(const LAS v4i*)(lds + PG8_SB(b, h) + boff + n * 2048), *(const LAS v4i*)(lds + PG8_SB(b, h) + boff1 + n * 2048), 0, 1, 2, 3, 4, 5, 6, 7); \
        else { dst[n][0] = *(const LAS bf16x8*)(lds + PG8_SB(b, h) + boff + n * 2048); dst[n][1] = *(const LAS bf16x8*)(lds + PG8_SB(b, h) + boff1 + n * 2048); } } } while (0)
#define PG8_CAT(x0, x1) __builtin_shufflevector(__builtin_bit_cast(v4i, x0), __builtin_bit_cast(v4i, x1), 0, 1, 2, 3, 4, 5, 6, 7)
#define PG8_MMA(ai, bj, At, Bt) do { __builtin_amdgcn_s_setprio(1); _Pragma("unroll") for (int m = 0; m < 4; ++m) _Pragma("unroll") for (int n = 0; n < 2; ++n) { \
        if constexpr (FP8) asm volatile("v_mfma_scale_f32_16x16x128_f8f6f4 %0, %1, %2, %0, %3, %3 op_sel_hi:[0,0,0]" : "+v"(acc[ai][bj][m][n]) : "v"(Bt##8[n]), "v"(At##8[m]), "v"(sc8));   \
        else { _Pragma("unroll") for (int k = 0; k < 2; ++k) acc[ai][bj][m][n] = __builtin_amdgcn_mfma_f32_16x16x32_bf16(Bt[n][k], At[m][k], acc[ai][bj][m][n], 0, 0, 0); } } \
        __builtin_amdgcn_s_setprio(0); } while (0)
#define PG8_WAIT_V(n) asm volatile("s_waitcnt vmcnt(" #n ")" ::: "memory")
#define PG8_WAIT_L(n) asm volatile("s_waitcnt lgkmcnt(" #n ")" ::: "memory")
#define PG8_BAR __builtin_amdgcn_s_barrier()
#define PG8_SCHED __builtin_amdgcn_sched_barrier(0)
    Unit cur, nxt; int ui = 0;
    if (!S.next(0, cur)) return;
    f32x4 acc[2][2][4][2];
#pragma unroll
    for (int a = 0; a < 2; ++a)
#pragma unroll
        for (int b = 0; b < 2; ++b)
#pragma unroll
            for (int m = 0; m < 4; ++m)
#pragma unroll
                for (int n = 0; n < 2; ++n) acc[a][b][m][n] = (f32x4){0.f, 0.f, 0.f, 0.f};
    const int sc8 = 0x7f7f7f7f;
    bf16x8 At[4][2], B0[2][2], B1[2][2]; v8i At8[4], B08[2], B18[2];
    const char* cA = S.a_base(cur); const char* cB = S.b_base(cur);
    if constexpr (KSPLIT) { cA += (size_t)cur.k0 * kstep; cB += (size_t)cur.k0 * kstep; }
    unsigned cvA[2][2] = {{0u, 0u}, {0u, 0u}};
    if constexpr (GATHER) {
        PG8_TABFILL(0, cur);
#pragma unroll
        for (int h = 0; h < 2; ++h)
#pragma unroll
            for (int i = 0; i < 2; ++i) cvA[h][i] = mytab[(h * 2 + i) * 512];
    }
    PG8_STAGE_B(PG8_SB(0, 0), cB); PG8_STAGE_B(PG8_SB(0, 1), cB + hstep); PG8_STAGE_A(PG8_SA(0, 0), cA, cvA, 0); PG8_STAGE_A(PG8_SA(0, 1), cA, cvA, 1);
    if (wr == 1) PG8_BAR;
    PG8_WAIT_V(2); PG8_BAR;
    PG8_STAGE_B(PG8_SB(1, 0), cB + kstep); PG8_STAGE_A(PG8_SA(1, 0), cA + kstep, cvA, 0); PG8_STAGE_B(PG8_SB(1, 1), cB + hstep + kstep);
    PG8_WAIT_V(6); PG8_BAR;
    for (;;) {
        const bool has_next = S.next(ui + 1, nxt);
        const char* nA = has_next ? S.a_base(nxt) : cA; const char* nB = has_next ? S.b_base(nxt) : cB;
        if constexpr (KSPLIT) { if (has_next) { nA += (size_t)nxt.k0 * kstep; nB += (size_t)nxt.k0 * kstep; } }
        if constexpr (GATHER) { if (has_next) PG8_TABFILL((ui + 1) & 1, nxt); }
        const int ntc = KSPLIT ? cur.nk : nt;
#pragma unroll 1
        for (int t = 0; t < ntc; t += 2) {
            const bool last = (t == ntc - 2);
            const char* a1 = cA + (size_t)(t + 1) * kstep;
            const char* a2 = last ? nA : cA + (size_t)(t + 2) * kstep; const char* b2 = last ? nB : cB + (size_t)(t + 2) * kstep;
            const char* a3 = a2 + kstep; const char* b3 = b2 + kstep;
            unsigned wA[2][2] = {{0u, 0u}, {0u, 0u}};
            if constexpr (GATHER) {
                const int pc = ui & 1, pw = (last && has_next) ? (pc ^ 1) : pc;
#pragma unroll
                for (int i = 0; i < 2; ++i) { cvA[1][i] = mytab[(pc * 4 + 2 + i) * 512]; wA[0][i] = mytab[(pw * 4 + i) * 512]; wA[1][i] = mytab[(pw * 4 + 2 + i) * 512]; }
            }
            PG8_LDB(B0, 0, 0); PG8_LDB(B1, 0, 1); PG8_SCHED; PG8_LDA(At, 0, 0); PG8_STAGE_A(PG8_SA(1, 1), a1, cvA, 1);
            PG8_WAIT_V(8); PG8_WAIT_L(0); PG8_BAR; PG8_MMA(0, 0, At, B0); PG8_MMA(0, 1, At, B1); PG8_BAR; PG8_SCHED;
            PG8_LDA(At, 0, 1); PG8_STAGE_B(PG8_SB(0, 0), b2); PG8_STAGE_B(PG8_SB(0, 1), b2 + hstep); PG8_STAGE_A(PG8_SA(0, 0), a2, wA, 0);
            PG8_WAIT_V(8); PG8_WAIT_L(0); PG8_BAR; PG8_MMA(1, 0, At, B0); PG8_MMA(1, 1, At, B1); PG8_BAR; PG8_SCHED;
            PG8_LDB(B0, 1, 0); PG8_LDB(B1, 1, 1); PG8_SCHED; PG8_LDA(At, 1, 0); PG8_STAGE_A(PG8_SA(0, 1), a2, wA, 1);
            PG8_WAIT_V(8); PG8_WAIT_L(0); PG8_BAR; PG8_MMA(0, 0, At, B0); PG8_MMA(0, 1, At, B1); PG8_BAR; PG8_SCHED;
            PG8_LDA(At, 1, 1); PG8_STAGE_B(PG8_SB(1, 0), b3); PG8_STAGE_B(PG8_SB(1, 1), b3 + hstep); PG8_STAGE_A(PG8_SA(1, 0), a3, wA, 0);
            PG8_WAIT_V(8); PG8_WAIT_L(0); PG8_BAR; PG8_MMA(1, 0, At, B0); PG8_MMA(1, 1, At, B1); PG8_BAR; PG8_SCHED;
        }
        if constexpr (ALIGN_EPI) { if (wr == 0) PG8_BAR; }
        if constexpr (FP8) asm volatile("s_nop 15\n\ts_nop 15" ::: "memory");
        { int el; asm volatile("v_mbcnt_lo_u32_b32 %0, -1, 0\n\tv_mbcnt_hi_u32_b32 %0, -1, %0" : "=v"(el));
          E(acc, cur, wr, wc, el & 15, el >> 4); }
        if (!has_next) break;
#pragma unroll
        for (int a = 0; a < 2; ++a)
#pragma unroll
            for (int b = 0; b < 2; ++b)
#pragma unroll
                for (int m = 0; m < 4; ++m)
#pragma unroll
                    for (int n = 0; n < 2; ++n) acc[a][b][m][n] = (f32x4){0.f, 0.f, 0.f, 0.f};
        cur = nxt; cA = nA; cB = nB; ++ui;
        if constexpr (ALIGN_EPI) { if (wr == 1) PG8_BAR; }
    }
    PG8_WAIT_V(0);
    if constexpr (!ALIGN_EPI) { if (wr == 0) PG8_BAR; }
    PG8_BAR;
#undef PG8_SA
#undef PG8_SB
#undef PG8_STAGE_A
#undef PG8_TABFILL
#undef PG8_STAGE_B
#undef PG8_LDA
#undef PG8_LDB
#undef PG8_MMA
#undef PG8_CAT
#undef PG8_WAIT_V
#undef PG8_WAIT_L
#undef PG8_BAR
#undef PG8_SCHED
}
}

#define XB_TMO      128
#define XB_XCNT(j)  (256  + 64 * (j))
#define XB_XSUB(j)  (1280 + 64 * (j))
#define XB_XGEN(j)  (2304 + 64 * (j))
#define XB_TOP      3328
#define XB_TOPGEN   3392
#define XCD_BAR_WORDS 3456
#define XB_SPIN_CAP (1u << 18)
__device__ __forceinline__ unsigned xb_ld(unsigned* p)              { return __hip_atomic_load(p, __ATOMIC_RELAXED, __HIP_MEMORY_SCOPE_AGENT); }
__device__ __forceinline__ unsigned xb_add(unsigned* p, unsigned v) { return __hip_atomic_fetch_add(p, v, __ATOMIC_RELAXED, __HIP_MEMORY_SCOPE_AGENT); }
__device__ __forceinline__ unsigned xb_xcc_id() { return (unsigned)__builtin_amdgcn_s_getreg((3 << 11) | 20) & 0xFu; }
#define XB_SPIN(cond, bar) do { unsigned _sp = 0; while (cond) { __builtin_amdgcn_s_sleep(1); \
    if ((++_sp & 255u) == 0u) { if (xb_ld(&(bar)[XB_TMO])) break; if (_sp > XB_SPIN_CAP) { atomicAdd(&(bar)[XB_TMO], 1u); break; } } } } while (0)
struct XcdBarrier { unsigned* bar; unsigned x; volatile LAS unsigned* st; };
__device__ __forceinline__ XcdBarrier xcd_barrier_post(unsigned* bar, volatile LAS unsigned* st) {
    XcdBarrier b; b.bar = bar; b.x = xb_xcc_id(); b.st = st;
    if (threadIdx.x == 0) (void)xb_add(&bar[XB_XCNT(b.x)], 1u);
    return b;
}
__device__ __forceinline__ void xcd_barrier_complete(unsigned* bar, unsigned x, unsigned& nloc, unsigned& nx) {
    const unsigned G = gridDim.x * gridDim.y * gridDim.z;
    unsigned sum, cnt, mine, sp = 0u;
    for (;;) {
        sum = 0u; cnt = 0u; mine = 0u;
#pragma unroll
        for (unsigned j = 0; j < 16; ++j) { const unsigned c = xb_ld(&bar[XB_XCNT(j)]); sum += c; cnt += (c > 0u) ? 1u : 0u; mine = (j == x) ? c : mine; }
        if (sum == G) break;
        __builtin_amdgcn_s_sleep(1);
        if ((++sp & 255u) == 0u) { if (xb_ld(&bar[XB_TMO])) break; if (sp > XB_SPIN_CAP) { atomicAdd(&bar[XB_TMO], 1u); break; } }
    }
    nloc = mine > 0u ? mine : 1u; nx = cnt > 0u ? cnt : 1u;
}
__device__ __forceinline__ void xcd_barrier(const XcdBarrier& b) {
    asm volatile("s_waitcnt vmcnt(0)" ::: "memory");
    __syncthreads();
    if (threadIdx.x == 0) {
        unsigned* bar = b.bar;
        __builtin_amdgcn_s_waitcnt(0);
        unsigned nloc = b.st[0], nx = b.st[1];
        if (nloc == 0u) { xcd_barrier_complete(bar, b.x, nloc, nx); b.st[0] = nloc; b.st[1] = nx; }
        const unsigned old = xb_add(&bar[XB_XSUB(b.x)], 1u);
        const unsigned gen = old / nloc;
        if (old + 1u == (gen + 1u) * nloc) {
            __builtin_amdgcn_fence(__ATOMIC_RELEASE, "agent");
            asm volatile("s_waitcnt vmcnt(0)" ::: "memory");
            const unsigned og = xb_add(&bar[XB_TOP], 1u);
            const unsigned tg = og / nx;
            if (og + 1u == (tg + 1u) * nx) xb_add(&bar[XB_TOPGEN], 1u);
            else XB_SPIN(xb_ld(&bar[XB_TOPGEN]) == tg, bar);
            __builtin_amdgcn_fence(__ATOMIC_ACQUIRE, "agent");
            xb_add(&bar[XB_XGEN(b.x)], 1u);
            asm volatile("s_waitcnt vmcnt(0)" ::: "memory");
        } else {
            XB_SPIN(xb_ld(&bar[XB_XGEN(b.x)]) == gen, bar);
            __builtin_amdgcn_fence(__ATOMIC_ACQUIRE, "agent");
            asm volatile("s_waitcnt vmcnt(0)" ::: "memory");
        }
    }
    __syncthreads();
}

struct Args {
    const float* x; const float* c; const float* ada_w; const float* ada_b; const float* norm1_g; const float* norm2_g;
    const float* da_w_in; const float* da_q_gain; const float* da_k_gain; const float* da_lam_q1; const float* da_lam_k1; const float* da_lam_q2; const float* da_lam_k2;
    const float* da_subln_g; const float* da_w_out;
    const float* gla_w_in; const float* gla_w_a1; const float* gla_w_a2; const float* gla_b_a; const float* gla_out_g; const float* gla_w_out;
    const float* ffn_w1; const float* ffn_w3; const float* ffn_w2;
    const float* moe_router; const float* moe_w1; const float* moe_w3; const float* moe_w2;
    float* out; unsigned char* ws; int ph_lo, ph_hi;
};

__device__ __forceinline__ void p0_transpose_item(const float* W, int ldw, int k0, int n0, bf16* WT, int dst_row0, int Kp, LAS float* scr, int lane) {
#pragma unroll 8
    for (int i = 0; i < 32; ++i) { const int kk = 2 * i + (lane >> 5); scr[kk * 33 + (lane & 31)] = W[(size_t)(k0 + kk) * ldw + n0 + (lane & 31)]; }
    asm volatile("s_waitcnt lgkmcnt(0)" ::: "memory");
    const int c = lane & 7;
#pragma unroll
    for (int j = 0; j < 4; ++j) { const int n = (lane >> 3) + 8 * j; const LAS float* s = scr + (8 * c) * 33 + n;
        u32x4 o; o.x = pk2(s[0 * 33], s[1 * 33]); o.y = pk2(s[2 * 33], s[3 * 33]); o.z = pk2(s[4 * 33], s[5 * 33]); o.w = pk2(s[6 * 33], s[7 * 33]);
        *(u32x4*)(WT + (size_t)(dst_row0 + n) * Kp + k0 + 8 * c) = o; }
    asm volatile("s_waitcnt lgkmcnt(0)" ::: "memory");
}

__device__ __forceinline__ void p0_transpose_item8(const float* W, int ldw, int k0, int n0, unsigned char* WT8, int dst_row0, int Kp, LAS float* scr, int lane) {
#pragma unroll 8
    for (int i = 0; i < 32; ++i) { const int kk = 2 * i + (lane >> 5); scr[kk * 33 + (lane & 31)] = W[(size_t)(k0 + kk) * ldw + n0 + (lane & 31)]; }
    asm volatile("s_waitcnt lgkmcnt(0)" ::: "memory");
    const int c = lane & 7;
#pragma unroll
    for (int j = 0; j < 4; ++j) { const int n = (lane >> 3) + 8 * j; const LAS float* sp = scr + (8 * c) * 33 + n;
        const u32x2 o = (u32x2){pk_fp8x4(sp[0 * 33] * W8_SCALE, sp[1 * 33] * W8_SCALE, sp[2 * 33] * W8_SCALE, sp[3 * 33] * W8_SCALE), pk_fp8x4(sp[4 * 33] * W8_SCALE, sp[5 * 33] * W8_SCALE, sp[6 * 33] * W8_SCALE, sp[7 * 33] * W8_SCALE)};
        *(u32x2*)(WT8 + (size_t)(dst_row0 + n) * Kp + k0 + 8 * c) = o; }
    asm volatile("s_waitcnt lgkmcnt(0)" ::: "memory");
}

namespace att {
__device__ __forceinline__ int crow(int r, int hi) { return (r & 3) + 8 * (r >> 2) + 4 * hi; }
__host__ __device__ constexpr int dwin(int h) { return (int)(150.0 / (1.4426950408889634 / (double)(1 << (h + 1)))); }
__host__ __device__ constexpr int tstart(int h, int jq) { const int q0 = 128 * jq, d = dwin(h); return q0 > d ? (q0 - d) / 64 : 0; }
struct Plan { unsigned char n[16]; unsigned char u[16][48]; };
constexpr Plan make_plan() {
    Plan p{}; int load[16] = {};
    for (int w = 0; w < 16; ++w) p.n[w] = 0;
    for (int h = 7; h >= 0; --h) {
        int cost[32] = {}, ord[32] = {};
        for (int j = 0; j < 32; ++j) { cost[j] = 2 * j + 2 - tstart(h, j); ord[j] = j; }
        for (int a = 1; a < 32; ++a) { const int x = ord[a]; int b = a - 1; while (b >= 0 && cost[ord[b]] < cost[x]) { ord[b + 1] = ord[b]; --b; } ord[b + 1] = x; }
        for (int a = 0; a < 32; ++a) { int best = 0; for (int w = 1; w < 16; ++w) if (load[w] < load[best]) best = w;
            p.u[best][p.n[best]++] = (unsigned char)(h * 32 + ord[a]); load[best] += cost[ord[a]]; }
    }
    return p;
}
__device__ const Plan PLAN = make_plan();
constexpr int BUFB = 32768, NBUF = 3, KOFF = 0, VOFF = 16384, WSF_OFF = NBUF * BUFB;
__device__ __forceinline__ s16x4 vtr(const LAS unsigned char* p) { return __builtin_bit_cast(s16x4, __builtin_amdgcn_ds_read_tr16_b64_v4i16((LAS s16x4*)p)); }

__device__ __forceinline__ void attn_unit(LAS unsigned char* lds, const bf16* Q, const bf16* K, const bf16* V, bf16* O, int b, int h, int jq,
                                          float sl2, float mref0, float mref1, float lam, const float* subg) {
    const int tid = threadIdx.x, lane = tid & 63, r32 = lane & 31, hi = lane >> 5; const int wid = __builtin_amdgcn_readfirstlane(tid >> 6);
    const int mp = wid >> 2, w4 = wid & 3;
    const size_t rowbase = (size_t)b * SEQ; const int q0 = jq * 128;
    const int nT = (q0 >> 6) + 2, myc = (q0 + 32 * w4) >> 6, t0 = tstart(h, jq);
    const bf16* Qw = Q + (rowbase + q0 + 32 * w4 + r32) * D + h * 128 + mp * 64 + hi * 8;
    bf16x8 qr[4];
#pragma unroll
    for (int d0 = 0; d0 < 4; ++d0) qr[d0] = *(const bf16x8*)(Qw + d0 * 16);
    const bf16* ksrc = K + ((size_t)(b * 8 + h) * 64 * 16 + wid) * 512 + lane * 8;
    const int p0 = wid, p1 = wid + 8;
    const bf16* vsrc0 = V + ((size_t)(b * 8 + h) * 64 * 16 + p0) * 512 + lane * 8;
    const bf16* vsrc1 = V + ((size_t)(b * 8 + h) * 64 * 16 + p1) * 512 + lane * 8;
#define ATT_DMA1(gp_, la_) asm volatile("s_mov_b32 m0, %0\n\ts_nop 0\n\tglobal_load_lds_dwordx4 %1, off" :: "s"(la_), "v"(gp_) : "memory", "m0")
#define ATT_DMA(t, bs) do { const unsigned bb_ = (unsigned)__builtin_amdgcn_readfirstlane((int)(ldsu + (unsigned)((bs) * BUFB))); \
        ATT_DMA1(ksrc + (size_t)(t) * 8192, bb_ + (unsigned)(KOFF + wid * 1024)); \
        ATT_DMA1(ksrc + (size_t)(t) * 8192 + 4096, bb_ + (unsigned)(KOFF + 8192 + wid * 1024)); \
        ATT_DMA1(vsrc0 + (size_t)(t) * 8192, bb_ + (unsigned)(VOFF + p0 * 1024)); \
        ATT_DMA1(vsrc1 + (size_t)(t) * 8192, bb_ + (unsigned)(VOFF + p1 * 1024)); } while (0)
    const unsigned ldsu = (unsigned)(unsigned long long)lds;
    const float qpos = (float)(q0 + 32 * w4 + r32);
    const float mref = mp ? mref1 : mref0;
    const float baseL = -sl2 * qpos - mref, sl8 = 8.0f * sl2, sl32 = 32.0f * sl2;
    float lsum = 0.f; f32x16 o[4];
#pragma unroll
    for (int d0 = 0; d0 < 4; ++d0)
#pragma unroll
        for (int r = 0; r < 16; ++r) o[d0][r] = 0.f;
    ATT_DMA(t0, 0);
    if (t0 + 1 < nT) ATT_DMA(t0 + 1, 1);
    asm volatile("" :: "v"(qr[0]), "v"(qr[1]), "v"(qr[2]), "v"(qr[3]) : "memory");
    int slot = 0;
    for (int t = t0; t < nT; ++t) {
        if (t + 1 < nT) asm volatile("s_waitcnt vmcnt(4)" ::: "memory"); else asm volatile("s_waitcnt vmcnt(0)" ::: "memory");
        asm volatile("s_waitcnt lgkmcnt(0)" ::: "memory"); __builtin_amdgcn_s_barrier(); asm volatile("" ::: "memory");
        if (t + 2 < nT) { const int s2 = slot >= 1 ? slot - 1 : 2; ATT_DMA(t + 2, s2); }
        if (t <= myc) {
            const LAS unsigned char* bb = lds + slot * BUFB;
            f32x16 c0, c1;
            if (t < myc) {
                const float kb = baseL + sl2 * (float)(64 * t + 4 * hi);
#pragma unroll
                for (int r = 0; r < 16; ++r) { c0[r] = (r == 0) ? kb : ((r & 3) ? c0[r - 1] + sl2 : c0[r - 4] + sl8); c1[r] = c0[r] + sl32; }
            } else {
                const float qk = qpos - (float)(64 * t + 4 * hi);
                float x[16];
#pragma unroll
                for (int r = 0; r < 16; ++r) { x[r] = (r == 0) ? qk : ((r & 3) ? x[r - 1] - 1.0f : x[r - 4] - 8.0f); c0[r] = -sl2 * fabsf(x[r]) - mref; c1[r] = -sl2 * fabsf(x[r] - 32.0f) - mref; }
            }
            const LAS unsigned char* kb_ = bb + KOFF + mp * 8192 + hi * 1024 + r32 * 16;
#define ATT_SB() __builtin_amdgcn_sched_barrier(0)
            bf16x8 kf[8];
#pragma unroll
            for (int d0 = 0; d0 < 4; ++d0) { kf[2 * d0] = *(const LAS bf16x8*)(kb_ + d0 * 2048); kf[2 * d0 + 1] = *(const LAS bf16x8*)(kb_ + d0 * 2048 + 512); }
            const LAS unsigned char* vp = bb + VOFF + ((lane >> 4) & 1) * 32 + (lane & 3) * 8 + (4 * hi + ((lane & 15) >> 2)) * 64;
            s16x4 vlo[16], vhi[16];
#pragma unroll
            for (int ks = 0; ks < 2; ++ks)
#pragma unroll
                for (int d0 = 0; d0 < 4; ++d0) { vlo[d0 * 4 + ks] = vtr(vp + d0 * 4096 + ks * 1024); vhi[d0 * 4 + ks] = vtr(vp + d0 * 4096 + ks * 1024 + 512); }
            ATT_SB();
#pragma unroll
            for (int d0 = 0; d0 < 4; ++d0) c0 = __builtin_amdgcn_mfma_f32_32x32x16_bf16(kf[2 * d0], qr[d0], c0, 0, 0, 0);
            ATT_SB();
            float sacc = 0.f;
#pragma unroll
            for (int d0 = 0; d0 < 4; ++d0) {
                c1 = __builtin_amdgcn_mfma_f32_32x32x16_bf16(kf[2 * d0 + 1], qr[d0], c1, 0, 0, 0);
                ATT_SB();
#pragma unroll
                for (int e = 0; e < 4; ++e) { c0[4 * d0 + e] = __builtin_amdgcn_exp2f(c0[4 * d0 + e]); sacc += c0[4 * d0 + e]; }
                ATT_SB();
            }
            u32x4 pw[4];
#pragma unroll
            for (int g = 0; g < 4; ++g) { pw[0][g] = cvt_pk_bf16(c0[2 * g], c0[2 * g + 1]); pw[1][g] = cvt_pk_bf16(c0[8 + 2 * g], c0[8 + 2 * g + 1]); }
#pragma unroll
            for (int ks = 2; ks < 4; ++ks)
#pragma unroll
                for (int d0 = 0; d0 < 4; ++d0) { vlo[d0 * 4 + ks] = vtr(vp + d0 * 4096 + ks * 1024); vhi[d0 * 4 + ks] = vtr(vp + d0 * 4096 + ks * 1024 + 512); }
            ATT_SB();
#pragma unroll
            for (int j = 0; j < 8; ++j) { const int ks = j >> 2, d0 = j & 3;
                { const s16x4 lo = vlo[d0 * 4 + ks], hh = vhi[d0 * 4 + ks];
                  const bf16x8 vf = (bf16x8){lo[0], lo[1], lo[2], lo[3], hh[0], hh[1], hh[2], hh[3]};
                  o[d0] = __builtin_amdgcn_mfma_f32_32x32x16_bf16(__builtin_bit_cast(bf16x8, pw[ks]), vf, o[d0], 0, 0, 0); }
                ATT_SB();
                c1[2 * j] = __builtin_amdgcn_exp2f(c1[2 * j]); c1[2 * j + 1] = __builtin_amdgcn_exp2f(c1[2 * j + 1]); sacc += c1[2 * j] + c1[2 * j + 1];
                ATT_SB();
            }
            lsum += sacc;
#pragma unroll
            for (int g = 0; g < 4; ++g) { pw[2][g] = cvt_pk_bf16(c1[2 * g], c1[2 * g + 1]); pw[3][g] = cvt_pk_bf16(c1[8 + 2 * g], c1[8 + 2 * g + 1]); }
            ATT_SB();
#pragma unroll
            for (int j = 8; j < 16; ++j) { const int ks = j >> 2, d0 = j & 3;
                const s16x4 lo = vlo[d0 * 4 + ks], hh = vhi[d0 * 4 + ks];
                const bf16x8 vf = (bf16x8){lo[0], lo[1], lo[2], lo[3], hh[0], hh[1], hh[2], hh[3]};
                o[d0] = __builtin_amdgcn_mfma_f32_32x32x16_bf16(__builtin_bit_cast(bf16x8, pw[ks]), vf, o[d0], 0, 0, 0); }
#undef ATT_SB
        }
        slot = slot == 2 ? 0 : slot + 1;
    }
#undef ATT_DMA
#undef ATT_DMA1
    int el; asm volatile("v_mbcnt_lo_u32_b32 %0, -1, 0\n\tv_mbcnt_hi_u32_b32 %0, -1, %0" : "=v"(el));
    const int r32e = el & 31, hie = el >> 5;
    lsum += __shfl_xor(lsum, 32);
    LAS float* wsf = (LAS float*)(lds + WSF_OFF) + wid * 32;
    if (hie == 0) wsf[r32e] = lsum;
    asm volatile("s_waitcnt lgkmcnt(0)" ::: "memory");
    float rl[16];
#pragma unroll
    for (int r = 0; r < 16; ++r) rl[r] = __builtin_amdgcn_rcpf(wsf[crow(r, hie)]);
#pragma unroll
    for (int d0 = 0; d0 < 4; ++d0)
#pragma unroll
        for (int r = 0; r < 16; ++r) o[d0][r] *= rl[r];
    __syncthreads();
    LAS float* X = (LAS float*)lds + w4 * 4096;
    if (mp == 1) {
#pragma unroll
        for (int d0 = 0; d0 < 4; ++d0)
#pragma unroll
            for (int r = 0; r < 16; ++r) X[(d0 * 16 + r) * 64 + el] = o[d0][r];
    }
    __syncthreads();
    if (mp == 0) {
        float ss[16];
#pragma unroll
        for (int r = 0; r < 16; ++r) ss[r] = 0.f;
#pragma unroll
        for (int d0 = 0; d0 < 4; ++d0)
#pragma unroll
            for (int r = 0; r < 16; ++r) { const float dd = o[d0][r] - lam * X[(d0 * 16 + r) * 64 + el]; o[d0][r] = dd; ss[r] += dd * dd; }
#pragma unroll
        for (int r = 0; r < 16; ++r) {
            float s = ss[r];
#pragma unroll
            for (int of = 1; of < 32; of <<= 1) s += __shfl_xor(s, of);
            ss[r] = __builtin_amdgcn_rsqf(s * (1.0f / 128.0f) + EPS) * 0.8f;
        }
        bf16* Ow = O + (rowbase + q0 + 32 * w4) * D + h * 128 + r32e;
#pragma unroll
        for (int d0 = 0; d0 < 4; ++d0) { const float gcol = subg[32 * d0 + r32e];
#pragma unroll
            for (int r = 0; r < 16; ++r) Ow[(size_t)crow(r, hie) * D + 32 * d0] = (bf16)f2bf(o[d0][r] * ss[r] * gcol); }
    }
    __syncthreads();
}
}

__global__ void __launch_bounds__(NWAVES * 64, 2) mk_fwd(Args args) {
    extern __shared__ __attribute__((aligned(16))) unsigned char lds_raw[];
    LAS unsigned char* lds = (LAS unsigned char*)lds_raw;
    volatile LAS unsigned* MISC = (volatile LAS unsigned*)(lds + MISC_OFF);
    const int tid = threadIdx.x, lane = tid & 63, wave = __builtin_amdgcn_readfirstlane(tid >> 6);
    const int G = gridDim.x; const int bx = blockIdx.x;
    const int vcu = (G % 8 == 0) ? (bx % 8) * (G / 8) + bx / 8 : bx;
    unsigned char* ws = args.ws;
    unsigned* ctl = (unsigned*)(ws + WS_CTL);
    float* MOD = (float*)(ws + WS_MOD);
    unsigned* LCNT = (unsigned*)(ws + WS_LCNT);
    int* META = (int*)(ws + WS_META);
    u32x4* ROUTE = (u32x4*)(ws + WS_ROUTE);
    int* TOKSLOT = (int*)(ws + WS_TOKSLOT);
    float* GSLOT = (float*)(ws + WS_GSLOT);
    bf16* W_DAIN = (bf16*)(ws + WS_W_DAIN); bf16* W_DAOUT = (bf16*)(ws + WS_W_DAOUT); bf16* W_FFN13 = (bf16*)(ws + WS_W_FFN13); bf16* W_FFN2 = (bf16*)(ws + WS_W_FFN2);
    bf16* W_GLAIN = (bf16*)(ws + WS_W_GLAIN); bf16* W_GLAOUT = (bf16*)(ws + WS_W_GLAOUT); bf16* W_MOE13 = (bf16*)(ws + WS_W_MOE13); bf16* W_MOE2 = (bf16*)(ws + WS_W_MOE2);
    bf16* HB = (bf16*)(ws + WS_H);
    bf16* QB = (bf16*)(ws + WS_Q);
    bf16* KB = QB + (size_t)M * D; bf16* VB = KB + (size_t)M * D;
    bf16* ACTB = QB;
    bf16* GP = QB;
    bf16* GLAB = QB + (size_t)M * 3072;
    float* out = args.out;
    bf16* XB = (bf16*)(ws + WS_XB);
    float* KPART = (float*)(ws + WS_Q + 320 * MiB);
    static_assert(MOE_DN8 && (size_t)MAXSLOT * EXPD <= 320 * MiB && 320 * MiB + 256 * (size_t)(32 * 512 * 16) <= 464 * MiB, "K-split partials do not fit behind the MoE activations");

    for (int u = tid; u < 256; u += NWAVES * 64) ((LAS unsigned*)(lds + MISC_OFF))[u] = 0u;
    __syncthreads();
    XcdBarrier bar; bar.bar = ctl + CW_BAR; bar.x = 0; bar.st = nullptr;
    if (MK_N_LAUNCHES == 1) bar = xcd_barrier_post(ctl + CW_BAR, MISC + 8);
    const int lo = args.ph_lo, hi = args.ph_hi;
#define IN(k) (lo <= (k) && (k) < hi)
#define SEAM(k) do { if (IN(k) && IN((k) + 1)) xcd_barrier(bar); } while (0)
    const int gw = vcu * NWAVES + wave, NGW = G * NWAVES;

    if (IN(0)) {
        if (bx < 192) {
            LAS float* cact = (LAS float*)lds;
            for (int e = tid; e < 16 * 1024; e += 512) { const int b = e >> 10, k = e & 1023; const float v = args.c[e]; cact[k * 16 + b] = v / (1.0f + __expf(-v)); }
            __syncthreads();
            const int col = tid & 63, ks = tid >> 6, n = bx * 64 + col, layer = n / 6144, nn = n % 6144;
            const float* wp = args.ada_w + (size_t)layer * 1024 * 6144 + nn;
            float a[16];
#pragma unroll
            for (int b = 0; b < 16; ++b) a[b] = 0.f;
            for (int k = ks * 128; k < ks * 128 + 128; ++k) { const float w = wp[(size_t)k * 6144];
#pragma unroll
                for (int q = 0; q < 4; ++q) { const f32x4 cv = *(const LAS f32x4*)(cact + k * 16 + 4 * q); a[4 * q] += cv[0] * w; a[4 * q + 1] += cv[1] * w; a[4 * q + 2] += cv[2] * w; a[4 * q + 3] += cv[3] * w; } }
            LAS float* red = (LAS float*)(lds + 65536);
#pragma unroll
            for (int b = 0; b < 16; ++b) red[(ks * 16 + b) * 64 + col] = a[b];
            __syncthreads();
            for (int e = tid; e < 1024; e += 512) { const int b = e >> 6, cc = e & 63; float s = 0.f;
#pragma unroll
                for (int k8 = 0; k8 < 8; ++k8) s += red[(k8 * 16 + b) * 64 + cc];
                const int n2 = bx * 64 + cc, l2 = n2 / 6144, nn2 = n2 % 6144;
                MOD[((size_t)l2 * 16 + b) * 6144 + nn2] = s + args.ada_b[l2 * 6144 + nn2]; }
            __syncthreads();
        }
        for (int i = bx * 512 + tid; i < 2 * MAXSLOT; i += G * 512) TOKSLOT[i] = -1;
        LAS float* scr = (LAS float*)(lds + wave * 16384);
        constexpr int I_DAIN = 16 * 96, I_SQ = 16 * 32, I_F13 = 16 * 88, I_F2 = 44 * 32, I_GLAIN = 16 * 96, I_GA = 512;
        constexpr int NITEMS = I_DAIN + I_SQ + 2 * I_F13 + I_F2 + I_GLAIN + I_SQ + I_GA;
        for (int it = gw; it < NITEMS; it += NGW) {
            int r = it;
            if (r < I_DAIN) { const int kb = r / 96, nb = r % 96, n0 = 32 * nb, l = n0 & 255;
                p0_transpose_item(args.da_w_in, 3072, 64 * kb, n0, W_DAIN, (n0 & ~255) + 128 * ((l >> 5) & 1) + 32 * (l >> 6), D, scr, lane); continue; } r -= I_DAIN;
            if (r < I_SQ) { const int kb = r / 32, nb = r % 32; p0_transpose_item(args.da_w_out, D, 64 * kb, 32 * nb, W_DAOUT, 32 * nb, D, scr, lane); continue; } r -= I_SQ;
            if (r < 2 * I_F13) { const int w = r / I_F13, q = r % I_F13, kb = q / 88, nb = q % 88, n0 = 32 * nb;
                if (FFN_UP8) p0_transpose_item8(w ? args.ffn_w3 : args.ffn_w1, FFN, 64 * kb, n0, (unsigned char*)W_FFN13, (n0 >> 7) * 256 + w * 128 + (n0 & 127), D, scr, lane);
                else p0_transpose_item(w ? args.ffn_w3 : args.ffn_w1, FFN, 64 * kb, n0, W_FFN13, (n0 >> 7) * 256 + w * 128 + (n0 & 127), D, scr, lane); continue; } r -= 2 * I_F13;
            if (r < I_F2) { const int kb = r / 32, nb = r % 32; if (FFN_DN8) p0_transpose_item8(args.ffn_w2, D, 64 * kb, 32 * nb, (unsigned char*)W_FFN2, 32 * nb, FFN, scr, lane); else p0_transpose_item(args.ffn_w2, D, 64 * kb, 32 * nb, W_FFN2, 32 * nb, FFN, scr, lane); continue; } r -= I_F2;
            if (r < I_GLAIN) { const int kb = r / 96, nb = r % 96; p0_transpose_item(args.gla_w_in, 3072, 64 * kb, 32 * nb, W_GLAIN, 32 * nb, D, scr, lane); continue; } r -= I_GLAIN;
            if (r < I_SQ) { const int kb = r / 32, nb = r % 32; p0_transpose_item(args.gla_w_out, D, 64 * kb, 32 * nb, W_GLAOUT, 32 * nb, D, scr, lane); continue; } r -= I_SQ;
            if (r < I_GA) {
                const int j = r; float a2[16];
#pragma unroll
                for (int q = 0; q < 16; ++q) a2[q] = args.gla_w_a2[q * 512 + j];
                bf16* dst = W_GLAIN + (size_t)(3072 + j) * D + lane * 16;
                unsigned pk[8];
#pragma unroll
                for (int kk = 0; kk < 16; kk += 2) { float s0 = 0.f, s1 = 0.f; const float* w1p = args.gla_w_a1 + (size_t)(lane * 16 + kk) * 16;
#pragma unroll
                    for (int q = 0; q < 16; ++q) { s0 += w1p[q] * a2[q]; s1 += w1p[16 + q] * a2[q]; }
                    pk[kk >> 1] = pk2(s0, s1); }
                *(u32x4*)dst = (u32x4){pk[0], pk[1], pk[2], pk[3]}; *(u32x4*)(dst + 8) = (u32x4){pk[4], pk[5], pk[6], pk[7]};
                continue; }
        }
    }
    SEAM(0);

#define NORM_LOAD(XSRC, SRC16, m_, v_, s_) do { s_ = 0.f; \
            _Pragma("unroll") for (int j = 0; j < 4; ++j) { v_[j] = (SRC16) ? ld_bf16x4((const bf16*)(XSRC) + (size_t)(m_) * D + 4 * lane + 256 * j) : *((const f32x4*)((const float*)(XSRC) + (size_t)(m_) * D) + lane + 64 * j); s_ += (v_[j][0] * v_[j][0] + v_[j][1] * v_[j][1]) + (v_[j][2] * v_[j][2] + v_[j][3] * v_[j][3]); } } while (0)
#define NORM_ROW(GVEC, MODROW, ROUTER, OUT8, m_, v_, s_) do { const int m = (m_); f32x4 (&v)[4] = v_; \
            { const int b = m >> 12; if (b != ncb) { ncb = b; const float* mrow = (MODROW) + (size_t)b * 6144;        \
                _Pragma("unroll") for (int j = 0; j < 4; ++j) { const f32x4 gg = *((const f32x4*)(GVEC) + lane + 64 * j), sc = *((const f32x4*)(mrow + 1024) + lane + 64 * j); ngs[j] = gg * (sc + 1.0f); nsh[j] = *((const f32x4*)mrow + lane + 64 * j); } } } \
            const float rstd = __builtin_amdgcn_rsqf(wave_sum(s_) * (1.0f / D) + EPS); \
            _Pragma("unroll") for (int j = 0; j < 4; ++j) v[j] = v[j] * rstd * ngs[j] + nsh[j]; \
            if (OUT8) { unsigned* o4 = (unsigned*)((unsigned char*)HB + (size_t)m * D) + lane; \
                _Pragma("unroll") for (int j = 0; j < 4; ++j) o4[64 * j] = pk_fp8x4(v[j][0] * H8_SCALE, v[j][1] * H8_SCALE, v[j][2] * H8_SCALE, v[j][3] * H8_SCALE); } \
            else { u32x2* o8 = (u32x2*)(HB + (size_t)m * D) + lane; \
                _Pragma("unroll") for (int j = 0; j < 4; ++j) o8[64 * j] = (u32x2){pk2(v[j][0], v[j][1]), pk2(v[j][2], v[j][3])}; } \
            if (ROUTER) { ROUTER_BODY } } while (0)
#define NORM_PHASE(XSRC, SRC16, GVEC, MODROW, ROUTER, OUT8) do { \
        const int rpw = (M + NGW - 1) / NGW; const int r_lo = (ROUTER ? (bx * NWAVES + wave) : gw) * rpw; int ncb = -1; f32x4 ngs[4], nsh[4]; \
        for (int rr = 0; rr < rpw; rr += 4) { const int m0 = r_lo + rr; if (m0 >= M) break; \
            f32x4 va[4], vb[4], vc[4], vd[4]; float sa, sb = 0.f, sc_ = 0.f, sd = 0.f; \
            const bool hb = (rr + 1 < rpw) && (m0 + 1 < M), hc = (rr + 2 < rpw) && (m0 + 2 < M), hd = (rr + 3 < rpw) && (m0 + 3 < M); \
            NORM_LOAD(XSRC, SRC16, m0, va, sa); if (hb) NORM_LOAD(XSRC, SRC16, m0 + 1, vb, sb); if (hc) NORM_LOAD(XSRC, SRC16, m0 + 2, vc, sc_); if (hd) NORM_LOAD(XSRC, SRC16, m0 + 3, vd, sd); \
            NORM_ROW(GVEC, MODROW, ROUTER, OUT8, m0, va, sa); if (hb) NORM_ROW(GVEC, MODROW, ROUTER, OUT8, m0 + 1, vb, sb); \
            if (hc) NORM_ROW(GVEC, MODROW, ROUTER, OUT8, m0 + 2, vc, sc_); if (hd) NORM_ROW(GVEC, MODROW, ROUTER, OUT8, m0 + 3, vd, sd); } } while (0)
#define ROUTER_BODY
    if (IN(1)) { NORM_PHASE(args.x, false, args.norm1_g, MOD, 0, false); }
    SEAM(1);

    if (IN(2)) {
        pg8::DenseSched S; S.init(M / 256, 12, G, bx); S.A = (const char*)HB; S.Bt = (const char*)W_DAIN; S.tstep = (size_t)256 * D * 2;
        pg8::EpiQKV E{QB, (size_t)M * D, args.da_q_gain, args.da_k_gain, 0.125f * LOG2E};
        pg8::gemm_phase<pg8::EpiQKV, pg8::DenseSched, true, false>(lds, 2 * D, S, E);
    }
    SEAM(2);

    if (IN(3)) {
        float a1 = args.da_lam_q1[lane] * args.da_lam_k1[lane], a2 = args.da_lam_q2[lane] * args.da_lam_k2[lane];
        const float lam = __expf(wave_sum(a1)) - __expf(wave_sum(a2)) + 0.2f;
        const float gq0 = wave_max(fabsf(args.da_q_gain[lane])), gq1 = wave_max(fabsf(args.da_q_gain[64 + lane]));
        const float gk0 = wave_max(fabsf(args.da_k_gain[lane])), gk1 = wave_max(fabsf(args.da_k_gain[64 + lane]));
        const float mref0 = 8.0f * LOG2E * gq0 * gk0 * 1.01f, mref1 = 8.0f * LOG2E * gq1 * gk1 * 1.01f;
        for (int rep = 0; rep < (PROBE_DUP == 3 ? 2 : 1); ++rep)
        for (int bb = vcu >> 4; bb < BATCH; bb += (G >= 16 ? (G >> 4) : 1)) {
            const int w16 = vcu & 15, nu = att::PLAN.n[w16];
            for (int i = 0; i < nu; ++i) { const int hj = att::PLAN.u[w16][i], h = hj >> 5, jq = hj & 31;
                const float sl2 = LOG2E * exp2f(-(float)(h + 1));
                att::attn_unit(lds, QB, KB, VB, HB, bb, h, jq, sl2, mref0, mref1, lam, args.da_subln_g); }
        }
    }
    SEAM(3);

    if (IN(4)) {
        pg8::DenseSched S; S.init(M / 256, 4, G, bx); S.A = (const char*)HB; S.Bt = (const char*)W_DAOUT; S.tstep = (size_t)256 * D * 2;
        pg8::EpiResid<false, true> E{args.x, XB, MOD + 2048, 1.0f};
        pg8::gemm_phase<pg8::EpiResid<false, true>, pg8::DenseSched, true, false>(lds, 2 * D, S, E);
    }
    SEAM(4);
    if (IN(5)) { NORM_PHASE(XB, true, args.norm2_g, MOD + 3072, 0, FFN_UP8); }
    SEAM(5);

    if (IN(6)) {
        pg8::DenseSched S; S.init(M / 256, 2 * FFN / 256, G, bx); S.A = (const char*)HB; S.Bt = (const char*)W_FFN13; S.tstep = (size_t)256 * D * (FFN_UP8 ? 1 : 2);
        pg8::EpiSwiGLU<FFN_DN8> E{ACTB, FFN, FFN_UP8 ? 1.0f / (H8_SCALE * W8_SCALE) : 1.0f};
        pg8::gemm_phase<pg8::EpiSwiGLU<FFN_DN8>, pg8::DenseSched, true, false, FFN_UP8>(lds, D * (FFN_UP8 ? 1 : 2), S, E);
    }
    SEAM(6);
    if (IN(7)) {
        pg8::DenseSched S; S.init(M / 256, 4, G, bx); S.A = (const char*)ACTB; S.Bt = (const char*)W_FFN2; S.tstep = (size_t)256 * FFN * (FFN_DN8 ? 1 : 2);
        pg8::EpiResid<true, true> E{XB, XB, MOD + 5 * 1024, FFN_DN8 ? 1.0f / (A8_SCALE * W8_SCALE) : 1.0f};
        pg8::gemm_phase<pg8::EpiResid<true, true>, pg8::DenseSched, true, false, FFN_DN8>(lds, FFN * (FFN_DN8 ? 1 : 2), S, E);
    }
    SEAM(7);

    float* MOD1 = MOD + 16 * 6144;
    if (IN(8)) { NORM_PHASE(XB, true, args.norm1_g + D, MOD1, 0, false); }
    SEAM(8);
    if (IN(9)) {
        pg8::DenseSched S; S.init(M / 256, GLA_N / 256, G, bx); S.A = (const char*)HB; S.Bt = (const char*)W_GLAIN; S.tstep = (size_t)256 * D * 2;
        pg8::EpiGLA E{GP, GLAB, args.gla_b_a, args.gla_out_g};
        pg8::gemm_phase<pg8::EpiGLA, pg8::DenseSched, true, false>(lds, 2 * D, S, E);
    }
    SEAM(9);

    unsigned char* GA = (unsigned char*)out;
    static_assert(4096 * GA_UNIT <= 192 * MiB && 256 * MiB <= (size_t)M * D * 4 && (size_t)M * 512 * 2 >= 64 * MiB, "o-fragment parking");
#define OFRAG(b_, n_, h_) (((b_) < 8 ? (unsigned char*)GLAB : (unsigned char*)out + 192 * MiB) + (size_t)(((((b_) & 7) * 64 + (n_)) * 4) + (h_)) * 32768)
    if (IN(10)) {
        LAS unsigned char* QDp = lds; LAS unsigned char* KDTc = lds + 16384; LAS unsigned char* ATc = lds + 32768; LAS float* DV = (LAS float*)(lds + 40960);
        LAS bf16* KI = (LAS bf16*)(lds + 43008); LAS float* QT = (LAS float*)(lds + 60416);
        const int fr = lane & 15, fq = lane >> 4;
        const int j = tid & 127, tq = tid >> 7;
        const int cq = j >> 4, wq = j & 15, hq = (wq >> 2) & 1, jq2 = ((wq >> 3) << 2) | (wq & 3);
        for (int rep = 0; rep < (PROBE_DUP == 10 ? 2 : 1); ++rep)
        for (int u = bx; u < 4096; u += G) {
            const int h = u & 3, n = (u >> 2) & 63, b = u >> 8;
            const size_t R0 = (size_t)b * SEQ + 64 * n;
            float la[16], qv[16], kv[16];
#pragma unroll
            for (int i = 0; i < 16; ++i) { const size_t row = R0 + 16 * tq + i; la[i] = bf2f(GLAB[row * 512 + h * 128 + j]); qv[i] = bf2f(GP[row * 3072 + h * 128 + j]); kv[i] = bf2f(GP[row * 3072 + 512 + h * 128 + j]); }
#pragma unroll
            for (int i = 1; i < 16; ++i) la[i] += la[i - 1];
            QT[tq * 128 + j] = la[15];
            __syncthreads();
            float pre = 0.f, tot = 0.f;
#pragma unroll
            for (int q = 0; q < 4; ++q) { const float v = QT[q * 128 + j]; tot += v; pre += (q < tq) ? v : 0.f; }
            unsigned kdp[8];
#pragma unroll
            for (int i = 0; i < 16; ++i) { const float bb = pre + la[i]; const int t = 16 * tq + i;
                *(LAS bf16*)(QDp + (((cq * 2 + hq) * 64 + t) * 16) + jq2 * 2) = (bf16)f2bf(qv[i] * 0.08838834764831845f * __expf(bb));
                KI[t * 136 + j] = (bf16)f2bf(kv[i] * __expf(-bb));
                const float kd = kv[i] * __expf(tot - bb);
                if (i & 1) kdp[i >> 1] |= f2bf(kd) << 16; else kdp[i >> 1] = f2bf(kd); }
            *(LAS u32x4*)(KDTc + ((2 * tq) * 128 + j) * 16) = (u32x4){kdp[0], kdp[1], kdp[2], kdp[3]};
            *(LAS u32x4*)(KDTc + ((2 * tq + 1) * 128 + j) * 16) = (u32x4){kdp[4], kdp[5], kdp[6], kdp[7]};
            if (tq == 0) DV[j] = __expf(tot);
            __syncthreads();
#pragma unroll
            for (int q = 0; q < 2; ++q) { const int idx = 2 * wave + q, ti = idx >> 2, si = idx & 3;
                f32x4 c = (f32x4){0.f, 0.f, 0.f, 0.f};
                if (si <= ti) {
#pragma unroll
                    for (int ks = 0; ks < 4; ++ks) { const int cc = 2 * ks + (fq >> 1), jb = 4 * (fq & 1), t = 16 * ti + fr;
                        const u32x2 alo = *(const LAS u32x2*)(QDp + (((cc * 2 + 0) * 64 + t) * 16) + jb * 2), ahi = *(const LAS u32x2*)(QDp + (((cc * 2 + 1) * 64 + t) * 16) + jb * 2);
                        const u32x4 af = (u32x4){alo[0], alo[1], ahi[0], ahi[1]};
                        const bf16x8 bfr = *(const LAS bf16x8*)(KI + (16 * si + fr) * 136 + 32 * ks + 8 * fq);
                        c = __builtin_amdgcn_mfma_f32_16x16x32_bf16(__builtin_bit_cast(bf16x8, af), bfr, c, 0, 0, 0); }
                }
#pragma unroll
                for (int r = 0; r < 4; ++r) { const int t = 16 * ti + 4 * fq + r, sx = 16 * si + fr; *(LAS bf16*)(ATc + (((sx >> 3) * 64 + t) * 16) + (sx & 7) * 2) = (bf16)f2bf(sx <= t ? c[r] : 0.f); } }
            __syncthreads();
            { u32x4* dst = (u32x4*)(GA + (size_t)u * GA_UNIT);
              for (int v = tid; v < 41472 / 16; v += 512) dst[v] = *(const LAS u32x4*)(lds + v * 16); }
            __syncthreads();
        }
    }
    SEAM(10);

    const int sstride = G >= 256 ? 2 : 1;
    const bool is_scan = (vcu % sstride == 0) && (vcu / sstride < 128);
    const int scan_id = vcu / sstride;
    const int copy_id = vcu < 128 * sstride ? (vcu / sstride) * (sstride - 1) + (vcu % sstride) - 1 : 128 * (sstride - 1) + (vcu - 128 * sstride);
    if (IN(11) && !is_scan) {
        LAS float* scr = (LAS float*)(lds + wave * 16384);
        constexpr int I_M13 = 16 * 112, I_M2 = 56 * 32, NIT = NEXP * 2 * I_M13 + NEXP * I_M2;
        const int nwv = (G - 128) * NWAVES;
        for (int rep = 0; rep < (PROBE_DUP == 20 ? 2 : 1); ++rep)
        for (int it = copy_id * NWAVES + wave; it < NIT; it += nwv) {
            int r = it;
            if (r < NEXP * 2 * I_M13) { const int e = r / (2 * I_M13), q2 = r % (2 * I_M13), w = q2 / I_M13, q = q2 % I_M13, kb = q / 112, nb = q % 112, n0 = 32 * nb;
                if (MOE_UP8) p0_transpose_item8((w ? args.moe_w3 : args.moe_w1) + (size_t)e * D * EXPD, EXPD, 64 * kb, n0, (unsigned char*)W_MOE13 + (size_t)e * 2 * EXPD * D, (n0 >> 7) * 256 + w * 128 + (n0 & 127), D, scr, lane);
                else p0_transpose_item((w ? args.moe_w3 : args.moe_w1) + (size_t)e * D * EXPD, EXPD, 64 * kb, n0, W_MOE13 + (size_t)e * 2 * EXPD * D, (n0 >> 7) * 256 + w * 128 + (n0 & 127), D, scr, lane); continue; }
            r -= NEXP * 2 * I_M13;
            { const int e = r / I_M2, q = r % I_M2, kb = q / 32, nb = q % 32;
                if (MOE_DN8) p0_transpose_item8(args.moe_w2 + (size_t)e * EXPD * D, D, 64 * kb, 32 * nb, (unsigned char*)W_MOE2 + (size_t)e * D * EXPD, 32 * nb, EXPD, scr, lane);
                else p0_transpose_item(args.moe_w2 + (size_t)e * EXPD * D, D, 64 * kb, 32 * nb, W_MOE2 + (size_t)e * D * EXPD, 32 * nb, EXPD, scr, lane); }
        }
    }
    if (IN(11) && is_scan) {
        const int b = scan_id >> 3, h = (scan_id >> 1) & 3, dvh = scan_id & 1;
        constexpr int BUFB = 58368, VOFF = 41984, XOFF = 2 * BUFB;
        static_assert(XOFF + 32768 <= MISC_OFF, "GLA scan LDS");
        const int r32 = lane & 31, hh = lane >> 5;
        const int w4 = wave & 3, kg = wave >> 2, cgi = dvh * 4 + w4;
        const unsigned char* gabase = GA + ((size_t)b * 256 + h) * GA_UNIT;
        const bf16* vsrc = GP + ((size_t)b * SEQ + (lane >> 2)) * 3072 + 1024 + h * 256 + 32 * cgi + (lane & 3) * 8;
        const unsigned ldsu = (unsigned)(unsigned long long)lds;
#define GLA_DMA1(gp_, la_) asm volatile("s_mov_b32 m0, %0\n\ts_nop 0\n\tglobal_load_lds_dwordx4 %1, off" :: "s"(la_), "v"(gp_) : "memory", "m0")
#define GLA_DMA(n_, bs_) do { const unsigned bb_ = (unsigned)__builtin_amdgcn_readfirstlane((int)(ldsu + (unsigned)((bs_) * BUFB))); const unsigned char* ga_ = gabase + (size_t)(n_) * 4 * GA_UNIT; \
        _Pragma("unroll") for (int k_ = 0; k_ < 6; ++k_) { int p_ = wave + 8 * k_; p_ = p_ > 40 ? 40 : p_; \
            GLA_DMA1(ga_ + p_ * 1024 + lane * 16, bb_ + (unsigned)(p_ * 1024)); } \
        _Pragma("unroll") for (int kq_ = 0; kq_ < 2; ++kq_) { const int ks_ = 2 * kg + kq_; \
            GLA_DMA1(vsrc + ((size_t)(n_) * 64 + 16 * ks_) * 3072, bb_ + (unsigned)(VOFF + (ks_ * 4 + w4) * 1024)); } } while (0)
        constexpr int SINK_OFF = XOFF + 32768;
        static_assert(SINK_OFF + 1024 <= MISC_OFF, "GLA scan LDS sink");
#define GLA_WARM(n_) do { const unsigned sk_ = (unsigned)__builtin_amdgcn_readfirstlane((int)(ldsu + (unsigned)SINK_OFF)); \
        const unsigned char* wp_ = warm_ga ? gabase + (size_t)(n_) * 4 * GA_UNIT + warm_off : (const unsigned char*)(GP + ((size_t)b * SEQ + (size_t)(n_) * 64) * 3072) + warm_off; \
        asm volatile("s_mov_b32 m0, %0\n\ts_nop 0\n\tglobal_load_lds_dword %1, off" :: "s"(sk_), "v"(wp_) : "memory", "m0"); } while (0)
        const int wl = wave * 64 + lane; const bool warm_ga = wl < 336; const int wj = wl - 336 < 127 ? wl - 336 : 127;
        const size_t warm_off = warm_ga ? (size_t)wl * 128 : ((size_t)(wj >> 1) * 3072 + 1024 + h * 256 + 128 * dvh) * 2 + (size_t)(wj & 1) * 128;
#define GLA_BAR() do { asm volatile("s_waitcnt lgkmcnt(0)" ::: "memory"); __builtin_amdgcn_s_barrier(); asm volatile("" ::: "memory"); } while (0)
        for (int rep = 0; rep < (PROBE_DUP == 11 ? 2 : 1); ++rep) {
        f32x16 Sacc[2];
#pragma unroll
        for (int kl = 0; kl < 2; ++kl)
#pragma unroll
            for (int r = 0; r < 16; ++r) Sacc[kl][r] = 0.f;
        f32x16 op[2];
#pragma unroll
        for (int tt = 0; tt < 2; ++tt)
#pragma unroll
            for (int r = 0; r < 16; ++r) op[tt][r] = 0.f;
        __builtin_amdgcn_s_waitcnt(0);
        GLA_DMA(0, 0);
        GLA_WARM(1);
        asm volatile("s_waitcnt vmcnt(0)" ::: "memory");
        for (int n = 0; n < 64; ++n) {
            if (n + 1 < 64) asm volatile("s_waitcnt vmcnt(1)" ::: "memory"); else asm volatile("s_waitcnt vmcnt(0)" ::: "memory");
            GLA_BAR();
            if (kg == 0 && n > 0) { u32x4* dst = (u32x4*)(OFRAG(b, n - 1, h)) + (cgi * 4) * 64 + lane;
                const LAS u32x4* XR = (const LAS u32x4*)(lds + XOFF + ((n - 1) & 1) * 16384 + w4 * 4096) + lane;
#pragma unroll
                for (int i = 0; i < 4; ++i) { const u32x4 xp = XR[i * 64]; const int tt = i >> 1, q = i & 1; u32x4 w;
#pragma unroll
                    for (int g = 0; g < 4; ++g) { const float x0 = __builtin_bit_cast(float, xp[g] << 16), x1 = __builtin_bit_cast(float, xp[g] & 0xffff0000u);
                        w[g] = cvt_pk_bf16(op[tt][8 * q + 2 * g] + x0, op[tt][8 * q + 2 * g + 1] + x1); }
                    asm volatile("global_store_dwordx4 %0, %1, off" :: "v"(dst + i * 64), "v"(w) : "memory"); } }
            if (n + 1 < 64) GLA_DMA(n + 1, (n + 1) & 1);
            if (n + 2 < 64) GLA_WARM(n + 2);
            LAS unsigned char* bb = lds + (n & 1) * BUFB;
            const LAS unsigned char* QDp = bb; const LAS unsigned char* KDTc = bb + 16384; const LAS unsigned char* ATc = bb + 32768; const LAS float* DV = (const LAS float*)(bb + 40960);
            bf16x8 vf[4];
#pragma unroll
            for (int ks = 0; ks < 4; ++ks) { const LAS unsigned char* vp = bb + VOFF + (ks * 4 + w4) * 1024 + ((lane >> 4) & 1) * 32 + (lane & 3) * 8 + (8 * hh + ((lane & 15) >> 2)) * 64;
                const s16x4 lo = att::vtr(vp), hi4 = att::vtr(vp + 256); vf[ks] = (bf16x8){lo[0], lo[1], lo[2], lo[3], hi4[0], hi4[1], hi4[2], hi4[3]}; }
            f32x16 o[2];
#pragma unroll
            for (int tt = 0; tt < 2; ++tt)
#pragma unroll
                for (int r = 0; r < 16; ++r) o[tt][r] = 0.f;
            bf16x8 qa[8], aa[4];
#pragma unroll
            for (int kl = 0; kl < 2; ++kl)
#pragma unroll
                for (int sx = 0; sx < 2; ++sx)
#pragma unroll
                    for (int tt = 0; tt < 2; ++tt) qa[(kl * 2 + sx) * 2 + tt] = *(const LAS bf16x8*)(QDp + (((((2 * kg + kl) * 2 + sx) * 2 + hh) * 64 + 32 * tt + r32) * 16));
#pragma unroll
            for (int ks = 0; ks < 4; ++ks) aa[ks] = *(const LAS bf16x8*)(ATc + (((2 * ks + hh) * 64 + 32 * kg + r32) * 16));
            __builtin_amdgcn_sched_barrier(0);
#pragma unroll
            for (int kl = 0; kl < 2; ++kl)
#pragma unroll
                for (int sx = 0; sx < 2; ++sx) {
                    u32x4 sb;
#pragma unroll
                    for (int g = 0; g < 4; ++g) sb[g] = cvt_pk_bf16(Sacc[kl][8 * sx + 2 * g], Sacc[kl][8 * sx + 2 * g + 1]);
#pragma unroll
                    for (int tt = 0; tt < 2; ++tt) o[tt] = __builtin_amdgcn_mfma_f32_32x32x16_bf16(qa[(kl * 2 + sx) * 2 + tt], __builtin_bit_cast(bf16x8, sb), o[tt], 0, 0, 0);
                }
            if (kg == 0) {
#pragma unroll
                for (int ks = 0; ks < 4; ++ks) o[0] = __builtin_amdgcn_mfma_f32_32x32x16_bf16(aa[ks], vf[ks], o[0], 0, 0, 0);
            } else {
#pragma unroll
                for (int ks = 0; ks < 4; ++ks) o[1] = __builtin_amdgcn_mfma_f32_32x32x16_bf16(aa[ks], vf[ks], o[1], 0, 0, 0);
            }
            __builtin_amdgcn_sched_barrier(0);
            f32x4 dvv[8]; bf16x8 ka[8];
#pragma unroll
            for (int kl = 0; kl < 2; ++kl)
#pragma unroll
                for (int g = 0; g < 4; ++g) dvv[kl * 4 + g] = *(const LAS f32x4*)(DV + 32 * (2 * kg + kl) + 8 * g + 4 * hh);
#pragma unroll
            for (int ks = 0; ks < 4; ++ks)
#pragma unroll
                for (int kl = 0; kl < 2; ++kl) ka[ks * 2 + kl] = *(const LAS bf16x8*)(KDTc + (((2 * ks + hh) * 128 + 32 * (2 * kg + kl) + r32) * 16));
            if (kg == 1) { LAS u32x4* XW = (LAS u32x4*)(lds + XOFF + (n & 1) * 16384 + w4 * 4096) + lane;
#pragma unroll
                for (int i = 0; i < 4; ++i) { const int tt = i >> 1, q = i & 1; u32x4 w;
#pragma unroll
                    for (int g = 0; g < 4; ++g) w[g] = cvt_pk_bf16(o[tt][8 * q + 2 * g], o[tt][8 * q + 2 * g + 1]);
                    XW[i * 64] = w; }
            } else {
#pragma unroll
                for (int tt = 0; tt < 2; ++tt)
#pragma unroll
                    for (int r = 0; r < 16; ++r) op[tt][r] = o[tt][r];
            }
            __builtin_amdgcn_sched_barrier(0);
#pragma unroll
            for (int kl = 0; kl < 2; ++kl)
#pragma unroll
                for (int g = 0; g < 4; ++g)
#pragma unroll
                    for (int e = 0; e < 4; ++e) Sacc[kl][4 * g + e] *= dvv[kl * 4 + g][e];
#pragma unroll
            for (int ks = 0; ks < 4; ++ks)
#pragma unroll
                for (int kl = 0; kl < 2; ++kl) Sacc[kl] = __builtin_amdgcn_mfma_f32_32x32x16_bf16(ka[ks * 2 + kl], vf[ks], Sacc[kl], 0, 0, 0);
        }
        GLA_BAR();
        if (kg == 0) { u32x4* dst = (u32x4*)(OFRAG(b, 63, h)) + (cgi * 4) * 64 + lane;
            const LAS u32x4* XR = (const LAS u32x4*)(lds + XOFF + (63 & 1) * 16384 + w4 * 4096) + lane;
#pragma unroll
            for (int i = 0; i < 4; ++i) { const u32x4 xp = XR[i * 64]; const int tt = i >> 1, q = i & 1; u32x4 w;
#pragma unroll
                for (int g = 0; g < 4; ++g) { const float x0 = __builtin_bit_cast(float, xp[g] << 16), x1 = __builtin_bit_cast(float, xp[g] & 0xffff0000u);
                    w[g] = cvt_pk_bf16(op[tt][8 * q + 2 * g] + x0, op[tt][8 * q + 2 * g + 1] + x1); }
                asm volatile("global_store_dwordx4 %0, %1, off" :: "v"(dst + i * 64), "v"(w) : "memory"); } }
        asm volatile("s_waitcnt vmcnt(0)" ::: "memory");
        GLA_BAR();
        }
#undef GLA_DMA
#undef GLA_DMA1
#undef GLA_WARM
#undef GLA_BAR
    }
    if (IN(11)) {
        static_assert(MK_N_LAUNCHES == 1, "the scan follow-up sits behind an in-phase grid barrier");
        xcd_barrier(bar);
        LAS float* OS = (LAS float*)lds;
        const int r32 = lane & 31, hh = lane >> 5, c0 = 32 * wave;
        u32x4 fr[4], rwv[4];
#define P10C_LOAD(u_) do { const int b_ = (u_) >> 8, n_ = ((u_) >> 2) & 63, h_ = (u_) & 3; const u32x4* src_ = (const u32x4*)(OFRAG(b_, n_, h_)) + (wave * 4) * 64 + lane; \
            _Pragma("unroll") for (int k_ = 0; k_ < 4; ++k_) fr[k_] = src_[k_ * 64]; \
            const bf16* rp0_ = GP + ((size_t)b_ * SEQ + 64 * n_ + (tid >> 3)) * 3072 + 2048 + h_ * 256 + 32 * (tid & 7); \
            _Pragma("unroll") for (int i_ = 0; i_ < 4; ++i_) rwv[i_] = *(const u32x4*)(rp0_ + 8 * i_); } while (0)
        int u = bx;
        if (u < 4096) P10C_LOAD(u);
        for (; u < 4096; u += G) {
            const int b = u >> 8, n = (u >> 2) & 63, h = u & 3; const size_t R0 = (size_t)b * SEQ + 64 * n;
            u32x4 rw_c[4];
#pragma unroll
            for (int i = 0; i < 4; ++i) rw_c[i] = rwv[i];
            __syncthreads();
#pragma unroll
            for (int tt = 0; tt < 2; ++tt)
#pragma unroll
                for (int q = 0; q < 2; ++q)
#pragma unroll
                    for (int g = 0; g < 4; ++g) { const unsigned w = fr[tt * 2 + q][g]; const int r = 8 * q + 2 * g;
                        OS[(32 * tt + att::crow(r, hh)) * 260 + c0 + r32] = __builtin_bit_cast(float, w << 16);
                        OS[(32 * tt + att::crow(r + 1, hh)) * 260 + c0 + r32] = __builtin_bit_cast(float, w & 0xffff0000u); }
            __syncthreads();
            if (u + G < 4096) P10C_LOAD(u + G);
            { const int t = tid >> 3, seg = tid & 7; f32x4 ov[8]; float ss = 0.f;
#pragma unroll
              for (int i = 0; i < 8; ++i) { ov[i] = *(const LAS f32x4*)(OS + t * 260 + 32 * seg + 4 * i); ss += (ov[i][0] * ov[i][0] + ov[i][1] * ov[i][1]) + (ov[i][2] * ov[i][2] + ov[i][3] * ov[i][3]); }
              ss += __shfl_xor(ss, 1); ss += __shfl_xor(ss, 2); ss += __shfl_xor(ss, 4);
              const float rs = __builtin_amdgcn_rsqf(ss * (1.0f / 256.0f) + EPS);
              bf16* op = HB + (R0 + t) * D + h * 256 + 32 * seg;
#pragma unroll
              for (int i = 0; i < 4; ++i) { const u32x4 rw = rw_c[i]; u32x4 w;
#pragma unroll
                  for (int e = 0; e < 4; ++e) { const float r0 = __builtin_bit_cast(float, rw[e] << 16), r1 = __builtin_bit_cast(float, rw[e] & 0xffff0000u);
                      const int cidx = 8 * i + 2 * e;
                      const float v0 = ov[(cidx) >> 2][(cidx) & 3] * rs * r0, v1 = ov[(cidx + 1) >> 2][(cidx + 1) & 3] * rs * r1;
                      w[e] = pk2(v0, v1); }
                  *(u32x4*)(op + 8 * i) = w; } }
        }
#undef P10C_LOAD
    }
    SEAM(11);


    if (IN(12)) {
        pg8::DenseSched S; S.init(M / 256, 4, G, bx); S.A = (const char*)HB; S.Bt = (const char*)W_GLAOUT; S.tstep = (size_t)256 * D * 2;
        pg8::EpiResid<true, true> E{XB, XB, MOD1 + 2048, 1.0f};
        pg8::gemm_phase<pg8::EpiResid<true, true>, pg8::DenseSched, true, false>(lds, 2 * D, S, E);
    }
    SEAM(12);

    if (IN(13)) {
        LAS float* RW = (LAS float*)lds;
        LAS unsigned* EL = (LAS unsigned*)(lds + 32768);
        LAS float* GL = (LAS float*)(lds + 32768 + 4096);
        for (int e = tid; e < 8192; e += 512) { const int k = e >> 3, ex = e & 7;
            RW[((((k >> 8) * 4 + (k & 3)) * 2 + (ex >> 2)) * 64 + ((k & 255) >> 2)) * 4 + (ex & 3)] = args.moe_router[e]; }
        __syncthreads();
#undef ROUTER_BODY
#define ROUTER_BODY { float lg[8]; \
            _Pragma("unroll") for (int e = 0; e < 8; ++e) lg[e] = 0.f; \
            _Pragma("unroll") for (int j = 0; j < 4; ++j) _Pragma("unroll") for (int i = 0; i < 4; ++i) { const f32x4 w0 = *((const LAS f32x4*)RW + ((j * 4 + i) * 2) * 64 + lane), w1 = *((const LAS f32x4*)RW + ((j * 4 + i) * 2 + 1) * 64 + lane); const float hv = v[j][i]; \
                lg[0] += hv * w0[0]; lg[1] += hv * w0[1]; lg[2] += hv * w0[2]; lg[3] += hv * w0[3]; lg[4] += hv * w1[0]; lg[5] += hv * w1[1]; lg[6] += hv * w1[2]; lg[7] += hv * w1[3]; } \
            _Pragma("unroll") for (int e = 0; e < 8; ++e) lg[e] = wave_sum(lg[e]); \
            float v1 = lg[0]; \
            _Pragma("unroll") for (int e = 1; e < 8; ++e) v1 = fmaxf(v1, lg[e]); \
            int e1 = 7; \
            _Pragma("unroll") for (int e = 6; e >= 0; --e) e1 = (lg[e] == v1) ? e : e1; \
            float v2 = -3.0e38f; \
            _Pragma("unroll") for (int e = 0; e < 8; ++e) v2 = fmaxf(v2, (e == e1) ? -3.0e38f : lg[e]); \
            int e2 = -1; \
            _Pragma("unroll") for (int e = 7; e >= 0; --e) e2 = (e != e1 && lg[e] == v2) ? e : e2; \
            if (lane == 0) { EL[m - wg_row0] = (unsigned)e1 | ((unsigned)e2 << 8); GL[m - wg_row0] = v1 - v2; } }
        const int rpw12 = (M + NGW - 1) / NGW, rows_wg12 = rpw12 * NWAVES, wg_row0 = bx * rows_wg12;
        NORM_PHASE(XB, true, args.norm2_g + D, MOD1 + 3072, 1, MOE_UP8);
        __syncthreads();
        {
            int nrows = M - wg_row0; nrows = nrows > rows_wg12 ? rows_wg12 : nrows;
            for (int r = tid; r < nrows; r += 512) { const unsigned ew = EL[r]; const unsigned e1 = ew & 255u, e2 = ew >> 8; unsigned l1 = 0, l2 = 0;
                for (int q = 0; q < r; ++q) { const unsigned w = EL[q]; l1 += ((w & 255u) == e1) ? 1u : 0u; l2 += ((w >> 8) == e2) ? 1u : 0u; }
                ROUTE[wg_row0 + r] = (u32x4){ew, __builtin_bit_cast(unsigned, GL[r]), l1, l2}; }
            if (tid < 16) { const unsigned e = tid & 7; unsigned cnt = 0; for (int q = 0; q < nrows; ++q) { const unsigned w = EL[q]; cnt += ((tid < 8 ? (w & 255u) : (w >> 8)) == e) ? 1u : 0u; } LCNT[bx * 16 + tid] = cnt; }
        }
    }
    SEAM(13);

    if (IN(14)) {
        LAS int* PRE = (LAS int*)lds;
        LAS int* GOFF = (LAS int*)(lds + 256);
        {
            LAS int* CNT = (LAS int*)(lds + 1024);
            LAS int* PART = (LAS int*)(lds + 1024 + 65536);
            for (int i = tid; i < G * 16; i += 512) CNT[i] = (int)LCNT[i];
            __syncthreads();
            { const int c = tid & 15, grp = tid >> 4; int pre = 0, tot = 0;
              for (int w = grp; w < G; w += 32) { const int v = CNT[w * 16 + c]; tot += v; pre += (w < bx) ? v : 0; }
              PART[(grp * 2) * 16 + c] = pre; PART[(grp * 2 + 1) * 16 + c] = tot; }
            __syncthreads();
            if (tid < 16) { int pre = 0, tot = 0; for (int g = 0; g < 32; ++g) { pre += PART[(g * 2) * 16 + tid]; tot += PART[(g * 2 + 1) * 16 + tid]; } PRE[tid] = pre; ((LAS int*)(lds + 512))[tid] = (tot + 255) & ~255; }
        }
        __syncthreads();
        if (tid < 2) { int acc = 0; for (int e = 0; e < 8; ++e) { GOFF[tid * 9 + e] = acc; acc += ((LAS int*)(lds + 512))[tid * 8 + e]; } GOFF[tid * 9 + 8] = acc;
            if (bx == 0) { for (int e = 0; e < 9; ++e) META[tid * 16 + e] = GOFF[tid * 9 + e]; } }
        __syncthreads();
        const int rpw = (M + NGW - 1) / NGW, rows_wg = rpw * NWAVES;
        for (int r = tid; r < rows_wg; r += 512) { const int m = bx * rows_wg + r; if (m >= M) break;
            const u32x4 rt = ROUTE[m]; const int e1 = rt[0] & 255, e2 = (rt[0] >> 8) & 255; const unsigned gbits = rt[1]; const float gap = __builtin_bit_cast(float, gbits); const float g1 = 1.0f / (1.0f + expf(-gap));
            const int s1 = GOFF[e1] + PRE[e1] + (int)rt[2], s2 = GOFF[9 + e2] + PRE[8 + e2] + (int)rt[3];
            TOKSLOT[s1] = m; GSLOT[s1] = g1; TOKSLOT[MAXSLOT + s2] = m; GSLOT[MAXSLOT + s2] = 1.0f - g1; }
    }
    SEAM(14);

#define MOE_SCHED(S, p) do { const int* mt = META + (p) * 16; S.g1 = mt[1]; S.g2 = mt[2]; S.g3 = mt[3]; S.g4 = mt[4]; S.g5 = mt[5]; S.g6 = mt[6]; S.g7 = mt[7]; } while (0)
#pragma unroll
    for (int p = 0; p < 2; ++p) {
        if (IN(15 + 2 * p)) {
            pg8::MoeSched S; MOE_SCHED(S, p); const int nP = META[p * 16 + 8] >> 8;
            S.init(nP, 2 * EXPD / 256, G, bx); S.A = (const char*)HB; S.a_tstep = 0; S.Bt = (const char*)W_MOE13; S.b_tstep = (size_t)256 * D * (MOE_UP8 ? 1 : 2); S.b_estride = (size_t)2 * EXPD * D * (MOE_UP8 ? 1 : 2);
            S.tokslot = TOKSLOT + p * MAXSLOT; S.rowbytes = D * (MOE_UP8 ? 1 : 2);
            pg8::EpiSwiGLU<MOE_DN8> E{ACTB, EXPD, MOE_UP8 ? 1.0f / (H8_SCALE * W8_SCALE) : 1.0f};
            pg8::gemm_phase<pg8::EpiSwiGLU<MOE_DN8>, pg8::MoeSched, true, true, MOE_UP8>(lds, D * (MOE_UP8 ? 1 : 2), S, E);
        }
        SEAM(15 + 2 * p);
        if (IN(16 + 2 * p)) {
            pg8::MoeSched S; MOE_SCHED(S, p); const int nP = META[p * 16 + 8] >> 8;
            constexpr int RBD = EXPD * (MOE_DN8 ? 1 : 2), NTD = RBD / 128;
            int nPm = nP, jpart = -1; const int qpart = bx & 7;
            { const int nwg = nP * 4, nfull = nwg / G, nrem = nwg - nfull * G; if (nrem > 0 && 8 * nrem <= G && (nfull * G) % 4 == 0 && NTD >= 16) { nPm = nfull * G / 4; if (bx < 8 * nrem) jpart = bx >> 3; } }
            S.init(nPm, 4, G, bx); S.A = (const char*)ACTB; S.a_tstep = (size_t)256 * RBD; S.Bt = (const char*)W_MOE2; S.b_tstep = (size_t)256 * RBD; S.b_estride = (size_t)D * RBD;
            S.tokslot = TOKSLOT + p * MAXSLOT; S.rowbytes = 0;
#define MOE_DOWN(FINAL_) do { pg8::EpiMoeDown<FINAL_> E{TOKSLOT + p * MAXSLOT, GSLOT + p * MAXSLOT, XB, out, MOD1 + 5 * 1024, MOE_DN8 ? 1.0f / (A8_SCALE * W8_SCALE) : 1.0f}; \
                if (nPm > 0) pg8::gemm_phase<pg8::EpiMoeDown<FINAL_>, pg8::MoeSched, true, false, MOE_DN8>(lds, RBD, S, E); \
                if (jpart >= 0) {       \
                    const int gsz = nP - nPm; pg8::Unit u; u.pm = nPm + jpart % gsz; u.pn = jpart / gsz; \
                    { pg8::MoeSchedTail T; MOE_SCHED(T, p); T.init(nP, 4, G, bx); T.A = S.A; T.a_tstep = S.a_tstep; T.Bt = S.Bt; T.b_tstep = S.b_tstep; T.b_estride = S.b_estride; T.tokslot = S.tokslot; T.rowbytes = 0; \
                      constexpr int P = NTD / 2, base = P / 8, extra = P % 8; T.pmT = u.pm; T.pnT = u.pn; T.k0T = 2 * (qpart * base + (qpart < extra ? qpart : extra)); T.nkT = 2 * (base + (qpart < extra ? 1 : 0)); \
                      pg8::EpiPartStore EP{KPART + (size_t)bx * (32 * 512 * 4)}; \
                      pg8::gemm_phase<pg8::EpiPartStore, pg8::MoeSchedTail, true, false, MOE_DN8, true>(lds, RBD, T, EP); } \
                    unsigned* kc = ctl + CW_KCNT + p * 64 + jpart; \
                    asm volatile("s_waitcnt vmcnt(0)" ::: "memory"); __syncthreads(); \
                    if (tid == 0) { __builtin_amdgcn_fence(__ATOMIC_RELEASE, "agent"); asm volatile("s_waitcnt vmcnt(0)" ::: "memory"); (void)xb_add(kc, 1u); \
                        XB_SPIN(xb_ld(kc) < 8u, ctl + CW_BAR); __builtin_amdgcn_fence(__ATOMIC_ACQUIRE, "agent"); asm volatile("s_waitcnt vmcnt(0)" ::: "memory"); } \
                    __syncthreads(); \
                    const int ai = qpart >> 2, m = qpart & 3; \
                    f32x4 v[2][2]; \
                    _Pragma("unroll") for (int bj = 0; bj < 2; ++bj) _Pragma("unroll") for (int n = 0; n < 2; ++n) { f32x4 a = (f32x4){0.f, 0.f, 0.f, 0.f}; \
                        const f32x4* pp = (const f32x4*)(KPART + (size_t)(jpart * 8) * (32 * 512 * 4)) + (size_t)((((ai * 2 + bj) * 4 + m) * 2 + n) * 512 + tid); \
                        _Pragma("unroll") for (int qq = 0; qq < 8; ++qq) a += pp[(size_t)qq * (32 * 512)]; \
                        v[bj][n] = a; } \
                    E.slice(v, u, ai, m, wave >> 2, wave & 3, lane & 15, lane >> 4); } } while (0)
            if (p == 0) MOE_DOWN(false); else MOE_DOWN(true);
#undef MOE_DOWN
        }
        if (p == 0) SEAM(16);
    }
#undef IN
#undef SEAM
}


constexpr int N_PHASES = 19;
extern "C" void kernel_launch(void* const* d_in, const int* in_sizes, int n_in, void* d_out, int out_size, void* d_ws, size_t ws_size, hipStream_t stream) {
    static int grid = 0;
    if (grid == 0) {
        if (n_in != 28 || in_sizes[0] != M * D || out_size != M * D || ws_size < WS_TOTAL) { fprintf(stderr, "kernel_launch: unexpected problem shape (n_in %d, out %d, ws %zu)\n", n_in, out_size, ws_size); grid = -1; return; }
        int dev = 0, cus = 0, per_cu = 0;
        if (hipGetDevice(&dev) != hipSuccess || hipDeviceGetAttribute(&cus, hipDeviceAttributeMultiprocessorCount, dev) != hipSuccess) { grid = -1; return; }
        if (hipFuncSetAttribute((const void*)mk_fwd, hipFuncAttributeMaxDynamicSharedMemorySize, LDS_BYTES) != hipSuccess) { fprintf(stderr, "kernel_launch: hipFuncSetAttribute failed\n"); grid = -1; return; }
        if (hipOccupancyMaxActiveBlocksPerMultiprocessor(&per_cu, (const void*)mk_fwd, NWAVES * 64, LDS_BYTES) != hipSuccess || per_cu < 1) { fprintf(stderr, "kernel_launch: occupancy query reports %d\n", per_cu); }
        (void)hipGetLastError();
        grid = cus;
        if (grid < 192) { fprintf(stderr, "kernel_launch: built for a >= 192-CU device (128 GLA scan workgroups + weight-copy workgroups); got %d\n", grid); grid = -1; return; }
    }
    if (grid < 0) return;
    if (hipMemsetAsync((char*)d_ws + WS_CTL, 0, CTL_ZERO_BYTES, stream) != hipSuccess) return;
    Args a{};
    const float** ap = (const float**)&a;
    for (int i = 0; i < 28; ++i) ap[i] = (const float*)d_in[i];
    a.out = (float*)d_out; a.ws = (unsigned char*)d_ws;
    if (MK_N_LAUNCHES == 1) { a.ph_lo = 0; a.ph_hi = N_PHASES; hipLaunchKernelGGL(mk_fwd, dim3(grid), dim3(NWAVES * 64), LDS_BYTES, stream, a); }
    else { for (int p = 0; p < N_PHASES; ++p) { a.ph_lo = p; a.ph_hi = p + 1; hipLaunchKernelGGL(mk_fwd, dim3(grid), dim3(NWAVES * 64), LDS_BYTES, stream, a); } }
}
```
